# Optimizing an MI355X kernel written in HIP

```python
import jax
import jax.numpy as jnp
from jax import lax
import numpy as np

D_MODEL = 1024
BATCH = 4
SEQ = 8192
DEPTH = 2

GRID_W = 64
CTX_LEN = 256
NORM_EPS = 1e-6
LRU_WIDTH = 512
LRU_BLOCKS = 8
LRU_BLOCK = LRU_WIDTH // LRU_BLOCKS
LRU_C = 8.0
CONV_W = 4
N_Q_HEADS = 8
N_KV_HEADS = 2
HEAD_DIM = 64
Q_GROUP = N_Q_HEADS // N_KV_HEADS
Q_BLOCK = 128
ROPE_BASE = 10000.0
ATTN_SCALE = HEAD_DIM ** -0.5
IN_WIDTH = 2 * LRU_WIDTH + (N_Q_HEADS + 2 * N_KV_HEADS) * HEAD_DIM
MIX_WIDTH = LRU_WIDTH + N_Q_HEADS * HEAD_DIM
RWKV_HEAD = 64
RWKV_HEADS = D_MODEL // RWKV_HEAD
DECAY_LORA = 64
AAA_LORA = 64
GATE_LORA = 160
GN_EPS = 64e-5
N_EXPERTS = 16
EXPERT_FF = 2048
CAPACITY_FACTOR = 2

kernel_name = 'hybrid_rglru_gqa_rwkv7_ecmoe_dit'


def rms_norm(x, gain):
    xf = x.astype(jnp.float32)
    y = xf * lax.rsqrt(jnp.mean(xf * xf, axis=-1, keepdims=True) + NORM_EPS)
    return (y * gain.astype(jnp.float32)).astype(x.dtype)


def ada_params(cond, w_mod, b_mod):
    m = jax.nn.silu(cond) @ w_mod + b_mod
    return jnp.split(m[:, None, :], 6, axis=-1)


def axial_rope(n_tokens):
    n_rows = n_tokens // GRID_W
    row = jnp.repeat(jnp.arange(n_rows, dtype=jnp.float32), GRID_W)
    col = jnp.tile(jnp.arange(GRID_W, dtype=jnp.float32), n_rows)
    axis_dim = HEAD_DIM // 2
    inv_freq = ROPE_BASE ** (-jnp.arange(0, axis_dim, 2, dtype=jnp.float32) / axis_dim)
    ang = jnp.concatenate([row[:, None] * inv_freq, col[:, None] * inv_freq], axis=-1)
    return jnp.cos(ang), jnp.sin(ang)


def apply_rope(x, cos, sin):
    xf = x.astype(jnp.float32)
    x1, x2 = xf[..., 0::2], xf[..., 1::2]
    c = cos[None, :, None, :]
    s = sin[None, :, None, :]
    out = jnp.stack([x1 * c - x2 * s, x1 * s + x2 * c], axis=-1).reshape(x.shape)
    return out.astype(x.dtype)


def attend(q, k, v):
    s = jnp.einsum('bhgqd,bkhd->bhgqk', q, k).astype(jnp.float32) * ATTN_SCALE
    p = jax.nn.softmax(s, axis=-1).astype(v.dtype)
    return jnp.einsum('bhgqk,bkhd->bhgqd', p, v)


def centred_depthwise_conv(x, w, b):
    left = CONV_W // 2
    y = lax.conv_general_dilated(x, w[:, None, :].astype(x.dtype), window_strides=(1,),
                                 padding=[(left, CONV_W - 1 - left)],
                                 dimension_numbers=('NWC', 'WIO', 'NWC'),
                                 feature_group_count=x.shape[-1])
    return y + b


def rglru_coeffs(xc, w_i, b_i, w_r, b_r, lam):
    B, T, _ = xc.shape
    f32 = jnp.float32
    xf = xc.astype(f32)
    xb = xf.reshape(B, T, LRU_BLOCKS, LRU_BLOCK)
    i_gate = jax.nn.sigmoid(jnp.einsum('btnd,nde->btne', xb, w_i.astype(f32)).reshape(B, T, LRU_WIDTH) + b_i)
    r_gate = jax.nn.sigmoid(jnp.einsum('btnd,nde->btne', xb, w_r.astype(f32)).reshape(B, T, LRU_WIDTH) + b_r)
    log_a = LRU_C * r_gate * jax.nn.log_sigmoid(lam.astype(f32))
    a = jnp.exp(log_a)
    b = jnp.sqrt(-jnp.expm1(2.0 * log_a)) * (i_gate * xf)
    return a, b


def linear_scan(a, b, h0, reverse):
    i0 = -1 if reverse else 0
    b = b.at[:, i0].add(a[:, i0] * h0)

    def combine(left, right):
        a1, b1 = left
        a2, b2 = right
        return a1 * a2, a2 * b1 + b2

    _, h = lax.associative_scan(combine, (a, b), reverse=reverse, axis=1)
    return h


def mixer_rglru_gqa(h_lat, h_ctx, w_in, conv_w, conv_b, lru_wi, lru_bi, lru_wr, lru_br, lru_lam,
                    q_gain, k_gain, w_out, ctx_out=True):
    f32 = jnp.float32
    cuts = np.cumsum([LRU_WIDTH, LRU_WIDTH, N_Q_HEADS * HEAD_DIM, N_KV_HEADS * HEAD_DIM]).tolist()

    def project(h):
        B, T, _ = h.shape
        xa, ga, q, k, v = jnp.split(h @ w_in, cuts, axis=-1)
        q = rms_norm(q.reshape(B, T, N_Q_HEADS, HEAD_DIM), q_gain)
        k = rms_norm(k.reshape(B, T, N_KV_HEADS, HEAD_DIM), k_gain)
        v = v.reshape(B, T, N_KV_HEADS, HEAD_DIM)
        return centred_depthwise_conv(xa, conv_w, conv_b), ga, q, k, v

    xc_c, ga_c, q_c, k_c, v_c = project(h_ctx)
    xc_l, ga_l, q_l, k_l, v_l = project(h_lat)
    B, T, _ = h_lat.shape
    cos, sin = axial_rope(T)
    q_l = apply_rope(q_l, cos, sin)
    k_l = apply_rope(k_l, cos, sin)

    rec_l = jnp.zeros(xc_l.shape, f32)
    rec_c = jnp.zeros(xc_c.shape, f32)
    for d, reverse in enumerate((False, True)):
        a_c, b_c = rglru_coeffs(xc_c, lru_wi[d], lru_bi[d], lru_wr[d], lru_br[d], lru_lam[d])
        hs_c = linear_scan(a_c, b_c, jnp.zeros((B, LRU_WIDTH), f32), reverse)
        h_last = hs_c[:, 0] if reverse else hs_c[:, -1]
        a_l, b_l = rglru_coeffs(xc_l, lru_wi[d], lru_bi[d], lru_wr[d], lru_br[d], lru_lam[d])
        rec_l = rec_l + linear_scan(a_l, b_l, h_last, reverse)
        if ctx_out:
            rec_c = rec_c + hs_c
    y_a_l = rec_l.astype(h_lat.dtype) * jax.nn.gelu(ga_l)

    k_all = jnp.concatenate([k_l, k_c], axis=1)
    v_all = jnp.concatenate([v_l, v_c], axis=1)
    n_blocks = T // Q_BLOCK
    qb = q_l.reshape(B, n_blocks, Q_BLOCK, N_KV_HEADS, Q_GROUP, HEAD_DIM).transpose(1, 0, 3, 4, 2, 5)
    o = lax.map(lambda blk: attend(blk, k_all, v_all), qb)
    y_b_l = o.transpose(1, 0, 4, 2, 3, 5).reshape(B, T, N_Q_HEADS * HEAD_DIM)
    y_lat = jnp.concatenate([y_a_l, y_b_l], axis=-1) @ w_out
    if not ctx_out:
        return y_lat, None

    Lc = h_ctx.shape[1]
    qc = q_c.reshape(B, Lc, N_KV_HEADS, Q_GROUP, HEAD_DIM).transpose(0, 2, 3, 1, 4)
    y_b_c = attend(qc, k_c, v_c).transpose(0, 3, 1, 2, 4).reshape(B, Lc, N_Q_HEADS * HEAD_DIM)
    y_a_c = rec_c.astype(h_ctx.dtype) * jax.nn.gelu(ga_c)
    y_ctx = jnp.concatenate([y_a_c, y_b_c], axis=-1) @ w_out
    return y_lat, y_ctx


def centred_shift_delta(h):
    hp = jnp.pad(h, ((0, 0), (1, 1), (0, 0)))
    return 0.5 * (hp[:, :-2] + hp[:, 2:]) - h


def wkv_scan(S0, seqs, reverse, emit):
    xs = tuple(jnp.swapaxes(t, 0, 1) for t in seqs)

    def step(S, inp):
        r, w, k, v, a, b = inp
        sa = jnp.einsum('bhvk,bhk->bhv', S, a)
        S = S * w[:, :, None, :] + sa[..., None] * b[:, :, None, :] + v[..., None] * k[:, :, None, :]
        y = jnp.einsum('bhvk,bhk->bhv', S, r) if emit else None
        return S, y

    S, ys = lax.scan(step, S0, xs, reverse=reverse)
    return S, (jnp.swapaxes(ys, 0, 1) if emit else None)


def mixer_rwkv7(h_lat, h_ctx, mu, w_r, w_k, w_v, w0, w1, w2, a0, a1, a2, g1, g2, k_k, k_a, r_k,
                gn_g, gn_b, w_o, ctx_out=True):
    f32 = jnp.float32
    kk_scale = k_k.astype(f32).reshape(RWKV_HEADS, RWKV_HEAD)
    ka = k_a.astype(f32).reshape(RWKV_HEADS, RWKV_HEAD)
    rk = r_k.astype(f32)

    def prepare(h):
        B, T, _ = h.shape
        xx = centred_shift_delta(h)
        xr, xw, xk, xv, xa, xg = [h + xx * mu[j] for j in range(6)]
        heads = lambda t: t.astype(f32).reshape(B, T, RWKV_HEADS, RWKV_HEAD)
        r = heads(xr @ w_r)
        k = heads(xk @ w_k)
        v = heads(xv @ w_v)
        g = jax.nn.sigmoid(xg @ g1) @ g2
        kk = k * kk_scale
        kk = kk * lax.rsqrt(jnp.maximum(jnp.sum(kk * kk, axis=-1, keepdims=True), 1e-24))
        per_dir = []
        for d in range(2):
            w_pre = (w0[d] + jnp.tanh(xw @ w1[d]) @ w2[d]).astype(f32)
            decay = heads(jnp.exp(-jnp.exp(-jax.nn.softplus(-w_pre) - 0.5)))
            a = heads(jax.nn.sigmoid(a0[d] + (xa @ a1[d]) @ a2[d]))
            per_dir.append((decay, k * (1.0 + (a - 1.0) * ka), -kk, kk * a))
        return r, v, g, per_dir

    def read_out(y, bonus, g):
        B, T = y.shape[:2]
        mean = jnp.mean(y, axis=-1, keepdims=True)
        var = jnp.mean(jnp.square(y - mean), axis=-1, keepdims=True)
        yn = ((y - mean) * lax.rsqrt(var + GN_EPS)).reshape(B, T, D_MODEL) * gn_g + gn_b
        out = (yn + bonus.reshape(B, T, D_MODEL)) * g
        return out.astype(g.dtype) @ w_o

    r_c, v_c, g_c, dirs_c = prepare(h_ctx)
    r_l, v_l, g_l, dirs_l = prepare(h_lat)
    B = h_lat.shape[0]
    S_zero = jnp.zeros((B, RWKV_HEADS, RWKV_HEAD, RWKV_HEAD), f32)
    y_l = jnp.zeros_like(v_l)
    bonus_l = jnp.zeros_like(v_l)
    y_c = jnp.zeros_like(v_c)
    bonus_c = jnp.zeros_like(v_c)
    for d, reverse in enumerate((False, True)):
        dec_c, kd_c, ia_c, ib_c = dirs_c[d]
        S_c, ys_c = wkv_scan(S_zero, (r_c, dec_c, kd_c, v_c, ia_c, ib_c), reverse, ctx_out)
        dec_l, kd_l, ia_l, ib_l = dirs_l[d]
        _, ys_l = wkv_scan(S_c, (r_l, dec_l, kd_l, v_l, ia_l, ib_l), reverse, True)
        y_l = y_l + ys_l
        bonus_l = bonus_l + jnp.sum(r_l * kd_l * rk, axis=-1, keepdims=True) * v_l
        if ctx_out:
            y_c = y_c + ys_c
            bonus_c = bonus_c + jnp.sum(r_c * kd_c * rk, axis=-1, keepdims=True) * v_c
    y_lat = read_out(y_l, bonus_l, g_l)
    if not ctx_out:
        return y_lat, None
    return y_lat, read_out(y_c, bonus_c, g_c)


def expert_choice_ffn(h, w_router, we_gate, we_up, we_down):
    N = h.shape[1]
    cap = max(1, CAPACITY_FACTOR * N // N_EXPERTS)

    def route(hs):
        aff = jax.nn.softmax((hs @ w_router).astype(jnp.float32), axis=-1)
        gate, idx = lax.top_k(aff.T, cap)
        xe = hs[idx]
        hid = jax.nn.silu(jnp.einsum('ecd,edf->ecf', xe, we_gate)) * jnp.einsum('ecd,edf->ecf', xe, we_up)
        ye = jnp.einsum('ecf,efd->ecd', hid, we_down) * gate[..., None].astype(hs.dtype)
        return jnp.zeros_like(hs).at[idx.reshape(-1)].add(ye.reshape(-1, hs.shape[-1]))

    return lax.map(route, h)


def setup_inputs(seed: int = 0) -> dict:
    key = jax.random.key(seed)
    keys = iter(jax.random.split(key, 64))
    f32 = jnp.float32
    D = D_MODEL

    def nrm(shape, scale):
        return jax.random.normal(next(keys), shape, f32) * scale

    def gain(shape):
        return 1.0 + nrm(shape, 0.01)

    inp = {}
    inp['x'] = nrm((BATCH, SEQ, D), 1.0)
    inp['c'] = nrm((BATCH, D), 1.0)
    inp['ctx'] = nrm((BATCH, CTX_LEN, D), 1.0)
    inp['c_ctx'] = nrm((D,), 1.0)

    def common(p):
        inp[p + 'w_mod'] = nrm((D, 6 * D), 0.5 * D ** -0.5)
        inp[p + 'b_mod'] = nrm((6 * D,), 0.01)
        inp[p + 'norm_mix'] = gain((D,))
        inp[p + 'norm_ffn'] = gain((D,))

    def moe(p):
        inp[p + 'router'] = nrm((D, N_EXPERTS), D ** -0.5)
        inp[p + 'we_gate'] = nrm((N_EXPERTS, D, EXPERT_FF), D ** -0.5)
        inp[p + 'we_up'] = nrm((N_EXPERTS, D, EXPERT_FF), D ** -0.5)
        inp[p + 'we_down'] = nrm((N_EXPERTS, EXPERT_FF, D), EXPERT_FF ** -0.5)

    common('l0_')
    inp['l0_w_in'] = nrm((D, IN_WIDTH), D ** -0.5)
    inp['l0_conv_w'] = nrm((CONV_W, LRU_WIDTH), CONV_W ** -0.5)
    inp['l0_conv_b'] = nrm((LRU_WIDTH,), 0.01)
    inp['l0_lru_wi'] = nrm((2, LRU_BLOCKS, LRU_BLOCK, LRU_BLOCK), LRU_BLOCK ** -0.5)
    inp['l0_lru_bi'] = nrm((2, LRU_WIDTH), 0.01)
    inp['l0_lru_wr'] = nrm((2, LRU_BLOCKS, LRU_BLOCK, LRU_BLOCK), LRU_BLOCK ** -0.5)
    inp['l0_lru_br'] = nrm((2, LRU_WIDTH), 0.01)
    a_c = jax.random.uniform(next(keys), (2, LRU_WIDTH), f32, 0.9, 0.999)
    sig = a_c ** (1.0 / LRU_C)
    inp['l0_lru_lam'] = jnp.log(sig) - jnp.log1p(-sig)
    inp['l0_q_gain'] = gain((HEAD_DIM,))
    inp['l0_k_gain'] = gain((HEAD_DIM,))
    inp['l0_w_out'] = nrm((MIX_WIDTH, D), MIX_WIDTH ** -0.5)
    moe('l0_')

    common('l1_')
    inp['l1_mu'] = jax.random.uniform(next(keys), (6, D), f32)
    inp['l1_w_r'] = nrm((D, D), D ** -0.5)
    inp['l1_w_k'] = nrm((D, D), D ** -0.5)
    inp['l1_w_v'] = nrm((D, D), D ** -0.5)
    inp['l1_w0'] = jax.random.uniform(next(keys), (2, D), f32, -6.0, -1.0)
    inp['l1_w1'] = nrm((2, D, DECAY_LORA), D ** -0.5)
    inp['l1_w2'] = nrm((2, DECAY_LORA, D), 0.1 * DECAY_LORA ** -0.5)
    inp['l1_a0'] = nrm((2, D), 0.1)
    inp['l1_a1'] = nrm((2, D, AAA_LORA), D ** -0.5)
    inp['l1_a2'] = nrm((2, AAA_LORA, D), 0.1 * AAA_LORA ** -0.5)
    inp['l1_g1'] = nrm((D, GATE_LORA), D ** -0.5)
    inp['l1_g2'] = nrm((GATE_LORA, D), GATE_LORA ** -0.5)
    inp['l1_k_k'] = 1.0 + nrm((D,), 0.1)
    inp['l1_k_a'] = 1.0 + nrm((D,), 0.1)
    inp['l1_r_k'] = nrm((RWKV_HEADS, RWKV_HEAD), 0.1)
    inp['l1_gn_g'] = gain((D,))
    inp['l1_gn_b'] = nrm((D,), 0.01)
    inp['l1_w_o'] = nrm((D, D), D ** -0.5)
    moe('l1_')
    return inp


def reference(x, c, ctx, c_ctx,
              l0_w_mod, l0_b_mod, l0_norm_mix, l0_norm_ffn, l0_w_in, l0_conv_w, l0_conv_b,
              l0_lru_wi, l0_lru_bi, l0_lru_wr, l0_lru_br, l0_lru_lam, l0_q_gain, l0_k_gain, l0_w_out,
              l0_router, l0_we_gate, l0_we_up, l0_we_down,
              l1_w_mod, l1_b_mod, l1_norm_mix, l1_norm_ffn, l1_mu, l1_w_r, l1_w_k, l1_w_v,
              l1_w0, l1_w1, l1_w2, l1_a0, l1_a1, l1_a2, l1_g1, l1_g2, l1_k_k, l1_k_a, l1_r_k,
              l1_gn_g, l1_gn_b, l1_w_o, l1_router, l1_we_gate, l1_we_up, l1_we_down):
    layers = [
        ((l0_w_mod, l0_b_mod, l0_norm_mix, l0_norm_ffn),
         (l0_w_in, l0_conv_w, l0_conv_b, l0_lru_wi, l0_lru_bi, l0_lru_wr, l0_lru_br, l0_lru_lam,
          l0_q_gain, l0_k_gain, l0_w_out),
         (l0_router, l0_we_gate, l0_we_up, l0_we_down)),
        ((l1_w_mod, l1_b_mod, l1_norm_mix, l1_norm_ffn),
         (l1_mu, l1_w_r, l1_w_k, l1_w_v, l1_w0, l1_w1, l1_w2, l1_a0, l1_a1, l1_a2, l1_g1, l1_g2,
          l1_k_k, l1_k_a, l1_r_k, l1_gn_g, l1_gn_b, l1_w_o),
         (l1_router, l1_we_gate, l1_we_up, l1_we_down)),
    ]
    for i in range(DEPTH):
        (w_mod, b_mod, norm_mix, norm_ffn), mix_params, moe_params = layers[i]
        last = i == DEPTH - 1
        sh1, sc1, gt1, sh2, sc2, gt2 = ada_params(c, w_mod, b_mod)
        csh1, csc1, cgt1, csh2, csc2, cgt2 = ada_params(c_ctx[None], w_mod, b_mod)
        h_lat = rms_norm(x, norm_mix) * (1.0 + sc1) + sh1
        h_ctx = rms_norm(ctx, norm_mix) * (1.0 + csc1) + csh1
        mixer = mixer_rglru_gqa if i % 2 == 0 else mixer_rwkv7
        y_lat, y_ctx = mixer(h_lat, h_ctx, *mix_params, ctx_out=not last)
        x = x + gt1 * y_lat
        x = x + gt2 * expert_choice_ffn(rms_norm(x, norm_ffn) * (1.0 + sc2) + sh2, *moe_params)
        if not last:
            ctx = ctx + cgt1 * y_ctx
            ctx = ctx + cgt2 * expert_choice_ffn(rms_norm(ctx, norm_ffn) * (1.0 + csc2) + csh2, *moe_params)
    return x
```

```cpp
#include <hip/hip_runtime.h>
#include <cstdio>
#include <cstdint>

#define GAS __attribute__((address_space(1)))
#define LAS __attribute__((address_space(3)))
typedef unsigned short bf16_t;
typedef short bf16x8 __attribute__((ext_vector_type(8)));
typedef short s16x4 __attribute__((ext_vector_type(4)));
typedef float f32x16 __attribute__((ext_vector_type(16)));
typedef float f32x4 __attribute__((ext_vector_type(4)));
typedef float f32x2 __attribute__((ext_vector_type(2)));
typedef unsigned u32x4 __attribute__((ext_vector_type(4)));
typedef unsigned u32x2 __attribute__((ext_vector_type(2)));

constexpr int NB = 4, SEQ = 8192, CTXL = 256, DM = 1024;
constexpr int TL = NB * SEQ, TC = NB * CTXL, TT = TL + TC;
constexpr int KVL = SEQ + CTXL;
constexpr int NE = 16, FF = 2048, CAPL = 1024, CAPC = 32;
constexpr int XE_CTX0 = NB * NE * CAPL;
constexpr int XE_ROWS = XE_CTX0 + NE * 256;

__device__ __forceinline__ unsigned cvt_pk_bf16(float lo, float hi) { unsigned r; asm volatile("v_cvt_pk_bf16_f32 %0, %1, %2" : "=v"(r) : "v"(lo), "v"(hi)); return r; }
__device__ __forceinline__ float bflo(unsigned w) { return __uint_as_float(w << 16); }
__device__ __forceinline__ float bfhi(unsigned w) { return __uint_as_float(w & 0xffff0000u); }
__device__ __forceinline__ float bf2f(bf16_t b) { return __uint_as_float(((unsigned)b) << 16); }
__device__ __forceinline__ float wave_sum(float v) {
#pragma unroll
    for (int o = 1; o < 64; o <<= 1) v += __shfl_xor(v, o);
    return v;
}
__device__ __forceinline__ float fexp(float x) { return __builtin_amdgcn_exp2f(x * 1.4426950408889634f); }
__device__ __forceinline__ float sigm(float x) { return __builtin_amdgcn_rcpf(1.0f + __builtin_amdgcn_exp2f(-1.4426950408889634f * x)); }
__device__ __forceinline__ float tanh_f(float x) { return 1.0f - 2.0f * __builtin_amdgcn_rcpf(1.0f + __builtin_amdgcn_exp2f(2.8853900817779268f * x)); }
__device__ __forceinline__ float gelu_tanh(float x) { const float u = 0.7978845608028654f * (x + 0.044715f * x * x * x); return x * sigm(2.0f * u); }
__device__ __forceinline__ float silu_f(float x) { return x * sigm(x); }

namespace pg8 {
#define PG8_LAS __attribute__((address_space(3)))
constexpr int BM = 256, BK = 64, HALF = 128, HTB = HALF * BK * 2  , STAGE_BYTES = 8 * HTB, NXCD = 8, WGM = 8;
__host__ __device__ __forceinline__ int lds_byte(int r, int c) { const int st = (r >> 4) * 2 + (c >> 5), rr = r & 15, cc = c & 31, ob = rr * 64 + cc * 2; return st * 1024 + (ob ^ (((ob >> 9) & 1) << 5)); }
__host__ __device__ __forceinline__ void stage_rc(int b, int& R, int& C) { const int st = b / 1024, sb = b % 1024, swz = sb ^ (((sb >> 9) & 1) << 5); R = (st >> 1) * 16 + swz / 64; C = (st & 1) * 32 + (swz % 64) / 2; }
__host__ __device__ __forceinline__ int perm32(int rho) { const int n = rho >> 4, i = rho & 15; return 8 * (i >> 2) + 4 * n + (i & 3); }

struct Unit { int pm, pn, am, bn; };
struct Gemm { const bf16_t* A; const bf16_t* Bt; int K; };

struct StaticOrder {
    int nM, nN, nwg, G, c;
    __device__ void init(int M, int N, int G_, int c_) { nM = M / BM; nN = N / BM; nwg = nM * nN; G = G_; c = c_; }
    __device__ bool next(int i, Unit& u) const {
        const long L = (long)i * G + c; if (L >= nwg) return false;
        int wgid = (int)L; { const int q = nwg / NXCD, r = nwg % NXCD, xcd = wgid % NXCD, off = wgid / NXCD; wgid = (xcd < r ? xcd * (q + 1) : r * (q + 1) + (xcd - r) * q) + off; }
        const int nig = WGM * nN, gid = wgid / nig, fm = gid * WGM, gsz = (nM - fm) < WGM ? (nM - fm) : WGM;
        u.pm = fm + ((wgid % nig) % gsz); u.pn = (wgid % nig) / gsz; u.am = u.pm; u.bn = u.pn; return true;
    }
    __device__ __forceinline__ void a_ready(const Unit&) const {}
    __device__ __forceinline__ void done(const Unit&) const {}
};

template <class Epi, class Sched, bool ALIGN_EPI = false, bool SP2 = false>
__device__ __forceinline__ void gemm_phase(PG8_LAS unsigned char* lds, const Gemm g, const Sched& S, const Epi& E) {
    const int tid = threadIdx.x, wid = __builtin_amdgcn_readfirstlane(tid >> 6), lane = tid & 63, wr = wid >> 2, wc = wid & 3, fr = lane & 15, fq = lane >> 4;
    const int K = g.K, nt = K / BK;
    unsigned voffA[2], voffB[2];
#pragma unroll
    for (int i = 0; i < 2; ++i) { int R, C; stage_rc(tid * 16 + i * 8192, R, C); const int Rb = Epi::PERM ? ((R & ~31) + perm32(R & 31)) : R;
        voffA[i] = (unsigned)(R * K + C) * 2u; voffB[i] = (unsigned)(Rb * K + C) * 2u; }
    const size_t kstep = (size_t)(BK * 2);
    const size_t hstep = (size_t)HALF * K * 2;
    const size_t tstep = 2 * hstep;
    const unsigned ldsw = (unsigned)wid * 1024u;
    const int aoff = lds_byte(wr * 64 + fr, fq * 8), boff = lds_byte(wc * 32 + fr, fq * 8);
#define PG8_SA(b, h) (((b) * 2 + (h)) * HTB)
#define PG8_SB(b, h) ((4 + (b) * 2 + (h)) * HTB)
#define PG8_STAGE(bufoff, gbase, voff) do { _Pragma("unroll") for (int _i = 0; _i < 2; ++_i) \
        __builtin_amdgcn_global_load_lds((const unsigned*)((const char*)(gbase) + (voff)[_i]), (PG8_LAS unsigned*)(lds + (bufoff) + ldsw + _i * 8192), 16, 0, 0); } while (0)
#define PG8_LDA(dst, b, h) do { _Pragma("unroll") for (int m = 0; m < 4; ++m) _Pragma("unroll") for (int k = 0; k < 2; ++k) dst[m][k] = *(const PG8_LAS bf16x8*)(lds + PG8_SA(b, h) + aoff + m * 2048 + k * 1024); } while (0)
#define PG8_LDB(dst, b, h) do { _Pragma("unroll") for (int n = 0; n < 2; ++n) _Pragma("unroll") for (int k = 0; k < 2; ++k) dst[n][k] = *(const PG8_LAS bf16x8*)(lds + PG8_SB(b, h) + boff + n * 2048 + k * 1024); } while (0)
#define PG8_MMA(ai, bj, At, Bt) do { __builtin_amdgcn_s_setprio(1); _Pragma("unroll") for (int m = 0; m < 4; ++m) _Pragma("unroll") for (int n = 0; n < 2; ++n) _Pragma("unroll") for (int k = 0; k < 2; ++k) \
        acc[ai][bj][m][n] = __builtin_amdgcn_mfma_f32_16x16x32_bf16(Bt[n][k], At[m][k], acc[ai][bj][m][n], 0, 0, 0); __builtin_amdgcn_s_setprio(0); } while (0)
#define PG8_WAIT_V(n) asm volatile("s_waitcnt vmcnt(" #n ")" ::: "memory")
#define PG8_WAIT_L(n) asm volatile("s_waitcnt lgkmcnt(" #n ")" ::: "memory")
#define PG8_BAR __builtin_amdgcn_s_barrier()
#define PG8_SCHED __builtin_amdgcn_sched_barrier(0)
    Unit cur, nxt; int ui = 0;
    if (!S.next(0, cur)) return;
    f32x4 acc[2][2][4][2];
#pragma unroll
    for (int a = 0; a < 2; ++a)
#pragma unroll
        for (int b = 0; b < 2; ++b)
#pragma unroll
            for (int m = 0; m < 4; ++m)
#pragma unroll
                for (int n = 0; n < 2; ++n) acc[a][b][m][n] = (f32x4){0.f, 0.f, 0.f, 0.f};
    bf16x8 At[4][2], B0[2][2], B1[2][2];
    const char* cA = (const char*)g.A + (size_t)cur.am * tstep; const char* cB = (const char*)g.Bt + (size_t)cur.bn * tstep;
    S.a_ready(cur);
    if constexpr (SP2) {
        PG8_STAGE(PG8_SB(0, 0), cB, voffB); PG8_STAGE(PG8_SB(0, 1), cB + hstep, voffB); PG8_STAGE(PG8_SA(0, 0), cA, voffA); PG8_STAGE(PG8_SA(0, 1), cA + hstep, voffA);
        if (wr == 1) PG8_BAR;
        PG8_WAIT_V(2); PG8_BAR;
        PG8_STAGE(PG8_SB(1, 0), cB + kstep, voffB); PG8_STAGE(PG8_SA(1, 0), cA + kstep, voffA); PG8_STAGE(PG8_SB(1, 1), cB + hstep + kstep, voffB);
        PG8_WAIT_V(6); PG8_BAR;
    } else {
        PG8_STAGE(PG8_SB(0, 0), cB, voffB); PG8_STAGE(PG8_SA(0, 0), cA, voffA); PG8_STAGE(PG8_SB(0, 1), cB + hstep, voffB); PG8_STAGE(PG8_SA(0, 1), cA + hstep, voffA);
        if (wr == 1) PG8_BAR;
        PG8_WAIT_V(4); PG8_BAR;
        PG8_STAGE(PG8_SB(1, 0), cB + kstep, voffB); PG8_STAGE(PG8_SA(1, 0), cA + kstep, voffA); PG8_STAGE(PG8_SB(1, 1), cB + hstep + kstep, voffB);
        PG8_WAIT_V(6); PG8_BAR;
    }
    for (;;) {
        const bool has_next = S.next(ui + 1, nxt);
        const char* nA = has_next ? (const char*)g.A + (size_t)nxt.am * tstep : cA; const char* nB = has_next ? (const char*)g.Bt + (size_t)nxt.bn * tstep : cB;
        for (int t = 0; t < nt; t += 2) {
            const bool last = (t == nt - 2);
            const char* a1 = cA + (size_t)(t + 1) * kstep;
            const char* a2 = last ? nA : cA + (size_t)(t + 2) * kstep; const char* b2 = last ? nB : cB + (size_t)(t + 2) * kstep;
            const char* a3 = a2 + kstep; const char* b3 = b2 + kstep;
            if (last && has_next) S.a_ready(nxt);
            if constexpr (SP2) {
            PG8_LDB(B0, 0, 0); PG8_LDB(B1, 0, 1); PG8_SCHED; PG8_LDA(At, 0, 0); PG8_STAGE(PG8_SA(1, 1), a1 + hstep, voffA);
            PG8_WAIT_V(8); PG8_WAIT_L(0); PG8_BAR; PG8_MMA(0, 0, At, B0); PG8_MMA(0, 1, At, B1); PG8_BAR; PG8_SCHED;
            PG8_LDA(At, 0, 1); PG8_STAGE(PG8_SB(0, 0), b2, voffB); PG8_STAGE(PG8_SB(0, 1), b2 + hstep, voffB); PG8_STAGE(PG8_SA(0, 0), a2, voffA);
            PG8_WAIT_V(8); PG8_WAIT_L(0); PG8_BAR; PG8_MMA(1, 0, At, B0); PG8_MMA(1, 1, At, B1); PG8_BAR; PG8_SCHED;
            PG8_LDB(B0, 1, 0); PG8_LDB(B1, 1, 1); PG8_SCHED; PG8_LDA(At, 1, 0); PG8_STAGE(PG8_SA(0, 1), a2 + hstep, voffA);
            PG8_WAIT_V(8); PG8_WAIT_L(0); PG8_BAR; PG8_MMA(0, 0, At, B0); PG8_MMA(0, 1, At, B1); PG8_BAR; PG8_SCHED;
            PG8_LDA(At, 1, 1); PG8_STAGE(PG8_SB(1, 0), b3, voffB); PG8_STAGE(PG8_SB(1, 1), b3 + hstep, voffB); PG8_STAGE(PG8_SA(1, 0), a3, voffA);
            PG8_WAIT_V(8); PG8_WAIT_L(0); PG8_BAR; PG8_MMA(1, 0, At, B0); PG8_MMA(1, 1, At, B1); PG8_BAR; PG8_SCHED;
            } else {
            PG8_LDB(B0, 0, 0); PG8_SCHED; PG8_LDA(At, 0, 0); PG8_STAGE(PG8_SA(1, 1), a1 + hstep, voffA);
            PG8_WAIT_L(8); PG8_BAR; PG8_WAIT_L(0); PG8_MMA(0, 0, At, B0); PG8_BAR; PG8_SCHED;
            PG8_LDB(B1, 0, 1); PG8_STAGE(PG8_SB(0, 0), b2, voffB);
            PG8_BAR; PG8_WAIT_L(0); PG8_MMA(0, 1, At, B1); PG8_BAR;
            PG8_LDA(At, 0, 1); PG8_STAGE(PG8_SA(0, 0), a2, voffA);
            PG8_BAR; PG8_WAIT_L(0); PG8_MMA(1, 0, At, B0); PG8_BAR; PG8_SCHED;
            PG8_STAGE(PG8_SB(0, 1), b2 + hstep, voffB);
            PG8_WAIT_V(6); PG8_BAR; PG8_MMA(1, 1, At, B1); PG8_BAR;
            PG8_LDB(B0, 1, 0); PG8_SCHED; PG8_LDA(At, 1, 0); PG8_STAGE(PG8_SA(0, 1), a2 + hstep, voffA);
            PG8_WAIT_L(8); PG8_BAR; PG8_WAIT_L(0); PG8_MMA(0, 0, At, B0); PG8_BAR; PG8_SCHED;
            PG8_LDB(B1, 1, 1); PG8_STAGE(PG8_SB(1, 0), b3, voffB);
            PG8_BAR; PG8_WAIT_L(0); PG8_MMA(0, 1, At, B1); PG8_BAR;
            PG8_LDA(At, 1, 1); PG8_STAGE(PG8_SA(1, 0), a3, voffA);
            PG8_BAR; PG8_WAIT_L(0); PG8_MMA(1, 0, At, B0); PG8_BAR; PG8_SCHED;
            PG8_STAGE(PG8_SB(1, 1), b3 + hstep, voffB);
            PG8_WAIT_V(6); PG8_BAR; PG8_MMA(1, 1, At, B1); PG8_BAR;
            }
        }
        if constexpr (ALIGN_EPI) { if (wr == 0) PG8_BAR; }
        E(acc, cur, wr, wc, fr, fq); S.done(cur);
        if (!has_next) break;
#pragma unroll
        for (int a = 0; a < 2; ++a)
#pragma unroll
            for (int b = 0; b < 2; ++b)
#pragma unroll
                for (int m = 0; m < 4; ++m)
#pragma unroll
                    for (int n = 0; n < 2; ++n) acc[a][b][m][n] = (f32x4){0.f, 0.f, 0.f, 0.f};
        cur = nxt; cA = nA; cB = nB; ++ui;
        if constexpr (ALIGN_EPI) { if (wr == 1) PG8_BAR; }
    }
    PG8_WAIT_V(0);
    if constexpr (!ALIGN_EPI) { if (wr == 0) PG8_BAR; }
    PG8_BAR;
#undef PG8_SA
#undef PG8_SB
#undef PG8_STAGE
#undef PG8_LDA
#undef PG8_LDB
#undef PG8_MMA
#undef PG8_WAIT_V
#undef PG8_WAIT_L
#undef PG8_BAR
#undef PG8_SCHED
}
}
#include <hip/hip_bf16.h>
namespace attn_body {
using bf16=__hip_bfloat16;
using bf16x8=__attribute__((ext_vector_type(8)))short;
using s16x4=__attribute__((ext_vector_type(4)))short;
using f32x16=__attribute__((ext_vector_type(16)))float;
using u32x4=__attribute__((ext_vector_type(4)))unsigned;
constexpr int D=64,KVP=128,OP=1024,QP=512;
constexpr int NW=8,QBLK=32,QB=QBLK*NW,KVBLK=64;
constexpr int ATTN_UNIT_ROWS=QB;
__device__ __forceinline__ int crow(int r,int hi){return (r&3)+8*(r>>2)+4*hi;}
#define SBAR() __builtin_amdgcn_sched_barrier(0)
constexpr int NSLOT=3, SLOTB=8192;
constexpr int LDS_K=0, LDS_V=NSLOT*SLOTB, LDS_WS=2*NSLOT*SLOTB, LDS_OST=LDS_WS+NW*64*4, LDS_BYTES=LDS_OST+NW*4096;
constexpr float C2=0.125f*1.4426950408889634f;
__device__ __forceinline__ void glds16(const void*gsrc,unsigned lds_dst){unsigned keep;
  asm volatile("s_mov_b32 %0, m0\n\ts_mov_b32 m0, %2\n\ts_nop 0\n\tglobal_load_lds_dwordx4 %1, off\n\ts_mov_b32 m0, %0":"=&s"(keep):"v"(gsrc),"s"(lds_dst):"memory");}
__device__ __forceinline__ float max3f(float a,float b,float c){float r;asm("v_max3_f32 %0, %1, %2, %3":"=v"(r):"v"(a),"v"(b),"v"(c));return r;}
__device__ __forceinline__ float max2f(float a,float b){float r;asm("v_max_f32_e32 %0, %1, %2":"=v"(r):"v"(a),"v"(b));return r;}
__device__ __forceinline__ float fadd_s(float a,float b){float r;asm("v_add_f32_e32 %0, %1, %2":"=v"(r):"v"(a),"v"(b));return r;}
__device__ __forceinline__ float fsub_s(float a,float b){float r;asm("v_sub_f32_e32 %0, %1, %2":"=v"(r):"v"(a),"v"(b));return r;}
typedef float f32x2_t __attribute__((ext_vector_type(2))); typedef __bf16 bf16x2_t __attribute__((ext_vector_type(2)));
__device__ __forceinline__ unsigned cvtpk_s(float lo,float hi){f32x2_t v={lo,hi};bf16x2_t b=__builtin_convertvector(v,bf16x2_t);return __builtin_bit_cast(unsigned,b);}
#define WAIT_BAR(N) asm volatile("s_waitcnt vmcnt(" #N ") lgkmcnt(0)\n\ts_barrier":::"memory")

__device__ __forceinline__ void qkt(f32x16&p0,f32x16&p1,const char*Kslot,const bf16x8*qr,const f32x16&negm,int r32,int hi){
  const char*kb=Kslot+hi*1024+r32*16;
  #pragma unroll
  for(int d0=0;d0<4;++d0){
    const bf16x8 b0=*reinterpret_cast<const bf16x8*>(kb+d0*2048);
    const bf16x8 b1=*reinterpret_cast<const bf16x8*>(kb+d0*2048+512);
    if(d0==0){p0=__builtin_amdgcn_mfma_f32_32x32x16_bf16(b0,qr[0],negm,0,0,0);p1=__builtin_amdgcn_mfma_f32_32x32x16_bf16(b1,qr[0],negm,0,0,0);}
    else{p0=__builtin_amdgcn_mfma_f32_32x32x16_bf16(b0,qr[d0],p0,0,0,0);p1=__builtin_amdgcn_mfma_f32_32x32x16_bf16(b1,qr[d0],p1,0,0,0);}}
}
typedef __attribute__((address_space(3))) const char* lds_cptr;
typedef short v4i16_t __attribute__((ext_vector_type(4)));
__device__ __forceinline__ void kload8(bf16x8*kf,lds_cptr kp){
  kf[0]=*(const __attribute__((address_space(3))) bf16x8*)(kp);      kf[1]=*(const __attribute__((address_space(3))) bf16x8*)(kp+512);
  kf[2]=*(const __attribute__((address_space(3))) bf16x8*)(kp+2048); kf[3]=*(const __attribute__((address_space(3))) bf16x8*)(kp+2560);
  kf[4]=*(const __attribute__((address_space(3))) bf16x8*)(kp+4096); kf[5]=*(const __attribute__((address_space(3))) bf16x8*)(kp+4608);
  kf[6]=*(const __attribute__((address_space(3))) bf16x8*)(kp+6144); kf[7]=*(const __attribute__((address_space(3))) bf16x8*)(kp+6656);
}
__device__ __forceinline__ void kload2(bf16x8*kf,lds_cptr kp,int j){ kf[2*j]=*(const __attribute__((address_space(3))) bf16x8*)(kp+j*2048); kf[2*j+1]=*(const __attribute__((address_space(3))) bf16x8*)(kp+j*2048+512); }
__device__ __forceinline__ s16x4 vtr(lds_cptr p){ return __builtin_bit_cast(s16x4,__builtin_amdgcn_ds_read_tr16_b64_v4i16((__attribute__((address_space(3))) v4i16_t*)p)); }
__device__ __forceinline__ float rowmax(const f32x16&p0,const f32x16&p1){
  float a=max3f(p0[0],p0[1],p1[0]),b=max3f(p0[2],p0[3],p1[1]);a=max3f(a,p1[2],p1[3]);
  #pragma unroll
  for(int r=4;r<16;r+=4){a=max3f(a,p0[r],p0[r+1]);b=max3f(b,p0[r+2],p0[r+3]);a=max3f(a,p1[r],p1[r+1]);b=max3f(b,p1[r+2],p1[r+3]);}
  const float m=max2f(a,b);
  auto rr=__builtin_amdgcn_permlane32_swap(__float_as_uint(m),__float_as_uint(m),false,false);
  return max2f(__uint_as_float(rr[0]),__uint_as_float(rr[1]));
}
__device__ __forceinline__ void pv(f32x16*o,int vb,bf16x8 pa0,bf16x8 pa1,bf16x8 pa2,bf16x8 pa3){
  #pragma unroll
  for(int d0=0;d0<2;++d0){s16x4 lo[4],hi[4];
    #pragma unroll
    for(int ks=0;ks<4;++ks){
      asm volatile("ds_read_b64_tr_b16 %0,%1 offset:%c2":"=&v"(lo[ks]):"v"(vb),"i"(d0*4096+ks*1024):"memory");
      asm volatile("ds_read_b64_tr_b16 %0,%1 offset:%c2":"=&v"(hi[ks]):"v"(vb),"i"(d0*4096+ks*1024+512):"memory");}
    asm volatile("s_waitcnt lgkmcnt(0)":::"memory");SBAR();
    #define PK(k) (bf16x8){lo[k][0],lo[k][1],lo[k][2],lo[k][3],hi[k][0],hi[k][1],hi[k][2],hi[k][3]}
    o[d0]=__builtin_amdgcn_mfma_f32_32x32x16_bf16(pa0,PK(0),o[d0],0,0,0);
    o[d0]=__builtin_amdgcn_mfma_f32_32x32x16_bf16(pa1,PK(1),o[d0],0,0,0);
    o[d0]=__builtin_amdgcn_mfma_f32_32x32x16_bf16(pa2,PK(2),o[d0],0,0,0);
    o[d0]=__builtin_amdgcn_mfma_f32_32x32x16_bf16(pa3,PK(3),o[d0],0,0,0);
    #undef PK
  }
}

#ifndef ATTN_STORE16
#define ATTN_STORE16(p,v) (*(u32x4*)(p)=(v))
#endif
template<int THRL> __device__ __forceinline__ void attn_unit(int qrow0,int h,int kvrow0,int NT,int rope,int qpos0,const float*QRAW,const float*qg,const float*ropetab,const bf16*__restrict__ K,const bf16*__restrict__ V,bf16*O,char*shm){
  const int tid=threadIdx.x,lane=tid&63,r32=lane&31,hi=lane>>5; const int wid=__builtin_amdgcn_readfirstlane(tid>>6);
  const float*Qw=QRAW+(long)(qrow0+wid*QBLK)*QP+h*D;
  const bf16*Kh=K+(long)kvrow0*KVP+(h>>2)*D,*Vh=V+(long)kvrow0*KVP+(h>>2)*D;
  const unsigned lds0=(unsigned)(uintptr_t)shm;
  float*wsf=(float*)(shm+LDS_WS)+wid*64;
  const bf16*ksrc=Kh+(long)lane*KVP+wid*8;
  const bf16*vsrc=Vh+(long)(16*(wid&3)+(lane>>2))*KVP+(wid>>2)*32+(lane&3)*8;
  const unsigned kdst=lds0+LDS_K+wid*1024, vdst=lds0+LDS_V+wid*1024;
  #define DMA_K(t,slot) glds16(ksrc+(long)(t)*KVBLK*KVP,(unsigned)__builtin_amdgcn_readfirstlane(kdst+(slot)))
  #define DMA_V(t,slot) glds16(vsrc+(long)(t)*KVBLK*KVP,(unsigned)__builtin_amdgcn_readfirstlane(vdst+(slot)))
  const int vb0=(int)(lds0+LDS_V)+((lane>>4)&1)*32+(lane&3)*8+(4*hi+((lane&15)>>2))*64;
  const char*Kbase=shm+LDS_K; bf16x8 kf[8];
  const lds_cptr shm3=(lds_cptr)shm; const lds_cptr kp0=shm3+LDS_K+hi*1024+r32*16; const lds_cptr vp0=shm3+LDS_V+((lane>>4)&1)*32+(lane&3)*8+(4*hi+((lane&15)>>2))*64;
  DMA_K(0,0);DMA_V(0,0);DMA_K(1,SLOTB);
  bf16x8 qr[4];
  { float qv[4][8]; float ss=0.f;
    #pragma unroll
    for(int d0=0;d0<4;++d0){ const f32x4 a=*reinterpret_cast<const f32x4*>(&Qw[(long)r32*QP+d0*16+hi*8]), c=*reinterpret_cast<const f32x4*>(&Qw[(long)r32*QP+d0*16+hi*8+4]);
      qv[d0][0]=a[0];qv[d0][1]=a[1];qv[d0][2]=a[2];qv[d0][3]=a[3];qv[d0][4]=c[0];qv[d0][5]=c[1];qv[d0][6]=c[2];qv[d0][7]=c[3];
      #pragma unroll
      for(int j=0;j<8;++j)ss+=qv[d0][j]*qv[d0][j]; }
    ss+=__shfl_xor(ss,32);
    const float rs=__builtin_amdgcn_rsqf(ss*(1.f/64.f)+1e-6f);
    const int qpos=qpos0+wid*QBLK+r32; const int prow=qpos>>6, pcol=qpos&63;
    #pragma unroll
    for(int d0=0;d0<4;++d0){
      const f32x4 g0=*reinterpret_cast<const f32x4*>(&qg[d0*16+hi*8]), g1=*reinterpret_cast<const f32x4*>(&qg[d0*16+hi*8+4]);
      float y[8]; y[0]=qv[d0][0]*rs*g0[0];y[1]=qv[d0][1]*rs*g0[1];y[2]=qv[d0][2]*rs*g0[2];y[3]=qv[d0][3]*rs*g0[3];y[4]=qv[d0][4]*rs*g1[0];y[5]=qv[d0][5]*rs*g1[1];y[6]=qv[d0][6]*rs*g1[2];y[7]=qv[d0][7]*rs*g1[3];
      if(rope){ const float*tb=ropetab+(d0<2?prow:(128+pcol))*32+((d0&1)*8+hi*4);
        const f32x4 cs=*reinterpret_cast<const f32x4*>(tb), sn=*reinterpret_cast<const f32x4*>(tb+16);
        #pragma unroll
        for(int p=0;p<4;++p){ const float x1=y[2*p],x2=y[2*p+1]; y[2*p]=x1*cs[p]-x2*sn[p]; y[2*p+1]=x1*sn[p]+x2*cs[p]; } }
      u32x4 w; w[0]=cvtpk_s(y[0]*C2,y[1]*C2); w[1]=cvtpk_s(y[2]*C2,y[3]*C2); w[2]=cvtpk_s(y[4]*C2,y[5]*C2); w[3]=cvtpk_s(y[6]*C2,y[7]*C2);
      qr[d0]=__builtin_bit_cast(bf16x8,w); } }
  float mhat=0.f,l_reg=0.f;f32x16 o[2];o[0]=f32x16{};o[1]=f32x16{};f32x16 negm=f32x16{};asm volatile("":"+v"(negm));
  #define CMASK(P0,P1,t) do{}while(0)
  bool resc=false;
  #define START(P0,P1) do{ const float rm=rowmax(P0,P1); resc=false; \
    { const float dl=rm; mhat=fadd_s(mhat,dl); \
      _Pragma("unroll") for(int r=0;r<16;++r){P0[r]=fsub_s(P0[r],dl);P1[r]=fsub_s(P1[r],dl);} \
      _Pragma("unroll") for(int r=0;r<16;++r)negm[r]=-mhat; asm volatile("":"+v"(negm)); } \
    _Pragma("unroll") for(int r=0;r<16;++r)P0[r]=__builtin_amdgcn_exp2f(P0[r]); }while(0)
  #define RESC() do{ if(resc){ asm volatile("s_waitcnt lgkmcnt(0)":::"memory"); \
      _Pragma("unroll") for(int d_=0;d_<2;++d_) _Pragma("unroll") for(int r=0;r<16;++r)o[d_][r]*=wsf[crow(r,hi)]; } }while(0)
  f32x16 pA0,pA1,pB0,pB1;
  int sl_prev=0,sl_cur=0,sl_next=SLOTB;
  #define ROT() do{sl_prev=sl_cur;sl_cur=sl_next;sl_next=(sl_next==(NSLOT-1)*SLOTB)?0:sl_next+SLOTB;}while(0)
  DMA_K(2,2*SLOTB);
  WAIT_BAR(3);
  qkt(pA0,pA1,Kbase,qr,negm,r32,hi);asm volatile("s_nop 15\n\ts_nop 7":"+v"(pA0),"+v"(pA1));CMASK(pA0,pA1,0);
  START(pA0,pA1);
  _Pragma("unroll") for(int r=0;r<16;++r)pA1[r]=__builtin_amdgcn_exp2f(pA1[r]);
  WAIT_BAR(0);
  DMA_K(3,0);DMA_V(1,SLOTB);
  ROT();
  kload8(kf,kp0+sl_cur);
  WAIT_BAR(2);
  s16x4 vlo[8],vhi[8]; u32x4 pw0,pw1,pw2,pw3;
  #define PKW(P,B) cvtpk_s(P[B],P[B+1])
  #define PAF(k) __builtin_bit_cast(bf16x8,pw##k)
  #define VFR(i) (bf16x8){vlo[i][0],vlo[i][1],vlo[i][2],vlo[i][3],vhi[i][0],vhi[i][1],vhi[i][2],vhi[i][3]}
  #define PIN(x) asm volatile("":"+v"(x))
  #define MX3(a,b,c) __builtin_fmaxf(__builtin_fmaxf((a),(b)),(c))
  #define GAPA(MF,A0,A1,A2,A3,W0,W1,PW) do{ MF; sacc+=A0; sacc+=A1; sacc+=A2; sacc+=A3; PIN(sacc); W0; W1; PIN(PW); SBAR(); }while(0)
  #define EX(v) __builtin_amdgcn_exp2f(v)
  #define GAPB(MF,X,B) do{ MF; X[B]=EX(X[B]); X[B+1]=EX(X[B+1]); X[B+2]=EX(X[B+2]); X[B+3]=EX(X[B+3]); PIN(X); SBAR(); }while(0)
  #define VRD(i) do{ vlo[i]=vtr(vp_+(((i)>>2)*4096+((i)&3)*1024)); vhi[i]=vtr(vp_+(((i)>>2)*4096+((i)&3)*1024+512)); }while(0)
  #define KRD(G,j) do{ if(G){ kload2(kf,kp0+sl_next,j); SBAR(); } }while(0)
  #define STEP(C0,C1,P0,P1,t,GK,GV,GL) do{ SBAR(); \
    const lds_cptr vp_=vp0+sl_prev; \
    VRD(0); SBAR(); float sacc=(P0[0]+P0[1]); \
    GAPA(C0=__builtin_amdgcn_mfma_f32_32x32x16_bf16(kf[0],qr[0],negm,0,0,0), P0[2],P0[3],P0[4],P0[5],     pw0[0]=PKW(P0,0), pw0[1]=PKW(P0,2), pw0); \
    VRD(4); SBAR(); GAPA(C1=__builtin_amdgcn_mfma_f32_32x32x16_bf16(kf[1],qr[0],negm,0,0,0), P0[6],P0[7],P0[8],P0[9],     pw0[2]=PKW(P0,4), pw0[3]=PKW(P0,6), pw0); \
    VRD(1); SBAR(); GAPA(C0=__builtin_amdgcn_mfma_f32_32x32x16_bf16(kf[2],qr[1],C0,0,0,0),   P0[10],P0[11],P0[12],P0[13], pw1[0]=PKW(P0,8), pw1[1]=PKW(P0,10), pw1); \
    VRD(5); SBAR(); GAPA(C1=__builtin_amdgcn_mfma_f32_32x32x16_bf16(kf[3],qr[1],C1,0,0,0),   P0[14],P0[15],P1[0],P1[1],   pw1[2]=PKW(P0,12),pw1[3]=PKW(P0,14), pw1); \
    VRD(2); SBAR(); GAPA(C0=__builtin_amdgcn_mfma_f32_32x32x16_bf16(kf[4],qr[2],C0,0,0,0),   P1[2],P1[3],P1[4],P1[5],     pw2[0]=PKW(P1,0), pw2[1]=PKW(P1,2), pw2); \
    VRD(6); SBAR(); GAPA(C1=__builtin_amdgcn_mfma_f32_32x32x16_bf16(kf[5],qr[2],C1,0,0,0),   P1[6],P1[7],P1[8],P1[9],     pw2[2]=PKW(P1,4), pw2[3]=PKW(P1,6), pw2); \
    VRD(3); SBAR(); GAPA(C0=__builtin_amdgcn_mfma_f32_32x32x16_bf16(kf[6],qr[3],C0,0,0,0),   P1[10],P1[11],P1[12],P1[13], pw3[0]=PKW(P1,8), pw3[1]=PKW(P1,10), pw3); \
    VRD(7); SBAR(); GAPA(C1=__builtin_amdgcn_mfma_f32_32x32x16_bf16(kf[7],qr[3],C1,0,0,0),   P1[14],P1[15],0.f,0.f,       pw3[2]=PKW(P1,12),pw3[3]=PKW(P1,14), pw3); \
    l_reg+=sacc; \
    if(GK){DMA_K((t)+3,sl_cur);} if(GV){DMA_V((t)+1,sl_next);} \
    CMASK(C0,C1,t); \
    { float a=MX3(C0[0],C0[1],C1[0]),b=MX3(C0[2],C0[3],C1[1]); a=MX3(a,C1[2],C1[3]); \
      _Pragma("unroll") for(int r=4;r<16;r+=4){a=MX3(a,C0[r],C0[r+1]);b=MX3(b,C0[r+2],C0[r+3]);a=MX3(a,C1[r],C1[r+1]);b=MX3(b,C1[r+2],C1[r+3]);} \
      float rm=__builtin_fmaxf(a,b); { auto rr=__builtin_amdgcn_permlane32_swap(__float_as_uint(rm),__float_as_uint(rm),false,false); rm=__builtin_fmaxf(__uint_as_float(rr[0]),__uint_as_float(rr[1])); } \
      resc=false; \
      if(__builtin_expect(__any(rm>(float)THRL),0)){ const float dl=__builtin_fmaxf(rm,0.f); mhat+=dl; \
        _Pragma("unroll") for(int r=0;r<16;++r){C0[r]-=dl;C1[r]-=dl;} \
        _Pragma("unroll") for(int r=0;r<16;++r)negm[r]=-mhat; asm volatile("":"+v"(negm)); \
        const float f=__builtin_amdgcn_exp2f(-dl); l_reg*=f; if(hi==0)wsf[r32]=f; resc=true; } } \
    SBAR(); \
    GAPB(o[0]=__builtin_amdgcn_mfma_f32_32x32x16_bf16(PAF(0),VFR(0),o[0],0,0,0), C0,0); \
    GAPB(o[1]=__builtin_amdgcn_mfma_f32_32x32x16_bf16(PAF(0),VFR(4),o[1],0,0,0), C0,4); \
    KRD(GL,0); GAPB(o[0]=__builtin_amdgcn_mfma_f32_32x32x16_bf16(PAF(1),VFR(1),o[0],0,0,0), C0,8); \
    KRD(GL,1); GAPB(o[1]=__builtin_amdgcn_mfma_f32_32x32x16_bf16(PAF(1),VFR(5),o[1],0,0,0), C0,12); \
    KRD(GL,2); GAPB(o[0]=__builtin_amdgcn_mfma_f32_32x32x16_bf16(PAF(2),VFR(2),o[0],0,0,0), C1,0); \
    KRD(GL,3); GAPB(o[1]=__builtin_amdgcn_mfma_f32_32x32x16_bf16(PAF(2),VFR(6),o[1],0,0,0), C1,4); \
    GAPB(o[0]=__builtin_amdgcn_mfma_f32_32x32x16_bf16(PAF(3),VFR(3),o[0],0,0,0), C1,8); \
    GAPB(o[1]=__builtin_amdgcn_mfma_f32_32x32x16_bf16(PAF(3),VFR(7),o[1],0,0,0), C1,12); \
    }while(0)
  int t=1;
  #undef CMASK
  #define CMASK(P0,P1,t) do{}while(0)
  for(;t+5<NT;t+=2){
    STEP(pB0,pB1,pA0,pA1,t,true,true,true);     WAIT_BAR(2); RESC(); ROT();
    STEP(pA0,pA1,pB0,pB1,t+1,true,true,true);   WAIT_BAR(2); RESC(); ROT();
  }
  #undef CMASK
  #define CMASK(P0,P1,t) do{}while(0)
  #define ENDW(tt) do{ if((tt)+3<NT){WAIT_BAR(2);} else if((tt)+2<NT){WAIT_BAR(1);} else {WAIT_BAR(0);} }while(0)
  for(;t+1<NT;t+=2){
    STEP(pB0,pB1,pA0,pA1,t,(t+3<NT),(t+1<NT),(t+1<NT));       ENDW(t);   RESC(); ROT();
    STEP(pA0,pA1,pB0,pB1,t+1,(t+4<NT),(t+2<NT),(t+2<NT));     ENDW(t+1); RESC(); ROT();
  }
  STEP(pB0,pB1,pA0,pA1,NT-1,false,false,false); RESC();
  { float sacc=pB0[0]+pB0[1]; _Pragma("unroll") for(int r=2;r<16;++r)sacc+=pB0[r]; _Pragma("unroll") for(int r=0;r<16;++r)sacc+=pB1[r]; l_reg+=sacc;
    pw0=(u32x4){PKW(pB0,0),PKW(pB0,2),PKW(pB0,4),PKW(pB0,6)};pw1=(u32x4){PKW(pB0,8),PKW(pB0,10),PKW(pB0,12),PKW(pB0,14)};pw2=(u32x4){PKW(pB1,0),PKW(pB1,2),PKW(pB1,4),PKW(pB1,6)};pw3=(u32x4){PKW(pB1,8),PKW(pB1,10),PKW(pB1,12),PKW(pB1,14)};
    SBAR(); pv(o,vb0+sl_cur,PAF(0),PAF(1),PAF(2),PAF(3)); }
  #undef PKW
  #undef PAF
  #undef VFR
  #undef PIN
  #undef MX3
  #undef GAPA
  #undef GAPB
  #undef EX
  #undef VRD
  #undef KRD
  #undef STEP
  #undef ENDW
  {auto rr=__builtin_amdgcn_permlane32_swap(__float_as_uint(l_reg),__float_as_uint(l_reg),false,false);l_reg=__uint_as_float(rr[0])+__uint_as_float(rr[1]);}
  if(hi==0)wsf[32+r32]=l_reg;asm volatile("s_waitcnt lgkmcnt(0)":::"memory");
  float rli[16];
  #pragma unroll
  for(int r=0;r<16;++r)rli[r]=__builtin_amdgcn_rcpf(wsf[32+crow(r,hi)]);
  bf16*Ow=O+(long)(qrow0+wid*QBLK)*OP+512+h*D;
  { bf16*stg=(bf16*)(shm+LDS_OST)+wid*2048;
    #pragma unroll
    for(int r=0;r<16;++r){const int orow=crow(r,hi);
      #pragma unroll
      for(int d0=0;d0<2;++d0)stg[orow*64+d0*32+r32]=__float2bfloat16(o[d0][r]*rli[r]);}
    asm volatile("s_waitcnt lgkmcnt(0)":::"memory");
    #pragma unroll
    for(int i=0;i<4;++i){const int row=i*8+(lane>>3),ch=lane&7; const u32x4 v=*(const u32x4*)(stg+row*64+ch*8); ATTN_STORE16(Ow+(long)row*OP+ch*8,v);} }
  asm volatile("s_waitcnt lgkmcnt(0)\n\ts_barrier":::"memory");
  #undef DMA_K
  #undef DMA_V
  #undef CMASK
  #undef START
  #undef RESC
  #undef ROT
}
constexpr int ATTN_LDS_BYTES=LDS_BYTES;
#undef SBAR
#undef WAIT_BAR
}
enum {
    I_X = 0, I_C, I_CTX, I_CCTX,
    I0_WMOD, I0_BMOD, I0_NMIX, I0_NFFN, I0_WIN, I0_CONVW, I0_CONVB, I0_WI, I0_BI, I0_WR, I0_BR, I0_LAM, I0_QG, I0_KG, I0_WOUT, I0_ROUTER, I0_WEG, I0_WEU, I0_WED,
    I1_WMOD, I1_BMOD, I1_NMIX, I1_NFFN, I1_MU, I1_WR, I1_WK, I1_WV, I1_W0, I1_W1, I1_W2, I1_A0, I1_A1, I1_A2, I1_G1, I1_G2, I1_KK, I1_KA, I1_RK, I1_GNG, I1_GNB, I1_WO, I1_ROUTER, I1_WEG, I1_WEU, I1_WED,
    N_IN
};
static_assert(N_IN == 49, "49 inputs");
struct KArgs { const float* in[N_IN]; float* out; unsigned char* ws; int ph_lo, ph_hi; };
#define KAREF const __attribute__((address_space(4))) KArgs&
__device__ __forceinline__ const __attribute__((address_space(4))) KArgs* ka_launder(const __attribute__((address_space(4))) KArgs* p) { asm volatile("" : "+s"(p)); return p; }

constexpr size_t MiB = 1u << 20;
constexpr size_t WS_CTL = 0;
constexpr size_t WS_BMIX = 1 * MiB;
constexpr size_t WS_B2 = 9 * MiB;
constexpr size_t ZERO_BYTES = 12 * MiB;
constexpr size_t WS_WIN = 12 * MiB;
constexpr size_t WS_WOUT = 16 * MiB;
constexpr size_t WS_WO = 18 * MiB;
constexpr size_t WS_WGATE = 20 * MiB;
constexpr size_t WS_ADA = 20 * MiB + 512 * 1024;
constexpr size_t WS_ROPE = 21 * MiB;
constexpr size_t WS_HLAST = 21 * MiB + 64 * 1024;
constexpr size_t WS_CARRY = 21 * MiB + 128 * 1024;
constexpr size_t WS_AFFL = 22 * MiB;
constexpr size_t WS_AFFC = 24 * MiB;
constexpr size_t WS_SRCROW = 25 * MiB;
constexpr size_t WS_GROW = 26 * MiB;
constexpr size_t WS_SLOTL = 27 * MiB;
constexpr size_t WS_SLOTC = 29 * MiB;
constexpr size_t WS_CTXS = 30 * MiB;
constexpr size_t WS_MOEW1 = 40 * MiB;
constexpr size_t WS_MOEW2 = 168 * MiB;
constexpr size_t WS_ACT = 232 * MiB;
constexpr size_t WS_END = WS_ACT + 660 * MiB;
constexpr size_t A_H = 0, A_XA = 66 * MiB, A_GA = 99 * MiB, A_QR = 132 * MiB, A_KR = 198 * MiB, A_KN = 215 * MiB, A_VB = 224 * MiB, A_HF = 233 * MiB, A_YCAT = 299 * MiB;
constexpr size_t A_H2 = 0, A_XE = 66 * MiB, A_HID = 202 * MiB, A_YE = 474 * MiB;
constexpr size_t A_XMIX = 0, A_RKV = 396 * MiB, A_LG = 594 * MiB, A_LWA = A_LG + (size_t)TT * 256 * 2;
constexpr size_t A_SD = 0, A_AD = 132 * MiB, A_G = 264 * MiB, A_YD0 = 330 * MiB, A_YD1 = 594 * MiB, A_O = 0;
constexpr size_t ROWB = (size_t)TT * DM * 2;

constexpr int RING_OFF = 0, RING_BYTES = 131072;
constexpr int LDSCTL_OFF = RING_BYTES, MISC_OFF = LDSCTL_OFF + 320;
constexpr int LDS_BYTES = 147456;

#define RLX_AGENT __ATOMIC_RELAXED, __HIP_MEMORY_SCOPE_AGENT
#define LDS_WAIT() asm volatile("s_waitcnt lgkmcnt(0)" ::: "memory")
#define VM_WAIT() asm volatile("s_waitcnt vmcnt(0)" ::: "memory")

#define XB_TMO      128
#define XB_XCNT(j)  (256  + 64 * (j))
#define XB_XSUB(j)  (1280 + 64 * (j))
#define XB_XGEN(j)  (2304 + 64 * (j))
#define XB_TOP      3328
#define XB_TOPGEN   3392
#define XCD_BAR_WORDS 3456
#define XB_SPIN_CAP (1u << 18)
__device__ __forceinline__ unsigned xb_ld(unsigned* p)              { return __hip_atomic_load(p, __ATOMIC_RELAXED, __HIP_MEMORY_SCOPE_AGENT); }
__device__ __forceinline__ unsigned xb_add(unsigned* p, unsigned v) { return __hip_atomic_fetch_add(p, v, __ATOMIC_RELAXED, __HIP_MEMORY_SCOPE_AGENT); }
__device__ __forceinline__ unsigned xb_xcc_id() { return (unsigned)__builtin_amdgcn_s_getreg((3 << 11) | 20) & 0xFu; }
#define XB_SPIN(cond, bar) do { unsigned _sp = 0; while (cond) { __builtin_amdgcn_s_sleep(1); \
    if ((++_sp & 255u) == 0u) { if (xb_ld(&(bar)[XB_TMO])) break; if (_sp > XB_SPIN_CAP) { atomicAdd(&(bar)[XB_TMO], 1u); break; } } } } while (0)
struct XcdBarrier { unsigned* bar; unsigned x; volatile LAS unsigned* st; };
__device__ __forceinline__ XcdBarrier xcd_barrier_post(unsigned* bar, volatile LAS unsigned* st) {
    XcdBarrier b; b.bar = bar; b.x = xb_xcc_id(); b.st = st;
    if (threadIdx.x == 0) (void)xb_add(&bar[XB_XCNT(b.x)], 1u);
    return b;
}
__device__ __forceinline__ void xcd_barrier_complete(unsigned* bar, unsigned x, unsigned& nloc, unsigned& nx) {
    const unsigned G = gridDim.x * gridDim.y * gridDim.z;
    unsigned sum, cnt, mine, sp = 0u;
    for (;;) {
        sum = 0u; cnt = 0u; mine = 0u;
#pragma unroll
        for (unsigned j = 0; j < 16; ++j) { const unsigned c = xb_ld(&bar[XB_XCNT(j)]); sum += c; cnt += (c > 0u) ? 1u : 0u; mine = (j == x) ? c : mine; }
        if (sum == G) break;
        __builtin_amdgcn_s_sleep(1);
        if ((++sp & 255u) == 0u) { if (xb_ld(&bar[XB_TMO])) break; if (sp > XB_SPIN_CAP) { atomicAdd(&bar[XB_TMO], 1u); break; } }
    }
    nloc = mine > 0u ? mine : 1u; nx = cnt > 0u ? cnt : 1u;
}
__device__ __forceinline__ void xcd_barrier(const XcdBarrier& b) {
    asm volatile("s_waitcnt vmcnt(0)" ::: "memory");
    __syncthreads();
    if (threadIdx.x == 0) {
        unsigned* bar = b.bar;
        __builtin_amdgcn_s_waitcnt(0);
        unsigned nloc = b.st[0], nx = b.st[1];
        if (nloc == 0u) { xcd_barrier_complete(bar, b.x, nloc, nx); b.st[0] = nloc; b.st[1] = nx; }
        const unsigned old = xb_add(&bar[XB_XSUB(b.x)], 1u);
        const unsigned gen = old / nloc;
        if (old + 1u == (gen + 1u) * nloc) {
            __builtin_amdgcn_fence(__ATOMIC_RELEASE, "agent");
            asm volatile("s_waitcnt vmcnt(0)" ::: "memory");
            const unsigned og = xb_add(&bar[XB_TOP], 1u);
            const unsigned tg = og / nx;
            if (og + 1u == (tg + 1u) * nx) xb_add(&bar[XB_TOPGEN], 1u);
            else XB_SPIN(xb_ld(&bar[XB_TOPGEN]) == tg, bar);
            __builtin_amdgcn_fence(__ATOMIC_ACQUIRE, "agent");
            xb_add(&bar[XB_XGEN(b.x)], 1u);
            asm volatile("s_waitcnt vmcnt(0)" ::: "memory");
        } else {
            XB_SPIN(xb_ld(&bar[XB_XGEN(b.x)]) == gen, bar);
            __builtin_amdgcn_fence(__ATOMIC_ACQUIRE, "agent");
            asm volatile("s_waitcnt vmcnt(0)" ::: "memory");
        }
    }
    __syncthreads();
}

__device__ __forceinline__ const float* ada_ptr(const unsigned char* ws, int layer, int r, int chunk) { return (const float*)(ws + WS_ADA) + (size_t)(layer * 5 + r) * 6144 + chunk * 1024; }
__device__ __forceinline__ int kv_row(int m) { return m < TL ? ((m >> 13) * KVL + (m & 8191)) : (((m - TL) >> 8) * KVL + SEQ + ((m - TL) & 255)); }
__device__ __forceinline__ int mod_row(int m) { return m < TL ? (m >> 13) : 4; }
__device__ __forceinline__ int block_excl_scan(int v, LAS int* tmp, int& total) {
    const int lane = threadIdx.x & 63, w = threadIdx.x >> 6;
    int inc = v;
#pragma unroll
    for (int o = 1; o < 64; o <<= 1) { const int t = __shfl_up(inc, o); if (lane >= o) inc += t; }
    if (lane == 63) tmp[w] = inc;
    __syncthreads();
    int base = 0, tot = 0;
#pragma unroll
    for (int i = 0; i < 8; ++i) { const int t = tmp[i]; if (i < w) base += t; tot += t; }
    __syncthreads();
    total = tot;
    return base + inc - v;
}
__device__ __forceinline__ void tr_item(const float* W, int Krows, int ldw, bf16_t* dst, long drow0, int ldd, int dk0, LAS float* scr, int k0, int n0, int lane) {
#pragma unroll 8
    for (int i = 0; i < 32; ++i) { const int kk = 2 * i + (lane >> 5); const int k = k0 + kk; scr[kk * 33 + (lane & 31)] = (k < Krows) ? W[(size_t)k * ldw + n0 + (lane & 31)] : 0.f; }
    LDS_WAIT(); asm volatile("" ::: "memory");
    const int c = lane & 7;
#pragma unroll
    for (int j = 0; j < 4; ++j) { const int n = (lane >> 3) + 8 * j; const LAS float* s = scr + (8 * c) * 33 + n;
        u32x4 o; o.x = cvt_pk_bf16(s[0 * 33], s[1 * 33]); o.y = cvt_pk_bf16(s[2 * 33], s[3 * 33]); o.z = cvt_pk_bf16(s[4 * 33], s[5 * 33]); o.w = cvt_pk_bf16(s[6 * 33], s[7 * 33]);
        *(u32x4*)(dst + (size_t)(drow0 + n) * ldd + dk0 + k0 + 8 * c) = o; }
    LDS_WAIT(); asm volatile("" ::: "memory");
}
__device__ __forceinline__ void moe_convert(KAREF A, int layer, LAS unsigned char* lds, int gw, int ngw, int wave, int lane) {
    LAS float* scr = (LAS float*)(lds + RING_OFF + wave * 16384);
    const float* WG = A.in[layer ? I1_WEG : I0_WEG]; const float* WU = A.in[layer ? I1_WEU : I0_WEU]; const float* WD = A.in[layer ? I1_WED : I0_WED];
    bf16_t* B1 = (bf16_t*)(A.ws + WS_MOEW1); bf16_t* B2 = (bf16_t*)(A.ws + WS_MOEW2);
    constexpr int I_GU = 32 * 1024, I_D = 16 * 1024;
    for (int it = gw; it < I_GU + I_D; it += ngw) {
        if (it < I_GU) { const int mi = it >> 10, e = mi >> 1, which = mi & 1, w = it & 1023, kb = w >> 6, nb = w & 63, n0 = 32 * nb;
            tr_item((which ? WU : WG) + (size_t)e * DM * FF, DM, FF, B1 + (size_t)e * 4096 * DM, (long)((n0 >> 7) * 256 + (n0 & 127) + which * 128), DM, 0, scr, 64 * kb, n0, lane); }
        else { const int r = it - I_GU, e = r >> 10, w = r & 1023, kb = w >> 5, nb = w & 31;
            tr_item(WD + (size_t)e * FF * DM, FF, DM, B2 + (size_t)e * DM * FF, (long)(32 * nb), FF, 0, scr, 64 * kb, 32 * nb, lane); }
    }
}
__device__ __forceinline__ void p0_prologue(KAREF A, LAS unsigned char* lds, int G) {
    const int tid = threadIdx.x, lane = tid & 63, wave = __builtin_amdgcn_readfirstlane(tid >> 6);
    const int gw = blockIdx.x * 8 + wave, ngw = G * 8;
    LAS float* scr = (LAS float*)(lds + RING_OFF + wave * 16384);
    unsigned char* ws = A.ws;
    bf16_t* BMIX = (bf16_t*)(ws + WS_BMIX); bf16_t* B2 = (bf16_t*)(ws + WS_B2);
    constexpr int NJ = 19;
    for (int it = gw; ; it += ngw) {
        int r = it; const float* W = nullptr; int Kr = 0, N = 0, ldd = 0, dk0 = 0; long drow = 0; bf16_t* dst = nullptr; bool found = false;
#define JOB(Wp, KR, NN, DST, DROW, LDD, DK0) if (!found) { const int cnt = (((KR) + 63) / 64) * ((NN) / 32); if (r < cnt) { W = (Wp); Kr = (KR); N = (NN); dst = (DST); drow = (DROW); ldd = (LDD); dk0 = (DK0); found = true; } else r -= cnt; }
        JOB(A.in[I0_WIN], DM, 1792, (bf16_t*)(ws + WS_WIN), 0, DM, 0)
        JOB(A.in[I0_WOUT], DM, DM, (bf16_t*)(ws + WS_WOUT), 0, DM, 0)
        JOB(A.in[I1_WR], DM, DM, BMIX, 0, DM, 0)
        JOB(A.in[I1_WK], DM, DM, BMIX, 1024, DM, 0)
        JOB(A.in[I1_WV], DM, DM, BMIX, 2048, DM, 0)
        JOB(A.in[I1_G1], DM, 160, BMIX, 3072, DM, 0)
        JOB(A.in[I1_W1], DM, 64, BMIX, 3328, DM, 0)
        JOB(A.in[I1_W1] + DM * 64, DM, 64, BMIX, 3328 + 64, DM, 0)
        JOB(A.in[I1_A1], DM, 64, BMIX, 3584, DM, 0)
        JOB(A.in[I1_A1] + DM * 64, DM, 64, BMIX, 3584 + 64, DM, 0)
        JOB(A.in[I1_W2], 64, DM, B2, 0, 256, 0)
        JOB(A.in[I1_W2] + 64 * DM, 64, DM, B2, 1024, 256, 64)
        JOB(A.in[I1_A2], 64, DM, B2, 2048, 256, 128)
        JOB(A.in[I1_A2] + 64 * DM, 64, DM, B2, 3072, 256, 192)
        JOB(A.in[I1_G2], 160, DM, B2, 4096, 256, 0)
        JOB(A.in[I1_WO], DM, DM, (bf16_t*)(ws + WS_WO), 0, DM, 0)
#undef JOB
        if (!found) {
            if (r >= 128) break;
            const int pair = r >> 2, which = (r >> 1) & 1, nb = r & 1;
            W = A.in[which ? I0_WR : I0_WI] + (size_t)pair * 64 * 64; Kr = 64; N = 64; dst = (bf16_t*)(ws + WS_WGATE); drow = (long)pair * 128 + which * 64 + 32 * nb; ldd = 64; dk0 = 0;
            tr_item(W, Kr, N, dst, drow, ldd, dk0, scr, 0, 32 * nb, lane);
            continue;
        }
        const int nblk = N / 32, kb = r / nblk, nb = r % nblk;
        tr_item(W, Kr, N, dst, drow + 32 * nb, ldd, dk0, scr, 64 * kb, 32 * nb, lane);
    }
    (void)NJ;
    moe_convert(A, 0, lds, gw, ngw, wave, lane);
    __syncthreads();
    if (blockIdx.x < 192) {
        const int layer = blockIdx.x / 96, cb = blockIdx.x % 96, col = cb * 64 + lane;
        LAS float* sil = (LAS float*)(lds);
        LAS float* part = (LAS float*)(lds + 32768);
        for (int i = tid; i < 5 * 1024; i += 512) { const int rr = i >> 10, k = i & 1023; const float v = rr < 4 ? A.in[I_C][rr * 1024 + k] : A.in[I_CCTX][k]; sil[i] = v / (1.0f + expf(-v)); }
        __syncthreads();
        const float* wm = A.in[layer ? I1_WMOD : I0_WMOD];
        float acc[5] = {0.f, 0.f, 0.f, 0.f, 0.f};
        for (int k = wave * 128; k < wave * 128 + 128; ++k) { const float wv = wm[(size_t)k * 6144 + col];
#pragma unroll
            for (int rr = 0; rr < 5; ++rr) acc[rr] += sil[rr * 1024 + k] * wv; }
#pragma unroll
        for (int rr = 0; rr < 5; ++rr) part[(wave * 5 + rr) * 64 + lane] = acc[rr];
        __syncthreads();
        if (tid < 320) { const int rr = tid >> 6, l = tid & 63; float s = 0.f;
#pragma unroll
            for (int w = 0; w < 8; ++w) s += part[(w * 5 + rr) * 64 + l];
            ((float*)(ws + WS_ADA))[(size_t)(layer * 5 + rr) * 6144 + cb * 64 + l] = s + A.in[layer ? I1_BMOD : I0_BMOD][cb * 64 + l]; }
        __syncthreads();
    }
    if (blockIdx.x == G - 1) {
        float* tab = (float*)(ws + WS_ROPE);
        for (int i = tid; i < 192 * 16; i += 512) {
            const int pos = i >> 4, f = i & 15; const int p = pos < 128 ? pos : pos - 128;
            double inv = 1.0; for (int q = 0; q < f; ++q) inv *= 0.5623413251903491;
            const float invf = (float)inv;
            const float angf = (float)p * invf;
            double x = (double)angf; const double n = rint(x * 0.15915494309189535); x -= n * 6.283185307179586477;
            const double x2 = x * x; double sn = 0.0, cs = 0.0;
            for (int t = 27; t >= 1; t -= 2) sn = sn * x2 * (-1.0 / ((double)(t + 1) * (double)(t + 2))) + 1.0;
            for (int t = 26; t >= 0; t -= 2) cs = cs * x2 * (-1.0 / ((double)(t + 1) * (double)(t + 2))) + 1.0;
            tab[pos * 32 + f] = (float)cs; tab[pos * 32 + 16 + f] = (float)(sn * x);
        }
    }
}
__device__ __forceinline__ void norm_mod_row(const float* xr, const float* gain, const float* sh, const float* sc, bf16_t* orow, int lane) {
    f32x4 v[4]; float ss = 0.f;
#pragma unroll
    for (int j = 0; j < 4; ++j) { v[j] = *(const f32x4*)(xr + 4 * (lane + 64 * j)); ss += (v[j].x * v[j].x + v[j].y * v[j].y) + (v[j].z * v[j].z + v[j].w * v[j].w); }
    const float rs = __builtin_amdgcn_rsqf(wave_sum(ss) * (1.f / DM) + 1e-6f);
#pragma unroll
    for (int j = 0; j < 4; ++j) { const int col = 4 * (lane + 64 * j);
        const f32x4 g = *(const f32x4*)(gain + col), a = *(const f32x4*)(sc + col), b = *(const f32x4*)(sh + col);
        const f32x4 y = v[j] * rs * g * (a + 1.0f) + b;
        u32x2 w; w.x = cvt_pk_bf16(y.x, y.y); w.y = cvt_pk_bf16(y.z, y.w);
        *(u32x2*)(orow + col) = w; }
}
__device__ __forceinline__ const float* xs_row(KAREF A, int m) { return m < TL ? A.out + (size_t)m * DM : (const float*)(A.ws + WS_CTXS) + (size_t)(m - TL) * DM; }
__device__ __forceinline__ float* xs_row_w(KAREF A, int m) { return m < TL ? A.out + (size_t)m * DM : (float*)(A.ws + WS_CTXS) + (size_t)(m - TL) * DM; }

__device__ __forceinline__ void p1_norm0(KAREF A, int G) {
    const int lane = threadIdx.x & 63, wave = threadIdx.x >> 6, gw = blockIdx.x * 8 + wave, ngw = G * 8;
    bf16_t* H = (bf16_t*)(A.ws + WS_ACT + A_H);
    for (int m = gw; m < TT; m += ngw) {
        const float* xr = m < TL ? A.in[I_X] + (size_t)m * DM : A.in[I_CTX] + (size_t)(m - TL) * DM; const int r = mod_row(m);
        norm_mod_row(xr, A.in[I0_NMIX], ada_ptr(A.ws, 0, r, 0), ada_ptr(A.ws, 0, r, 1), H + (size_t)m * DM, lane);
    }
}

struct EpiWin {
    static constexpr bool PERM = true;
    bf16_t* XA; bf16_t* GA; float* QR; float* KR; bf16_t* VB;
    __device__ __forceinline__ void operator()(const f32x4 (&acc)[2][2][4][2], const pg8::Unit& u, int wr, int wc, int fr, int fq) const {
        const int row0 = u.pm * 256 + wr * 64 + fr, tile = u.pn;
#pragma unroll
        for (int ai = 0; ai < 2; ++ai)
#pragma unroll
            for (int m = 0; m < 4; ++m) { const int row = row0 + ai * 128 + m * 16;
#pragma unroll
                for (int bj = 0; bj < 2; ++bj) { const int colt = bj * 128 + wc * 32 + 8 * fq; const f32x4 v0 = acc[ai][bj][m][0], v1 = acc[ai][bj][m][1];
                    u32x4 w; w.x = cvt_pk_bf16(v0[0], v0[1]); w.y = cvt_pk_bf16(v0[2], v0[3]); w.z = cvt_pk_bf16(v1[0], v1[1]); w.w = cvt_pk_bf16(v1[2], v1[3]);
                    if (tile < 2) *(u32x4*)(XA + (size_t)row * 512 + tile * 256 + colt) = w;
                    else if (tile < 4) *(u32x4*)(GA + (size_t)row * 512 + (tile - 2) * 256 + colt) = w;
                    else if (tile < 6) { float* p = QR + (size_t)row * 512 + (tile - 4) * 256 + colt; *(f32x4*)p = v0; *(f32x4*)(p + 4) = v1; }
                    else if (bj == 0) { float* p = KR + (size_t)row * 128 + colt; *(f32x4*)p = v0; *(f32x4*)(p + 4) = v1; }
                    else *(u32x4*)(VB + (size_t)kv_row(row) * 128 + (colt - 128)) = w; } }
    }
};

__device__ __forceinline__ void p3_kprep(KAREF A, int G) {
    const int lane = threadIdx.x & 63, wave = threadIdx.x >> 6, gw = blockIdx.x * 8 + wave, ngw = G * 8;
    const float* KR = (const float*)(A.ws + WS_ACT + A_KR); bf16_t* KN = (bf16_t*)(A.ws + WS_ACT + A_KN); const float* tab = (const float*)(A.ws + WS_ROPE);
    const int head = lane >> 5, p = lane & 31;
    const float g0 = A.in[I0_KG][2 * p], g1 = A.in[I0_KG][2 * p + 1];
    for (int m = gw; m < TT; m += ngw) {
        const f32x2 v = *(const f32x2*)(KR + (size_t)m * 128 + head * 64 + 2 * p);
        float ss = v.x * v.x + v.y * v.y;
#pragma unroll
        for (int o = 1; o < 32; o <<= 1) ss += __shfl_xor(ss, o);
        const float rs = __builtin_amdgcn_rsqf(ss * (1.f / 64.f) + 1e-6f);
        float y0 = v.x * rs * g0, y1 = v.y * rs * g1;
        if (m < TL) { const int t = m & 8191; const float* tb = tab + (p < 16 ? (t >> 6) : 128 + (t & 63)) * 32 + (p & 15); const float cs = tb[0], sn = tb[16];
            const float x1 = y0, x2 = y1; y0 = x1 * cs - x2 * sn; y1 = x1 * sn + x2 * cs; }
        *(unsigned*)(KN + (size_t)kv_row(m) * 128 + head * 64 + 2 * p) = cvt_pk_bf16(y0, y1);
    }
}

constexpr int L_XCF = 0, L_XCB = 17408, L_WG = 26624, L_AB = 45056, L_SC = 78336, L_CAR = 82432, L_PAR = 82944;
template <int MODE>
__device__ __forceinline__ void lru_dir(KAREF A, LAS unsigned char* lds, int d, int n, int seqrow0, int L, int t_begin, int t_end, float h0, float& h_end, float& a_prod) {
    const int tid = threadIdx.x, lane = tid & 63, wid = tid >> 6;
    LAS float* XCF = (LAS float*)(lds + L_XCF);
    LAS bf16_t* XCB = (LAS bf16_t*)(lds + L_XCB);
    LAS bf16_t* WGl = (LAS bf16_t*)(lds + L_WG);
    LAS f32x2* AB = (LAS f32x2*)(lds + L_AB);
    LAS f32x2* SC = (LAS f32x2*)(lds + L_SC);
    LAS float* CAR = (LAS float*)(lds + L_CAR);
    LAS float* PAR = (LAS float*)(lds + L_PAR);
    const bf16_t* XA = (const bf16_t*)(A.ws + WS_ACT + A_XA); const bf16_t* GA = (const bf16_t*)(A.ws + WS_ACT + A_GA);
    float* HF = (float*)(A.ws + WS_ACT + A_HF); bf16_t* YCAT = (bf16_t*)(A.ws + WS_ACT + A_YCAT);
    __syncthreads();
    { const bf16_t* src = (const bf16_t*)(A.ws + WS_WGATE) + (size_t)(d * 8 + n) * 128 * 64; const int row = tid >> 2, part = tid & 3;
      const u32x4 w0 = *(const u32x4*)(src + row * 64 + part * 16), w1 = *(const u32x4*)(src + row * 64 + part * 16 + 8);
      *(LAS u32x4*)(WGl + row * 72 + part * 16) = w0; *(LAS u32x4*)(WGl + row * 72 + part * 16 + 8) = w1; }
    if (tid < 64) { const int c = tid, ch = 64 * n + c;
#pragma unroll
        for (int j = 0; j < 4; ++j) PAR[j * 64 + c] = A.in[I0_CONVW][j * 512 + ch];
        PAR[256 + c] = A.in[I0_CONVB][ch]; PAR[320 + c] = A.in[I0_BI][d * 512 + ch]; PAR[384 + c] = A.in[I0_BR][d * 512 + ch];
        const float lam = A.in[I0_LAM][d * 512 + ch]; PAR[448 + c] = -8.0f * log1pf(expf(-lam));
        CAR[c] = h0; }
    __syncthreads();
    const int nsub = (t_end - t_begin) >> 6; float ap = 1.f, hfin = 0.f; int par = 0;
    for (int si = 0; si < nsub; ++si) {
        const int t0 = t_begin + (d ? nsub - 1 - si : si) * 64;
        { const int tt = tid >> 3, ch8 = (tid & 7) * 8; float a8[8];
#pragma unroll
          for (int i = 0; i < 8; ++i) a8[i] = PAR[256 + ch8 + i];
#pragma unroll
          for (int j = 0; j < 4; ++j) { const int ts = t0 + tt + j - 2;
              if (ts >= 0 && ts < L) { const u32x4 w = *(const u32x4*)(XA + (size_t)(seqrow0 + ts) * 512 + 64 * n + ch8);
                  a8[0] += PAR[j * 64 + ch8 + 0] * bflo(w.x); a8[1] += PAR[j * 64 + ch8 + 1] * bfhi(w.x); a8[2] += PAR[j * 64 + ch8 + 2] * bflo(w.y); a8[3] += PAR[j * 64 + ch8 + 3] * bfhi(w.y);
                  a8[4] += PAR[j * 64 + ch8 + 4] * bflo(w.z); a8[5] += PAR[j * 64 + ch8 + 5] * bfhi(w.z); a8[6] += PAR[j * 64 + ch8 + 6] * bflo(w.w); a8[7] += PAR[j * 64 + ch8 + 7] * bfhi(w.w); } }
          *(LAS f32x4*)(XCF + tt * 68 + ch8) = (f32x4){a8[0], a8[1], a8[2], a8[3]}; *(LAS f32x4*)(XCF + tt * 68 + ch8 + 4) = (f32x4){a8[4], a8[5], a8[6], a8[7]};
          u32x4 o; o.x = cvt_pk_bf16(a8[0], a8[1]); o.y = cvt_pk_bf16(a8[2], a8[3]); o.z = cvt_pk_bf16(a8[4], a8[5]); o.w = cvt_pk_bf16(a8[6], a8[7]);
          *(LAS u32x4*)(XCB + tt * 72 + ch8) = o; }
        __syncthreads();
        { const int mt = wid & 3, half = wid >> 2, fr = lane & 15, fq = lane >> 4;
          const bf16x8 a0 = *(const LAS bf16x8*)(XCB + (mt * 16 + fr) * 72 + 8 * fq), a1 = *(const LAS bf16x8*)(XCB + (mt * 16 + fr) * 72 + 32 + 8 * fq);
#pragma unroll
          for (int q = 0; q < 2; ++q) { const int cbase = 32 * half + 16 * q, c = cbase + fr;
              const bf16x8 bi0 = *(const LAS bf16x8*)(WGl + (cbase + fr) * 72 + 8 * fq), bi1 = *(const LAS bf16x8*)(WGl + (cbase + fr) * 72 + 32 + 8 * fq);
              const bf16x8 br0 = *(const LAS bf16x8*)(WGl + (64 + cbase + fr) * 72 + 8 * fq), br1 = *(const LAS bf16x8*)(WGl + (64 + cbase + fr) * 72 + 32 + 8 * fq);
              f32x4 gi = __builtin_amdgcn_mfma_f32_16x16x32_bf16(a0, bi0, (f32x4){0.f, 0.f, 0.f, 0.f}, 0, 0, 0); gi = __builtin_amdgcn_mfma_f32_16x16x32_bf16(a1, bi1, gi, 0, 0, 0);
              f32x4 gr = __builtin_amdgcn_mfma_f32_16x16x32_bf16(a0, br0, (f32x4){0.f, 0.f, 0.f, 0.f}, 0, 0, 0); gr = __builtin_amdgcn_mfma_f32_16x16x32_bf16(a1, br1, gr, 0, 0, 0);
              const float bic = PAR[320 + c], brc = PAR[384 + c], lsl = PAR[448 + c];
#pragma unroll
              for (int j = 0; j < 4; ++j) { const int tt = mt * 16 + 4 * fq + j; const float xcv = XCF[tt * 68 + c];
                  const float ig = sigm(gi[j] + bic), rg = sigm(gr[j] + brc), la = rg * lsl, av = fexp(la);
                  const float bb = __builtin_sqrtf(fmaxf(-expm1f(2.0f * la), 0.f)) * ig * xcv;
                  AB[tt * 65 + c] = (f32x2){av, bb}; } } }
        __syncthreads();
        { const int c = tid & 63, sc = wid; float av[8], bv[8]; float Al = 1.f, Hl = 0.f;
#pragma unroll
          for (int i = 0; i < 8; ++i) { const int p = 8 * sc + i, tt = d ? 63 - p : p; const f32x2 ab = AB[tt * 65 + c]; av[i] = ab.x; bv[i] = ab.y; Hl = ab.x * Hl + ab.y; Al *= ab.x; }
          SC[sc * 64 + c] = (f32x2){Al, Hl};
          __syncthreads();
          float h = CAR[par * 64 + c]; float apl = 1.f;
#pragma unroll
          for (int s2 = 0; s2 < 8; ++s2) { const f32x2 t = SC[s2 * 64 + c]; if (s2 < sc) h = t.x * h + t.y; apl *= t.x; }
          if (MODE == 0) { h = Al * h + Hl; }
          else {
#pragma unroll
              for (int i = 0; i < 8; ++i) { h = av[i] * h + bv[i]; const int p = 8 * sc + i, tt = d ? 63 - p : p; const size_t row = (size_t)(seqrow0 + t0 + tt);
                  if (MODE == 1) HF[row * 512 + 64 * n + c] = h;
                  else { const float hf = __hip_atomic_load(HF + row * 512 + 64 * n + c, RLX_AGENT); const float g = bf2f(GA[row * 512 + 64 * n + c]);
                      const float y = (h + hf) * gelu_tanh(g); YCAT[row * 1024 + 64 * n + c] = (bf16_t)(cvt_pk_bf16(y, 0.f) & 0xffffu); } } }
          if (sc == 7) { CAR[(par ^ 1) * 64 + c] = h; ap *= apl; hfin = h; }
          par ^= 1; }
    }
    h_end = hfin; a_prod = ap;
}
__device__ __forceinline__ void p3_lru_pass1(KAREF A, LAS unsigned char* lds, int G) {
    const int tid = threadIdx.x, c = tid & 63;
    f32x2* CARRY = (f32x2*)(A.ws + WS_CARRY); float* HLAST = (float*)(A.ws + WS_HLAST);
    for (int u = blockIdx.x; u < 256 + 32; u += G) {
        float he, ap;
        if (u < 256) { const int b = u >> 6, n = (u >> 3) & 7, s = u & 7;
#pragma unroll 1
            for (int d = 0; d < 2; ++d) { lru_dir<0>(A, lds, d, n, b * SEQ, SEQ, s * 1024, s * 1024 + 1024, 0.f, he, ap);
                if (tid >= 448) CARRY[(size_t)((b * 8 + s) * 2 + d) * 512 + 64 * n + c] = (f32x2){ap, he}; } }
        else { const int v = u - 256, b = v >> 3, n = v & 7;
            lru_dir<1>(A, lds, 0, n, TL + b * CTXL, CTXL, 0, CTXL, 0.f, he, ap);
            if (tid >= 448) HLAST[(b * 2 + 0) * 512 + 64 * n + c] = he;
            VM_WAIT(); __syncthreads();
            lru_dir<2>(A, lds, 1, n, TL + b * CTXL, CTXL, 0, CTXL, 0.f, he, ap);
            if (tid >= 448) HLAST[(b * 2 + 1) * 512 + 64 * n + c] = he; }
    }
}
__device__ __forceinline__ void p4_lru_pass2(KAREF A, LAS unsigned char* lds, int G) {
    const int tid = threadIdx.x, c = tid & 63;
    const f32x2* CARRY = (const f32x2*)(A.ws + WS_CARRY); const float* HLAST = (const float*)(A.ws + WS_HLAST);
    for (int u = blockIdx.x; u < 256; u += G) {
        const int b = u >> 6, n = (u >> 3) & 7, s = u & 7; float he, ap;
        float hf0 = HLAST[(b * 2 + 0) * 512 + 64 * n + c], hb0 = HLAST[(b * 2 + 1) * 512 + 64 * n + c];
        for (int s2 = 0; s2 < s; ++s2) { const f32x2 t = CARRY[(size_t)((b * 8 + s2) * 2 + 0) * 512 + 64 * n + c]; hf0 = t.x * hf0 + t.y; }
        for (int s2 = 7; s2 > s; --s2) { const f32x2 t = CARRY[(size_t)((b * 8 + s2) * 2 + 1) * 512 + 64 * n + c]; hb0 = t.x * hb0 + t.y; }
        lru_dir<1>(A, lds, 0, n, b * SEQ, SEQ, s * 1024, s * 1024 + 1024, hf0, he, ap);
        VM_WAIT(); __syncthreads();
        lru_dir<2>(A, lds, 1, n, b * SEQ, SEQ, s * 1024, s * 1024 + 1024, hb0, he, ap);
    }
}

struct EpiResid {
    static constexpr bool PERM = false;
    const float* src_lat; const float* src_ctx; float* dst_lat; float* dst_ctx; const float* gate;
    __device__ __forceinline__ void operator()(const f32x4 (&acc)[2][2][4][2], const pg8::Unit& u, int wr, int wc, int fr, int fq) const {
        const int row0 = u.pm * 256 + wr * 64 + fr, col0 = u.pn * 256 + wc * 32 + 4 * fq;
        const bool lat = u.pm < TL / 256; const int r = lat ? (u.pm >> 5) : 4;
        const float* src = lat ? src_lat + (size_t)row0 * DM : src_ctx + (size_t)(row0 - TL) * DM; float* dst = lat ? dst_lat + (size_t)row0 * DM : dst_ctx + (size_t)(row0 - TL) * DM;
        f32x4 gv[2][2];
#pragma unroll
        for (int bj = 0; bj < 2; ++bj)
#pragma unroll
            for (int n = 0; n < 2; ++n) gv[bj][n] = *(const f32x4*)(gate + (size_t)r * 6144 + col0 + bj * 128 + n * 16);
#pragma unroll
        for (int ai = 0; ai < 2; ++ai)
#pragma unroll
            for (int m = 0; m < 4; ++m) { const size_t off = (size_t)(ai * 128 + m * 16) * DM + col0;
#pragma unroll
                for (int bj = 0; bj < 2; ++bj)
#pragma unroll
                    for (int n = 0; n < 2; ++n) { const f32x4 s = *(const f32x4*)(src + off + bj * 128 + n * 16); *(f32x4*)(dst + off + bj * 128 + n * 16) = s + gv[bj][n] * acc[ai][bj][m][n]; }
                asm volatile("" ::: "memory"); }
    }
};
__device__ __forceinline__ void p4_attention(KAREF A, char* lds, int G) {
    const float* QR = (const float*)(A.ws + WS_ACT + A_QR); const attn_body::bf16* KN = (const attn_body::bf16*)(A.ws + WS_ACT + A_KN); const attn_body::bf16* VB = (const attn_body::bf16*)(A.ws + WS_ACT + A_VB);
    attn_body::bf16* YC = (attn_body::bf16*)(A.ws + WS_ACT + A_YCAT); const float* tab = (const float*)(A.ws + WS_ROPE); const float* qg = A.in[I0_QG];
    const int vcu = (G % 8 == 0) ? (int)((blockIdx.x % 8) * (G / 8) + blockIdx.x / 8) : (int)blockIdx.x;
    for (int u = vcu; u < 1024 + 32; u += G) {
        if (u < 1024) { const int bh = u >> 5, qb = u & 31, b = bh >> 3, h = bh & 7;
            attn_body::attn_unit<8>(b * SEQ + qb * 256, h, b * KVL, KVL / 64, 1, qb * 256, QR, qg, tab, KN, VB, YC, lds); }
        else { const int v = u - 1024, b = v >> 3, h = v & 7;
            attn_body::attn_unit<8>(TL + b * CTXL, h, b * KVL + SEQ, CTXL / 64, 0, 0, QR, qg, tab, KN, VB, YC, lds); }
    }
}

__device__ __forceinline__ void p6_norm_router(KAREF A, LAS unsigned char* lds, int G, int layer, int nrows) {
    const int tid = threadIdx.x, lane = tid & 63, wave = tid >> 6, gw = blockIdx.x * 8 + wave, ngw = G * 8;
    LAS float* RT = (LAS float*)lds;
    const float* router = A.in[layer ? I1_ROUTER : I0_ROUTER];
    for (int i = tid; i < 16 * 1024; i += 512) { const int k = i >> 4, e = i & 15; RT[e * 1024 + k] = router[i]; }
    __syncthreads();
    bf16_t* H2 = (bf16_t*)(A.ws + WS_ACT + A_H2); float* AFFL = (float*)(A.ws + WS_AFFL); float* AFFC = (float*)(A.ws + WS_AFFC);
    const float* gain = A.in[layer ? I1_NFFN : I0_NFFN];
    for (int m = gw; m < nrows; m += ngw) {
        const float* xr = xs_row(A, m); const int r = mod_row(m);
        const float* sh = ada_ptr(A.ws, layer, r, 3); const float* sc = ada_ptr(A.ws, layer, r, 4);
        f32x4 v[4]; float ss = 0.f;
#pragma unroll
        for (int j = 0; j < 4; ++j) { v[j] = *(const f32x4*)(xr + 4 * (lane + 64 * j)); ss += (v[j].x * v[j].x + v[j].y * v[j].y) + (v[j].z * v[j].z + v[j].w * v[j].w); }
        const float rs = __builtin_amdgcn_rsqf(wave_sum(ss) * (1.f / DM) + 1e-6f);
        float pe[16];
#pragma unroll
        for (int e = 0; e < 16; ++e) pe[e] = 0.f;
#pragma unroll
        for (int j = 0; j < 4; ++j) { const int col = 4 * (lane + 64 * j);
            const f32x4 g = *(const f32x4*)(gain + col), a = *(const f32x4*)(sc + col), b = *(const f32x4*)(sh + col);
            const f32x4 y = v[j] * rs * g * (a + 1.0f) + b;
            u32x2 w; w.x = cvt_pk_bf16(y.x, y.y); w.y = cvt_pk_bf16(y.z, y.w);
            *(u32x2*)(H2 + (size_t)m * DM + col) = w;
#pragma unroll
            for (int e = 0; e < 16; ++e) { const f32x4 rw = *(const LAS f32x4*)(RT + e * 1024 + col); pe[e] += (y.x * rw.x + y.y * rw.y) + (y.z * rw.z + y.w * rw.w); } }
#pragma unroll
        for (int i = 0; i < 8; ++i) { const bool up = (lane & 32) != 0; const float send = up ? pe[i] : pe[i + 8], keep = up ? pe[i + 8] : pe[i]; pe[i] = keep + __shfl_xor(send, 32); }
#pragma unroll
        for (int i = 0; i < 4; ++i) { const bool up = (lane & 16) != 0; const float send = up ? pe[i] : pe[i + 4], keep = up ? pe[i + 4] : pe[i]; pe[i] = keep + __shfl_xor(send, 16); }
#pragma unroll
        for (int i = 0; i < 2; ++i) { const bool up = (lane & 8) != 0; const float send = up ? pe[i] : pe[i + 2], keep = up ? pe[i + 2] : pe[i]; pe[i] = keep + __shfl_xor(send, 8); }
        { const bool up = (lane & 4) != 0; const float send = up ? pe[0] : pe[1], keep = up ? pe[1] : pe[0]; pe[0] = keep + __shfl_xor(send, 4); }
        float lg = pe[0]; lg += __shfl_xor(lg, 2); lg += __shfl_xor(lg, 1);
        float mx = lg;
#pragma unroll
        for (int o = 4; o < 64; o <<= 1) mx = fmaxf(mx, __shfl_xor(mx, o));
        const float ex = expf(lg - mx); float sm = ex;
#pragma unroll
        for (int o = 4; o < 64; o <<= 1) sm += __shfl_xor(sm, o);
        const float aff = ex / sm; const int e = (lane >> 2) & 15;
        if ((lane & 3) == 0) { if (m < TL) AFFL[(size_t)((m >> 13) * 16 + e) * SEQ + (m & 8191)] = aff; else { const int j = m - TL; AFFC[(size_t)((j >> 8) * 16 + e) * CTXL + (j & 255)] = aff; } }
    }
}

__device__ __forceinline__ void topk_unit(const float* aff, int N, int cap, int src_row0, int xe_row0, int* SRCROW, float* GROW, int* slotmap, LAS unsigned char* lds) {
    const int tid = threadIdx.x;
    LAS unsigned* keys = (LAS unsigned*)lds;
    LAS unsigned* hist = (LAS unsigned*)(lds + 32768);
    LAS unsigned* ctl = (LAS unsigned*)(lds + 32768 + 1024);
    LAS int* tmp = (LAS int*)(lds + 32768 + 1024 + 64);
    __syncthreads();
    for (int i = tid; i < N; i += 512) keys[i] = __float_as_uint(aff[i]);
    if (tid == 0) { ctl[0] = 0u; ctl[1] = (unsigned)cap; }
    unsigned mask = 0u;
#pragma unroll 1
    for (int shift = 24; shift >= 0; shift -= 8) {
        if (tid < 256) hist[tid] = 0u;
        __syncthreads();
        const unsigned prefix = ctl[0];
        for (int i = tid; i < N; i += 512) { const unsigned k = keys[i]; if ((k & mask) == prefix) __hip_atomic_fetch_add(&hist[(k >> shift) & 255u], 1u, __ATOMIC_RELAXED, __HIP_MEMORY_SCOPE_WORKGROUP); }
        __syncthreads();
        if (tid == 0) { unsigned need = ctl[1], cum = 0u; int dsel = 0;
            for (int dd = 255; dd >= 0; --dd) { const unsigned hcnt = hist[dd]; if (cum + hcnt >= need) { dsel = dd; break; } cum += hcnt; }
            ctl[0] = prefix | ((unsigned)dsel << shift); ctl[1] = need - cum; }
        mask |= 0xffu << shift;
        __syncthreads();
    }
    const unsigned tau = ctl[0]; const int need_eq = (int)ctl[1];
    const int per = N >= 512 ? N / 512 : 1; const int base = tid * per; const bool act = base < N;
    int neq = 0;
    if (act) for (int i = 0; i < per; ++i) neq += (keys[base + i] == tau) ? 1 : 0;
    int tot; int eqrank = block_excl_scan(neq, tmp, tot);
    int nsel = 0;
    if (act) { int er = eqrank; for (int i = 0; i < per; ++i) { const unsigned k = keys[base + i]; if (k > tau) ++nsel; else if (k == tau) { if (er < need_eq) ++nsel; ++er; } } }
    int slot = block_excl_scan(nsel, tmp, tot);
    if (act) { int er = eqrank; for (int i = 0; i < per; ++i) { const unsigned k = keys[base + i]; bool sel = false; if (k > tau) sel = true; else if (k == tau) { sel = er < need_eq; ++er; }
            if (sel) { SRCROW[xe_row0 + slot] = src_row0 + base + i; GROW[xe_row0 + slot] = __uint_as_float(k); slotmap[base + i] = xe_row0 + slot; ++slot; } else slotmap[base + i] = -1; } }
}
__device__ __forceinline__ void p7_topk(KAREF A, LAS unsigned char* lds, int G, bool with_ctx) {
    int* SRCROW = (int*)(A.ws + WS_SRCROW); float* GROW = (float*)(A.ws + WS_GROW);
    const int nun = with_ctx ? 128 : 64;
    for (int u = blockIdx.x; u < nun; u += G) {
        if (u < 64) { const int b = u >> 4, e = u & 15; topk_unit((const float*)(A.ws + WS_AFFL) + (size_t)u * SEQ, SEQ, CAPL, b * SEQ, (b * 16 + e) * CAPL, SRCROW, GROW, (int*)(A.ws + WS_SLOTL) + (size_t)u * SEQ, lds); }
        else { const int v = u - 64, b = v >> 4, e = v & 15; topk_unit((const float*)(A.ws + WS_AFFC) + (size_t)v * CTXL, CTXL, CAPC, TL + b * CTXL, XE_CTX0 + e * 256 + b * CAPC, SRCROW, GROW, (int*)(A.ws + WS_SLOTC) + (size_t)v * CTXL, lds); }
    }
}

__device__ __forceinline__ void p8_gather(KAREF A, int G, bool with_ctx) {
    const int lane = threadIdx.x & 63, wave = threadIdx.x >> 6, gw = blockIdx.x * 8 + wave, ngw = G * 8;
    const int* SRCROW = (const int*)(A.ws + WS_SRCROW); const bf16_t* H2 = (const bf16_t*)(A.ws + WS_ACT + A_H2); bf16_t* XE = (bf16_t*)(A.ws + WS_ACT + A_XE);
    const int nr = with_ctx ? XE_CTX0 + NE * 128 : XE_CTX0;
    for (int i = gw; i < nr; i += ngw) {
        int xr = i; if (i >= XE_CTX0) { const int j = i - XE_CTX0; xr = XE_CTX0 + (j >> 7) * 256 + (j & 127); }
        const int src = SRCROW[xr];
        const u32x4 a = *(const u32x4*)(H2 + (size_t)src * DM + 8 * lane), b = *(const u32x4*)(H2 + (size_t)src * DM + 512 + 8 * lane);
        *(u32x4*)(XE + (size_t)xr * DM + 8 * lane) = a; *(u32x4*)(XE + (size_t)xr * DM + 512 + 8 * lane) = b;
    }
}

struct MoeOrder1 {
    int G, c, nun;
    __device__ bool next(int i, pg8::Unit& u) const {
        const long L = (long)i * G + c; if (L >= nun) return false;
        if (L < 4096) { const int e = (int)(L >> 8), j = (int)(L & 255), v = (j & 7) * 32 + (j >> 3), rt = v >> 4, pnl = v & 15;
            u.am = ((rt >> 2) * 16 + e) * 4 + (rt & 3); u.bn = e * 16 + pnl; }
        else { const int j = (int)L - 4096, e = j >> 4, pnl = j & 15; u.am = XE_CTX0 / 256 + e; u.bn = e * 16 + pnl; }
        u.pm = u.am; u.pn = u.bn & 15; return true;
    }
    __device__ __forceinline__ void a_ready(const pg8::Unit&) const {}
    __device__ __forceinline__ void done(const pg8::Unit&) const {}
};
struct MoeOrder2 {
    int G, c, nun;
    __device__ bool next(int i, pg8::Unit& u) const {
        const long L = (long)i * G + c; if (L >= nun) return false;
        if (L < 1024) { const int e4 = (int)(L >> 8), j = (int)(L & 255), v = (j & 7) * 32 + (j >> 3), e = 4 * e4 + (v >> 6), w = v & 63, rt = w >> 2, pnl = w & 3;
            u.am = ((rt >> 2) * 16 + e) * 4 + (rt & 3); u.bn = e * 4 + pnl; }
        else { const int j = (int)L - 1024, e = j >> 2, pnl = j & 3; u.am = XE_CTX0 / 256 + e; u.bn = e * 4 + pnl; }
        u.pm = u.am; u.pn = u.bn & 3; return true;
    }
    __device__ __forceinline__ void a_ready(const pg8::Unit&) const {}
    __device__ __forceinline__ void done(const pg8::Unit&) const {}
};
struct EpiSwiGLU {
    static constexpr bool PERM = true;
    bf16_t* HID;
    __device__ __forceinline__ void operator()(const f32x4 (&acc)[2][2][4][2], const pg8::Unit& u, int wr, int wc, int fr, int fq) const {
        const int row0 = u.pm * 256 + wr * 64 + fr, col0 = u.pn * 128 + wc * 32 + 8 * fq;
#pragma unroll
        for (int ai = 0; ai < 2; ++ai)
#pragma unroll
            for (int m = 0; m < 4; ++m) { const f32x4 g0 = acc[ai][0][m][0], g1 = acc[ai][0][m][1], u0 = acc[ai][1][m][0], u1 = acc[ai][1][m][1];
                u32x4 w; w.x = cvt_pk_bf16(silu_f(g0[0]) * u0[0], silu_f(g0[1]) * u0[1]); w.y = cvt_pk_bf16(silu_f(g0[2]) * u0[2], silu_f(g0[3]) * u0[3]);
                w.z = cvt_pk_bf16(silu_f(g1[0]) * u1[0], silu_f(g1[1]) * u1[1]); w.w = cvt_pk_bf16(silu_f(g1[2]) * u1[2], silu_f(g1[3]) * u1[3]);
                *(u32x4*)(HID + (size_t)(row0 + ai * 128 + m * 16) * FF + col0) = w; }
    }
};
struct EpiDown {
    static constexpr bool PERM = true;
    bf16_t* YE; const float* GROW;
    __device__ __forceinline__ void operator()(const f32x4 (&acc)[2][2][4][2], const pg8::Unit& u, int wr, int wc, int fr, int fq) const {
        const int row0 = u.pm * 256 + wr * 64 + fr, col0 = u.pn * 256 + wc * 32 + 8 * fq;
#pragma unroll
        for (int ai = 0; ai < 2; ++ai)
#pragma unroll
            for (int m = 0; m < 4; ++m) { const int row = row0 + ai * 128 + m * 16; const float gt = GROW[row];
#pragma unroll
                for (int bj = 0; bj < 2; ++bj) { const f32x4 v0 = acc[ai][bj][m][0] * gt, v1 = acc[ai][bj][m][1] * gt;
                    u32x4 w; w.x = cvt_pk_bf16(v0[0], v0[1]); w.y = cvt_pk_bf16(v0[2], v0[3]); w.z = cvt_pk_bf16(v1[0], v1[1]); w.w = cvt_pk_bf16(v1[2], v1[3]);
                    *(u32x4*)(YE + (size_t)row * DM + col0 + bj * 128) = w; } }
    }
};

__device__ __forceinline__ void p11_combine(KAREF A, int G, int layer, int nrows) {
    const int lane = threadIdx.x & 63, wave = threadIdx.x >> 6, gw = blockIdx.x * 8 + wave, ngw = G * 8;
    const bf16_t* YE = (const bf16_t*)(A.ws + WS_ACT + A_YE); const int* SLOTL = (const int*)(A.ws + WS_SLOTL); const int* SLOTC = (const int*)(A.ws + WS_SLOTC);
    for (int m = gw; m < nrows; m += ngw) {
        int sm = -1;
        if (lane < 16) { if (m < TL) sm = SLOTL[(size_t)((m >> 13) * 16 + lane) * SEQ + (m & 8191)]; else { const int j = m - TL; sm = SLOTC[(size_t)((j >> 8) * 16 + lane) * CTXL + (j & 255)]; } }
        unsigned long long bal = __ballot(sm >= 0);
        f32x4 acc[4];
#pragma unroll
        for (int j = 0; j < 4; ++j) acc[j] = (f32x4){0.f, 0.f, 0.f, 0.f};
        while (bal) { const int e = __builtin_ctzll(bal); bal &= bal - 1; const int xr = __shfl(sm, e);
#pragma unroll
            for (int j = 0; j < 4; ++j) { const u32x2 w = *(const u32x2*)(YE + (size_t)xr * DM + 4 * (lane + 64 * j)); acc[j] += (f32x4){bflo(w.x), bfhi(w.x), bflo(w.y), bfhi(w.y)}; } }
        float* xr_ = xs_row_w(A, m); const float* gt = ada_ptr(A.ws, layer, mod_row(m), 5);
#pragma unroll
        for (int j = 0; j < 4; ++j) { const int col = 4 * (lane + 64 * j); const f32x4 x = *(const f32x4*)(xr_ + col), g = *(const f32x4*)(gt + col); *(f32x4*)(xr_ + col) = x + g * acc[j]; }
    }
}
__device__ __forceinline__ void l1_h_row(const float* xr, const float* gain, const float* sh, const float* sc, int lane, f32x4 (&h)[4]) {
    f32x4 v[4]; float ss = 0.f;
#pragma unroll
    for (int j = 0; j < 4; ++j) { v[j] = *(const f32x4*)(xr + 4 * (lane + 64 * j)); ss += (v[j].x * v[j].x + v[j].y * v[j].y) + (v[j].z * v[j].z + v[j].w * v[j].w); }
    const float rs = __builtin_amdgcn_rsqf(wave_sum(ss) * (1.f / DM) + 1e-6f);
#pragma unroll
    for (int j = 0; j < 4; ++j) { const int col = 4 * (lane + 64 * j); const f32x4 g = *(const f32x4*)(gain + col), a = *(const f32x4*)(sc + col), b = *(const f32x4*)(sh + col); h[j] = v[j] * rs * g * (a + 1.0f) + b; }
}
__device__ __forceinline__ void p12_l1_prep(KAREF A, int G) {
    const int lane = threadIdx.x & 63, wave = threadIdx.x >> 6, gw = blockIdx.x * 8 + wave, ngw = G * 8;
    bf16_t* XMIX = (bf16_t*)(A.ws + WS_ACT + A_XMIX); const float* gain = A.in[I1_NMIX]; const float* mu = A.in[I1_MU];
    for (int m = gw; m < TT; m += ngw) {
        const int r = mod_row(m); const float* sh = ada_ptr(A.ws, 1, r, 0); const float* sc = ada_ptr(A.ws, 1, r, 1);
        const int t = m < TL ? (m & 8191) : ((m - TL) & 255), Ls = m < TL ? SEQ : CTXL;
        f32x4 h[4], hp[4], hn[4];
        l1_h_row(xs_row(A, m), gain, sh, sc, lane, h);
        if (t > 0) l1_h_row(xs_row(A, m - 1), gain, sh, sc, lane, hp); else {
#pragma unroll
            for (int j = 0; j < 4; ++j) hp[j] = (f32x4){0.f, 0.f, 0.f, 0.f}; }
        if (t < Ls - 1) l1_h_row(xs_row(A, m + 1), gain, sh, sc, lane, hn); else {
#pragma unroll
            for (int j = 0; j < 4; ++j) hn[j] = (f32x4){0.f, 0.f, 0.f, 0.f}; }
#pragma unroll
        for (int j = 0; j < 4; ++j) { const int col = 4 * (lane + 64 * j); const f32x4 xx = (hp[j] + hn[j]) * 0.5f - h[j];
#pragma unroll
            for (int q = 0; q < 6; ++q) { const f32x4 mq = *(const f32x4*)(mu + q * DM + col); const f32x4 y = h[j] + xx * mq;
                u32x2 w; w.x = cvt_pk_bf16(y.x, y.y); w.y = cvt_pk_bf16(y.z, y.w);
                *(u32x2*)(XMIX + (size_t)q * TT * DM + (size_t)m * DM + col) = w; } }
    }
}

struct MixOrder {
    int G, c;
    __device__ bool next(int i, pg8::Unit& u) const {
        const long L = (long)i * G + c; if (L >= 132 * 15) return false;
        const int wgid = (int)L; const int grp = wgid / (8 * 15), w = wgid % (8 * 15), fm = grp * 8, gsz = (132 - fm) < 8 ? (132 - fm) : 8;
        u.pm = fm + w % gsz; u.pn = w / gsz;
        const int sel = u.pn < 4 ? 0 : u.pn < 8 ? 2 : u.pn < 12 ? 3 : u.pn == 12 ? 5 : u.pn == 13 ? 1 : 4;
        u.am = sel * 132 + u.pm; u.bn = u.pn; return true;
    }
    __device__ __forceinline__ void a_ready(const pg8::Unit&) const {}
    __device__ __forceinline__ void done(const pg8::Unit&) const {}
};
struct EpiMix {
    static constexpr bool PERM = true;
    bf16_t* RKV; bf16_t* LG; bf16_t* LWA;
    __device__ __forceinline__ void operator()(const f32x4 (&acc)[2][2][4][2], const pg8::Unit& u, int wr, int wc, int fr, int fq) const {
        const int row0 = u.pm * 256 + wr * 64 + fr, tile = u.pn;
#pragma unroll
        for (int ai = 0; ai < 2; ++ai)
#pragma unroll
            for (int m = 0; m < 4; ++m) { const int row = row0 + ai * 128 + m * 16;
#pragma unroll
                for (int bj = 0; bj < 2; ++bj) { const int colt = bj * 128 + wc * 32 + 8 * fq; f32x4 v0 = acc[ai][bj][m][0], v1 = acc[ai][bj][m][1];
                    if (tile == 12) {
#pragma unroll
                        for (int i = 0; i < 4; ++i) { v0[i] = sigm(v0[i]); v1[i] = sigm(v1[i]); } }
                    if (tile == 13) {
#pragma unroll
                        for (int i = 0; i < 4; ++i) { v0[i] = tanh_f(v0[i]); v1[i] = tanh_f(v1[i]); } }
                    u32x4 w; w.x = cvt_pk_bf16(v0[0], v0[1]); w.y = cvt_pk_bf16(v0[2], v0[3]); w.z = cvt_pk_bf16(v1[0], v1[1]); w.w = cvt_pk_bf16(v1[2], v1[3]);
                    if (tile < 12) *(u32x4*)(RKV + (size_t)(tile >> 2) * TT * DM + (size_t)row * DM + (tile & 3) * 256 + colt) = w;
                    else if (tile == 12) *(u32x4*)(LG + (size_t)row * 256 + colt) = w;
                    else if (bj == 0) *(u32x4*)(LWA + (size_t)row * 256 + (tile - 13) * 128 + colt) = w; } }
    }
};
struct LoraOrder {
    int G, c;
    __device__ bool next(int i, pg8::Unit& u) const {
        const long L = (long)i * G + c; if (L >= 132 * 20) return false;
        const int wgid = (int)L; const int grp = wgid / (8 * 20), w = wgid % (8 * 20), fm = grp * 8, gsz = (132 - fm) < 8 ? (132 - fm) : 8;
        u.pm = fm + w % gsz; u.pn = w / gsz; u.am = (u.pn < 16 ? 132 : 0) + u.pm; u.bn = u.pn; return true;
    }
    __device__ __forceinline__ void a_ready(const pg8::Unit&) const {}
    __device__ __forceinline__ void done(const pg8::Unit&) const {}
};
struct EpiLora {
    static constexpr bool PERM = true;
    bf16_t* SD; bf16_t* AD; bf16_t* Gg; const float* w0; const float* a0;
    __device__ __forceinline__ void operator()(const f32x4 (&acc)[2][2][4][2], const pg8::Unit& u, int wr, int wc, int fr, int fq) const {
        const int row0 = u.pm * 256 + wr * 64 + fr, tile = u.pn, kind = tile >> 2;
        bf16_t* dst = kind < 2 ? SD + (size_t)kind * TT * DM : kind < 4 ? AD + (size_t)(kind - 2) * TT * DM : Gg;
        const float* bias = kind < 2 ? w0 + kind * DM : a0 + (kind - 2) * DM;
#pragma unroll
        for (int ai = 0; ai < 2; ++ai)
#pragma unroll
            for (int m = 0; m < 4; ++m) { const int row = row0 + ai * 128 + m * 16;
#pragma unroll
                for (int bj = 0; bj < 2; ++bj) { const int col = (tile & 3) * 256 + bj * 128 + wc * 32 + 8 * fq;
                    f32x4 v0 = acc[ai][bj][m][0], v1 = acc[ai][bj][m][1];
                    if (kind < 4) { v0 += *(const f32x4*)(bias + col); v1 += *(const f32x4*)(bias + col + 4);
#pragma unroll
                        for (int i = 0; i < 4; ++i) { v0[i] = sigm(v0[i]); v1[i] = sigm(v1[i]); } }
                    u32x4 w; w.x = cvt_pk_bf16(v0[0], v0[1]); w.y = cvt_pk_bf16(v0[2], v0[3]); w.z = cvt_pk_bf16(v1[0], v1[1]); w.w = cvt_pk_bf16(v1[2], v1[3]);
                    *(u32x4*)(dst + (size_t)row * DM + col) = w; }
                asm volatile("" ::: "memory"); }
    }
};

#define DPP_ADD(x, ctrl) ((x) + __builtin_bit_cast(float, __builtin_amdgcn_update_dpp(0, __builtin_bit_cast(int, (x)), (ctrl), 0xf, 0xf, true)))
__device__ __forceinline__ float rowsum16(float x) { x = DPP_ADD(x, 0xB1); x = DPP_ADD(x, 0x4E); x = DPP_ADD(x, 0x141); x = DPP_ADD(x, 0x140); return x; }
constexpr int WKV_TB = 32, WKV_STEP_F = 6 * 64, WKV_BUF_F = WKV_TB * WKV_STEP_F;
__device__ __forceinline__ int wkv_row(int b, int d, int i) { return i < CTXL ? TL + b * CTXL + (d ? CTXL - 1 - i : i) : b * SEQ + (d ? SEQ - 1 - (i - CTXL) : (i - CTXL)); }
__device__ __forceinline__ void p15_wkv(KAREF A, LAS unsigned char* lds, int G) {
    const int tid = threadIdx.x, lane = tid & 63, wid = tid >> 6;
    LAS float* BUF = (LAS float*)lds;
    LAS float* YB = (LAS float*)(lds + 2 * WKV_BUF_F * 4);
    const bf16_t* R = (const bf16_t*)(A.ws + WS_ACT + A_RKV); const bf16_t* Kk = R + (size_t)TT * DM; const bf16_t* V = Kk + (size_t)TT * DM;
    for (int u = blockIdx.x; u < 256; u += G) {
        const int chain = u >> 1, half = u & 1, b = chain >> 5, h = (chain >> 1) & 15, d = chain & 1;
        const bf16_t* SD = (const bf16_t*)(A.ws + WS_ACT + A_SD) + (size_t)d * TT * DM; const bf16_t* AD = (const bf16_t*)(A.ws + WS_ACT + A_AD) + (size_t)d * TT * DM;
        bf16_t* YD = (bf16_t*)(A.ws + WS_ACT + (d ? A_YD1 : A_YD0));
        const int ls = tid >> 4, lc = 4 * (tid & 15), hc = h * 64 + lc;
        const f32x4 kkw = *(const f32x4*)(A.in[I1_KK] + hc), kaw = *(const f32x4*)(A.in[I1_KA] + hc);
        u32x2 gr, gk, gv, gs, ga;
#define WKV_LOAD(blk) do { const size_t ro = (size_t)wkv_row(b, d, (blk) * WKV_TB + ls) * DM + hc; gr = *(const u32x2*)(R + ro); gk = *(const u32x2*)(Kk + ro); gv = *(const u32x2*)(V + ro); gs = *(const u32x2*)(SD + ro); ga = *(const u32x2*)(AD + ro); } while (0)
#define WKV_STORE(bufi) do { LAS float* dst = BUF + (bufi) * WKV_BUF_F + ls * WKV_STEP_F + lc; \
        const f32x4 kf = (f32x4){bflo(gk.x), bfhi(gk.x), bflo(gk.y), bfhi(gk.y)}, af = (f32x4){bflo(ga.x), bfhi(ga.x), bflo(ga.y), bfhi(ga.y)}, sf = (f32x4){bflo(gs.x), bfhi(gs.x), bflo(gs.y), bfhi(gs.y)}; \
        const f32x4 kkv = kf * kkw; float ssq = (kkv.x * kkv.x + kkv.y * kkv.y) + (kkv.z * kkv.z + kkv.w * kkv.w); ssq = rowsum16(ssq); \
        const f32x4 kkn = kkv * __builtin_amdgcn_rsqf(fmaxf(ssq, 1e-24f)); \
        f32x4 wd; wd.x = fexp(-0.6065306597126334f * sf.x); wd.y = fexp(-0.6065306597126334f * sf.y); wd.z = fexp(-0.6065306597126334f * sf.z); wd.w = fexp(-0.6065306597126334f * sf.w); \
        *(LAS f32x4*)(dst) = wd; *(LAS f32x4*)(dst + 64) = -kkn; *(LAS f32x4*)(dst + 128) = kkn * af; *(LAS f32x4*)(dst + 192) = kf * ((af - 1.0f) * kaw + 1.0f); \
        *(LAS f32x4*)(dst + 256) = (f32x4){bflo(gr.x), bfhi(gr.x), bflo(gr.y), bfhi(gr.y)}; *(LAS f32x4*)(dst + 320) = (f32x4){bflo(gv.x), bfhi(gv.x), bflo(gv.y), bfhi(gv.y)}; } while (0)
        __syncthreads();
        WKV_LOAD(0); WKV_STORE(0);
        __syncthreads();
        const int g = lane >> 4, j = lane & 15, vrow = 32 * half + 4 * wid + g;
        float S0 = 0.f, S1 = 0.f, S2 = 0.f, S3 = 0.f;
        constexpr int NBLK = (CTXL + SEQ) / WKV_TB;
#pragma unroll 1
        for (int blk = 0; blk < NBLK; ++blk) {
            const int cur = blk & 1;
            if (blk + 1 < NBLK) WKV_LOAD(blk + 1);
            const LAS float* bp = BUF + cur * WKV_BUF_F + 4 * j;
#pragma unroll 4
            for (int t = 0; t < WKV_TB; ++t) {
                const LAS float* sp = bp + t * WKV_STEP_F;
                const f32x4 w4 = *(const LAS f32x4*)(sp), a4 = *(const LAS f32x4*)(sp + 64), b4 = *(const LAS f32x4*)(sp + 128), k4 = *(const LAS f32x4*)(sp + 192), r4 = *(const LAS f32x4*)(sp + 256);
                const float v1 = BUF[cur * WKV_BUF_F + t * WKV_STEP_F + 320 + vrow];
                float sa = (S0 * a4.x + S1 * a4.y) + (S2 * a4.z + S3 * a4.w); sa = rowsum16(sa);
                S0 = S0 * w4.x + (sa * b4.x + v1 * k4.x); S1 = S1 * w4.y + (sa * b4.y + v1 * k4.y); S2 = S2 * w4.z + (sa * b4.z + v1 * k4.z); S3 = S3 * w4.w + (sa * b4.w + v1 * k4.w);
                float y = (S0 * r4.x + S1 * r4.y) + (S2 * r4.z + S3 * r4.w); y = rowsum16(y);
                if (j == 0) YB[t * 32 + 4 * wid + g] = y;
            }
            __syncthreads();
            if (blk * WKV_TB >= CTXL) {
                const int m = wkv_row(b, d, blk * WKV_TB + ls); const int r2 = 2 * (tid & 15);
                *(unsigned*)(YD + (size_t)m * DM + h * 64 + 32 * half + r2) = cvt_pk_bf16(YB[ls * 32 + r2], YB[ls * 32 + r2 + 1]); }
            if (blk + 1 < NBLK) WKV_STORE(cur ^ 1);
            __syncthreads();
        }
#undef WKV_LOAD
#undef WKV_STORE
    }
}

__device__ __forceinline__ void p16_readout(KAREF A, int G) {
    const int lane = threadIdx.x & 63, wave = threadIdx.x >> 6, gw = blockIdx.x * 8 + wave, ngw = G * 8;
    const bf16_t* R = (const bf16_t*)(A.ws + WS_ACT + A_RKV); const bf16_t* Kk = R + (size_t)TT * DM; const bf16_t* V = Kk + (size_t)TT * DM;
    const bf16_t* AD0 = (const bf16_t*)(A.ws + WS_ACT + A_AD); const bf16_t* AD1 = AD0 + (size_t)TT * DM; const bf16_t* Gg = (const bf16_t*)(A.ws + WS_ACT + A_G);
    const bf16_t* Y0 = (const bf16_t*)(A.ws + WS_ACT + A_YD0); const bf16_t* Y1 = (const bf16_t*)(A.ws + WS_ACT + A_YD1); bf16_t* O = (bf16_t*)(A.ws + WS_ACT + A_O);
    const int c0 = 16 * lane;
    float ka[16], rk[16], gng[16], gnb[16];
#pragma unroll
    for (int i = 0; i < 16; ++i) { ka[i] = A.in[I1_KA][c0 + i]; rk[i] = A.in[I1_RK][c0 + i]; gng[i] = A.in[I1_GNG][c0 + i]; gnb[i] = A.in[I1_GNB][c0 + i]; }
    for (int m = gw; m < TL; m += ngw) {
        const size_t o = (size_t)m * DM + c0;
        float y[16], rr[16], kk[16], vv[16], a0[16], a1[16], gg[16];
#define LD16(dst, P) do { const u32x4 w0 = *(const u32x4*)((P) + o), w1 = *(const u32x4*)((P) + o + 8); dst[0] = bflo(w0.x); dst[1] = bfhi(w0.x); dst[2] = bflo(w0.y); dst[3] = bfhi(w0.y); dst[4] = bflo(w0.z); dst[5] = bfhi(w0.z); dst[6] = bflo(w0.w); dst[7] = bfhi(w0.w); \
        dst[8] = bflo(w1.x); dst[9] = bfhi(w1.x); dst[10] = bflo(w1.y); dst[11] = bfhi(w1.y); dst[12] = bflo(w1.z); dst[13] = bfhi(w1.z); dst[14] = bflo(w1.w); dst[15] = bfhi(w1.w); } while (0)
        LD16(y, Y0); LD16(rr, Y1);
#pragma unroll
        for (int i = 0; i < 16; ++i) y[i] += rr[i];
        LD16(rr, R); LD16(kk, Kk); LD16(vv, V); LD16(a0, AD0); LD16(a1, AD1); LD16(gg, Gg);
#undef LD16
        float s = 0.f, bs = 0.f;
#pragma unroll
        for (int i = 0; i < 16; ++i) { s += y[i]; bs += rr[i] * kk[i] * rk[i] * (2.0f + (a0[i] + a1[i] - 2.0f) * ka[i]); }
        s += __shfl_xor(s, 1); s += __shfl_xor(s, 2); bs += __shfl_xor(bs, 1); bs += __shfl_xor(bs, 2);
        const float mean = s * (1.f / 64.f); float q = 0.f;
#pragma unroll
        for (int i = 0; i < 16; ++i) { const float dlt = y[i] - mean; q += dlt * dlt; }
        q += __shfl_xor(q, 1); q += __shfl_xor(q, 2);
        const float rstd = __builtin_amdgcn_rsqf(q * (1.f / 64.f) + 64e-5f);
        unsigned w[8];
#pragma unroll
        for (int i = 0; i < 8; ++i) { const float o0 = ((y[2 * i] - mean) * rstd * gng[2 * i] + gnb[2 * i] + bs * vv[2 * i]) * gg[2 * i], o1 = ((y[2 * i + 1] - mean) * rstd * gng[2 * i + 1] + gnb[2 * i + 1] + bs * vv[2 * i + 1]) * gg[2 * i + 1];
            w[i] = cvt_pk_bf16(o0, o1); }
        *(u32x4*)(O + o) = (u32x4){w[0], w[1], w[2], w[3]}; *(u32x4*)(O + o + 8) = (u32x4){w[4], w[5], w[6], w[7]};
    }
}
constexpr int N_PHASES = 24;
__global__ void __launch_bounds__(512, 2) fwd_kernel(KArgs A_unused) {
    const __attribute__((address_space(4))) KArgs* kp = (const __attribute__((address_space(4))) KArgs*)__builtin_amdgcn_kernarg_segment_ptr();
    extern __shared__ __attribute__((aligned(16))) unsigned char lds_raw[];
    LAS unsigned char* lds = (LAS unsigned char*)lds_raw;
    const int G = gridDim.x, tid = threadIdx.x;
    for (int u = tid; u < (LDS_BYTES - LDSCTL_OFF) / 4; u += 512) ((LAS unsigned*)(lds + LDSCTL_OFF))[u] = 0u;
    __syncthreads();
    const int lo = kp->ph_lo, hi = kp->ph_hi;
    const bool use_bar = (hi - lo) > 1;
    XcdBarrier bar; bar.bar = (unsigned*)(kp->ws + WS_CTL) + 4096; bar.x = 0; bar.st = (volatile LAS unsigned*)(lds + MISC_OFF) + 8;
    if (use_bar) bar = xcd_barrier_post((unsigned*)(kp->ws + WS_CTL) + 4096, (volatile LAS unsigned*)(lds + MISC_OFF) + 8);
#ifndef ONLY_PHASE
#define ONLY_PHASE -1
#endif
#ifndef DBG_STOP
#define DBG_STOP 99
#endif
#define IN(k) ((ONLY_PHASE < 0 || ONLY_PHASE == (k)) && (k) < DBG_STOP && lo <= (k) && (k) < hi)
#define SEAM(k) do { if (IN(k) && IN((k) + 1)) xcd_barrier(bar); } while (0)

    if (IN(0)) { KAREF A = *ka_launder(kp); unsigned char* ws = A.ws; unsigned char* act = ws + WS_ACT; (void)act; p0_prologue(A, lds, G); } SEAM(0);
    if (IN(1)) { KAREF A = *ka_launder(kp); unsigned char* ws = A.ws; unsigned char* act = ws + WS_ACT; (void)act; p1_norm0(A, G); } SEAM(1);
    if (IN(2)) { KAREF A = *ka_launder(kp); unsigned char* ws = A.ws; unsigned char* act = ws + WS_ACT; (void)act;
        pg8::Gemm g{(const bf16_t*)(act + A_H), (const bf16_t*)(ws + WS_WIN), DM}; pg8::StaticOrder S; S.init(TT, 1792, G, (int)blockIdx.x);
        EpiWin E{(bf16_t*)(act + A_XA), (bf16_t*)(act + A_GA), (float*)(act + A_QR), (float*)(act + A_KR), (bf16_t*)(act + A_VB)};
        pg8::gemm_phase<EpiWin, pg8::StaticOrder, true, true>(lds + RING_OFF, g, S, E);
    } SEAM(2);
    if (IN(3)) { KAREF A = *ka_launder(kp); unsigned char* ws = A.ws; unsigned char* act = ws + WS_ACT; (void)act; p3_kprep(A, G); p3_lru_pass1(A, lds, G); } SEAM(3);
    if (IN(4)) { KAREF A = *ka_launder(kp); unsigned char* ws = A.ws; unsigned char* act = ws + WS_ACT; (void)act; p4_lru_pass2(A, lds, G); __syncthreads(); p4_attention(A, (char*)lds_raw + RING_OFF, G); } SEAM(4);
    if (IN(5)) { KAREF A = *ka_launder(kp); unsigned char* ws = A.ws; unsigned char* act = ws + WS_ACT; (void)act;
        pg8::Gemm g{(const bf16_t*)(act + A_YCAT), (const bf16_t*)(ws + WS_WOUT), DM}; pg8::StaticOrder S; S.init(TT, DM, G, (int)blockIdx.x);
        EpiResid E{A.in[I_X], A.in[I_CTX], A.out, (float*)(ws + WS_CTXS), ada_ptr(ws, 0, 0, 2)};
        pg8::gemm_phase<EpiResid, pg8::StaticOrder, true, true>(lds + RING_OFF, g, S, E);
    } SEAM(5);
    if (IN(6)) { KAREF A = *ka_launder(kp); unsigned char* ws = A.ws; unsigned char* act = ws + WS_ACT; (void)act; p6_norm_router(A, lds, G, 0, TT); } SEAM(6);
    if (IN(7)) { KAREF A = *ka_launder(kp); unsigned char* ws = A.ws; unsigned char* act = ws + WS_ACT; (void)act; p7_topk(A, lds, G, true); } SEAM(7);
    if (IN(8)) { KAREF A = *ka_launder(kp); unsigned char* ws = A.ws; unsigned char* act = ws + WS_ACT; (void)act; p8_gather(A, G, true); } SEAM(8);
    if (IN(9)) { KAREF A = *ka_launder(kp); unsigned char* ws = A.ws; unsigned char* act = ws + WS_ACT; (void)act;
        pg8::Gemm g{(const bf16_t*)(act + A_XE), (const bf16_t*)(ws + WS_MOEW1), DM}; MoeOrder1 S{G, (int)blockIdx.x, 4096 + 256};
        EpiSwiGLU E{(bf16_t*)(act + A_HID)};
        pg8::gemm_phase<EpiSwiGLU, MoeOrder1, true, true>(lds + RING_OFF, g, S, E);
    } SEAM(9);
    if (IN(10)) { KAREF A = *ka_launder(kp); unsigned char* ws = A.ws; unsigned char* act = ws + WS_ACT; (void)act;
        pg8::Gemm g{(const bf16_t*)(act + A_HID), (const bf16_t*)(ws + WS_MOEW2), FF}; MoeOrder2 S{G, (int)blockIdx.x, 1024 + 64};
        EpiDown E{(bf16_t*)(act + A_YE), (const float*)(ws + WS_GROW)};
        pg8::gemm_phase<EpiDown, MoeOrder2, true, true>(lds + RING_OFF, g, S, E);
    } SEAM(10);
    if (IN(11)) { KAREF A = *ka_launder(kp); unsigned char* ws = A.ws; unsigned char* act = ws + WS_ACT; (void)act; p11_combine(A, G, 0, TT); } SEAM(11);
    if (IN(12)) { KAREF A = *ka_launder(kp); unsigned char* ws = A.ws; unsigned char* act = ws + WS_ACT; (void)act; p12_l1_prep(A, G); { const int wave = tid >> 6; moe_convert(A, 1, lds, blockIdx.x * 8 + wave, G * 8, wave, tid & 63); } } SEAM(12);
    if (IN(13)) { KAREF A = *ka_launder(kp); unsigned char* ws = A.ws; unsigned char* act = ws + WS_ACT; (void)act;
        pg8::Gemm g{(const bf16_t*)(act + A_XMIX), (const bf16_t*)(ws + WS_BMIX), DM}; MixOrder S{G, (int)blockIdx.x};
        EpiMix E{(bf16_t*)(act + A_RKV), (bf16_t*)(act + A_LG), (bf16_t*)(act + A_LWA)};
        pg8::gemm_phase<EpiMix, MixOrder, true, true>(lds + RING_OFF, g, S, E);
    } SEAM(13);
    if (IN(14)) { KAREF A = *ka_launder(kp); unsigned char* ws = A.ws; unsigned char* act = ws + WS_ACT; (void)act;
        pg8::Gemm g{(const bf16_t*)(act + A_LG), (const bf16_t*)(ws + WS_B2), 256}; LoraOrder S{G, (int)blockIdx.x};
        EpiLora E{(bf16_t*)(act + A_SD), (bf16_t*)(act + A_AD), (bf16_t*)(act + A_G), A.in[I1_W0], A.in[I1_A0]};
        pg8::gemm_phase<EpiLora, LoraOrder, true, true>(lds + RING_OFF, g, S, E);
    } SEAM(14);
    if (IN(15)) { KAREF A = *ka_launder(kp); unsigned char* ws = A.ws; unsigned char* act = ws + WS_ACT; (void)act; p15_wkv(A, lds, G); } SEAM(15);
    if (IN(16)) { KAREF A = *ka_launder(kp); unsigned char* ws = A.ws; unsigned char* act = ws + WS_ACT; (void)act; p16_readout(A, G); } SEAM(16);
    if (IN(17)) { KAREF A = *ka_launder(kp); unsigned char* ws = A.ws; unsigned char* act = ws + WS_ACT; (void)act;
        pg8::Gemm g{(const bf16_t*)(act + A_O), (const bf16_t*)(ws + WS_WO), DM}; pg8::StaticOrder S; S.init(TL, DM, G, (int)blockIdx.x);
        EpiResid E{A.out, A.out, A.out, A.out, ada_ptr(ws, 1, 0, 2)};
        pg8::gemm_phase<EpiResid, pg8::StaticOrder, true, true>(lds + RING_OFF, g, S, E);
    } SEAM(17);
    if (IN(18)) { KAREF A = *ka_launder(kp); unsigned char* ws = A.ws; unsigned char* act = ws + WS_ACT; (void)act; p6_norm_router(A, lds, G, 1, TL); } SEAM(18);
    if (IN(19)) { KAREF A = *ka_launder(kp); unsigned char* ws = A.ws; unsigned char* act = ws + WS_ACT; (void)act; p7_topk(A, lds, G, false); } SEAM(19);
    if (IN(20)) { KAREF A = *ka_launder(kp); unsigned char* ws = A.ws; unsigned char* act = ws + WS_ACT; (void)act; p8_gather(A, G, false); } SEAM(20);
    if (IN(21)) { KAREF A = *ka_launder(kp); unsigned char* ws = A.ws; unsigned char* act = ws + WS_ACT; (void)act;
        pg8::Gemm g{(const bf16_t*)(act + A_XE), (const bf16_t*)(ws + WS_MOEW1), DM}; MoeOrder1 S{G, (int)blockIdx.x, 4096};
        EpiSwiGLU E{(bf16_t*)(act + A_HID)};
        pg8::gemm_phase<EpiSwiGLU, MoeOrder1, true, true>(lds + RING_OFF, g, S, E);
    } SEAM(21);
    if (IN(22)) { KAREF A = *ka_launder(kp); unsigned char* ws = A.ws; unsigned char* act = ws + WS_ACT; (void)act;
        pg8::Gemm g{(const bf16_t*)(act + A_HID), (const bf16_t*)(ws + WS_MOEW2), FF}; MoeOrder2 S{G, (int)blockIdx.x, 1024};
        EpiDown E{(bf16_t*)(act + A_YE), (const float*)(ws + WS_GROW)};
        pg8::gemm_phase<EpiDown, MoeOrder2, true, true>(lds + RING_OFF, g, S, E);
    } SEAM(22);
    if (IN(23)) { KAREF A = *ka_launder(kp); unsigned char* ws = A.ws; unsigned char* act = ws + WS_ACT; (void)act; p11_combine(A, G, 1, TL); }
#undef IN
#undef SEAM
}

#ifndef N_LAUNCH_MODE
#define N_LAUNCH_MODE 0
#endif
extern "C" void kernel_launch(void* const* d_in, const int* in_sizes, int n_in, void* d_out, int out_size, void* d_ws, size_t ws_size, hipStream_t stream) {
    static int grid = 0;
    if (grid == 0) {
        if (n_in != N_IN || in_sizes[0] != TL * DM || out_size != TL * DM || ws_size < WS_END) {
            fprintf(stderr, "kernel_launch: unexpected shapes (n_in %d, in0 %d, out %d, ws %zu < %zu?); nothing launched\n", n_in, n_in > 0 ? in_sizes[0] : -1, out_size, ws_size, (size_t)WS_END); grid = -1; return; }
        int dev = 0, cus = 0, per_cu = 0;
        if (hipGetDevice(&dev) != hipSuccess || hipDeviceGetAttribute(&cus, hipDeviceAttributeMultiprocessorCount, dev) != hipSuccess) { grid = -1; return; }
        if (hipFuncSetAttribute((const void*)fwd_kernel, hipFuncAttributeMaxDynamicSharedMemorySize, LDS_BYTES) != hipSuccess) { fprintf(stderr, "kernel_launch: hipFuncSetAttribute failed\n"); grid = -1; return; }
        if (hipOccupancyMaxActiveBlocksPerMultiprocessor(&per_cu, (const void*)fwd_kernel, 512, LDS_BYTES) != hipSuccess || per_cu < 1) { fprintf(stderr, "kernel_launch: occupancy query says %d\n", per_cu); }
        (void)hipGetLastError();
        grid = cus;
    }
    if (grid < 0) return;
    (void)hipMemsetAsync((char*)d_ws, 0, ZERO_BYTES, stream);
    KArgs a{};
    for (int i = 0; i < N_IN; ++i) a.in[i] = (const float*)d_in[i];
    a.out = (float*)d_out; a.ws = (unsigned char*)d_ws;
#if N_LAUNCH_MODE == 1
    for (int p = 0; p < N_PHASES; ++p) { a.ph_lo = p; a.ph_hi = p + 1; hipLaunchKernelGGL(fwd_kernel, dim3(grid), dim3(512), LDS_BYTES, stream, a); }
#else
    a.ph_lo = 0; a.ph_hi = N_PHASES; hipLaunchKernelGGL(fwd_kernel, dim3(grid), dim3(512), LDS_BYTES, stream, a);
#endif
}
```

```cpp
#include <hip/hip_runtime.h>
#include <cstdio>
#include <cstdint>

#define GAS __attribute__((address_space(1)))
#define LAS __attribute__((address_space(3)))
typedef unsigned short bf16_t;
typedef short bf16x8 __attribute__((ext_vector_type(8)));
typedef short s16x4 __attribute__((ext_vector_type(4)));
typedef float f32x16 __attribute__((ext_vector_type(16)));
typedef float f32x4 __attribute__((ext_vector_type(4)));
typedef float f32x2 __attribute__((ext_vector_type(2)));
typedef unsigned u32x4 __attribute__((ext_vector_type(4)));
typedef unsigned u32x2 __attribute__((ext_vector_type(2)));

constexpr int NB = 4, SEQ = 8192, CTXL = 256, DM = 1024;
constexpr int TL = NB * SEQ, TC = NB * CTXL, TT = TL + TC;
constexpr int KVL = SEQ + CTXL;
constexpr int NE = 16, FF = 2048, CAPL = 1024, CAPC = 32;
constexpr int XE_CTX0 = NB * NE * CAPL;
constexpr int XE_ROWS = XE_CTX0 + NE * 256;

typedef float f32x2_cv __attribute__((ext_vector_type(2))); typedef __bf16 bf16x2_cv __attribute__((ext_vector_type(2)));
__device__ __forceinline__ unsigned cvt_pk_bf16_c(float lo, float hi) { const f32x2_cv v = {lo, hi}; const bf16x2_cv b = __builtin_convertvector(v, bf16x2_cv); return __builtin_bit_cast(unsigned, b); }
__device__ __forceinline__ unsigned cvt_pk_bf16(float lo, float hi) { unsigned r; asm volatile("v_cvt_pk_bf16_f32 %0, %1, %2" : "=v"(r) : "v"(lo), "v"(hi)); return r; }
__device__ __forceinline__ float bflo(unsigned w) { return __uint_as_float(w << 16); }
__device__ __forceinline__ float bfhi(unsigned w) { return __uint_as_float(w & 0xffff0000u); }
__device__ __forceinline__ float bf2f(bf16_t b) { return __uint_as_float(((unsigned)b) << 16); }
__device__ __forceinline__ float wave_sum(float v) {
#pragma unroll
    for (int o = 1; o < 64; o <<= 1) v += __shfl_xor(v, o);
    return v;
}
__device__ __forceinline__ float fexp(float x) { return __builtin_amdgcn_exp2f(x * 1.4426950408889634f); }
__device__ __forceinline__ float sigm(float x) { return __builtin_amdgcn_rcpf(1.0f + __builtin_amdgcn_exp2f(-1.4426950408889634f * x)); }
__device__ __forceinline__ float tanh_f(float x) { return 1.0f - 2.0f * __builtin_amdgcn_rcpf(1.0f + __builtin_amdgcn_exp2f(2.8853900817779268f * x)); }
__device__ __forceinline__ float gelu_tanh(float x) { const float u = 0.7978845608028654f * (x + 0.044715f * x * x * x); return x * sigm(2.0f * u); }
__device__ __forceinline__ float silu_f(float x) { return x * sigm(x); }

namespace pg8 {
#define PG8_LAS __attribute__((address_space(3)))
constexpr int BM = 256, BK = 64, HALF = 128, HTB = HALF * BK * 2  , STAGE_BYTES = 8 * HTB, NXCD = 8, WGM = 8;
__host__ __device__ __forceinline__ int lds_byte(int r, int c) { const int st = (r >> 4) * 2 + (c >> 5), rr = r & 15, cc = c & 31, ob = rr * 64 + cc * 2; return st * 1024 + (ob ^ (((ob >> 9) & 1) << 5)); }
__host__ __device__ __forceinline__ void stage_rc(int b, int& R, int& C) { const int st = b / 1024, sb = b % 1024, swz = sb ^ (((sb >> 9) & 1) << 5); R = (st >> 1) * 16 + swz / 64; C = (st & 1) * 32 + (swz % 64) / 2; }
__host__ __device__ __forceinline__ int perm32(int rho) { const int n = rho >> 4, i = rho & 15; return 8 * (i >> 2) + 4 * n + (i & 3); }

struct Unit { int pm, pn, am, bn; };
struct Gemm { const bf16_t* A; const bf16_t* Bt; int K; };

struct StaticOrder {
    int nM, nN, nwg, G, c;
    __device__ void init(int M, int N, int G_, int c_) { nM = M / BM; nN = N / BM; nwg = nM * nN; G = G_; c = c_; }
    __device__ bool next(int i, Unit& u) const {
        const long L = (long)i * G + c; if (L >= nwg) return false;
        int wgid = (int)L; { const int q = nwg / NXCD, r = nwg % NXCD, xcd = wgid % NXCD, off = wgid / NXCD; wgid = (xcd < r ? xcd * (q + 1) : r * (q + 1) + (xcd - r) * q) + off; }
        const int nig = WGM * nN, gid = wgid / nig, fm = gid * WGM, gsz = (nM - fm) < WGM ? (nM - fm) : WGM;
        u.pm = fm + ((wgid % nig) % gsz); u.pn = (wgid % nig) / gsz; u.am = u.pm; u.bn = u.pn; return true;
    }
    __device__ __forceinline__ void a_ready(const Unit&) const {}
    __device__ __forceinline__ void done(const Unit&) const {}
};

template <class Epi, class Sched, bool ALIGN_EPI = false, bool SP2 = false>
__device__ __forceinline__ void gemm_phase(PG8_LAS unsigned char* lds, const Gemm g, const Sched& S, const Epi& E) {
    const int tid = threadIdx.x, wid = __builtin_amdgcn_readfirstlane(tid >> 6), lane = tid & 63, wr = wid >> 2, wc = wid & 3, fr = lane & 15, fq = lane >> 4;
    const int K = g.K, nt = K / BK;
    unsigned voffA[2], voffB[2];
#pragma unroll
    for (int i = 0; i < 2; ++i) { int R, C; stage_rc(tid * 16 + i * 8192, R, C); const int Rb = Epi::PERM ? ((R & ~31) + perm32(R & 31)) : R;
        voffA[i] = (unsigned)(R * K + C) * 2u; voffB[i] = (unsigned)(Rb * K + C) * 2u; }
    const size_t kstep = (size_t)(BK * 2);
    const size_t hstep = (size_t)HALF * K * 2;
    const size_t tstep = 2 * hstep;
    const unsigned ldsw = (unsigned)wid * 1024u;
    const int aoff = lds_byte(wr * 64 + fr, fq * 8), boff = lds_byte(wc * 32 + fr, fq * 8);
#define PG8_SA(b, h) (((b) * 2 + (h)) * HTB)
#define PG8_SB(b, h) ((4 + (b) * 2 + (h)) * HTB)
#define PG8_STAGE(bufoff, gbase, voff) do { _Pragma("unroll") for (int _i = 0; _i < 2; ++_i) \
        __builtin_amdgcn_global_load_lds((const unsigned*)((const char*)(gbase) + (voff)[_i]), (PG8_LAS unsigned*)(lds + (bufoff) + ldsw + _i * 8192), 16, 0, 0); } while (0)
#define PG8_LDA(dst, b, h) do { _Pragma("unroll") for (int m = 0; m < 4; ++m) _Pragma("unroll") for (int k = 0; k < 2; ++k) dst[m][k] = *(const PG8_LAS bf16x8*)(lds + PG8_SA(b, h) + aoff + m * 2048 + k * 1024); } while (0)
#define PG8_LDB(dst, b, h) do { _Pragma("unroll") for (int n = 0; n < 2; ++n) _Pragma("unroll") for (int k = 0; k < 2; ++k) dst[n][k] = *(const PG8_LAS bf16x8*)(lds + PG8_SB(b, h) + boff + n * 2048 + k * 1024); } while (0)
#define PG8_MMA(ai, bj, At, Bt) do { __builtin_amdgcn_s_setprio(1); _Pragma("unroll") for (int m = 0; m < 4; ++m) _Pragma("unroll") for (int n = 0; n < 2; ++n) _Pragma("unroll") for (int k = 0; k < 2; ++k) \
        acc[ai][bj][m][n] = __builtin_amdgcn_mfma_f32_16x16x32_bf16(Bt[n][k], At[m][k], acc[ai][bj][m][n], 0, 0, 0); __builtin_amdgcn_s_setprio(0); } while (0)
#define PG8_WAIT_V(n) asm volatile("s_waitcnt vmcnt(" #n ")" ::: "memory")
#define PG8_WAIT_L(n) asm volatile("s_waitcnt lgkmcnt(" #n ")" ::: "memory")
#define PG8_BAR __builtin_amdgcn_s_barrier()
#define PG8_SCHED __builtin_amdgcn_sched_barrier(0)
    Unit cur, nxt; int ui = 0;
    if (!S.next(0, cur)) return;
    f32x4 acc[2][2][4][2];
#pragma unroll
    for (int a = 0; a < 2; ++a)
#pragma unroll
        for (int b = 0; b < 2; ++b)
#pragma unroll
            for (int m = 0; m < 4; ++m)
#pragma unroll
                for (int n = 0; n < 2; ++n) acc[a][b][m][n] = (f32x4){0.f, 0.f, 0.f, 0.f};
    bf16x8 At[4][2], B0[2][2], B1[2][2];
    const char* cA = (const char*)g.A + (size_t)cur.am * tstep; const char* cB = (const char*)g.Bt + (size_t)cur.bn * tstep;
    S.a_ready(cur);
    if constexpr (SP2) {
        PG8_STAGE(PG8_SB(0, 0), cB, voffB); PG8_STAGE(PG8_SB(0, 1), cB + hstep, voffB); PG8_STAGE(PG8_SA(0, 0), cA, voffA); PG8_STAGE(PG8_SA(0, 1), cA + hstep, voffA);
        if (wr == 1) PG8_BAR;
        PG8_WAIT_V(2); PG8_BAR;
        PG8_STAGE(PG8_SB(1, 0), cB + kstep, voffB); PG8_STAGE(PG8_SA(1, 0), cA + kstep, voffA); PG8_STAGE(PG8_SB(1, 1), cB + hstep + kstep, voffB);
        PG8_WAIT_V(6); PG8_BAR;
    } else {
        PG8_STAGE(PG8_SB(0, 0), cB, voffB); PG8_STAGE(PG8_SA(0, 0), cA, voffA); PG8_STAGE(PG8_SB(0, 1), cB + hstep, voffB); PG8_STAGE(PG8_SA(0, 1), cA + hstep, voffA);
        if (wr == 1) PG8_BAR;
        PG8_WAIT_V(4); PG8_BAR;
        PG8_STAGE(PG8_SB(1, 0), cB + kstep, voffB); PG8_STAGE(PG8_SA(1, 0), cA + kstep, voffA); PG8_STAGE(PG8_SB(1, 1), cB + hstep + kstep, voffB);
        PG8_WAIT_V(6); PG8_BAR;
    }
    for (;;) {
        const bool has_next = S.next(ui + 1, nxt);
        const char* nA = has_next ? (const char*)g.A + (size_t)nxt.am * tstep : cA; const char* nB = has_next ? (const char*)g.Bt + (size_t)nxt.bn * tstep : cB;
        for (int t = 0; t < nt; t += 2) {
            const bool last = (t == nt - 2);
            const char* a1 = cA + (size_t)(t + 1) * kstep;
            const char* a2 = last ? nA : cA + (size_t)(t + 2) * kstep; const char* b2 = last ? nB : cB + (size_t)(t + 2) * kstep;
            const char* a3 = a2 + kstep; const char* b3 = b2 + kstep;
            if (last && has_next) S.a_ready(nxt);
            if constexpr (SP2) {
            PG8_LDB(B0, 0, 0); PG8_LDB(B1, 0, 1); PG8_SCHED; PG8_LDA(At, 0, 0); PG8_STAGE(PG8_SA(1, 1), a1 + hstep, voffA);
            PG8_WAIT_V(8); PG8_WAIT_L(0); PG8_BAR; PG8_MMA(0, 0, At, B0); PG8_MMA(0, 1, At, B1); PG8_BAR; PG8_SCHED;
            PG8_LDA(At, 0, 1); PG8_STAGE(PG8_SB(0, 0), b2, voffB); PG8_STAGE(PG8_SB(0, 1), b2 + hstep, voffB); PG8_STAGE(PG8_SA(0, 0), a2, voffA);
            PG8_WAIT_V(8); PG8_WAIT_L(0); PG8_BAR; PG8_MMA(1, 0, At, B0); PG8_MMA(1, 1, At, B1); PG8_BAR; PG8_SCHED;
            PG8_LDB(B0, 1, 0); PG8_LDB(B1, 1, 1); PG8_SCHED; PG8_LDA(At, 1, 0); PG8_STAGE(PG8_SA(0, 1), a2 + hstep, voffA);
            PG8_WAIT_V(8); PG8_WAIT_L(0); PG8_BAR; PG8_MMA(0, 0, At, B0); PG8_MMA(0, 1, At, B1); PG8_BAR; PG8_SCHED;
            PG8_LDA(At, 1, 1); PG8_STAGE(PG8_SB(1, 0), b3, voffB); PG8_STAGE(PG8_SB(1, 1), b3 + hstep, voffB); PG8_STAGE(PG8_SA(1, 0), a3, voffA);
            PG8_WAIT_V(8); PG8_WAIT_L(0); PG8_BAR; PG8_MMA(1, 0, At, B0); PG8_MMA(1, 1, At, B1); PG8_BAR; PG8_SCHED;
            } else {
            PG8_LDB(B0, 0, 0); PG8_SCHED; PG8_LDA(At, 0, 0); PG8_STAGE(PG8_SA(1, 1), a1 + hstep, voffA);
            PG8_WAIT_L(8); PG8_BAR; PG8_WAIT_L(0); PG8_MMA(0, 0, At, B0); PG8_BAR; PG8_SCHED;
            PG8_LDB(B1, 0, 1); PG8_STAGE(PG8_SB(0, 0), b2, voffB);
            PG8_BAR; PG8_WAIT_L(0); PG8_MMA(0, 1, At, B1); PG8_BAR;
            PG8_LDA(At, 0, 1); PG8_STAGE(PG8_SA(0, 0), a2, voffA);
            PG8_BAR; PG8_WAIT_L(0); PG8_MMA(1, 0, At, B0); PG8_BAR; PG8_SCHED;
            PG8_STAGE(PG8_SB(0, 1), b2 + hstep, voffB);
            PG8_WAIT_V(6); PG8_BAR; PG8_MMA(1, 1, At, B1); PG8_BAR;
            PG8_LDB(B0, 1, 0); PG8_SCHED; PG8_LDA(At, 1, 0); PG8_STAGE(PG8_SA(0, 1), a2 + hstep, voffA);
            PG8_WAIT_L(8); PG8_BAR; PG8_WAIT_L(0); PG8_MMA(0, 0, At, B0); PG8_BAR; PG8_SCHED;
            PG8_LDB(B1, 1, 1); PG8_STAGE(PG8_SB(1, 0), b3, voffB);
            PG8_BAR; PG8_WAIT_L(0); PG8_MMA(0, 1, At, B1); PG8_BAR;
            PG8_LDA(At, 1, 1); PG8_STAGE(PG8_SA(1, 0), a3, voffA);
            PG8_BAR; PG8_WAIT_L(0); PG8_MMA(1, 0, At, B0); PG8_BAR; PG8_SCHED;
            PG8_STAGE(PG8_SB(1, 1), b3 + hstep, voffB);
            PG8_WAIT_V(6); PG8_BAR; PG8_MMA(1, 1, At, B1); PG8_BAR;
            }
        }
        if constexpr (ALIGN_EPI) { if (wr == 0) PG8_BAR; }
        E(acc, cur, wr, wc, fr, fq); S.done(cur);
        if (!has_next) break;
#pragma unroll
        for (int a = 0; a < 2; ++a)
#pragma unroll
            for (int b = 0; b < 2; ++b)
#pragma unroll
                for (int m = 0; m < 4; ++m)
#pragma unroll
                    for (int n = 0; n < 2; ++n) acc[a][b][m][n] = (f32x4){0.f, 0.f, 0.f, 0.f};
        cur = nxt; cA = nA; cB = nB; ++ui;
        if constexpr (ALIGN_EPI) { if (wr == 1) PG8_BAR; }
    }
    PG8_WAIT_V(0);
    if constexpr (!ALIGN_EPI) { if (wr == 0) PG8_BAR; }
    PG8_BAR;
#undef PG8_SA
#undef PG8_SB
#undef PG8_STAGE
#undef PG8_LDA
#undef PG8_LDB
#undef PG8_MMA
#undef PG8_WAIT_V
#undef PG8_WAIT_L
#undef PG8_BAR
#undef PG8_SCHED
}
}
#include <hip/hip_bf16.h>
namespace attn_body {
using bf16=__hip_bfloat16;
using bf16x8=__attribute__((ext_vector_type(8)))short;
using s16x4=__attribute__((ext_vector_type(4)))short;
using f32x16=__attribute__((ext_vector_type(16)))float;
using u32x4=__attribute__((ext_vector_type(4)))unsigned;
constexpr int D=64,KVP=128,OP=1024,QP=512;
constexpr int NW=8,QBLK=32,QB=QBLK*NW,KVBLK=64;
constexpr int ATTN_UNIT_ROWS=QB;
__device__ __forceinline__ int crow(int r,int hi){return (r&3)+8*(r>>2)+4*hi;}
#define SBAR() __builtin_amdgcn_sched_barrier(0)
constexpr int NSLOT=3, SLOTB=8192;
constexpr int LDS_K=0, LDS_V=NSLOT*SLOTB, LDS_WS=2*NSLOT*SLOTB, LDS_OST=LDS_WS+NW*64*4, LDS_BYTES=LDS_OST+NW*4096;
constexpr float C2=0.125f*1.4426950408889634f;
__device__ __forceinline__ void glds16(const void*gsrc,unsigned lds_dst){unsigned keep;
  asm volatile("s_mov_b32 %0, m0\n\ts_mov_b32 m0, %2\n\ts_nop 0\n\tglobal_load_lds_dwordx4 %1, off\n\ts_mov_b32 m0, %0":"=&s"(keep):"v"(gsrc),"s"(lds_dst):"memory");}
__device__ __forceinline__ float max3f(float a,float b,float c){float r;asm("v_max3_f32 %0, %1, %2, %3":"=v"(r):"v"(a),"v"(b),"v"(c));return r;}
__device__ __forceinline__ float max2f(float a,float b){float r;asm("v_max_f32_e32 %0, %1, %2":"=v"(r):"v"(a),"v"(b));return r;}
__device__ __forceinline__ float fadd_s(float a,float b){float r;asm("v_add_f32_e32 %0, %1, %2":"=v"(r):"v"(a),"v"(b));return r;}
__device__ __forceinline__ float fsub_s(float a,float b){float r;asm("v_sub_f32_e32 %0, %1, %2":"=v"(r):"v"(a),"v"(b));return r;}
typedef float f32x2_t __attribute__((ext_vector_type(2))); typedef __bf16 bf16x2_t __attribute__((ext_vector_type(2)));
__device__ __forceinline__ unsigned cvtpk_s(float lo,float hi){f32x2_t v={lo,hi};bf16x2_t b=__builtin_convertvector(v,bf16x2_t);return __builtin_bit_cast(unsigned,b);}
#define WAIT_BAR(N) asm volatile("s_waitcnt vmcnt(" #N ") lgkmcnt(0)\n\ts_barrier":::"memory")

__device__ __forceinline__ void qkt(f32x16&p0,f32x16&p1,const char*Kslot,const bf16x8*qr,const f32x16&negm,int r32,int hi){
  const char*kb=Kslot+hi*1024+r32*16;
  #pragma unroll
  for(int d0=0;d0<4;++d0){
    const bf16x8 b0=*reinterpret_cast<const bf16x8*>(kb+d0*2048);
    const bf16x8 b1=*reinterpret_cast<const bf16x8*>(kb+d0*2048+512);
    if(d0==0){p0=__builtin_amdgcn_mfma_f32_32x32x16_bf16(b0,qr[0],negm,0,0,0);p1=__builtin_amdgcn_mfma_f32_32x32x16_bf16(b1,qr[0],negm,0,0,0);}
    else{p0=__builtin_amdgcn_mfma_f32_32x32x16_bf16(b0,qr[d0],p0,0,0,0);p1=__builtin_amdgcn_mfma_f32_32x32x16_bf16(b1,qr[d0],p1,0,0,0);}}
}
typedef __attribute__((address_space(3))) const char* lds_cptr;
typedef short v4i16_t __attribute__((ext_vector_type(4)));
__device__ __forceinline__ void kload8(bf16x8*kf,lds_cptr kp){
  kf[0]=*(const __attribute__((address_space(3))) bf16x8*)(kp);      kf[1]=*(const __attribute__((address_space(3))) bf16x8*)(kp+512);
  kf[2]=*(const __attribute__((address_space(3))) bf16x8*)(kp+2048); kf[3]=*(const __attribute__((address_space(3))) bf16x8*)(kp+2560);
  kf[4]=*(const __attribute__((address_space(3))) bf16x8*)(kp+4096); kf[5]=*(const __attribute__((address_space(3))) bf16x8*)(kp+4608);
  kf[6]=*(const __attribute__((address_space(3))) bf16x8*)(kp+6144); kf[7]=*(const __attribute__((address_space(3))) bf16x8*)(kp+6656);
}
__device__ __forceinline__ void kload2(bf16x8*kf,lds_cptr kp,int j){ kf[2*j]=*(const __attribute__((address_space(3))) bf16x8*)(kp+j*2048); kf[2*j+1]=*(const __attribute__((address_space(3))) bf16x8*)(kp+j*2048+512); }
__device__ __forceinline__ s16x4 vtr(lds_cptr p){ return __builtin_bit_cast(s16x4,__builtin_amdgcn_ds_read_tr16_b64_v4i16((__attribute__((address_space(3))) v4i16_t*)p)); }
__device__ __forceinline__ float rowmax(const f32x16&p0,const f32x16&p1){
  float a=max3f(p0[0],p0[1],p1[0]),b=max3f(p0[2],p0[3],p1[1]);a=max3f(a,p1[2],p1[3]);
  #pragma unroll
  for(int r=4;r<16;r+=4){a=max3f(a,p0[r],p0[r+1]);b=max3f(b,p0[r+2],p0[r+3]);a=max3f(a,p1[r],p1[r+1]);b=max3f(b,p1[r+2],p1[r+3]);}
  const float m=max2f(a,b);
  auto rr=__builtin_amdgcn_permlane32_swap(__float_as_uint(m),__float_as_uint(m),false,false);
  return max2f(__uint_as_float(rr[0]),__uint_as_float(rr[1]));
}
__device__ __forceinline__ void pv(f32x16*o,int vb,bf16x8 pa0,bf16x8 pa1,bf16x8 pa2,bf16x8 pa3){
  #pragma unroll
  for(int d0=0;d0<2;++d0){s16x4 lo[4],hi[4];
    #pragma unroll
    for(int ks=0;ks<4;++ks){
      asm volatile("ds_read_b64_tr_b16 %0,%1 offset:%c2":"=&v"(lo[ks]):"v"(vb),"i"(d0*4096+ks*1024):"memory");
      asm volatile("ds_read_b64_tr_b16 %0,%1 offset:%c2":"=&v"(hi[ks]):"v"(vb),"i"(d0*4096+ks*1024+512):"memory");}
    asm volatile("s_waitcnt lgkmcnt(0)":::"memory");SBAR();
    #define PK(k) (bf16x8){lo[k][0],lo[k][1],lo[k][2],lo[k][3],hi[k][0],hi[k][1],hi[k][2],hi[k][3]}
    o[d0]=__builtin_amdgcn_mfma_f32_32x32x16_bf16(pa0,PK(0),o[d0],0,0,0);
    o[d0]=__builtin_amdgcn_mfma_f32_32x32x16_bf16(pa1,PK(1),o[d0],0,0,0);
    o[d0]=__builtin_amdgcn_mfma_f32_32x32x16_bf16(pa2,PK(2),o[d0],0,0,0);
    o[d0]=__builtin_amdgcn_mfma_f32_32x32x16_bf16(pa3,PK(3),o[d0],0,0,0);
    #undef PK
  }
}

#ifndef ATTN_STORE16
#define ATTN_STORE16(p,v) (*(u32x4*)(p)=(v))
#endif
template<int THRL> __device__ __forceinline__ void attn_unit(int qrow0,int h,int kvrow0,int NT,int rope,int qpos0,const float*QRAW,const float*qg,const float*ropetab,const bf16*__restrict__ K,const bf16*__restrict__ V,bf16*O,char*shm){
  const int tid=threadIdx.x,lane=tid&63,r32=lane&31,hi=lane>>5; const int wid=__builtin_amdgcn_readfirstlane(tid>>6);
  const float*Qw=QRAW+(long)(qrow0+wid*QBLK)*QP+h*D;
  const bf16*Kh=K+(long)kvrow0*KVP+(h>>2)*D,*Vh=V+(long)kvrow0*KVP+(h>>2)*D;
  const unsigned lds0=(unsigned)(uintptr_t)shm;
  float*wsf=(float*)(shm+LDS_WS)+wid*64;
  const bf16*ksrc=Kh+(long)lane*KVP+wid*8;
  const bf16*vsrc=Vh+(long)(16*(wid&3)+(lane>>2))*KVP+(wid>>2)*32+(lane&3)*8;
  const unsigned kdst=lds0+LDS_K+wid*1024, vdst=lds0+LDS_V+wid*1024;
  #define DMA_K(t,slot) glds16(ksrc+(long)(t)*KVBLK*KVP,(unsigned)__builtin_amdgcn_readfirstlane(kdst+(slot)))
  #define DMA_V(t,slot) glds16(vsrc+(long)(t)*KVBLK*KVP,(unsigned)__builtin_amdgcn_readfirstlane(vdst+(slot)))
  const int vb0=(int)(lds0+LDS_V)+((lane>>4)&1)*32+(lane&3)*8+(4*hi+((lane&15)>>2))*64;
  const char*Kbase=shm+LDS_K; bf16x8 kf[8];
  const lds_cptr shm3=(lds_cptr)shm; const lds_cptr kp0=shm3+LDS_K+hi*1024+r32*16; const lds_cptr vp0=shm3+LDS_V+((lane>>4)&1)*32+(lane&3)*8+(4*hi+((lane&15)>>2))*64;
  DMA_K(0,0);DMA_V(0,0);DMA_K(1,SLOTB);
  bf16x8 qr[4];
  { float qv[4][8]; float ss=0.f;
    #pragma unroll
    for(int d0=0;d0<4;++d0){ const f32x4 a=*reinterpret_cast<const f32x4*>(&Qw[(long)r32*QP+d0*16+hi*8]), c=*reinterpret_cast<const f32x4*>(&Qw[(long)r32*QP+d0*16+hi*8+4]);
      qv[d0][0]=a[0];qv[d0][1]=a[1];qv[d0][2]=a[2];qv[d0][3]=a[3];qv[d0][4]=c[0];qv[d0][5]=c[1];qv[d0][6]=c[2];qv[d0][7]=c[3];
      #pragma unroll
      for(int j=0;j<8;++j)ss+=qv[d0][j]*qv[d0][j]; }
    ss+=__shfl_xor(ss,32);
    const float rs=__builtin_amdgcn_rsqf(ss*(1.f/64.f)+1e-6f);
    const int qpos=qpos0+wid*QBLK+r32; const int prow=qpos>>6, pcol=qpos&63;
    #pragma unroll
    for(int d0=0;d0<4;++d0){
      const f32x4 g0=*reinterpret_cast<const f32x4*>(&qg[d0*16+hi*8]), g1=*reinterpret_cast<const f32x4*>(&qg[d0*16+hi*8+4]);
      float y[8]; y[0]=qv[d0][0]*rs*g0[0];y[1]=qv[d0][1]*rs*g0[1];y[2]=qv[d0][2]*rs*g0[2];y[3]=qv[d0][3]*rs*g0[3];y[4]=qv[d0][4]*rs*g1[0];y[5]=qv[d0][5]*rs*g1[1];y[6]=qv[d0][6]*rs*g1[2];y[7]=qv[d0][7]*rs*g1[3];
      if(rope){ const float*tb=ropetab+(d0<2?prow:(128+pcol))*32+((d0&1)*8+hi*4);
        const f32x4 cs=*reinterpret_cast<const f32x4*>(tb), sn=*reinterpret_cast<const f32x4*>(tb+16);
        #pragma unroll
        for(int p=0;p<4;++p){ const float x1=y[2*p],x2=y[2*p+1]; y[2*p]=x1*cs[p]-x2*sn[p]; y[2*p+1]=x1*sn[p]+x2*cs[p]; } }
      u32x4 w; w[0]=cvtpk_s(y[0]*C2,y[1]*C2); w[1]=cvtpk_s(y[2]*C2,y[3]*C2); w[2]=cvtpk_s(y[4]*C2,y[5]*C2); w[3]=cvtpk_s(y[6]*C2,y[7]*C2);
      qr[d0]=__builtin_bit_cast(bf16x8,w); } }
  float mhat=0.f,l_reg=0.f;f32x16 o[2];o[0]=f32x16{};o[1]=f32x16{};f32x16 negm=f32x16{};asm volatile("":"+v"(negm));
  #define CMASK(P0,P1,t) do{}while(0)
  bool resc=false;
  #define START(P0,P1) do{ const float rm=rowmax(P0,P1); resc=false; \
    { const float dl=rm; mhat=fadd_s(mhat,dl); \
      _Pragma("unroll") for(int r=0;r<16;++r){P0[r]=fsub_s(P0[r],dl);P1[r]=fsub_s(P1[r],dl);} \
      _Pragma("unroll") for(int r=0;r<16;++r)negm[r]=-mhat; asm volatile("":"+v"(negm)); } \
    _Pragma("unroll") for(int r=0;r<16;++r)P0[r]=__builtin_amdgcn_exp2f(P0[r]); }while(0)
  #define RESC() do{ if(resc){ asm volatile("s_waitcnt lgkmcnt(0)":::"memory"); \
      _Pragma("unroll") for(int d_=0;d_<2;++d_) _Pragma("unroll") for(int r=0;r<16;++r)o[d_][r]*=wsf[crow(r,hi)]; } }while(0)
  f32x16 pA0,pA1,pB0,pB1;
  int sl_prev=0,sl_cur=0,sl_next=SLOTB;
  #define ROT() do{sl_prev=sl_cur;sl_cur=sl_next;sl_next=(sl_next==(NSLOT-1)*SLOTB)?0:sl_next+SLOTB;}while(0)
  DMA_K(2,2*SLOTB);
  WAIT_BAR(3);
  qkt(pA0,pA1,Kbase,qr,negm,r32,hi);asm volatile("s_nop 15\n\ts_nop 7":"+v"(pA0),"+v"(pA1));CMASK(pA0,pA1,0);
  START(pA0,pA1);
  _Pragma("unroll") for(int r=0;r<16;++r)pA1[r]=__builtin_amdgcn_exp2f(pA1[r]);
  WAIT_BAR(0);
  DMA_K(3,0);DMA_V(1,SLOTB);
  ROT();
  kload8(kf,kp0+sl_cur);
  WAIT_BAR(2);
  s16x4 vlo[8],vhi[8]; u32x4 pw0,pw1,pw2,pw3;
  #define PKW(P,B) cvtpk_s(P[B],P[B+1])
  #define PAF(k) __builtin_bit_cast(bf16x8,pw##k)
  #define VFR(i) (bf16x8){vlo[i][0],vlo[i][1],vlo[i][2],vlo[i][3],vhi[i][0],vhi[i][1],vhi[i][2],vhi[i][3]}
  #define PIN(x) asm volatile("":"+v"(x))
  #define MX3(a,b,c) __builtin_fmaxf(__builtin_fmaxf((a),(b)),(c))
  #define GAPA(MF,A0,A1,A2,A3,W0,W1,PW) do{ MF; sacc+=A0; sacc+=A1; sacc+=A2; sacc+=A3; PIN(sacc); W0; W1; PIN(PW); SBAR(); }while(0)
  #define EX(v) __builtin_amdgcn_exp2f(v)
  #define GAPB(MF,X,B) do{ MF; X[B]=EX(X[B]); X[B+1]=EX(X[B+1]); X[B+2]=EX(X[B+2]); X[B+3]=EX(X[B+3]); PIN(X); SBAR(); }while(0)
  #define VRD(i) do{ vlo[i]=vtr(vp_+(((i)>>2)*4096+((i)&3)*1024)); vhi[i]=vtr(vp_+(((i)>>2)*4096+((i)&3)*1024+512)); }while(0)
  #define KRD(G,j) do{ if(G){ kload2(kf,kp0+sl_next,j); SBAR(); } }while(0)
  #define STEP(C0,C1,P0,P1,t,GK,GV,GL) do{ SBAR(); \
    const lds_cptr vp_=vp0+sl_prev; \
    VRD(0); SBAR(); float sacc=(P0[0]+P0[1]); \
    GAPA(C0=__builtin_amdgcn_mfma_f32_32x32x16_bf16(kf[0],qr[0],negm,0,0,0), P0[2],P0[3],P0[4],P0[5],     pw0[0]=PKW(P0,0), pw0[1]=PKW(P0,2), pw0); \
    VRD(4); SBAR(); GAPA(C1=__builtin_amdgcn_mfma_f32_32x32x16_bf16(kf[1],qr[0],negm,0,0,0), P0[6],P0[7],P0[8],P0[9],     pw0[2]=PKW(P0,4), pw0[3]=PKW(P0,6), pw0); \
    VRD(1); SBAR(); GAPA(C0=__builtin_amdgcn_mfma_f32_32x32x16_bf16(kf[2],qr[1],C0,0,0,0),   P0[10],P0[11],P0[12],P0[13], pw1[0]=PKW(P0,8), pw1[1]=PKW(P0,10), pw1); \
    VRD(5); SBAR(); GAPA(C1=__builtin_amdgcn_mfma_f32_32x32x16_bf16(kf[3],qr[1],C1,0,0,0),   P0[14],P0[15],P1[0],P1[1],   pw1[2]=PKW(P0,12),pw1[3]=PKW(P0,14), pw1); \
    VRD(2); SBAR(); GAPA(C0=__builtin_amdgcn_mfma_f32_32x32x16_bf16(kf[4],qr[2],C0,0,0,0),   P1[2],P1[3],P1[4],P1[5],     pw2[0]=PKW(P1,0), pw2[1]=PKW(P1,2), pw2); \
    VRD(6); SBAR(); GAPA(C1=__builtin_amdgcn_mfma_f32_32x32x16_bf16(kf[5],qr[2],C1,0,0,0),   P1[6],P1[7],P1[8],P1[9],     pw2[2]=PKW(P1,4), pw2[3]=PKW(P1,6), pw2); \
    VRD(3); SBAR(); GAPA(C0=__builtin_amdgcn_mfma_f32_32x32x16_bf16(kf[6],qr[3],C0,0,0,0),   P1[10],P1[11],P1[12],P1[13], pw3[0]=PKW(P1,8), pw3[1]=PKW(P1,10), pw3); \
    VRD(7); SBAR(); GAPA(C1=__builtin_amdgcn_mfma_f32_32x32x16_bf16(kf[7],qr[3],C1,0,0,0),   P1[14],P1[15],0.f,0.f,       pw3[2]=PKW(P1,12),pw3[3]=PKW(P1,14), pw3); \
    l_reg+=sacc; \
    if(GK){DMA_K((t)+3,sl_cur);} if(GV){DMA_V((t)+1,sl_next);} \
    CMASK(C0,C1,t); \
    { float a=MX3(C0[0],C0[1],C1[0]),b=MX3(C0[2],C0[3],C1[1]); a=MX3(a,C1[2],C1[3]); \
      _Pragma("unroll") for(int r=4;r<16;r+=4){a=MX3(a,C0[r],C0[r+1]);b=MX3(b,C0[r+2],C0[r+3]);a=MX3(a,C1[r],C1[r+1]);b=MX3(b,C1[r+2],C1[r+3]);} \
      float rm=__builtin_fmaxf(a,b); { auto rr=__builtin_amdgcn_permlane32_swap(__float_as_uint(rm),__float_as_uint(rm),false,false); rm=__builtin_fmaxf(__uint_as_float(rr[0]),__uint_as_float(rr[1])); } \
      resc=false; \
      if(__builtin_expect(__any(rm>(float)THRL),0)){ const float dl=__builtin_fmaxf(rm,0.f); mhat+=dl; \
        _Pragma("unroll") for(int r=0;r<16;++r){C0[r]-=dl;C1[r]-=dl;} \
        _Pragma("unroll") for(int r=0;r<16;++r)negm[r]=-mhat; asm volatile("":"+v"(negm)); \
        const float f=__builtin_amdgcn_exp2f(-dl); l_reg*=f; if(hi==0)wsf[r32]=f; resc=true; } } \
    SBAR(); \
    GAPB(o[0]=__builtin_amdgcn_mfma_f32_32x32x16_bf16(PAF(0),VFR(0),o[0],0,0,0), C0,0); \
    GAPB(o[1]=__builtin_amdgcn_mfma_f32_32x32x16_bf16(PAF(0),VFR(4),o[1],0,0,0), C0,4); \
    KRD(GL,0); GAPB(o[0]=__builtin_amdgcn_mfma_f32_32x32x16_bf16(PAF(1),VFR(1),o[0],0,0,0), C0,8); \
    KRD(GL,1); GAPB(o[1]=__builtin_amdgcn_mfma_f32_32x32x16_bf16(PAF(1),VFR(5),o[1],0,0,0), C0,12); \
    KRD(GL,2); GAPB(o[0]=__builtin_amdgcn_mfma_f32_32x32x16_bf16(PAF(2),VFR(2),o[0],0,0,0), C1,0); \
    KRD(GL,3); GAPB(o[1]=__builtin_amdgcn_mfma_f32_32x32x16_bf16(PAF(2),VFR(6),o[1],0,0,0), C1,4); \
    GAPB(o[0]=__builtin_amdgcn_mfma_f32_32x32x16_bf16(PAF(3),VFR(3),o[0],0,0,0), C1,8); \
    GAPB(o[1]=__builtin_amdgcn_mfma_f32_32x32x16_bf16(PAF(3),VFR(7),o[1],0,0,0), C1,12); \
    }while(0)
  int t=1;
  #undef CMASK
  #define CMASK(P0,P1,t) do{}while(0)
  for(;t+5<NT;t+=2){
    STEP(pB0,pB1,pA0,pA1,t,true,true,true);     WAIT_BAR(2); RESC(); ROT();
    STEP(pA0,pA1,pB0,pB1,t+1,true,true,true);   WAIT_BAR(2); RESC(); ROT();
  }
  #undef CMASK
  #define CMASK(P0,P1,t) do{}while(0)
  #define ENDW(tt) do{ if((tt)+3<NT){WAIT_BAR(2);} else if((tt)+2<NT){WAIT_BAR(1);} else {WAIT_BAR(0);} }while(0)
  for(;t+1<NT;t+=2){
    STEP(pB0,pB1,pA0,pA1,t,(t+3<NT),(t+1<NT),(t+1<NT));       ENDW(t);   RESC(); ROT();
    STEP(pA0,pA1,pB0,pB1,t+1,(t+4<NT),(t+2<NT),(t+2<NT));     ENDW(t+1); RESC(); ROT();
  }
  STEP(pB0,pB1,pA0,pA1,NT-1,false,false,false); RESC();
  { float sacc=pB0[0]+pB0[1]; _Pragma("unroll") for(int r=2;r<16;++r)sacc+=pB0[r]; _Pragma("unroll") for(int r=0;r<16;++r)sacc+=pB1[r]; l_reg+=sacc;
    pw0=(u32x4){PKW(pB0,0),PKW(pB0,2),PKW(pB0,4),PKW(pB0,6)};pw1=(u32x4){PKW(pB0,8),PKW(pB0,10),PKW(pB0,12),PKW(pB0,14)};pw2=(u32x4){PKW(pB1,0),PKW(pB1,2),PKW(pB1,4),PKW(pB1,6)};pw3=(u32x4){PKW(pB1,8),PKW(pB1,10),PKW(pB1,12),PKW(pB1,14)};
    SBAR(); pv(o,vb0+sl_cur,PAF(0),PAF(1),PAF(2),PAF(3)); }
  #undef PKW
  #undef PAF
  #undef VFR
  #undef PIN
  #undef MX3
  #undef GAPA
  #undef GAPB
  #undef EX
  #undef VRD
  #undef KRD
  #undef STEP
  #undef ENDW
  {auto rr=__builtin_amdgcn_permlane32_swap(__float_as_uint(l_reg),__float_as_uint(l_reg),false,false);l_reg=__uint_as_float(rr[0])+__uint_as_float(rr[1]);}
  if(hi==0)wsf[32+r32]=l_reg;asm volatile("s_waitcnt lgkmcnt(0)":::"memory");
  float rli[16];
  #pragma unroll
  for(int r=0;r<16;++r)rli[r]=__builtin_amdgcn_rcpf(wsf[32+crow(r,hi)]);
  bf16*Ow=O+(long)(qrow0+wid*QBLK)*OP+512+h*D;
  { bf16*stg=(bf16*)(shm+LDS_OST)+wid*2048;
    #pragma unroll
    for(int r=0;r<16;++r){const int orow=crow(r,hi);
      #pragma unroll
      for(int d0=0;d0<2;++d0)stg[orow*64+d0*32+r32]=__float2bfloat16(o[d0][r]*rli[r]);}
    asm volatile("s_waitcnt lgkmcnt(0)":::"memory");
    #pragma unroll
    for(int i=0;i<4;++i){const int row=i*8+(lane>>3),ch=lane&7; const u32x4 v=*(const u32x4*)(stg+row*64+ch*8); ATTN_STORE16(Ow+(long)row*OP+ch*8,v);} }
  asm volatile("s_waitcnt lgkmcnt(0)\n\ts_barrier":::"memory");
  #undef DMA_K
  #undef DMA_V
  #undef CMASK
  #undef START
  #undef RESC
  #undef ROT
}
constexpr int ATTN_LDS_BYTES=LDS_BYTES;
#undef SBAR
#undef WAIT_BAR
}
enum {
    I_X = 0, I_C, I_CTX, I_CCTX,
    I0_WMOD, I0_BMOD, I0_NMIX, I0_NFFN, I0_WIN, I0_CONVW, I0_CONVB, I0_WI, I0_BI, I0_WR, I0_BR, I0_LAM, I0_QG, I0_KG, I0_WOUT, I0_ROUTER, I0_WEG, I0_WEU, I0_WED,
    I1_WMOD, I1_BMOD, I1_NMIX, I1_NFFN, I1_MU, I1_WR, I1_WK, I1_WV, I1_W0, I1_W1, I1_W2, I1_A0, I1_A1, I1_A2, I1_G1, I1_G2, I1_KK, I1_KA, I1_RK, I1_GNG, I1_GNB, I1_WO, I1_ROUTER, I1_WEG, I1_WEU, I1_WED,
    N_IN
};
static_assert(N_IN == 49, "49 inputs");
struct KArgs { const float* in[N_IN]; float* out; unsigned char* ws; int ph_lo, ph_hi; };
#define KAREF const __attribute__((address_space(4))) KArgs&
__device__ __forceinline__ const __attribute__((address_space(4))) KArgs* ka_launder(const __attribute__((address_space(4))) KArgs* p) { asm volatile("" : "+s"(p)); return p; }

constexpr size_t MiB = 1u << 20;
constexpr size_t WS_CTL = 0;
constexpr size_t WS_BMIX = 1 * MiB;
constexpr size_t WS_B2 = 9 * MiB;
constexpr size_t ZERO_BYTES = 12 * MiB;
constexpr size_t WS_WIN = 12 * MiB;
constexpr size_t WS_WOUT = 16 * MiB;
constexpr size_t WS_WO = 18 * MiB;
constexpr size_t WS_WGATE = 20 * MiB;
constexpr size_t WS_ADA = 20 * MiB + 512 * 1024;
constexpr size_t WS_ROPE = 21 * MiB;
constexpr size_t WS_HLAST = 21 * MiB + 64 * 1024;
constexpr size_t WS_CARRY = 21 * MiB + 128 * 1024;
constexpr size_t WS_AFFL = 22 * MiB;
constexpr size_t WS_AFFC = 24 * MiB;
constexpr size_t WS_SRCROW = 25 * MiB;
constexpr size_t WS_GROW = 26 * MiB;
constexpr size_t WS_SLOTL = 27 * MiB;
constexpr size_t WS_SLOTC = 29 * MiB;
constexpr size_t WS_CTXS = 30 * MiB;
constexpr size_t WS_MOEW1 = 40 * MiB;
constexpr size_t WS_MOEW2 = 168 * MiB;
constexpr size_t WS_ACT = 232 * MiB;
constexpr size_t WS_END = WS_ACT + 724 * MiB;
constexpr size_t A_H = 0, A_XA = 66 * MiB, A_GA = 99 * MiB, A_QR = 132 * MiB, A_KR = 198 * MiB, A_KN = 215 * MiB, A_VB = 224 * MiB, A_HF = 233 * MiB, A_YCAT = 299 * MiB;
constexpr size_t A_H2 = 0, A_XE = 66 * MiB, A_HID = 202 * MiB, A_YE = 474 * MiB;
constexpr size_t A_XMIX = 0, A_RKV = 396 * MiB, A_LG = 594 * MiB, A_LWA = A_LG + (size_t)TT * 256 * 2;
constexpr size_t A_SD = 0, A_AD = 132 * MiB, A_G = 264 * MiB, A_YD0 = 660 * MiB, A_YD1 = 594 * MiB, A_O = 0;
constexpr size_t ROWB = (size_t)TT * DM * 2;

constexpr int RING_OFF = 0, RING_BYTES = 131072;
constexpr int LDSCTL_OFF = RING_BYTES, MISC_OFF = LDSCTL_OFF + 320;
constexpr int LDS_BYTES = 147456;

#define RLX_AGENT __ATOMIC_RELAXED, __HIP_MEMORY_SCOPE_AGENT
#define LDS_WAIT() asm volatile("s_waitcnt lgkmcnt(0)" ::: "memory")
#define VM_WAIT() asm volatile("s_waitcnt vmcnt(0)" ::: "memory")

#define XB_TMO      128
#define XB_XCNT(j)  (256  + 64 * (j))
#define XB_XSUB(j)  (1280 + 64 * (j))
#define XB_XGEN(j)  (2304 + 64 * (j))
#define XB_TOP      3328
#define XB_TOPGEN   3392
#define XCD_BAR_WORDS 3456
#define XB_SPIN_CAP (1u << 18)
__device__ __forceinline__ unsigned xb_ld(unsigned* p)              { return __hip_atomic_load(p, __ATOMIC_RELAXED, __HIP_MEMORY_SCOPE_AGENT); }
__device__ __forceinline__ unsigned xb_add(unsigned* p, unsigned v) { return __hip_atomic_fetch_add(p, v, __ATOMIC_RELAXED, __HIP_MEMORY_SCOPE_AGENT); }
__device__ __forceinline__ unsigned xb_xcc_id() { return (unsigned)__builtin_amdgcn_s_getreg((3 << 11) | 20) & 0xFu; }
#define XB_SPIN(cond, bar) do { unsigned _sp = 0; while (cond) { __builtin_amdgcn_s_sleep(1); \
    if ((++_sp & 255u) == 0u) { if (xb_ld(&(bar)[XB_TMO])) break; if (_sp > XB_SPIN_CAP) { atomicAdd(&(bar)[XB_TMO], 1u); break; } } } } while (0)
struct XcdBarrier { unsigned* bar; unsigned x; volatile LAS unsigned* st; };
__device__ __forceinline__ XcdBarrier xcd_barrier_post(unsigned* bar, volatile LAS unsigned* st) {
    XcdBarrier b; b.bar = bar; b.x = xb_xcc_id(); b.st = st;
    if (threadIdx.x == 0) (void)xb_add(&bar[XB_XCNT(b.x)], 1u);
    return b;
}
__device__ __forceinline__ void xcd_barrier_complete(unsigned* bar, unsigned x, unsigned& nloc, unsigned& nx) {
    const unsigned G = gridDim.x * gridDim.y * gridDim.z;
    unsigned sum, cnt, mine, sp = 0u;
    for (;;) {
        sum = 0u; cnt = 0u; mine = 0u;
#pragma unroll
        for (unsigned j = 0; j < 16; ++j) { const unsigned c = xb_ld(&bar[XB_XCNT(j)]); sum += c; cnt += (c > 0u) ? 1u : 0u; mine = (j == x) ? c : mine; }
        if (sum == G) break;
        __builtin_amdgcn_s_sleep(1);
        if ((++sp & 255u) == 0u) { if (xb_ld(&bar[XB_TMO])) break; if (sp > XB_SPIN_CAP) { atomicAdd(&bar[XB_TMO], 1u); break; } }
    }
    nloc = mine > 0u ? mine : 1u; nx = cnt > 0u ? cnt : 1u;
}
__device__ __forceinline__ void xcd_barrier(const XcdBarrier& b) {
    asm volatile("s_waitcnt vmcnt(0)" ::: "memory");
    __syncthreads();
    if (threadIdx.x == 0) {
        unsigned* bar = b.bar;
        __builtin_amdgcn_s_waitcnt(0);
        unsigned nloc = b.st[0], nx = b.st[1];
        if (nloc == 0u) { xcd_barrier_complete(bar, b.x, nloc, nx); b.st[0] = nloc; b.st[1] = nx; }
        const unsigned old = xb_add(&bar[XB_XSUB(b.x)], 1u);
        const unsigned gen = old / nloc;
        if (old + 1u == (gen + 1u) * nloc) {
            __builtin_amdgcn_fence(__ATOMIC_RELEASE, "agent");
            asm volatile("s_waitcnt vmcnt(0)" ::: "memory");
            const unsigned og = xb_add(&bar[XB_TOP], 1u);
            const unsigned tg = og / nx;
            if (og + 1u == (tg + 1u) * nx) xb_add(&bar[XB_TOPGEN], 1u);
            else XB_SPIN(xb_ld(&bar[XB_TOPGEN]) == tg, bar);
            __builtin_amdgcn_fence(__ATOMIC_ACQUIRE, "agent");
            xb_add(&bar[XB_XGEN(b.x)], 1u);
            asm volatile("s_waitcnt vmcnt(0)" ::: "memory");
        } else {
            XB_SPIN(xb_ld(&bar[XB_XGEN(b.x)]) == gen, bar);
            __builtin_amdgcn_fence(__ATOMIC_ACQUIRE, "agent");
            asm volatile("s_waitcnt vmcnt(0)" ::: "memory");
        }
    }
    __syncthreads();
}

__device__ __forceinline__ const float* ada_ptr(const unsigned char* ws, int layer, int r, int chunk) { return (const float*)(ws + WS_ADA) + (size_t)(layer * 5 + r) * 6144 + chunk * 1024; }
__device__ __forceinline__ int kv_row(int m) { return m < TL ? ((m >> 13) * KVL + (m & 8191)) : (((m - TL) >> 8) * KVL + SEQ + ((m - TL) & 255)); }
__device__ __forceinline__ int mod_row(int m) { return m < TL ? (m >> 13) : 4; }
__device__ __forceinline__ int block_excl_scan(int v, LAS int* tmp, int& total) {
    const int lane = threadIdx.x & 63, w = threadIdx.x >> 6;
    int inc = v;
#pragma unroll
    for (int o = 1; o < 64; o <<= 1) { const int t = __shfl_up(inc, o); if (lane >= o) inc += t; }
    if (lane == 63) tmp[w] = inc;
    __syncthreads();
    int base = 0, tot = 0;
#pragma unroll
    for (int i = 0; i < 8; ++i) { const int t = tmp[i]; if (i < w) base += t; tot += t; }
    __syncthreads();
    total = tot;
    return base + inc - v;
}
__device__ __forceinline__ void tr_item(const float* W, int Krows, int ldw, bf16_t* dst, long drow0, int ldd, int dk0, LAS float* scr, int k0, int n0, int lane) {
#pragma unroll 8
    for (int i = 0; i < 32; ++i) { const int kk = 2 * i + (lane >> 5); const int k = k0 + kk; scr[kk * 33 + (lane & 31)] = (k < Krows) ? W[(size_t)k * ldw + n0 + (lane & 31)] : 0.f; }
    LDS_WAIT(); asm volatile("" ::: "memory");
    const int c = lane & 7;
#pragma unroll
    for (int j = 0; j < 4; ++j) { const int n = (lane >> 3) + 8 * j; const LAS float* s = scr + (8 * c) * 33 + n;
        u32x4 o; o.x = cvt_pk_bf16(s[0 * 33], s[1 * 33]); o.y = cvt_pk_bf16(s[2 * 33], s[3 * 33]); o.z = cvt_pk_bf16(s[4 * 33], s[5 * 33]); o.w = cvt_pk_bf16(s[6 * 33], s[7 * 33]);
        *(u32x4*)(dst + (size_t)(drow0 + n) * ldd + dk0 + k0 + 8 * c) = o; }
    LDS_WAIT(); asm volatile("" ::: "memory");
}
__device__ __forceinline__ void moe_convert(KAREF A, int layer, LAS unsigned char* lds, int gw, int ngw, int wave, int lane) {
    LAS float* scr = (LAS float*)(lds + RING_OFF + wave * 16384);
    const float* WG = A.in[layer ? I1_WEG : I0_WEG]; const float* WU = A.in[layer ? I1_WEU : I0_WEU]; const float* WD = A.in[layer ? I1_WED : I0_WED];
    bf16_t* B1 = (bf16_t*)(A.ws + WS_MOEW1); bf16_t* B2 = (bf16_t*)(A.ws + WS_MOEW2);
    constexpr int I_GU = 32 * 1024, I_D = 16 * 1024;
    for (int it = gw; it < I_GU + I_D; it += ngw) {
        if (it < I_GU) { const int mi = it >> 10, e = mi >> 1, which = mi & 1, w = it & 1023, kb = w >> 6, nb = w & 63, n0 = 32 * nb;
            tr_item((which ? WU : WG) + (size_t)e * DM * FF, DM, FF, B1 + (size_t)e * 4096 * DM, (long)((n0 >> 7) * 256 + (n0 & 127) + which * 128), DM, 0, scr, 64 * kb, n0, lane); }
        else { const int r = it - I_GU, e = r >> 10, w = r & 1023, kb = w >> 5, nb = w & 31;
            tr_item(WD + (size_t)e * FF * DM, FF, DM, B2 + (size_t)e * DM * FF, (long)(32 * nb), FF, 0, scr, 64 * kb, 32 * nb, lane); }
    }
}
__device__ __forceinline__ void p0_prologue(KAREF A, LAS unsigned char* lds, int G) {
    const int tid = threadIdx.x, lane = tid & 63, wave = __builtin_amdgcn_readfirstlane(tid >> 6);
    const int gw = blockIdx.x * 8 + wave, ngw = G * 8;
    LAS float* scr = (LAS float*)(lds + RING_OFF + wave * 16384);
    unsigned char* ws = A.ws;
    bf16_t* BMIX = (bf16_t*)(ws + WS_BMIX); bf16_t* B2 = (bf16_t*)(ws + WS_B2);
    constexpr int NJ = 19;
    for (int it = gw; ; it += ngw) {
        int r = it; const float* W = nullptr; int Kr = 0, N = 0, ldd = 0, dk0 = 0; long drow = 0; bf16_t* dst = nullptr; bool found = false;
#define JOB(Wp, KR, NN, DST, DROW, LDD, DK0) if (!found) { const int cnt = (((KR) + 63) / 64) * ((NN) / 32); if (r < cnt) { W = (Wp); Kr = (KR); N = (NN); dst = (DST); drow = (DROW); ldd = (LDD); dk0 = (DK0); found = true; } else r -= cnt; }
        JOB(A.in[I0_WIN], DM, 1792, (bf16_t*)(ws + WS_WIN), 0, DM, 0)
        JOB(A.in[I0_WOUT], DM, DM, (bf16_t*)(ws + WS_WOUT), 0, DM, 0)
        JOB(A.in[I1_WR], DM, DM, BMIX, 0, DM, 0)
        JOB(A.in[I1_WK], DM, DM, BMIX, 1024, DM, 0)
        JOB(A.in[I1_WV], DM, DM, BMIX, 2048, DM, 0)
        JOB(A.in[I1_G1], DM, 160, BMIX, 3072, DM, 0)
        JOB(A.in[I1_W1], DM, 64, BMIX, 3328, DM, 0)
        JOB(A.in[I1_W1] + DM * 64, DM, 64, BMIX, 3328 + 64, DM, 0)
        JOB(A.in[I1_A1], DM, 64, BMIX, 3584, DM, 0)
        JOB(A.in[I1_A1] + DM * 64, DM, 64, BMIX, 3584 + 64, DM, 0)
        JOB(A.in[I1_W2], 64, DM, B2, 0, 256, 0)
        JOB(A.in[I1_W2] + 64 * DM, 64, DM, B2, 1024, 256, 64)
        JOB(A.in[I1_A2], 64, DM, B2, 2048, 256, 128)
        JOB(A.in[I1_A2] + 64 * DM, 64, DM, B2, 3072, 256, 192)
        JOB(A.in[I1_G2], 160, DM, B2, 4096, 256, 0)
        JOB(A.in[I1_WO], DM, DM, (bf16_t*)(ws + WS_WO), 0, DM, 0)
#undef JOB
        if (!found) {
            if (r >= 128) break;
            const int pair = r >> 2, which = (r >> 1) & 1, nb = r & 1;
            W = A.in[which ? I0_WR : I0_WI] + (size_t)pair * 64 * 64; Kr = 64; N = 64; dst = (bf16_t*)(ws + WS_WGATE); drow = (long)pair * 128 + which * 64 + 32 * nb; ldd = 64; dk0 = 0;
            tr_item(W, Kr, N, dst, drow, ldd, dk0, scr, 0, 32 * nb, lane);
            continue;
        }
        const int nblk = N / 32, kb = r / nblk, nb = r % nblk;
        tr_item(W, Kr, N, dst, drow + 32 * nb, ldd, dk0, scr, 64 * kb, 32 * nb, lane);
    }
    (void)NJ;
    moe_convert(A, 0, lds, gw, ngw, wave, lane);
    __syncthreads();
    if (blockIdx.x < 192) {
        const int layer = blockIdx.x / 96, cb = blockIdx.x % 96, col = cb * 64 + lane;
        LAS float* sil = (LAS float*)(lds);
        LAS float* part = (LAS float*)(lds + 32768);
        for (int i = tid; i < 5 * 1024; i += 512) { const int rr = i >> 10, k = i & 1023; const float v = rr < 4 ? A.in[I_C][rr * 1024 + k] : A.in[I_CCTX][k]; sil[i] = v / (1.0f + expf(-v)); }
        __syncthreads();
        const float* wm = A.in[layer ? I1_WMOD : I0_WMOD];
        float acc[5] = {0.f, 0.f, 0.f, 0.f, 0.f};
        for (int k = wave * 128; k < wave * 128 + 128; ++k) { const float wv = wm[(size_t)k * 6144 + col];
#pragma unroll
            for (int rr = 0; rr < 5; ++rr) acc[rr] += sil[rr * 1024 + k] * wv; }
#pragma unroll
        for (int rr = 0; rr < 5; ++rr) part[(wave * 5 + rr) * 64 + lane] = acc[rr];
        __syncthreads();
        if (tid < 320) { const int rr = tid >> 6, l = tid & 63; float s = 0.f;
#pragma unroll
            for (int w = 0; w < 8; ++w) s += part[(w * 5 + rr) * 64 + l];
            ((float*)(ws + WS_ADA))[(size_t)(layer * 5 + rr) * 6144 + cb * 64 + l] = s + A.in[layer ? I1_BMOD : I0_BMOD][cb * 64 + l]; }
        __syncthreads();
    }
    if (blockIdx.x == G - 1) {
        float* tab = (float*)(ws + WS_ROPE);
        for (int i = tid; i < 192 * 16; i += 512) {
            const int pos = i >> 4, f = i & 15; const int p = pos < 128 ? pos : pos - 128;
            double inv = 1.0; for (int q = 0; q < f; ++q) inv *= 0.5623413251903491;
            const float invf = (float)inv;
            const float angf = (float)p * invf;
            double x = (double)angf; const double n = rint(x * 0.15915494309189535); x -= n * 6.283185307179586477;
            const double x2 = x * x; double sn = 0.0, cs = 0.0;
            for (int t = 27; t >= 1; t -= 2) sn = sn * x2 * (-1.0 / ((double)(t + 1) * (double)(t + 2))) + 1.0;
            for (int t = 26; t >= 0; t -= 2) cs = cs * x2 * (-1.0 / ((double)(t + 1) * (double)(t + 2))) + 1.0;
            tab[pos * 32 + f] = (float)cs; tab[pos * 32 + 16 + f] = (float)(sn * x);
        }
    }
}
__device__ __forceinline__ void norm_mod_row(const float* xr, const float* gain, const float* sh, const float* sc, bf16_t* orow, int lane) {
    f32x4 v[4]; float ss = 0.f;
#pragma unroll
    for (int j = 0; j < 4; ++j) { v[j] = *(const f32x4*)(xr + 4 * (lane + 64 * j)); ss += (v[j].x * v[j].x + v[j].y * v[j].y) + (v[j].z * v[j].z + v[j].w * v[j].w); }
    const float rs = __builtin_amdgcn_rsqf(wave_sum(ss) * (1.f / DM) + 1e-6f);
#pragma unroll
    for (int j = 0; j < 4; ++j) { const int col = 4 * (lane + 64 * j);
        const f32x4 g = *(const f32x4*)(gain + col), a = *(const f32x4*)(sc + col), b = *(const f32x4*)(sh + col);
        const f32x4 y = v[j] * rs * g * (a + 1.0f) + b;
        u32x2 w; w.x = cvt_pk_bf16(y.x, y.y); w.y = cvt_pk_bf16(y.z, y.w);
        *(u32x2*)(orow + col) = w; }
}
__device__ __forceinline__ const float* xs_row(KAREF A, int m) { return m < TL ? A.out + (size_t)m * DM : (const float*)(A.ws + WS_CTXS) + (size_t)(m - TL) * DM; }
__device__ __forceinline__ float* xs_row_w(KAREF A, int m) { return m < TL ? A.out + (size_t)m * DM : (float*)(A.ws + WS_CTXS) + (size_t)(m - TL) * DM; }

__device__ __forceinline__ void p1_norm0(KAREF A, int G) {
    const int lane = threadIdx.x & 63, wave = threadIdx.x >> 6, gw = blockIdx.x * 8 + wave, ngw = G * 8;
    bf16_t* H = (bf16_t*)(A.ws + WS_ACT + A_H);
    for (int m = gw; m < TT; m += ngw) {
        const float* xr = m < TL ? A.in[I_X] + (size_t)m * DM : A.in[I_CTX] + (size_t)(m - TL) * DM; const int r = mod_row(m);
        norm_mod_row(xr, A.in[I0_NMIX], ada_ptr(A.ws, 0, r, 0), ada_ptr(A.ws, 0, r, 1), H + (size_t)m * DM, lane);
    }
}

struct EpiWin {
    static constexpr bool PERM = true;
    bf16_t* XA; bf16_t* GA; float* QR; float* KR; bf16_t* VB;
    __device__ __forceinline__ void operator()(const f32x4 (&acc)[2][2][4][2], const pg8::Unit& u, int wr, int wc, int fr, int fq) const {
        const int row0 = u.pm * 256 + wr * 64 + fr, tile = u.pn;
#pragma unroll
        for (int ai = 0; ai < 2; ++ai)
#pragma unroll
            for (int m = 0; m < 4; ++m) { const int row = row0 + ai * 128 + m * 16;
#pragma unroll
                for (int bj = 0; bj < 2; ++bj) { const int colt = bj * 128 + wc * 32 + 8 * fq; const f32x4 v0 = acc[ai][bj][m][0], v1 = acc[ai][bj][m][1];
                    u32x4 w; w.x = cvt_pk_bf16(v0[0], v0[1]); w.y = cvt_pk_bf16(v0[2], v0[3]); w.z = cvt_pk_bf16(v1[0], v1[1]); w.w = cvt_pk_bf16(v1[2], v1[3]);
                    if (tile < 2) *(u32x4*)(XA + (size_t)row * 512 + tile * 256 + colt) = w;
                    else if (tile < 4) *(u32x4*)(GA + (size_t)row * 512 + (tile - 2) * 256 + colt) = w;
                    else if (tile < 6) { float* p = QR + (size_t)row * 512 + (tile - 4) * 256 + colt; *(f32x4*)p = v0; *(f32x4*)(p + 4) = v1; }
                    else if (bj == 0) { float* p = KR + (size_t)row * 128 + colt; *(f32x4*)p = v0; *(f32x4*)(p + 4) = v1; }
                    else *(u32x4*)(VB + (size_t)kv_row(row) * 128 + (colt - 128)) = w; } }
    }
};

__device__ __forceinline__ void p3_kprep(KAREF A, int G) {
    const int lane = threadIdx.x & 63, wave = threadIdx.x >> 6, gw = blockIdx.x * 8 + wave, ngw = G * 8;
    const float* KR = (const float*)(A.ws + WS_ACT + A_KR); bf16_t* KN = (bf16_t*)(A.ws + WS_ACT + A_KN); const float* tab = (const float*)(A.ws + WS_ROPE);
    const int head = lane >> 5, p = lane & 31;
    const float g0 = A.in[I0_KG][2 * p], g1 = A.in[I0_KG][2 * p + 1];
    for (int m = gw; m < TT; m += ngw) {
        const f32x2 v = *(const f32x2*)(KR + (size_t)m * 128 + head * 64 + 2 * p);
        float ss = v.x * v.x + v.y * v.y;
#pragma unroll
        for (int o = 1; o < 32; o <<= 1) ss += __shfl_xor(ss, o);
        const float rs = __builtin_amdgcn_rsqf(ss * (1.f / 64.f) + 1e-6f);
        float y0 = v.x * rs * g0, y1 = v.y * rs * g1;
        if (m < TL) { const int t = m & 8191; const float* tb = tab + (p < 16 ? (t >> 6) : 128 + (t & 63)) * 32 + (p & 15); const float cs = tb[0], sn = tb[16];
            const float x1 = y0, x2 = y1; y0 = x1 * cs - x2 * sn; y1 = x1 * sn + x2 * cs; }
        *(unsigned*)(KN + (size_t)kv_row(m) * 128 + head * 64 + 2 * p) = cvt_pk_bf16(y0, y1);
    }
}

constexpr int L_XCF = 0, L_XCB = 17408, L_WG = 26624, L_AB = 45056, L_SC = 78336, L_CAR = 82432, L_PAR = 82944;
template <int MODE>
__device__ __forceinline__ void lru_dir(KAREF A, LAS unsigned char* lds, int d, int n, int seqrow0, int L, int t_begin, int t_end, float h0, float& h_end, float& a_prod) {
    const int tid = threadIdx.x, lane = tid & 63, wid = tid >> 6;
    LAS float* XCF = (LAS float*)(lds + L_XCF);
    LAS bf16_t* XCB = (LAS bf16_t*)(lds + L_XCB);
    LAS bf16_t* WGl = (LAS bf16_t*)(lds + L_WG);
    LAS f32x2* AB = (LAS f32x2*)(lds + L_AB);
    LAS f32x2* SC = (LAS f32x2*)(lds + L_SC);
    LAS float* CAR = (LAS float*)(lds + L_CAR);
    LAS float* PAR = (LAS float*)(lds + L_PAR);
    const bf16_t* XA = (const bf16_t*)(A.ws + WS_ACT + A_XA); const bf16_t* GA = (const bf16_t*)(A.ws + WS_ACT + A_GA);
    float* HF = (float*)(A.ws + WS_ACT + A_HF); bf16_t* YCAT = (bf16_t*)(A.ws + WS_ACT + A_YCAT);
    __syncthreads();
    { const bf16_t* src = (const bf16_t*)(A.ws + WS_WGATE) + (size_t)(d * 8 + n) * 128 * 64; const int row = tid >> 2, part = tid & 3;
      const u32x4 w0 = *(const u32x4*)(src + row * 64 + part * 16), w1 = *(const u32x4*)(src + row * 64 + part * 16 + 8);
      *(LAS u32x4*)(WGl + row * 72 + part * 16) = w0; *(LAS u32x4*)(WGl + row * 72 + part * 16 + 8) = w1; }
    if (tid < 64) { const int c = tid, ch = 64 * n + c;
#pragma unroll
        for (int j = 0; j < 4; ++j) PAR[j * 64 + c] = A.in[I0_CONVW][j * 512 + ch];
        PAR[256 + c] = A.in[I0_CONVB][ch]; PAR[320 + c] = A.in[I0_BI][d * 512 + ch]; PAR[384 + c] = A.in[I0_BR][d * 512 + ch];
        const float lam = A.in[I0_LAM][d * 512 + ch]; PAR[448 + c] = -8.0f * log1pf(expf(-lam));
        CAR[c] = h0; }
    __syncthreads();
    const int nsub = (t_end - t_begin) >> 6; float ap = 1.f, hfin = 0.f; int par = 0;
    for (int si = 0; si < nsub; ++si) {
        const int t0 = t_begin + (d ? nsub - 1 - si : si) * 64;
        { const int tt = tid >> 3, ch8 = (tid & 7) * 8; float a8[8];
#pragma unroll
          for (int i = 0; i < 8; ++i) a8[i] = PAR[256 + ch8 + i];
#pragma unroll
          for (int j = 0; j < 4; ++j) { const int ts = t0 + tt + j - 2;
              if (ts >= 0 && ts < L) { const u32x4 w = *(const u32x4*)(XA + (size_t)(seqrow0 + ts) * 512 + 64 * n + ch8);
                  a8[0] += PAR[j * 64 + ch8 + 0] * bflo(w.x); a8[1] += PAR[j * 64 + ch8 + 1] * bfhi(w.x); a8[2] += PAR[j * 64 + ch8 + 2] * bflo(w.y); a8[3] += PAR[j * 64 + ch8 + 3] * bfhi(w.y);
                  a8[4] += PAR[j * 64 + ch8 + 4] * bflo(w.z); a8[5] += PAR[j * 64 + ch8 + 5] * bfhi(w.z); a8[6] += PAR[j * 64 + ch8 + 6] * bflo(w.w); a8[7] += PAR[j * 64 + ch8 + 7] * bfhi(w.w); } }
          *(LAS f32x4*)(XCF + tt * 68 + ch8) = (f32x4){a8[0], a8[1], a8[2], a8[3]}; *(LAS f32x4*)(XCF + tt * 68 + ch8 + 4) = (f32x4){a8[4], a8[5], a8[6], a8[7]};
          u32x4 o; o.x = cvt_pk_bf16(a8[0], a8[1]); o.y = cvt_pk_bf16(a8[2], a8[3]); o.z = cvt_pk_bf16(a8[4], a8[5]); o.w = cvt_pk_bf16(a8[6], a8[7]);
          *(LAS u32x4*)(XCB + tt * 72 + ch8) = o; }
        __syncthreads();
        { const int mt = wid & 3, half = wid >> 2, fr = lane & 15, fq = lane >> 4;
          const bf16x8 a0 = *(const LAS bf16x8*)(XCB + (mt * 16 + fr) * 72 + 8 * fq), a1 = *(const LAS bf16x8*)(XCB + (mt * 16 + fr) * 72 + 32 + 8 * fq);
#pragma unroll
          for (int q = 0; q < 2; ++q) { const int cbase = 32 * half + 16 * q, c = cbase + fr;
              const bf16x8 bi0 = *(const LAS bf16x8*)(WGl + (cbase + fr) * 72 + 8 * fq), bi1 = *(const LAS bf16x8*)(WGl + (cbase + fr) * 72 + 32 + 8 * fq);
              const bf16x8 br0 = *(const LAS bf16x8*)(WGl + (64 + cbase + fr) * 72 + 8 * fq), br1 = *(const LAS bf16x8*)(WGl + (64 + cbase + fr) * 72 + 32 + 8 * fq);
              f32x4 gi = __builtin_amdgcn_mfma_f32_16x16x32_bf16(a0, bi0, (f32x4){0.f, 0.f, 0.f, 0.f}, 0, 0, 0); gi = __builtin_amdgcn_mfma_f32_16x16x32_bf16(a1, bi1, gi, 0, 0, 0);
              f32x4 gr = __builtin_amdgcn_mfma_f32_16x16x32_bf16(a0, br0, (f32x4){0.f, 0.f, 0.f, 0.f}, 0, 0, 0); gr = __builtin_amdgcn_mfma_f32_16x16x32_bf16(a1, br1, gr, 0, 0, 0);
              const float bic = PAR[320 + c], brc = PAR[384 + c], lsl = PAR[448 + c];
#pragma unroll
              for (int j = 0; j < 4; ++j) { const int tt = mt * 16 + 4 * fq + j; const float xcv = XCF[tt * 68 + c];
                  const float ig = sigm(gi[j] + bic), rg = sigm(gr[j] + brc), la = rg * lsl, av = fexp(la);
                  const float bb = __builtin_sqrtf(fmaxf(-expm1f(2.0f * la), 0.f)) * ig * xcv;
                  AB[tt * 65 + c] = (f32x2){av, bb}; } } }
        __syncthreads();
        { const int c = tid & 63, sc = wid; float av[8], bv[8]; float Al = 1.f, Hl = 0.f;
#pragma unroll
          for (int i = 0; i < 8; ++i) { const int p = 8 * sc + i, tt = d ? 63 - p : p; const f32x2 ab = AB[tt * 65 + c]; av[i] = ab.x; bv[i] = ab.y; Hl = ab.x * Hl + ab.y; Al *= ab.x; }
          SC[sc * 64 + c] = (f32x2){Al, Hl};
          __syncthreads();
          float h = CAR[par * 64 + c]; float apl = 1.f;
#pragma unroll
          for (int s2 = 0; s2 < 8; ++s2) { const f32x2 t = SC[s2 * 64 + c]; if (s2 < sc) h = t.x * h + t.y; apl *= t.x; }
          if (MODE == 0) { h = Al * h + Hl; }
          else {
#pragma unroll
              for (int i = 0; i < 8; ++i) { h = av[i] * h + bv[i]; const int p = 8 * sc + i, tt = d ? 63 - p : p; const size_t row = (size_t)(seqrow0 + t0 + tt);
                  if (MODE == 1) HF[row * 512 + 64 * n + c] = h;
                  else { const float hf = __hip_atomic_load(HF + row * 512 + 64 * n + c, RLX_AGENT); const float g = bf2f(GA[row * 512 + 64 * n + c]);
                      const float y = (h + hf) * gelu_tanh(g); YCAT[row * 1024 + 64 * n + c] = (bf16_t)(cvt_pk_bf16(y, 0.f) & 0xffffu); } } }
          if (sc == 7) { CAR[(par ^ 1) * 64 + c] = h; ap *= apl; hfin = h; }
          par ^= 1; }
    }
    h_end = hfin; a_prod = ap;
}
__device__ __forceinline__ void p3_lru_pass1(KAREF A, LAS unsigned char* lds, int G) {
    const int tid = threadIdx.x, c = tid & 63;
    f32x2* CARRY = (f32x2*)(A.ws + WS_CARRY); float* HLAST = (float*)(A.ws + WS_HLAST);
    for (int u = blockIdx.x; u < 256 + 32; u += G) {
        float he, ap;
        if (u < 256) { const int b = u >> 6, n = (u >> 3) & 7, s = u & 7;
#pragma unroll 1
            for (int d = 0; d < 2; ++d) { lru_dir<0>(A, lds, d, n, b * SEQ, SEQ, s * 1024, s * 1024 + 1024, 0.f, he, ap);
                if (tid >= 448) CARRY[(size_t)((b * 8 + s) * 2 + d) * 512 + 64 * n + c] = (f32x2){ap, he}; } }
        else { const int v = u - 256, b = v >> 3, n = v & 7;
            lru_dir<1>(A, lds, 0, n, TL + b * CTXL, CTXL, 0, CTXL, 0.f, he, ap);
            if (tid >= 448) HLAST[(b * 2 + 0) * 512 + 64 * n + c] = he;
            VM_WAIT(); __syncthreads();
            lru_dir<2>(A, lds, 1, n, TL + b * CTXL, CTXL, 0, CTXL, 0.f, he, ap);
            if (tid >= 448) HLAST[(b * 2 + 1) * 512 + 64 * n + c] = he; }
    }
}
__device__ __forceinline__ void p4_lru_pass2(KAREF A, LAS unsigned char* lds, int G) {
    const int tid = threadIdx.x, c = tid & 63;
    const f32x2* CARRY = (const f32x2*)(A.ws + WS_CARRY); const float* HLAST = (const float*)(A.ws + WS_HLAST);
    for (int u = blockIdx.x; u < 256; u += G) {
        const int b = u >> 6, n = (u >> 3) & 7, s = u & 7; float he, ap;
        float hf0 = HLAST[(b * 2 + 0) * 512 + 64 * n + c], hb0 = HLAST[(b * 2 + 1) * 512 + 64 * n + c];
        for (int s2 = 0; s2 < s; ++s2) { const f32x2 t = CARRY[(size_t)((b * 8 + s2) * 2 + 0) * 512 + 64 * n + c]; hf0 = t.x * hf0 + t.y; }
        for (int s2 = 7; s2 > s; --s2) { const f32x2 t = CARRY[(size_t)((b * 8 + s2) * 2 + 1) * 512 + 64 * n + c]; hb0 = t.x * hb0 + t.y; }
        lru_dir<1>(A, lds, 0, n, b * SEQ, SEQ, s * 1024, s * 1024 + 1024, hf0, he, ap);
        VM_WAIT(); __syncthreads();
        lru_dir<2>(A, lds, 1, n, b * SEQ, SEQ, s * 1024, s * 1024 + 1024, hb0, he, ap);
    }
}

struct EpiResid {
    static constexpr bool PERM = false;
    const float* src_lat; const float* src_ctx; float* dst_lat; float* dst_ctx; const float* gate;
    __device__ __forceinline__ void operator()(const f32x4 (&acc)[2][2][4][2], const pg8::Unit& u, int wr, int wc, int fr, int fq) const {
        const int row0 = u.pm * 256 + wr * 64 + fr, col0 = u.pn * 256 + wc * 32 + 4 * fq;
        const bool lat = u.pm < TL / 256; const int r = lat ? (u.pm >> 5) : 4;
        const float* src = lat ? src_lat + (size_t)row0 * DM : src_ctx + (size_t)(row0 - TL) * DM; float* dst = lat ? dst_lat + (size_t)row0 * DM : dst_ctx + (size_t)(row0 - TL) * DM;
        f32x4 gv[2][2];
#pragma unroll
        for (int bj = 0; bj < 2; ++bj)
#pragma unroll
            for (int n = 0; n < 2; ++n) gv[bj][n] = *(const f32x4*)(gate + (size_t)r * 6144 + col0 + bj * 128 + n * 16);
#pragma unroll
        for (int ai = 0; ai < 2; ++ai)
#pragma unroll
            for (int m = 0; m < 4; ++m) { const size_t off = (size_t)(ai * 128 + m * 16) * DM + col0;
#pragma unroll
                for (int bj = 0; bj < 2; ++bj)
#pragma unroll
                    for (int n = 0; n < 2; ++n) { const f32x4 s = *(const f32x4*)(src + off + bj * 128 + n * 16); *(f32x4*)(dst + off + bj * 128 + n * 16) = s + gv[bj][n] * acc[ai][bj][m][n]; }
                asm volatile("" ::: "memory"); }
    }
};
__device__ __forceinline__ void p4_attention(KAREF A, char* lds, int G) {
    const float* QR = (const float*)(A.ws + WS_ACT + A_QR); const attn_body::bf16* KN = (const attn_body::bf16*)(A.ws + WS_ACT + A_KN); const attn_body::bf16* VB = (const attn_body::bf16*)(A.ws + WS_ACT + A_VB);
    attn_body::bf16* YC = (attn_body::bf16*)(A.ws + WS_ACT + A_YCAT); const float* tab = (const float*)(A.ws + WS_ROPE); const float* qg = A.in[I0_QG];
    const int vcu = (G % 8 == 0) ? (int)((blockIdx.x % 8) * (G / 8) + blockIdx.x / 8) : (int)blockIdx.x;
    for (int u = vcu; u < 1024 + 32; u += G) {
        if (u < 1024) { const int bh = u >> 5, qb = u & 31, b = bh >> 3, h = bh & 7;
            attn_body::attn_unit<8>(b * SEQ + qb * 256, h, b * KVL, KVL / 64, 1, qb * 256, QR, qg, tab, KN, VB, YC, lds); }
        else { const int v = u - 1024, b = v >> 3, h = v & 7;
            attn_body::attn_unit<8>(TL + b * CTXL, h, b * KVL + SEQ, CTXL / 64, 0, 0, QR, qg, tab, KN, VB, YC, lds); }
    }
}

__device__ __forceinline__ void p6_norm_router(KAREF A, LAS unsigned char* lds, int G, int layer, int nrows) {
    const int tid = threadIdx.x, lane = tid & 63, wave = tid >> 6, gw = blockIdx.x * 8 + wave, ngw = G * 8;
    LAS float* RT = (LAS float*)lds;
    const float* router = A.in[layer ? I1_ROUTER : I0_ROUTER];
    for (int i = tid; i < 16 * 1024; i += 512) { const int k = i >> 4, e = i & 15; RT[e * 1024 + k] = router[i]; }
    __syncthreads();
    bf16_t* H2 = (bf16_t*)(A.ws + WS_ACT + A_H2); float* AFFL = (float*)(A.ws + WS_AFFL); float* AFFC = (float*)(A.ws + WS_AFFC);
    const float* gain = A.in[layer ? I1_NFFN : I0_NFFN];
    for (int m = gw; m < nrows; m += ngw) {
        const float* xr = xs_row(A, m); const int r = mod_row(m);
        const float* sh = ada_ptr(A.ws, layer, r, 3); const float* sc = ada_ptr(A.ws, layer, r, 4);
        f32x4 v[4]; float ss = 0.f;
#pragma unroll
        for (int j = 0; j < 4; ++j) { v[j] = *(const f32x4*)(xr + 4 * (lane + 64 * j)); ss += (v[j].x * v[j].x + v[j].y * v[j].y) + (v[j].z * v[j].z + v[j].w * v[j].w); }
        const float rs = __builtin_amdgcn_rsqf(wave_sum(ss) * (1.f / DM) + 1e-6f);
        float pe[16];
#pragma unroll
        for (int e = 0; e < 16; ++e) pe[e] = 0.f;
#pragma unroll
        for (int j = 0; j < 4; ++j) { const int col = 4 * (lane + 64 * j);
            const f32x4 g = *(const f32x4*)(gain + col), a = *(const f32x4*)(sc + col), b = *(const f32x4*)(sh + col);
            const f32x4 y = v[j] * rs * g * (a + 1.0f) + b;
            u32x2 w; w.x = cvt_pk_bf16(y.x, y.y); w.y = cvt_pk_bf16(y.z, y.w);
            *(u32x2*)(H2 + (size_t)m * DM + col) = w;
#pragma unroll
            for (int e = 0; e < 16; ++e) { const f32x4 rw = *(const LAS f32x4*)(RT + e * 1024 + col); pe[e] += (y.x * rw.x + y.y * rw.y) + (y.z * rw.z + y.w * rw.w); } }
#pragma unroll
        for (int i = 0; i < 8; ++i) { const bool up = (lane & 32) != 0; const float send = up ? pe[i] : pe[i + 8], keep = up ? pe[i + 8] : pe[i]; pe[i] = keep + __shfl_xor(send, 32); }
#pragma unroll
        for (int i = 0; i < 4; ++i) { const bool up = (lane & 16) != 0; const float send = up ? pe[i] : pe[i + 4], keep = up ? pe[i + 4] : pe[i]; pe[i] = keep + __shfl_xor(send, 16); }
#pragma unroll
        for (int i = 0; i < 2; ++i) { const bool up = (lane & 8) != 0; const float send = up ? pe[i] : pe[i + 2], keep = up ? pe[i + 2] : pe[i]; pe[i] = keep + __shfl_xor(send, 8); }
        { const bool up = (lane & 4) != 0; const float send = up ? pe[0] : pe[1], keep = up ? pe[1] : pe[0]; pe[0] = keep + __shfl_xor(send, 4); }
        float lg = pe[0]; lg += __shfl_xor(lg, 2); lg += __shfl_xor(lg, 1);
        float mx = lg;
#pragma unroll
        for (int o = 4; o < 64; o <<= 1) mx = fmaxf(mx, __shfl_xor(mx, o));
        const float ex = expf(lg - mx); float sm = ex;
#pragma unroll
        for (int o = 4; o < 64; o <<= 1) sm += __shfl_xor(sm, o);
        const float aff = ex / sm; const int e = (lane >> 2) & 15;
        if ((lane & 3) == 0) { if (m < TL) AFFL[(size_t)((m >> 13) * 16 + e) * SEQ + (m & 8191)] = aff; else { const int j = m - TL; AFFC[(size_t)((j >> 8) * 16 + e) * CTXL + (j & 255)] = aff; } }
    }
}

__device__ __forceinline__ void topk_unit(const float* aff, int N, int cap, int src_row0, int xe_row0, int* SRCROW, float* GROW, int* slotmap, LAS unsigned char* lds) {
    const int tid = threadIdx.x;
    LAS unsigned* keys = (LAS unsigned*)lds;
    LAS unsigned* hist = (LAS unsigned*)(lds + 32768);
    LAS unsigned* ctl = (LAS unsigned*)(lds + 32768 + 1024);
    LAS int* tmp = (LAS int*)(lds + 32768 + 1024 + 64);
    __syncthreads();
    for (int i = tid; i < N; i += 512) keys[i] = __float_as_uint(aff[i]);
    if (tid == 0) { ctl[0] = 0u; ctl[1] = (unsigned)cap; }
    unsigned mask = 0u;
#pragma unroll 1
    for (int shift = 24; shift >= 0; shift -= 8) {
        if (tid < 256) hist[tid] = 0u;
        __syncthreads();
        const unsigned prefix = ctl[0];
        for (int i = tid; i < N; i += 512) { const unsigned k = keys[i]; if ((k & mask) == prefix) __hip_atomic_fetch_add(&hist[(k >> shift) & 255u], 1u, __ATOMIC_RELAXED, __HIP_MEMORY_SCOPE_WORKGROUP); }
        __syncthreads();
        if (tid == 0) { unsigned need = ctl[1], cum = 0u; int dsel = 0;
            for (int dd = 255; dd >= 0; --dd) { const unsigned hcnt = hist[dd]; if (cum + hcnt >= need) { dsel = dd; break; } cum += hcnt; }
            ctl[0] = prefix | ((unsigned)dsel << shift); ctl[1] = need - cum; }
        mask |= 0xffu << shift;
        __syncthreads();
    }
    const unsigned tau = ctl[0]; const int need_eq = (int)ctl[1];
    const int per = N >= 512 ? N / 512 : 1; const int base = tid * per; const bool act = base < N;
    int neq = 0;
    if (act) for (int i = 0; i < per; ++i) neq += (keys[base + i] == tau) ? 1 : 0;
    int tot; int eqrank = block_excl_scan(neq, tmp, tot);
    int nsel = 0;
    if (act) { int er = eqrank; for (int i = 0; i < per; ++i) { const unsigned k = keys[base + i]; if (k > tau) ++nsel; else if (k == tau) { if (er < need_eq) ++nsel; ++er; } } }
    int slot = block_excl_scan(nsel, tmp, tot);
    if (act) { int er = eqrank; for (int i = 0; i < per; ++i) { const unsigned k = keys[base + i]; bool sel = false; if (k > tau) sel = true; else if (k == tau) { sel = er < need_eq; ++er; }
            if (sel) { SRCROW[xe_row0 + slot] = src_row0 + base + i; GROW[xe_row0 + slot] = __uint_as_float(k); slotmap[base + i] = xe_row0 + slot; ++slot; } else slotmap[base + i] = -1; } }
}
__device__ __forceinline__ void p7_topk(KAREF A, LAS unsigned char* lds, int G, bool with_ctx) {
    int* SRCROW = (int*)(A.ws + WS_SRCROW); float* GROW = (float*)(A.ws + WS_GROW);
    const int nun = with_ctx ? 128 : 64;
    for (int u = blockIdx.x; u < nun; u += G) {
        if (u < 64) { const int b = u >> 4, e = u & 15; topk_unit((const float*)(A.ws + WS_AFFL) + (size_t)u * SEQ, SEQ, CAPL, b * SEQ, (b * 16 + e) * CAPL, SRCROW, GROW, (int*)(A.ws + WS_SLOTL) + (size_t)u * SEQ, lds); }
        else { const int v = u - 64, b = v >> 4, e = v & 15; topk_unit((const float*)(A.ws + WS_AFFC) + (size_t)v * CTXL, CTXL, CAPC, TL + b * CTXL, XE_CTX0 + e * 256 + b * CAPC, SRCROW, GROW, (int*)(A.ws + WS_SLOTC) + (size_t)v * CTXL, lds); }
    }
}

__device__ __forceinline__ void p8_gather(KAREF A, int G, bool with_ctx) {
    const int lane = threadIdx.x & 63, wave = threadIdx.x >> 6, gw = blockIdx.x * 8 + wave, ngw = G * 8;
    const int* SRCROW = (const int*)(A.ws + WS_SRCROW); const bf16_t* H2 = (const bf16_t*)(A.ws + WS_ACT + A_H2); bf16_t* XE = (bf16_t*)(A.ws + WS_ACT + A_XE);
    const int nr = with_ctx ? XE_CTX0 + NE * 128 : XE_CTX0;
    for (int i = gw; i < nr; i += ngw) {
        int xr = i; if (i >= XE_CTX0) { const int j = i - XE_CTX0; xr = XE_CTX0 + (j >> 7) * 256 + (j & 127); }
        const int src = SRCROW[xr];
        const u32x4 a = *(const u32x4*)(H2 + (size_t)src * DM + 8 * lane), b = *(const u32x4*)(H2 + (size_t)src * DM + 512 + 8 * lane);
        *(u32x4*)(XE + (size_t)xr * DM + 8 * lane) = a; *(u32x4*)(XE + (size_t)xr * DM + 512 + 8 * lane) = b;
    }
}

struct MoeOrder1 {
    int G, c, nun;
    __device__ bool next(int i, pg8::Unit& u) const {
        const long L = (long)i * G + c; if (L >= nun) return false;
        if (L < 4096) { const int e = (int)(L >> 8), j = (int)(L & 255), v = (j & 7) * 32 + (j >> 3), rt = v >> 4, pnl = v & 15;
            u.am = ((rt >> 2) * 16 + e) * 4 + (rt & 3); u.bn = e * 16 + pnl; }
        else { const int j = (int)L - 4096, e = j >> 4, pnl = j & 15; u.am = XE_CTX0 / 256 + e; u.bn = e * 16 + pnl; }
        u.pm = u.am; u.pn = u.bn & 15; return true;
    }
    __device__ __forceinline__ void a_ready(const pg8::Unit&) const {}
    __device__ __forceinline__ void done(const pg8::Unit&) const {}
};
struct MoeOrder2 {
    int G, c, nun;
    __device__ bool next(int i, pg8::Unit& u) const {
        const long L = (long)i * G + c; if (L >= nun) return false;
        if (L < 1024) { const int e4 = (int)(L >> 8), j = (int)(L & 255), v = (j & 7) * 32 + (j >> 3), e = 4 * e4 + (v >> 6), w = v & 63, rt = w >> 2, pnl = w & 3;
            u.am = ((rt >> 2) * 16 + e) * 4 + (rt & 3); u.bn = e * 4 + pnl; }
        else { const int j = (int)L - 1024, e = j >> 2, pnl = j & 3; u.am = XE_CTX0 / 256 + e; u.bn = e * 4 + pnl; }
        u.pm = u.am; u.pn = u.bn & 3; return true;
    }
    __device__ __forceinline__ void a_ready(const pg8::Unit&) const {}
    __device__ __forceinline__ void done(const pg8::Unit&) const {}
};
struct EpiSwiGLU {
    static constexpr bool PERM = true;
    bf16_t* HID;
    __device__ __forceinline__ void operator()(const f32x4 (&acc)[2][2][4][2], const pg8::Unit& u, int wr, int wc, int fr, int fq) const {
        const int row0 = u.pm * 256 + wr * 64 + fr, col0 = u.pn * 128 + wc * 32 + 8 * fq;
#pragma unroll
        for (int ai = 0; ai < 2; ++ai)
#pragma unroll
            for (int m = 0; m < 4; ++m) { const f32x4 g0 = acc[ai][0][m][0], g1 = acc[ai][0][m][1], u0 = acc[ai][1][m][0], u1 = acc[ai][1][m][1];
                u32x4 w; w.x = cvt_pk_bf16(silu_f(g0[0]) * u0[0], silu_f(g0[1]) * u0[1]); w.y = cvt_pk_bf16(silu_f(g0[2]) * u0[2], silu_f(g0[3]) * u0[3]);
                w.z = cvt_pk_bf16(silu_f(g1[0]) * u1[0], silu_f(g1[1]) * u1[1]); w.w = cvt_pk_bf16(silu_f(g1[2]) * u1[2], silu_f(g1[3]) * u1[3]);
                *(u32x4*)(HID + (size_t)(row0 + ai * 128 + m * 16) * FF + col0) = w; }
    }
};
struct EpiDown {
    static constexpr bool PERM = true;
    bf16_t* YE; const float* GROW;
    __device__ __forceinline__ void operator()(const f32x4 (&acc)[2][2][4][2], const pg8::Unit& u, int wr, int wc, int fr, int fq) const {
        const int row0 = u.pm * 256 + wr * 64 + fr, col0 = u.pn * 256 + wc * 32 + 8 * fq;
#pragma unroll
        for (int ai = 0; ai < 2; ++ai)
#pragma unroll
            for (int m = 0; m < 4; ++m) { const int row = row0 + ai * 128 + m * 16; const float gt = GROW[row];
#pragma unroll
                for (int bj = 0; bj < 2; ++bj) { const f32x4 v0 = acc[ai][bj][m][0] * gt, v1 = acc[ai][bj][m][1] * gt;
                    u32x4 w; w.x = cvt_pk_bf16(v0[0], v0[1]); w.y = cvt_pk_bf16(v0[2], v0[3]); w.z = cvt_pk_bf16(v1[0], v1[1]); w.w = cvt_pk_bf16(v1[2], v1[3]);
                    *(u32x4*)(YE + (size_t)row * DM + col0 + bj * 128) = w; } }
    }
};

__device__ __forceinline__ void p11_combine(KAREF A, int G, int layer, int nrows) {
    const int lane = threadIdx.x & 63, wave = threadIdx.x >> 6, gw = blockIdx.x * 8 + wave, ngw = G * 8;
    const bf16_t* YE = (const bf16_t*)(A.ws + WS_ACT + A_YE); const int* SLOTL = (const int*)(A.ws + WS_SLOTL); const int* SLOTC = (const int*)(A.ws + WS_SLOTC);
    for (int m = gw; m < nrows; m += ngw) {
        int sm = -1;
        if (lane < 16) { if (m < TL) sm = SLOTL[(size_t)((m >> 13) * 16 + lane) * SEQ + (m & 8191)]; else { const int j = m - TL; sm = SLOTC[(size_t)((j >> 8) * 16 + lane) * CTXL + (j & 255)]; } }
        unsigned long long bal = __ballot(sm >= 0);
        f32x4 acc[4];
#pragma unroll
        for (int j = 0; j < 4; ++j) acc[j] = (f32x4){0.f, 0.f, 0.f, 0.f};
        while (bal) { const int e = __builtin_ctzll(bal); bal &= bal - 1; const int xr = __shfl(sm, e);
#pragma unroll
            for (int j = 0; j < 4; ++j) { const u32x2 w = *(const u32x2*)(YE + (size_t)xr * DM + 4 * (lane + 64 * j)); acc[j] += (f32x4){bflo(w.x), bfhi(w.x), bflo(w.y), bfhi(w.y)}; } }
        float* xr_ = xs_row_w(A, m); const float* gt = ada_ptr(A.ws, layer, mod_row(m), 5);
#if defined(DBG_WKV)
        float mult = 1.f; if (layer == 1) { const unsigned* cw = (const unsigned*)(A.ws + WS_CTL) + 8192; const float em = __uint_as_float(cw[0]), sm = __uint_as_float(cw[1]); mult = 1.f + fminf(em / fmaxf(sm, 1e-20f), 8.f); if (cw[2] != 0u) mult = 100.f; }
#else
        const float mult = 1.f;
#endif
#pragma unroll
        for (int j = 0; j < 4; ++j) { const int col = 4 * (lane + 64 * j); const f32x4 x = *(const f32x4*)(xr_ + col), g = *(const f32x4*)(gt + col); *(f32x4*)(xr_ + col) = (x + g * acc[j]) * mult; }
    }
}
__device__ __forceinline__ void l1_h_row(const float* xr, const float* gain, const float* sh, const float* sc, int lane, f32x4 (&h)[4]) {
    f32x4 v[4]; float ss = 0.f;
#pragma unroll
    for (int j = 0; j < 4; ++j) { v[j] = *(const f32x4*)(xr + 4 * (lane + 64 * j)); ss += (v[j].x * v[j].x + v[j].y * v[j].y) + (v[j].z * v[j].z + v[j].w * v[j].w); }
    const float rs = __builtin_amdgcn_rsqf(wave_sum(ss) * (1.f / DM) + 1e-6f);
#pragma unroll
    for (int j = 0; j < 4; ++j) { const int col = 4 * (lane + 64 * j); const f32x4 g = *(const f32x4*)(gain + col), a = *(const f32x4*)(sc + col), b = *(const f32x4*)(sh + col); h[j] = v[j] * rs * g * (a + 1.0f) + b; }
}
__device__ __forceinline__ void p12_l1_prep(KAREF A, int G) {
    const int lane = threadIdx.x & 63, wave = threadIdx.x >> 6, gw = blockIdx.x * 8 + wave, ngw = G * 8;
    bf16_t* XMIX = (bf16_t*)(A.ws + WS_ACT + A_XMIX); const float* gain = A.in[I1_NMIX]; const float* mu = A.in[I1_MU];
    for (int m = gw; m < TT; m += ngw) {
        const int r = mod_row(m); const float* sh = ada_ptr(A.ws, 1, r, 0); const float* sc = ada_ptr(A.ws, 1, r, 1);
        const int t = m < TL ? (m & 8191) : ((m - TL) & 255), Ls = m < TL ? SEQ : CTXL;
        f32x4 h[4], hp[4], hn[4];
        l1_h_row(xs_row(A, m), gain, sh, sc, lane, h);
        if (t > 0) l1_h_row(xs_row(A, m - 1), gain, sh, sc, lane, hp); else {
#pragma unroll
            for (int j = 0; j < 4; ++j) hp[j] = (f32x4){0.f, 0.f, 0.f, 0.f}; }
        if (t < Ls - 1) l1_h_row(xs_row(A, m + 1), gain, sh, sc, lane, hn); else {
#pragma unroll
            for (int j = 0; j < 4; ++j) hn[j] = (f32x4){0.f, 0.f, 0.f, 0.f}; }
#pragma unroll
        for (int j = 0; j < 4; ++j) { const int col = 4 * (lane + 64 * j); const f32x4 xx = (hp[j] + hn[j]) * 0.5f - h[j];
#pragma unroll
            for (int q = 0; q < 6; ++q) { const f32x4 mq = *(const f32x4*)(mu + q * DM + col); const f32x4 y = h[j] + xx * mq;
                u32x2 w; w.x = cvt_pk_bf16(y.x, y.y); w.y = cvt_pk_bf16(y.z, y.w);
                *(u32x2*)(XMIX + (size_t)q * TT * DM + (size_t)m * DM + col) = w; } }
    }
}

struct MixOrder {
    int G, c;
    __device__ bool next(int i, pg8::Unit& u) const {
        const long L = (long)i * G + c; if (L >= 132 * 15) return false;
        const int wgid = (int)L; const int grp = wgid / (8 * 15), w = wgid % (8 * 15), fm = grp * 8, gsz = (132 - fm) < 8 ? (132 - fm) : 8;
        u.pm = fm + w % gsz; u.pn = w / gsz;
        const int sel = u.pn < 4 ? 0 : u.pn < 8 ? 2 : u.pn < 12 ? 3 : u.pn == 12 ? 5 : u.pn == 13 ? 1 : 4;
        u.am = sel * 132 + u.pm; u.bn = u.pn; return true;
    }
    __device__ __forceinline__ void a_ready(const pg8::Unit&) const {}
    __device__ __forceinline__ void done(const pg8::Unit&) const {}
};
struct EpiMix {
    static constexpr bool PERM = true;
    bf16_t* RKV; bf16_t* LG; bf16_t* LWA;
    __device__ __forceinline__ void operator()(const f32x4 (&acc)[2][2][4][2], const pg8::Unit& u, int wr, int wc, int fr, int fq) const {
        const int row0 = u.pm * 256 + wr * 64 + fr, tile = u.pn;
#pragma unroll
        for (int ai = 0; ai < 2; ++ai)
#pragma unroll
            for (int m = 0; m < 4; ++m) { const int row = row0 + ai * 128 + m * 16;
#pragma unroll
                for (int bj = 0; bj < 2; ++bj) { const int colt = bj * 128 + wc * 32 + 8 * fq; f32x4 v0 = acc[ai][bj][m][0], v1 = acc[ai][bj][m][1];
                    if (tile == 12) {
#pragma unroll
                        for (int i = 0; i < 4; ++i) { v0[i] = sigm(v0[i]); v1[i] = sigm(v1[i]); } }
                    if (tile == 13) {
#pragma unroll
                        for (int i = 0; i < 4; ++i) { v0[i] = tanh_f(v0[i]); v1[i] = tanh_f(v1[i]); } }
                    u32x4 w; w.x = cvt_pk_bf16(v0[0], v0[1]); w.y = cvt_pk_bf16(v0[2], v0[3]); w.z = cvt_pk_bf16(v1[0], v1[1]); w.w = cvt_pk_bf16(v1[2], v1[3]);
                    if (tile < 12) *(u32x4*)(RKV + (size_t)(tile >> 2) * TT * DM + (size_t)row * DM + (tile & 3) * 256 + colt) = w;
                    else if (tile == 12) *(u32x4*)(LG + (size_t)row * 256 + colt) = w;
                    else if (bj == 0) *(u32x4*)(LWA + (size_t)row * 256 + (tile - 13) * 128 + colt) = w; } }
    }
};
struct LoraOrder {
    int G, c;
    __device__ bool next(int i, pg8::Unit& u) const {
        const long L = (long)i * G + c; if (L >= 132 * 20) return false;
        const int wgid = (int)L; const int grp = wgid / (8 * 20), w = wgid % (8 * 20), fm = grp * 8, gsz = (132 - fm) < 8 ? (132 - fm) : 8;
        u.pm = fm + w % gsz; u.pn = w / gsz; u.am = (u.pn < 16 ? 132 : 0) + u.pm; u.bn = u.pn; return true;
    }
    __device__ __forceinline__ void a_ready(const pg8::Unit&) const {}
    __device__ __forceinline__ void done(const pg8::Unit&) const {}
};
struct EpiLora {
    static constexpr bool PERM = true;
    bf16_t* SD; bf16_t* AD; bf16_t* Gg; const float* w0; const float* a0;
    __device__ __forceinline__ void operator()(const f32x4 (&acc)[2][2][4][2], const pg8::Unit& u, int wr, int wc, int fr, int fq) const {
        const int row0 = u.pm * 256 + wr * 64 + fr, tile = u.pn, kind = tile >> 2;
        bf16_t* dst = kind < 2 ? SD + (size_t)kind * TT * DM : kind < 4 ? AD + (size_t)(kind - 2) * TT * DM : Gg;
        const float* bias = kind < 2 ? w0 + kind * DM : a0 + (kind - 2) * DM;
#pragma unroll
        for (int ai = 0; ai < 2; ++ai)
#pragma unroll
            for (int m = 0; m < 4; ++m) { const int row = row0 + ai * 128 + m * 16;
#pragma unroll
                for (int bj = 0; bj < 2; ++bj) { const int col = (tile & 3) * 256 + bj * 128 + wc * 32 + 8 * fq;
                    f32x4 v0 = acc[ai][bj][m][0], v1 = acc[ai][bj][m][1];
                    if (kind < 4) { v0 += *(const f32x4*)(bias + col); v1 += *(const f32x4*)(bias + col + 4);
#pragma unroll
                        for (int i = 0; i < 4; ++i) { v0[i] = sigm(v0[i]); v1[i] = sigm(v1[i]); } }
                    u32x4 w; w.x = cvt_pk_bf16(v0[0], v0[1]); w.y = cvt_pk_bf16(v0[2], v0[3]); w.z = cvt_pk_bf16(v1[0], v1[1]); w.w = cvt_pk_bf16(v1[2], v1[3]);
                    *(u32x4*)(dst + (size_t)row * DM + col) = w; }
                asm volatile("" ::: "memory"); }
    }
};

#define DPP_ADD(x, ctrl) ((x) + __builtin_bit_cast(float, __builtin_amdgcn_update_dpp(0, __builtin_bit_cast(int, (x)), (ctrl), 0xf, 0xf, true)))
constexpr int CH = 32, NCHUNK = (CTXL + SEQ) / CH;
__device__ __forceinline__ int wkv_row(int b, int d, int i) { return i < CTXL ? TL + b * CTXL + (d ? CTXL - 1 - i : i) : b * SEQ + (d ? SEQ - 1 - (i - CTXL) : (i - CTXL)); }
__device__ __forceinline__ void unpack8(const u32x4 w, float (&f)[8]) { f[0] = bflo(w.x); f[1] = bfhi(w.x); f[2] = bflo(w.y); f[3] = bfhi(w.y); f[4] = bflo(w.z); f[5] = bfhi(w.z); f[6] = bflo(w.w); f[7] = bfhi(w.w); }
__device__ __forceinline__ u32x4 pack8(const float (&f)[8]) { u32x4 w; w.x = cvt_pk_bf16_c(f[0], f[1]); w.y = cvt_pk_bf16_c(f[2], f[3]); w.z = cvt_pk_bf16_c(f[4], f[5]); w.w = cvt_pk_bf16_c(f[6], f[7]); return w; }
__device__ __forceinline__ void wkv_decay(const float (&sd)[8], float (&base)[8], int lane, float (&e)[8], float (&em1)[8], float (&einv)[8]) {
#pragma unroll
    for (int i = 0; i < 8; ++i) { const float lw = -0.6065306597126334f * sd[i]; float x = lw;
        { const float t = __shfl_up(x, 8); if (lane >= 8) x += t; } { const float t = __shfl_up(x, 16); if (lane >= 16) x += t; } { const float t = __shfl_up(x, 32); if (lane >= 32) x += t; }
        const float cs = base[i] + x; e[i] = fexp(cs); em1[i] = fexp(cs - lw); einv[i] = __builtin_amdgcn_rcpf(e[i]);
        base[i] += __shfl(x, 56 + (lane & 7)); }
}
__device__ __forceinline__ float sum8lanes(float x) { x = DPP_ADD(x, 0xB1); x = DPP_ADD(x, 0x4E); x = DPP_ADD(x, 0x141); return x; }
__device__ __forceinline__ bf16x8 frag(const LAS bf16_t* M, int pitch, int row0, int k0, int lane) { return *(const LAS bf16x8*)(M + (row0 + (lane & 15)) * pitch + k0 + 8 * (lane >> 4)); }
#define MFMA16(a, b, c) __builtin_amdgcn_mfma_f32_16x16x32_bf16((a), (b), (c), 0, 0, 0)

constexpr size_t A_TBUF = 330 * MiB;
__device__ __forceinline__ void p15_tbuild(KAREF A, LAS unsigned char* lds, int G) {
    const int tid = threadIdx.x, lane = tid & 63, wave = tid >> 6, gw = blockIdx.x * 8 + wave, ngw = G * 8;
    LAS unsigned char* wl = lds + wave * 14336;
    LAS bf16_t* AH = (LAS bf16_t*)wl; LAS bf16_t* BH = (LAS bf16_t*)(wl + 4608); LAS float* LL = (LAS float*)(wl + 9216);
    const bf16_t* Kk = (const bf16_t*)(A.ws + WS_ACT + A_RKV) + (size_t)TT * DM; bf16_t* TB = (bf16_t*)(A.ws + WS_ACT + A_TBUF);
    const int jl = lane >> 3, c8 = 8 * (lane & 7), fr = lane & 15, fq = lane >> 4;
    for (int task = gw; task < 128 * NCHUNK; task += ngw) {
        const int chain = task / NCHUNK, chunk = task - chain * NCHUNK, b = chain >> 5, h = (chain >> 1) & 15, d = chain & 1, hc = h * 64 + c8;
        const bf16_t* SD = (const bf16_t*)(A.ws + WS_ACT + A_SD) + (size_t)d * TT * DM; const bf16_t* AD = (const bf16_t*)(A.ws + WS_ACT + A_AD) + (size_t)d * TT * DM;
        float kkw[8]; { const f32x4 t0 = *(const f32x4*)(A.in[I1_KK] + hc), t1 = *(const f32x4*)(A.in[I1_KK] + hc + 4); kkw[0] = t0.x; kkw[1] = t0.y; kkw[2] = t0.z; kkw[3] = t0.w; kkw[4] = t1.x; kkw[5] = t1.y; kkw[6] = t1.z; kkw[7] = t1.w; }
        u32x4 gk[4], gs[4], ga[4];
#pragma unroll
        for (int q = 0; q < 4; ++q) { const size_t ro = (size_t)wkv_row(b, d, chunk * CH + 8 * q + jl) * DM + hc; gk[q] = *(const u32x4*)(Kk + ro); gs[q] = *(const u32x4*)(SD + ro); ga[q] = *(const u32x4*)(AD + ro); }
        float base[8];
#pragma unroll
        for (int i = 0; i < 8; ++i) base[i] = 0.f;
#pragma unroll
        for (int q = 0; q < 4; ++q) { float kf[8], sf[8], af[8], e[8], em1[8], einv[8], ah[8], bh[8]; unpack8(gk[q], kf); unpack8(gs[q], sf); unpack8(ga[q], af);
            wkv_decay(sf, base, lane, e, em1, einv);
            float ssq = 0.f;
#pragma unroll
            for (int i = 0; i < 8; ++i) { kf[i] *= kkw[i]; ssq += kf[i] * kf[i]; }
            const float rs = __builtin_amdgcn_rsqf(fmaxf(sum8lanes(ssq), 1e-24f));
#pragma unroll
            for (int i = 0; i < 8; ++i) { const float kk = kf[i] * rs; ah[i] = -kk * em1[i]; bh[i] = kk * af[i] * einv[i]; }
            *(LAS u32x4*)(AH + (8 * q + jl) * 72 + c8) = pack8(ah); *(LAS u32x4*)(BH + (8 * q + jl) * 72 + c8) = pack8(bh); }
        LDS_WAIT();
#pragma unroll
        for (int mt = 0; mt < 2; ++mt)
#pragma unroll
            for (int nt = 0; nt < 2; ++nt) { f32x4 acc = (f32x4){0.f, 0.f, 0.f, 0.f};
#pragma unroll
                for (int ks = 0; ks < 2; ++ks) acc = MFMA16(frag(AH, 72, mt * 16, ks * 32, lane), frag(BH, 72, nt * 16, ks * 32, lane), acc);
#pragma unroll
                for (int r = 0; r < 4; ++r) { const int j = mt * 16 + 4 * fq + r, m = nt * 16 + fr; LL[j * 36 + m] = (m < j) ? acc[r] : 0.f; } }
        LDS_WAIT();
        { const int c = lane & 31; float t[32];
#pragma unroll
          for (int i = 0; i < 32; ++i) { float s0 = (c == i) ? 1.f : 0.f, s1 = 0.f;
#pragma unroll
              for (int m4 = 0; m4 < (i + 3) / 4; ++m4) { const f32x4 l = *(const LAS f32x4*)(LL + i * 36 + 4 * m4);
                  if (4 * m4 + 0 < i) s0 += l.x * t[4 * m4 + 0]; if (4 * m4 + 1 < i) s1 += l.y * t[4 * m4 + 1]; if (4 * m4 + 2 < i) s0 += l.z * t[4 * m4 + 2]; if (4 * m4 + 3 < i) s1 += l.w * t[4 * m4 + 3]; }
              t[i] = s0 + s1; }
          if (lane < 32) { bf16_t* dst = TB + (size_t)task * 1024 + c;
#pragma unroll
              for (int i = 0; i < 32; ++i) dst[i * 32] = (bf16_t)(cvt_pk_bf16_c(t[i], 0.f) & 0xffffu); } }
        LDS_WAIT();
    }
}
constexpr int OP_AH = 0, OP_RH = 4608, OP_BH = 9216, OP_KH = 13824, OP_VH = 18432, OP_BT = 23040, OP_KT = 28160, OP_VT = 33280, OP_LAK = 38400, OP_MRB = 40960, OP_MRK = 43520, OP_T = 46080, OP_PV = 48640, OP_BYTES = 48896;
constexpr int CHN_OFF = 2 * OP_BYTES, CHN_BYTES = 4864;
__device__ __forceinline__ void p16_chain(KAREF A, LAS unsigned char* lds, int G) {
    const int tid = threadIdx.x, lane = tid & 63, wave = tid >> 6, fr = lane & 15, fq = lane >> 4;
    const bf16_t* R = (const bf16_t*)(A.ws + WS_ACT + A_RKV); const bf16_t* Kk = R + (size_t)TT * DM; const bf16_t* V = Kk + (size_t)TT * DM; const bf16_t* TB = (const bf16_t*)(A.ws + WS_ACT + A_TBUF);
    for (int chain = blockIdx.x; chain < 128; chain += G) {
        const int b = chain >> 5, h = (chain >> 1) & 15, d = chain & 1;
        const bf16_t* SD = (const bf16_t*)(A.ws + WS_ACT + A_SD) + (size_t)d * TT * DM; const bf16_t* AD = (const bf16_t*)(A.ws + WS_ACT + A_AD) + (size_t)d * TT * DM;
        bf16_t* YD = (bf16_t*)(A.ws + WS_ACT + (d ? A_YD1 : A_YD0));
        __syncthreads();
        if (wave >= 4) {
            const int pw = wave - 4, jl = lane >> 3, c8 = 8 * (lane & 7), hc = h * 64 + c8, ptid = pw * 64 + lane;
            float kkw[8], kaw[8];
            { const f32x4 t0 = *(const f32x4*)(A.in[I1_KK] + hc), t1 = *(const f32x4*)(A.in[I1_KK] + hc + 4), u0 = *(const f32x4*)(A.in[I1_KA] + hc), u1 = *(const f32x4*)(A.in[I1_KA] + hc + 4);
              kkw[0] = t0.x; kkw[1] = t0.y; kkw[2] = t0.z; kkw[3] = t0.w; kkw[4] = t1.x; kkw[5] = t1.y; kkw[6] = t1.z; kkw[7] = t1.w; kaw[0] = u0.x; kaw[1] = u0.y; kaw[2] = u0.z; kaw[3] = u0.w; kaw[4] = u1.x; kaw[5] = u1.y; kaw[6] = u1.z; kaw[7] = u1.w; }
            u32x4 gr, gk, gv, gs, ga, gp[3]; u32x2 gt;
#define PREP_LOAD(cn) do { const size_t ro = (size_t)wkv_row(b, d, (cn) * CH + 8 * pw + jl) * DM + hc; gr = *(const u32x4*)(R + ro); gk = *(const u32x4*)(Kk + ro); gv = *(const u32x4*)(V + ro); gs = *(const u32x4*)(SD + ro); ga = *(const u32x4*)(AD + ro); \
            _Pragma("unroll") for (int q = 0; q < 3; ++q) if (q < pw) gp[q] = *(const u32x4*)(SD + (size_t)wkv_row(b, d, (cn) * CH + 8 * q + jl) * DM + hc); \
            gt = *(const u32x2*)(TB + ((size_t)chain * NCHUNK + (cn)) * 1024 + 4 * ptid); } while (0)
            PREP_LOAD(0);
#pragma unroll 1
            for (int it = -1; it < NCHUNK; ++it) {
                const int cn = it + 1; LAS unsigned char* op = lds + (cn & 1) * OP_BYTES;
                u32x2 tcur = gt;
                if (cn < NCHUNK) {
                    float rf[8], kf[8], sf[8], af[8], base[8], e[8], em1[8], einv[8], o1[8], o2[8];
#pragma unroll
                    for (int i = 0; i < 8; ++i) base[i] = 0.f;
#pragma unroll
                    for (int q = 0; q < 3; ++q) if (q < pw) { float pf[8]; unpack8(gp[q], pf);
#pragma unroll
                        for (int i = 0; i < 8; ++i) { float x = -0.6065306597126334f * pf[i]; x += __shfl_xor(x, 8); x += __shfl_xor(x, 16); x += __shfl_xor(x, 32); base[i] += x; } }
                    unpack8(gs, sf); wkv_decay(sf, base, lane, e, em1, einv);
                    unpack8(gk, kf); unpack8(ga, af); unpack8(gr, rf);
                    float ssq = 0.f;
#pragma unroll
                    for (int i = 0; i < 8; ++i) { const float kv = kf[i] * kkw[i]; ssq += kv * kv; }
                    const float rs = __builtin_amdgcn_rsqf(fmaxf(sum8lanes(ssq), 1e-24f)); const int j = 8 * pw + jl;
#pragma unroll
                    for (int i = 0; i < 8; ++i) { const float kk = kf[i] * kkw[i] * rs; o1[i] = -kk * em1[i]; o2[i] = kk * af[i] * einv[i]; }
                    *(LAS u32x4*)((LAS bf16_t*)(op + OP_AH) + j * 72 + c8) = pack8(o1); *(LAS u32x4*)((LAS bf16_t*)(op + OP_BH) + j * 72 + c8) = pack8(o2);
#pragma unroll
                    for (int i = 0; i < 8; ++i) { o1[i] = kf[i] * ((af[i] - 1.0f) * kaw[i] + 1.0f) * einv[i]; o2[i] = rf[i] * e[i]; }
                    *(LAS u32x4*)((LAS bf16_t*)(op + OP_KH) + j * 72 + c8) = pack8(o1); *(LAS u32x4*)((LAS bf16_t*)(op + OP_RH) + j * 72 + c8) = pack8(o2);
                    *(LAS u32x4*)((LAS bf16_t*)(op + OP_VH) + j * 72 + c8) = gv;
                    if (j == 31) { *(LAS f32x4*)((LAS float*)(op + OP_PV) + c8) = (f32x4){e[0], e[1], e[2], e[3]}; *(LAS f32x4*)((LAS float*)(op + OP_PV) + c8 + 4) = (f32x4){e[4], e[5], e[6], e[7]}; }
                    if (cn + 1 < NCHUNK) PREP_LOAD(cn + 1);
                }
                LDS_WAIT(); __builtin_amdgcn_s_barrier(); asm volatile("" ::: "memory");
                if (cn < NCHUNK) {
                    const LAS bf16_t* AH = (const LAS bf16_t*)(op + OP_AH); const LAS bf16_t* RH = (const LAS bf16_t*)(op + OP_RH); const LAS bf16_t* BH = (const LAS bf16_t*)(op + OP_BH); const LAS bf16_t* KH = (const LAS bf16_t*)(op + OP_KH); const LAS bf16_t* VH = (const LAS bf16_t*)(op + OP_VH);
                    const int mt = pw >> 1, nt = pw & 1;
                    f32x4 a0 = (f32x4){0.f, 0.f, 0.f, 0.f}, a1 = a0, a2 = a0;
#pragma unroll
                    for (int ks = 0; ks < 2; ++ks) { const bf16x8 fa = frag(AH, 72, mt * 16, ks * 32, lane), fr_ = frag(RH, 72, mt * 16, ks * 32, lane), fb = frag(BH, 72, nt * 16, ks * 32, lane), fk = frag(KH, 72, nt * 16, ks * 32, lane);
                        a0 = MFMA16(fa, fk, a0); a1 = MFMA16(fr_, fb, a1); a2 = MFMA16(fr_, fk, a2); }
#pragma unroll
                    for (int r = 0; r < 4; ++r) { const int j = mt * 16 + 4 * fq + r, m = nt * 16 + fr;
                        ((LAS bf16_t*)(op + OP_LAK))[j * 40 + m] = (bf16_t)(cvt_pk_bf16_c((m < j) ? a0[r] : 0.f, 0.f) & 0xffffu);
                        ((LAS bf16_t*)(op + OP_MRB))[j * 40 + m] = (bf16_t)(cvt_pk_bf16_c((m <= j) ? a1[r] : 0.f, 0.f) & 0xffffu);
                        ((LAS bf16_t*)(op + OP_MRK))[j * 40 + m] = (bf16_t)(cvt_pk_bf16_c((m <= j) ? a2[r] : 0.f, 0.f) & 0xffffu); }
                    { u32x4 tb, tk, tv; unsigned short eb[8], ek[8], ev[8];
#pragma unroll
                      for (int i = 0; i < 8; ++i) { eb[i] = BH[(8 * pw + i) * 72 + lane]; ek[i] = KH[(8 * pw + i) * 72 + lane]; ev[i] = VH[(8 * pw + i) * 72 + lane]; }
                      tb.x = eb[0] | ((unsigned)eb[1] << 16); tb.y = eb[2] | ((unsigned)eb[3] << 16); tb.z = eb[4] | ((unsigned)eb[5] << 16); tb.w = eb[6] | ((unsigned)eb[7] << 16);
                      tk.x = ek[0] | ((unsigned)ek[1] << 16); tk.y = ek[2] | ((unsigned)ek[3] << 16); tk.z = ek[4] | ((unsigned)ek[5] << 16); tk.w = ek[6] | ((unsigned)ek[7] << 16);
                      tv.x = ev[0] | ((unsigned)ev[1] << 16); tv.y = ev[2] | ((unsigned)ev[3] << 16); tv.z = ev[4] | ((unsigned)ev[5] << 16); tv.w = ev[6] | ((unsigned)ev[7] << 16);
                      *(LAS u32x4*)((LAS bf16_t*)(op + OP_BT) + lane * 40 + 8 * pw) = tb; *(LAS u32x4*)((LAS bf16_t*)(op + OP_KT) + lane * 40 + 8 * pw) = tk; *(LAS u32x4*)((LAS bf16_t*)(op + OP_VT) + lane * 40 + 8 * pw) = tv; }
                    *(LAS u32x2*)((LAS bf16_t*)(op + OP_T) + (ptid >> 3) * 40 + 4 * (ptid & 7)) = tcur;
                }
                LDS_WAIT(); __builtin_amdgcn_s_barrier(); asm volatile("" ::: "memory");
            }
#undef PREP_LOAD
        } else {
            LAS bf16_t* XT = (LAS bf16_t*)(lds + CHN_OFF + wave * CHN_BYTES); LAS bf16_t* ZT = XT + 16 * 72; LAS bf16_t* UT = ZT + 16 * 40;
            f32x4 X[4];
#pragma unroll
            for (int mt = 0; mt < 4; ++mt) X[mt] = (f32x4){0.f, 0.f, 0.f, 0.f};
#pragma unroll 1
            for (int it = -1; it < NCHUNK; ++it) {
                const LAS unsigned char* op = lds + (it & 1) * OP_BYTES;
                f32x4 U0, U1;
                if (it >= 0) {
                    const LAS bf16_t* AH = (const LAS bf16_t*)(op + OP_AH); const LAS bf16_t* LAK = (const LAS bf16_t*)(op + OP_LAK); const LAS bf16_t* TT_ = (const LAS bf16_t*)(op + OP_T); const LAS bf16_t* VT = (const LAS bf16_t*)(op + OP_VT);
#pragma unroll
                    for (int mt = 0; mt < 4; ++mt) { u32x2 w; w.x = cvt_pk_bf16_c(X[mt][0], X[mt][1]); w.y = cvt_pk_bf16_c(X[mt][2], X[mt][3]); *(LAS u32x2*)(XT + fr * 72 + mt * 16 + 4 * fq) = w; }
                    LDS_WAIT();
                    const bf16x8 x0 = frag(XT, 72, 0, 0, lane), x1 = frag(XT, 72, 0, 32, lane), vt = frag(VT, 40, 16 * wave, 0, lane);
                    f32x4 Z0 = (f32x4){0.f, 0.f, 0.f, 0.f}, Z1 = Z0;
                    Z0 = MFMA16(frag(AH, 72, 0, 0, lane), x0, Z0); Z0 = MFMA16(frag(AH, 72, 0, 32, lane), x1, Z0); Z0 = MFMA16(frag(LAK, 40, 0, 0, lane), vt, Z0);
                    Z1 = MFMA16(frag(AH, 72, 16, 0, lane), x0, Z1); Z1 = MFMA16(frag(AH, 72, 16, 32, lane), x1, Z1); Z1 = MFMA16(frag(LAK, 40, 16, 0, lane), vt, Z1);
                    { u32x2 w; w.x = cvt_pk_bf16_c(Z0[0], Z0[1]); w.y = cvt_pk_bf16_c(Z0[2], Z0[3]); *(LAS u32x2*)(ZT + fr * 40 + 4 * fq) = w; w.x = cvt_pk_bf16_c(Z1[0], Z1[1]); w.y = cvt_pk_bf16_c(Z1[2], Z1[3]); *(LAS u32x2*)(ZT + fr * 40 + 16 + 4 * fq) = w; }
                    LDS_WAIT();
                    const bf16x8 zt = frag(ZT, 40, 0, 0, lane);
                    const f32x4 zero4 = (f32x4){0.f, 0.f, 0.f, 0.f}; U0 = MFMA16(frag(TT_, 40, 0, 0, lane), zt, zero4); U1 = MFMA16(frag(TT_, 40, 16, 0, lane), zt, zero4);
                    { u32x2 w; w.x = cvt_pk_bf16_c(U0[0], U0[1]); w.y = cvt_pk_bf16_c(U0[2], U0[3]); *(LAS u32x2*)(UT + fr * 40 + 4 * fq) = w; w.x = cvt_pk_bf16_c(U1[0], U1[1]); w.y = cvt_pk_bf16_c(U1[2], U1[3]); *(LAS u32x2*)(UT + fr * 40 + 16 + 4 * fq) = w; }
                }
                LDS_WAIT(); __builtin_amdgcn_s_barrier(); asm volatile("" ::: "memory");
                if (it >= 0) {
                    const LAS bf16_t* RH = (const LAS bf16_t*)(op + OP_RH); const LAS bf16_t* MRB = (const LAS bf16_t*)(op + OP_MRB); const LAS bf16_t* MRK = (const LAS bf16_t*)(op + OP_MRK);
                    const LAS bf16_t* BT = (const LAS bf16_t*)(op + OP_BT); const LAS bf16_t* KT = (const LAS bf16_t*)(op + OP_KT); const LAS bf16_t* VT = (const LAS bf16_t*)(op + OP_VT); const LAS float* PV = (const LAS float*)(op + OP_PV);
                    const bf16x8 x0 = frag(XT, 72, 0, 0, lane), x1 = frag(XT, 72, 0, 32, lane), vt = frag(VT, 40, 16 * wave, 0, lane), ut = frag(UT, 40, 0, 0, lane);
                    if (it >= CTXL / CH) {
#pragma unroll
                        for (int mt = 0; mt < 2; ++mt) { f32x4 Y = (f32x4){0.f, 0.f, 0.f, 0.f};
                            Y = MFMA16(frag(RH, 72, mt * 16, 0, lane), x0, Y); Y = MFMA16(frag(RH, 72, mt * 16, 32, lane), x1, Y); Y = MFMA16(frag(MRB, 40, mt * 16, 0, lane), ut, Y); Y = MFMA16(frag(MRK, 40, mt * 16, 0, lane), vt, Y);
#pragma unroll
                            for (int r = 0; r < 4; ++r) { const int m = wkv_row(b, d, it * CH + mt * 16 + 4 * fq + r); YD[(size_t)m * DM + h * 64 + 16 * wave + fr] = (bf16_t)(cvt_pk_bf16_c(Y[r], 0.f) & 0xffffu); } } }
#pragma unroll
                    for (int mt = 0; mt < 4; ++mt) { X[mt] = MFMA16(frag(BT, 40, mt * 16, 0, lane), ut, X[mt]); X[mt] = MFMA16(frag(KT, 40, mt * 16, 0, lane), vt, X[mt]);
                        const f32x4 p = *(const LAS f32x4*)(PV + mt * 16 + 4 * fq); X[mt] = X[mt] * p; }
                }
                LDS_WAIT(); __builtin_amdgcn_s_barrier(); asm volatile("" ::: "memory");
            }
        }
    }
}

__device__ __forceinline__ void p16_readout(KAREF A, int G) {
    const int lane = threadIdx.x & 63, wave = threadIdx.x >> 6, gw = blockIdx.x * 8 + wave, ngw = G * 8;
    const bf16_t* R = (const bf16_t*)(A.ws + WS_ACT + A_RKV); const bf16_t* Kk = R + (size_t)TT * DM; const bf16_t* V = Kk + (size_t)TT * DM;
    const bf16_t* AD0 = (const bf16_t*)(A.ws + WS_ACT + A_AD); const bf16_t* AD1 = AD0 + (size_t)TT * DM; const bf16_t* Gg = (const bf16_t*)(A.ws + WS_ACT + A_G);
    const bf16_t* Y0 = (const bf16_t*)(A.ws + WS_ACT + A_YD0); const bf16_t* Y1 = (const bf16_t*)(A.ws + WS_ACT + A_YD1); bf16_t* O = (bf16_t*)(A.ws + WS_ACT + A_O);
    const int c0 = 16 * lane;
    float ka[16], rk[16], gng[16], gnb[16];
#pragma unroll
    for (int i = 0; i < 16; ++i) { ka[i] = A.in[I1_KA][c0 + i]; rk[i] = A.in[I1_RK][c0 + i]; gng[i] = A.in[I1_GNG][c0 + i]; gnb[i] = A.in[I1_GNB][c0 + i]; }
    for (int m = gw; m < TL; m += ngw) {
        const size_t o = (size_t)m * DM + c0;
        float y[16], rr[16], kk[16], vv[16], a0[16], a1[16], gg[16];
#define LD16(dst, P) do { const u32x4 w0 = *(const u32x4*)((P) + o), w1 = *(const u32x4*)((P) + o + 8); dst[0] = bflo(w0.x); dst[1] = bfhi(w0.x); dst[2] = bflo(w0.y); dst[3] = bfhi(w0.y); dst[4] = bflo(w0.z); dst[5] = bfhi(w0.z); dst[6] = bflo(w0.w); dst[7] = bfhi(w0.w); \
        dst[8] = bflo(w1.x); dst[9] = bfhi(w1.x); dst[10] = bflo(w1.y); dst[11] = bfhi(w1.y); dst[12] = bflo(w1.z); dst[13] = bfhi(w1.z); dst[14] = bflo(w1.w); dst[15] = bfhi(w1.w); } while (0)
#if defined(DBG_WKV)
        { const bf16_t* YO0 = (const bf16_t*)(A.ws + WS_MOEW1); const bf16_t* YO1 = YO0 + (size_t)TL * DM; float yn0[16], yn1[16];
          LD16(yn0, Y0); LD16(yn1, Y1); LD16(y, YO0); LD16(rr, YO1);
          float em = 0.f, sm = 0.f; bool bad = false;
#pragma unroll
          for (int i = 0; i < 16; ++i) { const float d0 = fabsf(yn0[i] - y[i]), d1 = fabsf(yn1[i] - rr[i]); bad = bad || !(d0 < 1e30f) || !(d1 < 1e30f); em = fmaxf(em, fmaxf(d0, d1)); sm = fmaxf(sm, fmaxf(fabsf(y[i]), fabsf(rr[i]))); }
#pragma unroll
          for (int o = 1; o < 64; o <<= 1) { em = fmaxf(em, __shfl_xor(em, o)); sm = fmaxf(sm, __shfl_xor(sm, o)); }
          const bool anybad = __any(bad);
          if (lane == 0) { unsigned* cw = (unsigned*)(A.ws + WS_CTL) + 8192; if (!anybad) atomicMax(cw, __float_as_uint(em)); atomicMax(cw + 1, __float_as_uint(sm)); if (anybad) atomicAdd(cw + 2, 1u); } }
#else
        LD16(y, Y0); LD16(rr, Y1);
#endif
#pragma unroll
        for (int i = 0; i < 16; ++i) y[i] += rr[i];
        LD16(rr, R); LD16(kk, Kk); LD16(vv, V); LD16(a0, AD0); LD16(a1, AD1); LD16(gg, Gg);
#undef LD16
        float s = 0.f, bs = 0.f;
#pragma unroll
        for (int i = 0; i < 16; ++i) { s += y[i]; bs += rr[i] * kk[i] * rk[i] * (2.0f + (a0[i] + a1[i] - 2.0f) * ka[i]); }
        s += __shfl_xor(s, 1); s += __shfl_xor(s, 2); bs += __shfl_xor(bs, 1); bs += __shfl_xor(bs, 2);
        const float mean = s * (1.f / 64.f); float q = 0.f;
#pragma unroll
        for (int i = 0; i < 16; ++i) { const float dlt = y[i] - mean; q += dlt * dlt; }
        q += __shfl_xor(q, 1); q += __shfl_xor(q, 2);
        const float rstd = __builtin_amdgcn_rsqf(q * (1.f / 64.f) + 64e-5f);
        unsigned w[8];
#pragma unroll
        for (int i = 0; i < 8; ++i) { const float o0 = ((y[2 * i] - mean) * rstd * gng[2 * i] + gnb[2 * i] + bs * vv[2 * i]) * gg[2 * i], o1 = ((y[2 * i + 1] - mean) * rstd * gng[2 * i + 1] + gnb[2 * i + 1] + bs * vv[2 * i + 1]) * gg[2 * i + 1];
            w[i] = cvt_pk_bf16(o0, o1); }
        *(u32x4*)(O + o) = (u32x4){w[0], w[1], w[2], w[3]}; *(u32x4*)(O + o + 8) = (u32x4){w[4], w[5], w[6], w[7]};
    }
}
#if defined(DBG_WKV)
__device__ __forceinline__ float rowsum16(float x) { x = DPP_ADD(x, 0xB1); x = DPP_ADD(x, 0x4E); x = DPP_ADD(x, 0x141); x = DPP_ADD(x, 0x140); return x; }
constexpr int WKV_TB = 32, WKV_STEP_F = 6 * 64, WKV_BUF_F = WKV_TB * WKV_STEP_F;
__device__ __forceinline__ void p15_wkv_old(KAREF A, LAS unsigned char* lds, int G) {
    const int tid = threadIdx.x, lane = tid & 63, wid = tid >> 6;
    LAS float* BUF = (LAS float*)lds;
    LAS float* YB = (LAS float*)(lds + 2 * WKV_BUF_F * 4);
    const bf16_t* R = (const bf16_t*)(A.ws + WS_ACT + A_RKV); const bf16_t* Kk = R + (size_t)TT * DM; const bf16_t* V = Kk + (size_t)TT * DM;
    for (int u = blockIdx.x; u < 256; u += G) {
        const int chain = u >> 1, half = u & 1, b = chain >> 5, h = (chain >> 1) & 15, d = chain & 1;
        const bf16_t* SD = (const bf16_t*)(A.ws + WS_ACT + A_SD) + (size_t)d * TT * DM; const bf16_t* AD = (const bf16_t*)(A.ws + WS_ACT + A_AD) + (size_t)d * TT * DM;
        bf16_t* YD = (bf16_t*)(A.ws + WS_MOEW1) + (size_t)d * TL * DM;
        const int ls = tid >> 4, lc = 4 * (tid & 15), hc = h * 64 + lc;
        const f32x4 kkw = *(const f32x4*)(A.in[I1_KK] + hc), kaw = *(const f32x4*)(A.in[I1_KA] + hc);
        u32x2 gr, gk, gv, gs, ga;
#define WKV_LOAD(blk) do { const size_t ro = (size_t)wkv_row(b, d, (blk) * WKV_TB + ls) * DM + hc; gr = *(const u32x2*)(R + ro); gk = *(const u32x2*)(Kk + ro); gv = *(const u32x2*)(V + ro); gs = *(const u32x2*)(SD + ro); ga = *(const u32x2*)(AD + ro); } while (0)
#define WKV_STORE(bufi) do { LAS float* dst = BUF + (bufi) * WKV_BUF_F + ls * WKV_STEP_F + lc; \
        const f32x4 kf = (f32x4){bflo(gk.x), bfhi(gk.x), bflo(gk.y), bfhi(gk.y)}, af = (f32x4){bflo(ga.x), bfhi(ga.x), bflo(ga.y), bfhi(ga.y)}, sf = (f32x4){bflo(gs.x), bfhi(gs.x), bflo(gs.y), bfhi(gs.y)}; \
        const f32x4 kkv = kf * kkw; float ssq = (kkv.x * kkv.x + kkv.y * kkv.y) + (kkv.z * kkv.z + kkv.w * kkv.w); ssq = rowsum16(ssq); \
        const f32x4 kkn = kkv * __builtin_amdgcn_rsqf(fmaxf(ssq, 1e-24f)); \
        f32x4 wd; wd.x = fexp(-0.6065306597126334f * sf.x); wd.y = fexp(-0.6065306597126334f * sf.y); wd.z = fexp(-0.6065306597126334f * sf.z); wd.w = fexp(-0.6065306597126334f * sf.w); \
        *(LAS f32x4*)(dst) = wd; *(LAS f32x4*)(dst + 64) = -kkn; *(LAS f32x4*)(dst + 128) = kkn * af; *(LAS f32x4*)(dst + 192) = kf * ((af - 1.0f) * kaw + 1.0f); \
        *(LAS f32x4*)(dst + 256) = (f32x4){bflo(gr.x), bfhi(gr.x), bflo(gr.y), bfhi(gr.y)}; *(LAS f32x4*)(dst + 320) = (f32x4){bflo(gv.x), bfhi(gv.x), bflo(gv.y), bfhi(gv.y)}; } while (0)
        __syncthreads();
        WKV_LOAD(0); WKV_STORE(0);
        __syncthreads();
        const int g = lane >> 4, j = lane & 15, vrow = 32 * half + 4 * wid + g;
        float S0 = 0.f, S1 = 0.f, S2 = 0.f, S3 = 0.f;
        constexpr int NBLK = (CTXL + SEQ) / WKV_TB;
#pragma unroll 1
        for (int blk = 0; blk < NBLK; ++blk) {
            const int cur = blk & 1;
            if (blk + 1 < NBLK) WKV_LOAD(blk + 1);
            const LAS float* bp = BUF + cur * WKV_BUF_F + 4 * j;
#pragma unroll 1
            for (int t8 = 0; t8 < WKV_TB; t8 += 8) {
                float yv[8];
#pragma unroll
                for (int tt = 0; tt < 8; ++tt) {
                    const LAS float* sp = bp + (t8 + tt) * WKV_STEP_F;
                    const f32x4 w4 = *(const LAS f32x4*)(sp), a4 = *(const LAS f32x4*)(sp + 64), b4 = *(const LAS f32x4*)(sp + 128), k4 = *(const LAS f32x4*)(sp + 192), r4 = *(const LAS f32x4*)(sp + 256);
                    const float v1 = BUF[cur * WKV_BUF_F + (t8 + tt) * WKV_STEP_F + 320 + vrow];
                    float sa = (S0 * a4.x + S1 * a4.y) + (S2 * a4.z + S3 * a4.w);
                    const float t0 = S0 * w4.x + v1 * k4.x, t1 = S1 * w4.y + v1 * k4.y, t2 = S2 * w4.z + v1 * k4.z, t3 = S3 * w4.w + v1 * k4.w;
                    sa = rowsum16(sa);
                    S0 = sa * b4.x + t0; S1 = sa * b4.y + t1; S2 = sa * b4.z + t2; S3 = sa * b4.w + t3;
                    yv[tt] = (S0 * r4.x + S1 * r4.y) + (S2 * r4.z + S3 * r4.w);
                }
#pragma unroll
                for (int tt = 0; tt < 8; ++tt) { const float y = rowsum16(yv[tt]); if (j == 0) YB[(t8 + tt) * 32 + 4 * wid + g] = y; }
            }
            __syncthreads();
            if (blk * WKV_TB >= CTXL) {
                const int m = wkv_row(b, d, blk * WKV_TB + ls); const int r2 = 2 * (tid & 15);
                *(unsigned*)(YD + (size_t)m * DM + h * 64 + 32 * half + r2) = cvt_pk_bf16(YB[ls * 32 + r2], YB[ls * 32 + r2 + 1]); }
            if (blk + 1 < NBLK) WKV_STORE(cur ^ 1);
            __syncthreads();
        }
#undef WKV_LOAD
#undef WKV_STORE
    }
}

#endif
constexpr int N_PHASES = 25;
__global__ void __launch_bounds__(512, 2) fwd_kernel(KArgs A_unused) {
    const __attribute__((address_space(4))) KArgs* kp = (const __attribute__((address_space(4))) KArgs*)__builtin_amdgcn_kernarg_segment_ptr();
    extern __shared__ __attribute__((aligned(16))) unsigned char lds_raw[];
    LAS unsigned char* lds = (LAS unsigned char*)lds_raw;
    const int G = gridDim.x, tid = threadIdx.x;
    for (int u = tid; u < (LDS_BYTES - LDSCTL_OFF) / 4; u += 512) ((LAS unsigned*)(lds + LDSCTL_OFF))[u] = 0u;
    __syncthreads();
    const int lo = kp->ph_lo, hi = kp->ph_hi;
    const bool use_bar = (hi - lo) > 1;
    XcdBarrier bar; bar.bar = (unsigned*)(kp->ws + WS_CTL) + 4096; bar.x = 0; bar.st = (volatile LAS unsigned*)(lds + MISC_OFF) + 8;
    if (use_bar) bar = xcd_barrier_post((unsigned*)(kp->ws + WS_CTL) + 4096, (volatile LAS unsigned*)(lds + MISC_OFF) + 8);
#ifndef ONLY_PHASE
#define ONLY_PHASE -1
#endif
#ifndef DBG_STOP
#define DBG_STOP 99
#endif
#define IN(k) ((ONLY_PHASE < 0 || ONLY_PHASE == (k)) && (k) < DBG_STOP && lo <= (k) && (k) < hi)
#ifndef DBG_REP
#define DBG_REP -1
#endif
#ifndef DBG_REPN
#define DBG_REPN 2
#endif
#define REPEAT(k) for (int rep_ = 0; rep_ < ((k) == DBG_REP ? DBG_REPN : 1); ++rep_)
#define SEAM(k) do { if (IN(k) && IN((k) + 1)) xcd_barrier(bar); } while (0)

    if (IN(0)) REPEAT(0) { __syncthreads(); KAREF A = *ka_launder(kp); unsigned char* ws = A.ws; unsigned char* act = ws + WS_ACT; (void)act; p0_prologue(A, lds, G); } SEAM(0);
    if (IN(1)) REPEAT(1) { __syncthreads(); KAREF A = *ka_launder(kp); unsigned char* ws = A.ws; unsigned char* act = ws + WS_ACT; (void)act; p1_norm0(A, G); } SEAM(1);
    if (IN(2)) REPEAT(2) { __syncthreads(); KAREF A = *ka_launder(kp); unsigned char* ws = A.ws; unsigned char* act = ws + WS_ACT; (void)act;
        pg8::Gemm g{(const bf16_t*)(act + A_H), (const bf16_t*)(ws + WS_WIN), DM}; pg8::StaticOrder S; S.init(TT, 1792, G, (int)blockIdx.x);
        EpiWin E{(bf16_t*)(act + A_XA), (bf16_t*)(act + A_GA), (float*)(act + A_QR), (float*)(act + A_KR), (bf16_t*)(act + A_VB)};
        pg8::gemm_phase<EpiWin, pg8::StaticOrder, true, true>(lds + RING_OFF, g, S, E);
    } SEAM(2);
    if (IN(3)) REPEAT(3) { __syncthreads(); KAREF A = *ka_launder(kp); unsigned char* ws = A.ws; unsigned char* act = ws + WS_ACT; (void)act; p3_kprep(A, G); p3_lru_pass1(A, lds, G); } SEAM(3);
    if (IN(4)) REPEAT(4) { __syncthreads(); KAREF A = *ka_launder(kp); unsigned char* ws = A.ws; unsigned char* act = ws + WS_ACT; (void)act; p4_lru_pass2(A, lds, G); __syncthreads(); p4_attention(A, (char*)lds_raw + RING_OFF, G); } SEAM(4);
    if (IN(5)) REPEAT(5) { __syncthreads(); KAREF A = *ka_launder(kp); unsigned char* ws = A.ws; unsigned char* act = ws + WS_ACT; (void)act;
        pg8::Gemm g{(const bf16_t*)(act + A_YCAT), (const bf16_t*)(ws + WS_WOUT), DM}; pg8::StaticOrder S; S.init(TT, DM, G, (int)blockIdx.x);
        EpiResid E{A.in[I_X], A.in[I_CTX], A.out, (float*)(ws + WS_CTXS), ada_ptr(ws, 0, 0, 2)};
        pg8::gemm_phase<EpiResid, pg8::StaticOrder, true, true>(lds + RING_OFF, g, S, E);
    } SEAM(5);
    if (IN(6)) REPEAT(6) { __syncthreads(); KAREF A = *ka_launder(kp); unsigned char* ws = A.ws; unsigned char* act = ws + WS_ACT; (void)act; p6_norm_router(A, lds, G, 0, TT); } SEAM(6);
    if (IN(7)) REPEAT(7) { __syncthreads(); KAREF A = *ka_launder(kp); unsigned char* ws = A.ws; unsigned char* act = ws + WS_ACT; (void)act; p7_topk(A, lds, G, true); } SEAM(7);
    if (IN(8)) REPEAT(8) { __syncthreads(); KAREF A = *ka_launder(kp); unsigned char* ws = A.ws; unsigned char* act = ws + WS_ACT; (void)act; p8_gather(A, G, true); } SEAM(8);
    if (IN(9)) REPEAT(9) { __syncthreads(); KAREF A = *ka_launder(kp); unsigned char* ws = A.ws; unsigned char* act = ws + WS_ACT; (void)act;
        pg8::Gemm g{(const bf16_t*)(act + A_XE), (const bf16_t*)(ws + WS_MOEW1), DM}; MoeOrder1 S{G, (int)blockIdx.x, 4096 + 256};
        EpiSwiGLU E{(bf16_t*)(act + A_HID)};
        pg8::gemm_phase<EpiSwiGLU, MoeOrder1, true, true>(lds + RING_OFF, g, S, E);
    } SEAM(9);
    if (IN(10)) REPEAT(10) { __syncthreads(); KAREF A = *ka_launder(kp); unsigned char* ws = A.ws; unsigned char* act = ws + WS_ACT; (void)act;
        pg8::Gemm g{(const bf16_t*)(act + A_HID), (const bf16_t*)(ws + WS_MOEW2), FF}; MoeOrder2 S{G, (int)blockIdx.x, 1024 + 64};
        EpiDown E{(bf16_t*)(act + A_YE), (const float*)(ws + WS_GROW)};
        pg8::gemm_phase<EpiDown, MoeOrder2, true, true>(lds + RING_OFF, g, S, E);
    } SEAM(10);
    if (IN(11)) REPEAT(11) { __syncthreads(); KAREF A = *ka_launder(kp); unsigned char* ws = A.ws; unsigned char* act = ws + WS_ACT; (void)act; p11_combine(A, G, 0, TT); } SEAM(11);
    if (IN(12)) REPEAT(12) { __syncthreads(); KAREF A = *ka_launder(kp); unsigned char* ws = A.ws; unsigned char* act = ws + WS_ACT; (void)act; p12_l1_prep(A, G);
#if !defined(DBG_WKV)
        { const int wave = tid >> 6; moe_convert(A, 1, lds, blockIdx.x * 8 + wave, G * 8, wave, tid & 63); }
#endif
    } SEAM(12);
    if (IN(13)) REPEAT(13) { __syncthreads(); KAREF A = *ka_launder(kp); unsigned char* ws = A.ws; unsigned char* act = ws + WS_ACT; (void)act;
        pg8::Gemm g{(const bf16_t*)(act + A_XMIX), (const bf16_t*)(ws + WS_BMIX), DM}; MixOrder S{G, (int)blockIdx.x};
        EpiMix E{(bf16_t*)(act + A_RKV), (bf16_t*)(act + A_LG), (bf16_t*)(act + A_LWA)};
        pg8::gemm_phase<EpiMix, MixOrder, true, true>(lds + RING_OFF, g, S, E);
    } SEAM(13);
    if (IN(14)) REPEAT(14) { __syncthreads(); KAREF A = *ka_launder(kp); unsigned char* ws = A.ws; unsigned char* act = ws + WS_ACT; (void)act;
        int k2 = 256; asm volatile("" : "+s"(k2));
        pg8::Gemm g{(const bf16_t*)(act + A_LG), (const bf16_t*)(ws + WS_B2), k2}; LoraOrder S{G, (int)blockIdx.x};
        EpiLora E{(bf16_t*)(act + A_SD), (bf16_t*)(act + A_AD), (bf16_t*)(act + A_G), A.in[I1_W0], A.in[I1_A0]};
        pg8::gemm_phase<EpiLora, LoraOrder, true, true>(lds + RING_OFF, g, S, E);
    } SEAM(14);
    if (IN(15)) REPEAT(15) { __syncthreads(); KAREF A = *ka_launder(kp); unsigned char* ws = A.ws; unsigned char* act = ws + WS_ACT; (void)act; p15_tbuild(A, lds, G); } SEAM(15);
    if (IN(16)) REPEAT(16) { __syncthreads(); KAREF A = *ka_launder(kp); unsigned char* ws = A.ws; unsigned char* act = ws + WS_ACT; (void)act; (void)ws; p16_chain(A, lds, G);
#if defined(DBG_WKV)
        __syncthreads(); p15_wkv_old(A, lds, G);
#endif
    } SEAM(16);
    if (IN(17)) REPEAT(17) { __syncthreads(); KAREF A = *ka_launder(kp); unsigned char* ws = A.ws; unsigned char* act = ws + WS_ACT; (void)act; p16_readout(A, G);
#if defined(DBG_WKV)
        __syncthreads(); { const int wave = tid >> 6; moe_convert(A, 1, lds, blockIdx.x * 8 + wave, G * 8, wave, tid & 63); }
#endif
    } SEAM(17);
    if (IN(18)) REPEAT(18) { __syncthreads(); KAREF A = *ka_launder(kp); unsigned char* ws = A.ws; unsigned char* act = ws + WS_ACT; (void)act;
        pg8::Gemm g{(const bf16_t*)(act + A_O), (const bf16_t*)(ws + WS_WO), DM}; pg8::StaticOrder S; S.init(TL, DM, G, (int)blockIdx.x);
        EpiResid E{A.out, A.out, A.out, A.out, ada_ptr(ws, 1, 0, 2)};
        pg8::gemm_phase<EpiResid, pg8::StaticOrder, true, true>(lds + RING_OFF, g, S, E);
    } SEAM(18);
    if (IN(19)) REPEAT(19) { __syncthreads(); KAREF A = *ka_launder(kp); unsigned char* ws = A.ws; unsigned char* act = ws + WS_ACT; (void)act; p6_norm_router(A, lds, G, 1, TL); } SEAM(19);
    if (IN(20)) REPEAT(20) { __syncthreads(); KAREF A = *ka_launder(kp); unsigned char* ws = A.ws; unsigned char* act = ws + WS_ACT; (void)act; p7_topk(A, lds, G, false); } SEAM(20);
    if (IN(21)) REPEAT(21) { __syncthreads(); KAREF A = *ka_launder(kp); unsigned char* ws = A.ws; unsigned char* act = ws + WS_ACT; (void)act; p8_gather(A, G, false); } SEAM(21);
    if (IN(22)) REPEAT(22) { __syncthreads(); KAREF A = *ka_launder(kp); unsigned char* ws = A.ws; unsigned char* act = ws + WS_ACT; (void)act;
        pg8::Gemm g{(const bf16_t*)(act + A_XE), (const bf16_t*)(ws + WS_MOEW1), DM}; MoeOrder1 S{G, (int)blockIdx.x, 4096};
        EpiSwiGLU E{(bf16_t*)(act + A_HID)};
        pg8::gemm_phase<EpiSwiGLU, MoeOrder1, true, true>(lds + RING_OFF, g, S, E);
    } SEAM(22);
    if (IN(23)) REPEAT(23) { __syncthreads(); KAREF A = *ka_launder(kp); unsigned char* ws = A.ws; unsigned char* act = ws + WS_ACT; (void)act;
        pg8::Gemm g{(const bf16_t*)(act + A_HID), (const bf16_t*)(ws + WS_MOEW2), FF}; MoeOrder2 S{G, (int)blockIdx.x, 1024};
        EpiDown E{(bf16_t*)(act + A_YE), (const float*)(ws + WS_GROW)};
        pg8::gemm_phase<EpiDown, MoeOrder2, true, true>(lds + RING_OFF, g, S, E);
    } SEAM(23);
    if (IN(24)) REPEAT(24) { __syncthreads(); KAREF A = *ka_launder(kp); unsigned char* ws = A.ws; unsigned char* act = ws + WS_ACT; (void)act; p11_combine(A, G, 1, TL); }
#undef IN
#undef SEAM
}

#ifndef N_LAUNCH_MODE
#define N_LAUNCH_MODE 0
#endif
extern "C" void kernel_launch(void* const* d_in, const int* in_sizes, int n_in, void* d_out, int out_size, void* d_ws, size_t ws_size, hipStream_t stream) {
    static int grid = 0;
    if (grid == 0) {
        if (n_in != N_IN || in_sizes[0] != TL * DM || out_size != TL * DM || ws_size < WS_END) {
            fprintf(stderr, "kernel_launch: unexpected shapes (n_in %d, in0 %d, out %d, ws %zu < %zu?); nothing launched\n", n_in, n_in > 0 ? in_sizes[0] : -1, out_size, ws_size, (size_t)WS_END); grid = -1; return; }
        int dev = 0, cus = 0, per_cu = 0;
        if (hipGetDevice(&dev) != hipSuccess || hipDeviceGetAttribute(&cus, hipDeviceAttributeMultiprocessorCount, dev) != hipSuccess) { grid = -1; return; }
        if (hipFuncSetAttribute((const void*)fwd_kernel, hipFuncAttributeMaxDynamicSharedMemorySize, LDS_BYTES) != hipSuccess) { fprintf(stderr, "kernel_launch: hipFuncSetAttribute failed\n"); grid = -1; return; }
        if (hipOccupancyMaxActiveBlocksPerMultiprocessor(&per_cu, (const void*)fwd_kernel, 512, LDS_BYTES) != hipSuccess || per_cu < 1) { fprintf(stderr, "kernel_launch: occupancy query says %d\n", per_cu); }
        (void)hipGetLastError();
        grid = cus;
    }
    if (grid < 0) return;
    (void)hipMemsetAsync((char*)d_ws, 0, ZERO_BYTES, stream);
    KArgs a{};
    for (int i = 0; i < N_IN; ++i) a.in[i] = (const float*)d_in[i];
    a.out = (float*)d_out; a.ws = (unsigned char*)d_ws;
#if N_LAUNCH_MODE == 1
    for (int p = 0; p < N_PHASES; ++p) { a.ph_lo = p; a.ph_hi = p + 1; hipLaunchKernelGGL(fwd_kernel, dim3(grid), dim3(512), LDS_BYTES, stream, a); }
#else
    a.ph_lo = 0; a.ph_hi = N_PHASES; hipLaunchKernelGGL(fwd_kernel, dim3(grid), dim3(512), LDS_BYTES, stream, a);
#endif
}
```

```cpp
#include <hip/hip_runtime.h>
#include <cstdio>
#include <cstdint>

#define GAS __attribute__((address_space(1)))
#define LAS __attribute__((address_space(3)))
typedef unsigned short bf16_t;
typedef short bf16x8 __attribute__((ext_vector_type(8)));
typedef short s16x4 __attribute__((ext_vector_type(4)));
typedef float f32x16 __attribute__((ext_vector_type(16)));
typedef float f32x4 __attribute__((ext_vector_type(4)));
typedef float f32x2 __attribute__((ext_vector_type(2)));
typedef unsigned u32x4 __attribute__((ext_vector_type(4)));
typedef unsigned u32x2 __attribute__((ext_vector_type(2)));

constexpr int NB = 4, SEQ = 8192, CTXL = 256, DM = 1024;
constexpr int TL = NB * SEQ, TC = NB * CTXL, TT = TL + TC;
constexpr int KVL = SEQ + CTXL;
constexpr int NE = 16, FF = 2048, CAPL = 1024, CAPC = 32;
constexpr int XE_CTX0 = NB * NE * CAPL;
constexpr int XE_ROWS = XE_CTX0 + NE * 256;

typedef float f32x2_cv __attribute__((ext_vector_type(2))); typedef __bf16 bf16x2_cv __attribute__((ext_vector_type(2)));
__device__ __forceinline__ unsigned cvt_pk_bf16_c(float lo, float hi) { const f32x2_cv v = {lo, hi}; const bf16x2_cv b = __builtin_convertvector(v, bf16x2_cv); return __builtin_bit_cast(unsigned, b); }
__device__ __forceinline__ unsigned cvt_pk_bf16(float lo, float hi) { unsigned r; asm volatile("v_cvt_pk_bf16_f32 %0, %1, %2" : "=v"(r) : "v"(lo), "v"(hi)); return r; }
__device__ __forceinline__ unsigned pk_fp8x4(float a, float b, float c, float d) { unsigned w; asm volatile("v_cvt_pk_fp8_f32 %0, %1, %2\n\tv_cvt_pk_fp8_f32 %0, %3, %4 op_sel:[0,0,1]" : "=&v"(w) : "v"(a), "v"(b), "v"(c), "v"(d)); return w; }
__device__ __forceinline__ float bflo(unsigned w) { return __uint_as_float(w << 16); }
__device__ __forceinline__ float bfhi(unsigned w) { return __uint_as_float(w & 0xffff0000u); }
__device__ __forceinline__ float bf2f(bf16_t b) { return __uint_as_float(((unsigned)b) << 16); }
__device__ __forceinline__ float wave_sum(float v) {
#pragma unroll
    for (int o = 1; o < 64; o <<= 1) v += __shfl_xor(v, o);
    return v;
}
__device__ __forceinline__ float fexp(float x) { return __builtin_amdgcn_exp2f(x * 1.4426950408889634f); }
__device__ __forceinline__ float sigm(float x) { return __builtin_amdgcn_rcpf(1.0f + __builtin_amdgcn_exp2f(-1.4426950408889634f * x)); }
__device__ __forceinline__ float tanh_f(float x) { return 1.0f - 2.0f * __builtin_amdgcn_rcpf(1.0f + __builtin_amdgcn_exp2f(2.8853900817779268f * x)); }
__device__ __forceinline__ float gelu_tanh(float x) { const float u = 0.7978845608028654f * (x + 0.044715f * x * x * x); return x * sigm(2.0f * u); }
__device__ __forceinline__ float silu_f(float x) { return x * sigm(x); }

namespace pg8 {
#define PG8_LAS __attribute__((address_space(3)))
constexpr int BM = 256, BK = 64, HALF = 128, HTB = HALF * BK * 2  , STAGE_BYTES = 8 * HTB, NXCD = 8, WGM = 8;
__host__ __device__ __forceinline__ int lds_byte(int r, int c) { const int st = (r >> 4) * 2 + (c >> 5), rr = r & 15, cc = c & 31, ob = rr * 64 + cc * 2; return st * 1024 + (ob ^ (((ob >> 9) & 1) << 5)); }
__host__ __device__ __forceinline__ void stage_rc(int b, int& R, int& C) { const int st = b / 1024, sb = b % 1024, swz = sb ^ (((sb >> 9) & 1) << 5); R = (st >> 1) * 16 + swz / 64; C = (st & 1) * 32 + (swz % 64) / 2; }
__host__ __device__ __forceinline__ int perm32(int rho) { const int n = rho >> 4, i = rho & 15; return 8 * (i >> 2) + 4 * n + (i & 3); }

struct Unit { int pm, pn, am, bn; };
struct Gemm { const bf16_t* A; const bf16_t* Bt; int K; };

struct StaticOrder {
    int nM, nN, nwg, G, c;
    __device__ void init(int M, int N, int G_, int c_) { nM = M / BM; nN = N / BM; nwg = nM * nN; G = G_; c = c_; }
    __device__ bool next(int i, Unit& u) const {
        const long L = (long)i * G + c; if (L >= nwg) return false;
        int wgid = (int)L; { const int q = nwg / NXCD, r = nwg % NXCD, xcd = wgid % NXCD, off = wgid / NXCD; wgid = (xcd < r ? xcd * (q + 1) : r * (q + 1) + (xcd - r) * q) + off; }
        const int nig = WGM * nN, gid = wgid / nig, fm = gid * WGM, gsz = (nM - fm) < WGM ? (nM - fm) : WGM;
        u.pm = fm + ((wgid % nig) % gsz); u.pn = (wgid % nig) / gsz; u.am = u.pm; u.bn = u.pn; return true;
    }
    __device__ __forceinline__ void a_ready(const Unit&) const {}
    __device__ __forceinline__ void done(const Unit&) const {}
};

typedef int v8i_t __attribute__((ext_vector_type(8)));
template <class Epi, class Sched, bool ALIGN_EPI = false, bool SP2 = false, bool FP8 = false>
__device__ __forceinline__ void gemm_phase(PG8_LAS unsigned char* lds, const Gemm g, const Sched& S, const Epi& E) {
    const int tid = threadIdx.x, wid = __builtin_amdgcn_readfirstlane(tid >> 6), lane = tid & 63, wr = wid >> 2, wc = wid & 3, fr = lane & 15, fq = lane >> 4;
    const int K = g.K, nt = K / BK;
    unsigned voffA[2], voffB[2];
#pragma unroll
    for (int i = 0; i < 2; ++i) { int R, C; stage_rc(tid * 16 + i * 8192, R, C); const int Rb = Epi::PERM ? ((R & ~31) + perm32(R & 31)) : R;
        voffA[i] = (unsigned)(R * K + C) * 2u; voffB[i] = (unsigned)(Rb * K + C) * 2u; }
    const size_t kstep = (size_t)(BK * 2);
    const size_t hstep = (size_t)HALF * K * 2;
    const size_t tstep = 2 * hstep;
    const unsigned ldsw = (unsigned)wid * 1024u;
    const int aoff = lds_byte(wr * 64 + fr, fq * 8), boff = lds_byte(wc * 32 + fr, fq * 8);
#define PG8_SA(b, h) (((b) * 2 + (h)) * HTB)
#define PG8_SB(b, h) ((4 + (b) * 2 + (h)) * HTB)
#define PG8_STAGE(bufoff, gbase, voff) do { _Pragma("unroll") for (int _i = 0; _i < 2; ++_i) \
        __builtin_amdgcn_global_load_lds((const unsigned*)((const char*)(gbase) + (voff)[_i]), (PG8_LAS unsigned*)(lds + (bufoff) + ldsw + _i * 8192), 16, 0, 0); } while (0)
#define PG8_LD8(p) __builtin_bit_cast(v8i_t, __builtin_shufflevector(*(const PG8_LAS u32x4*)(p), *(const PG8_LAS u32x4*)((p) + 1024), 0, 1, 2, 3, 4, 5, 6, 7))
#define PG8_LDA(dst, b, h) do { if constexpr (FP8) { _Pragma("unroll") for (int m = 0; m < 4; ++m) dst##8[m] = PG8_LD8(lds + PG8_SA(b, h) + aoff + m * 2048); } \
        else { _Pragma("unroll") for (int m = 0; m < 4; ++m) _Pragma("unroll") for (int k = 0; k < 2; ++k) dst[m][k] = *(const PG8_LAS bf16x8*)(lds + PG8_SA(b, h) + aoff + m * 2048 + k * 1024); } } while (0)
#define PG8_LDB(dst, b, h) do { if constexpr (FP8) { _Pragma("unroll") for (int n = 0; n < 2; ++n) dst##8[n] = PG8_LD8(lds + PG8_SB(b, h) + boff + n * 2048); } \
        else { _Pragma("unroll") for (int n = 0; n < 2; ++n) _Pragma("unroll") for (int k = 0; k < 2; ++k) dst[n][k] = *(const PG8_LAS bf16x8*)(lds + PG8_SB(b, h) + boff + n * 2048 + k * 1024); } } while (0)
#define PG8_MMA(ai, bj, At, Bt) do { __builtin_amdgcn_s_setprio(1); _Pragma("unroll") for (int m = 0; m < 4; ++m) _Pragma("unroll") for (int n = 0; n < 2; ++n) { \
        if constexpr (FP8) asm volatile("v_mfma_scale_f32_16x16x128_f8f6f4 %0, %1, %2, %0, %3, %3 op_sel_hi:[0,0,0]" : "+v"(acc[ai][bj][m][n]) : "v"(Bt##8[n]), "v"(At##8[m]), "v"(sc8));   \
        else { _Pragma("unroll") for (int k = 0; k < 2; ++k) acc[ai][bj][m][n] = __builtin_amdgcn_mfma_f32_16x16x32_bf16(Bt[n][k], At[m][k], acc[ai][bj][m][n], 0, 0, 0); } } __builtin_amdgcn_s_setprio(0); } while (0)
#define PG8_WAIT_V(n) asm volatile("s_waitcnt vmcnt(" #n ")" ::: "memory")
#define PG8_WAIT_L(n) asm volatile("s_waitcnt lgkmcnt(" #n ")" ::: "memory")
#define PG8_BAR __builtin_amdgcn_s_barrier()
#define PG8_SCHED __builtin_amdgcn_sched_barrier(0)
    Unit cur, nxt; int ui = 0;
    if (!S.next(0, cur)) return;
    f32x4 acc[2][2][4][2];
#pragma unroll
    for (int a = 0; a < 2; ++a)
#pragma unroll
        for (int b = 0; b < 2; ++b)
#pragma unroll
            for (int m = 0; m < 4; ++m)
#pragma unroll
                for (int n = 0; n < 2; ++n) acc[a][b][m][n] = (f32x4){0.f, 0.f, 0.f, 0.f};
    bf16x8 At[4][2], B0[2][2], B1[2][2]; v8i_t At8[4], B08[2], B18[2]; const unsigned sc8 = 0x7f7f7f7fu; (void)At; (void)B0; (void)B1; (void)At8; (void)B08; (void)B18; (void)sc8;
    const char* cA = (const char*)g.A + (size_t)cur.am * tstep; const char* cB = (const char*)g.Bt + (size_t)cur.bn * tstep;
    S.a_ready(cur);
    if constexpr (SP2) {
        PG8_STAGE(PG8_SB(0, 0), cB, voffB); PG8_STAGE(PG8_SB(0, 1), cB + hstep, voffB); PG8_STAGE(PG8_SA(0, 0), cA, voffA); PG8_STAGE(PG8_SA(0, 1), cA + hstep, voffA);
        if (wr == 1) PG8_BAR;
        PG8_WAIT_V(2); PG8_BAR;
        PG8_STAGE(PG8_SB(1, 0), cB + kstep, voffB); PG8_STAGE(PG8_SA(1, 0), cA + kstep, voffA); PG8_STAGE(PG8_SB(1, 1), cB + hstep + kstep, voffB);
        PG8_WAIT_V(6); PG8_BAR;
    } else {
        PG8_STAGE(PG8_SB(0, 0), cB, voffB); PG8_STAGE(PG8_SA(0, 0), cA, voffA); PG8_STAGE(PG8_SB(0, 1), cB + hstep, voffB); PG8_STAGE(PG8_SA(0, 1), cA + hstep, voffA);
        if (wr == 1) PG8_BAR;
        PG8_WAIT_V(4); PG8_BAR;
        PG8_STAGE(PG8_SB(1, 0), cB + kstep, voffB); PG8_STAGE(PG8_SA(1, 0), cA + kstep, voffA); PG8_STAGE(PG8_SB(1, 1), cB + hstep + kstep, voffB);
        PG8_WAIT_V(6); PG8_BAR;
    }
    for (;;) {
        const bool has_next = S.next(ui + 1, nxt);
        const char* nA = has_next ? (const char*)g.A + (size_t)nxt.am * tstep : cA; const char* nB = has_next ? (const char*)g.Bt + (size_t)nxt.bn * tstep : cB;
        for (int t = 0; t < nt; t += 2) {
            const bool last = (t == nt - 2);
            const char* a1 = cA + (size_t)(t + 1) * kstep;
            const char* a2 = last ? nA : cA + (size_t)(t + 2) * kstep; const char* b2 = last ? nB : cB + (size_t)(t + 2) * kstep;
            const char* a3 = a2 + kstep; const char* b3 = b2 + kstep;
            if (last && has_next) S.a_ready(nxt);
            if constexpr (SP2) {
            PG8_LDB(B0, 0, 0); PG8_LDB(B1, 0, 1); PG8_SCHED; PG8_LDA(At, 0, 0); PG8_STAGE(PG8_SA(1, 1), a1 + hstep, voffA);
            PG8_WAIT_V(8); PG8_WAIT_L(0); PG8_BAR; PG8_MMA(0, 0, At, B0); PG8_MMA(0, 1, At, B1); PG8_BAR; PG8_SCHED;
            PG8_LDA(At, 0, 1); PG8_STAGE(PG8_SB(0, 0), b2, voffB); PG8_STAGE(PG8_SB(0, 1), b2 + hstep, voffB); PG8_STAGE(PG8_SA(0, 0), a2, voffA);
            PG8_WAIT_V(8); PG8_WAIT_L(0); PG8_BAR; PG8_MMA(1, 0, At, B0); PG8_MMA(1, 1, At, B1); PG8_BAR; PG8_SCHED;
            PG8_LDB(B0, 1, 0); PG8_LDB(B1, 1, 1); PG8_SCHED; PG8_LDA(At, 1, 0); PG8_STAGE(PG8_SA(0, 1), a2 + hstep, voffA);
            PG8_WAIT_V(8); PG8_WAIT_L(0); PG8_BAR; PG8_MMA(0, 0, At, B0); PG8_MMA(0, 1, At, B1); PG8_BAR; PG8_SCHED;
            PG8_LDA(At, 1, 1); PG8_STAGE(PG8_SB(1, 0), b3, voffB); PG8_STAGE(PG8_SB(1, 1), b3 + hstep, voffB); PG8_STAGE(PG8_SA(1, 0), a3, voffA);
            PG8_WAIT_V(8); PG8_WAIT_L(0); PG8_BAR; PG8_MMA(1, 0, At, B0); PG8_MMA(1, 1, At, B1); PG8_BAR; PG8_SCHED;
            } else {
            PG8_LDB(B0, 0, 0); PG8_SCHED; PG8_LDA(At, 0, 0); PG8_STAGE(PG8_SA(1, 1), a1 + hstep, voffA);
            PG8_WAIT_L(8); PG8_BAR; PG8_WAIT_L(0); PG8_MMA(0, 0, At, B0); PG8_BAR; PG8_SCHED;
            PG8_LDB(B1, 0, 1); PG8_STAGE(PG8_SB(0, 0), b2, voffB);
            PG8_BAR; PG8_WAIT_L(0); PG8_MMA(0, 1, At, B1); PG8_BAR;
            PG8_LDA(At, 0, 1); PG8_STAGE(PG8_SA(0, 0), a2, voffA);
            PG8_BAR; PG8_WAIT_L(0); PG8_MMA(1, 0, At, B0); PG8_BAR; PG8_SCHED;
            PG8_STAGE(PG8_SB(0, 1), b2 + hstep, voffB);
            PG8_WAIT_V(6); PG8_BAR; PG8_MMA(1, 1, At, B1); PG8_BAR;
            PG8_LDB(B0, 1, 0); PG8_SCHED; PG8_LDA(At, 1, 0); PG8_STAGE(PG8_SA(0, 1), a2 + hstep, voffA);
            PG8_WAIT_L(8); PG8_BAR; PG8_WAIT_L(0); PG8_MMA(0, 0, At, B0); PG8_BAR; PG8_SCHED;
            PG8_LDB(B1, 1, 1); PG8_STAGE(PG8_SB(1, 0), b3, voffB);
            PG8_BAR; PG8_WAIT_L(0); PG8_MMA(0, 1, At, B1); PG8_BAR;
            PG8_LDA(At, 1, 1); PG8_STAGE(PG8_SA(1, 0), a3, voffA);
            PG8_BAR; PG8_WAIT_L(0); PG8_MMA(1, 0, At, B0); PG8_BAR; PG8_SCHED;
            PG8_STAGE(PG8_SB(1, 1), b3 + hstep, voffB);
            PG8_WAIT_V(6); PG8_BAR; PG8_MMA(1, 1, At, B1); PG8_BAR;
            }
        }
        if constexpr (FP8) asm volatile("s_nop 15\n\ts_nop 7" ::: "memory");
        if constexpr (ALIGN_EPI) { if (wr == 0) PG8_BAR; }
        E(acc, cur, wr, wc, fr, fq); S.done(cur);
        if (!has_next) break;
#pragma unroll
        for (int a = 0; a < 2; ++a)
#pragma unroll
            for (int b = 0; b < 2; ++b)
#pragma unroll
                for (int m = 0; m < 4; ++m)
#pragma unroll
                    for (int n = 0; n < 2; ++n) acc[a][b][m][n] = (f32x4){0.f, 0.f, 0.f, 0.f};
        cur = nxt; cA = nA; cB = nB; ++ui;
        if constexpr (ALIGN_EPI) { if (wr == 1) PG8_BAR; }
    }
    PG8_WAIT_V(0);
    if constexpr (!ALIGN_EPI) { if (wr == 0) PG8_BAR; }
    PG8_BAR;
#undef PG8_SA
#undef PG8_SB
#undef PG8_STAGE
#undef PG8_LDA
#undef PG8_LDB
#undef PG8_MMA
#undef PG8_LD8
#undef PG8_WAIT_V
#undef PG8_WAIT_L
#undef PG8_BAR
#undef PG8_SCHED
}
}
#include <hip/hip_bf16.h>
namespace attn_body {
using bf16=__hip_bfloat16;
using bf16x8=__attribute__((ext_vector_type(8)))short;
using s16x4=__attribute__((ext_vector_type(4)))short;
using f32x16=__attribute__((ext_vector_type(16)))float;
using u32x4=__attribute__((ext_vector_type(4)))unsigned;
constexpr int D=64,KVP=128,OP=1024,QP=512;
constexpr int NW=8,QBLK=32,QB=QBLK*NW,KVBLK=64;
constexpr int ATTN_UNIT_ROWS=QB;
__device__ __forceinline__ int crow(int r,int hi){return (r&3)+8*(r>>2)+4*hi;}
#define SBAR() __builtin_amdgcn_sched_barrier(0)
constexpr int NSLOT=3, SLOTB=8192;
constexpr int LDS_K=0, LDS_V=NSLOT*SLOTB, LDS_WS=2*NSLOT*SLOTB, LDS_OST=LDS_WS+NW*64*4, LDS_BYTES=LDS_OST+NW*4096;
constexpr float C2=0.125f*1.4426950408889634f;
__device__ __forceinline__ void glds16(const void*gsrc,unsigned lds_dst){unsigned keep;
  asm volatile("s_mov_b32 %0, m0\n\ts_mov_b32 m0, %2\n\ts_nop 0\n\tglobal_load_lds_dwordx4 %1, off\n\ts_mov_b32 m0, %0":"=&s"(keep):"v"(gsrc),"s"(lds_dst):"memory");}
__device__ __forceinline__ float max3f(float a,float b,float c){float r;asm("v_max3_f32 %0, %1, %2, %3":"=v"(r):"v"(a),"v"(b),"v"(c));return r;}
__device__ __forceinline__ float max2f(float a,float b){float r;asm("v_max_f32_e32 %0, %1, %2":"=v"(r):"v"(a),"v"(b));return r;}
__device__ __forceinline__ float fadd_s(float a,float b){float r;asm("v_add_f32_e32 %0, %1, %2":"=v"(r):"v"(a),"v"(b));return r;}
__device__ __forceinline__ float fsub_s(float a,float b){float r;asm("v_sub_f32_e32 %0, %1, %2":"=v"(r):"v"(a),"v"(b));return r;}
typedef float f32x2_t __attribute__((ext_vector_type(2))); typedef __bf16 bf16x2_t __attribute__((ext_vector_type(2)));
__device__ __forceinline__ unsigned cvtpk_s(float lo,float hi){f32x2_t v={lo,hi};bf16x2_t b=__builtin_convertvector(v,bf16x2_t);return __builtin_bit_cast(unsigned,b);}
#define WAIT_BAR(N) asm volatile("s_waitcnt vmcnt(" #N ") lgkmcnt(0)\n\ts_barrier":::"memory")

__device__ __forceinline__ void qkt(f32x16&p0,f32x16&p1,const char*Kslot,const bf16x8*qr,const f32x16&negm,int r32,int hi){
  const char*kb=Kslot+hi*1024+r32*16;
  #pragma unroll
  for(int d0=0;d0<4;++d0){
    const bf16x8 b0=*reinterpret_cast<const bf16x8*>(kb+d0*2048);
    const bf16x8 b1=*reinterpret_cast<const bf16x8*>(kb+d0*2048+512);
    if(d0==0){p0=__builtin_amdgcn_mfma_f32_32x32x16_bf16(b0,qr[0],negm,0,0,0);p1=__builtin_amdgcn_mfma_f32_32x32x16_bf16(b1,qr[0],negm,0,0,0);}
    else{p0=__builtin_amdgcn_mfma_f32_32x32x16_bf16(b0,qr[d0],p0,0,0,0);p1=__builtin_amdgcn_mfma_f32_32x32x16_bf16(b1,qr[d0],p1,0,0,0);}}
}
typedef __attribute__((address_space(3))) const char* lds_cptr;
typedef short v4i16_t __attribute__((ext_vector_type(4)));
__device__ __forceinline__ void kload8(bf16x8*kf,lds_cptr kp){
  kf[0]=*(const __attribute__((address_space(3))) bf16x8*)(kp);      kf[1]=*(const __attribute__((address_space(3))) bf16x8*)(kp+512);
  kf[2]=*(const __attribute__((address_space(3))) bf16x8*)(kp+2048); kf[3]=*(const __attribute__((address_space(3))) bf16x8*)(kp+2560);
  kf[4]=*(const __attribute__((address_space(3))) bf16x8*)(kp+4096); kf[5]=*(const __attribute__((address_space(3))) bf16x8*)(kp+4608);
  kf[6]=*(const __attribute__((address_space(3))) bf16x8*)(kp+6144); kf[7]=*(const __attribute__((address_space(3))) bf16x8*)(kp+6656);
}
__device__ __forceinline__ void kload2(bf16x8*kf,lds_cptr kp,int j){ kf[2*j]=*(const __attribute__((address_space(3))) bf16x8*)(kp+j*2048); kf[2*j+1]=*(const __attribute__((address_space(3))) bf16x8*)(kp+j*2048+512); }
__device__ __forceinline__ s16x4 vtr(lds_cptr p){ return __builtin_bit_cast(s16x4,__builtin_amdgcn_ds_read_tr16_b64_v4i16((__attribute__((address_space(3))) v4i16_t*)p)); }
__device__ __forceinline__ float rowmax(const f32x16&p0,const f32x16&p1){
  float a=max3f(p0[0],p0[1],p1[0]),b=max3f(p0[2],p0[3],p1[1]);a=max3f(a,p1[2],p1[3]);
  #pragma unroll
  for(int r=4;r<16;r+=4){a=max3f(a,p0[r],p0[r+1]);b=max3f(b,p0[r+2],p0[r+3]);a=max3f(a,p1[r],p1[r+1]);b=max3f(b,p1[r+2],p1[r+3]);}
  const float m=max2f(a,b);
  auto rr=__builtin_amdgcn_permlane32_swap(__float_as_uint(m),__float_as_uint(m),false,false);
  return max2f(__uint_as_float(rr[0]),__uint_as_float(rr[1]));
}
__device__ __forceinline__ void pv(f32x16*o,int vb,bf16x8 pa0,bf16x8 pa1,bf16x8 pa2,bf16x8 pa3){
  #pragma unroll
  for(int d0=0;d0<2;++d0){s16x4 lo[4],hi[4];
    #pragma unroll
    for(int ks=0;ks<4;++ks){
      asm volatile("ds_read_b64_tr_b16 %0,%1 offset:%c2":"=&v"(lo[ks]):"v"(vb),"i"(d0*4096+ks*1024):"memory");
      asm volatile("ds_read_b64_tr_b16 %0,%1 offset:%c2":"=&v"(hi[ks]):"v"(vb),"i"(d0*4096+ks*1024+512):"memory");}
    asm volatile("s_waitcnt lgkmcnt(0)":::"memory");SBAR();
    #define PK(k) (bf16x8){lo[k][0],lo[k][1],lo[k][2],lo[k][3],hi[k][0],hi[k][1],hi[k][2],hi[k][3]}
    o[d0]=__builtin_amdgcn_mfma_f32_32x32x16_bf16(pa0,PK(0),o[d0],0,0,0);
    o[d0]=__builtin_amdgcn_mfma_f32_32x32x16_bf16(pa1,PK(1),o[d0],0,0,0);
    o[d0]=__builtin_amdgcn_mfma_f32_32x32x16_bf16(pa2,PK(2),o[d0],0,0,0);
    o[d0]=__builtin_amdgcn_mfma_f32_32x32x16_bf16(pa3,PK(3),o[d0],0,0,0);
    #undef PK
  }
}

#ifndef ATTN_STORE16
#define ATTN_STORE16(p,v) (*(u32x4*)(p)=(v))
#endif
template<int THRL> __device__ __forceinline__ void attn_unit(int qrow0,int h,int kvrow0,int NT,int rope,int qpos0,const float*QRAW,const float*qg,const float*ropetab,const bf16*__restrict__ K,const bf16*__restrict__ V,bf16*O,char*shm){
  const int tid=threadIdx.x,lane=tid&63,r32=lane&31,hi=lane>>5; const int wid=__builtin_amdgcn_readfirstlane(tid>>6);
  const float*Qw=QRAW+(long)(qrow0+wid*QBLK)*QP+h*D;
  const bf16*Kh=K+(long)kvrow0*KVP+(h>>2)*D,*Vh=V+(long)kvrow0*KVP+(h>>2)*D;
  const unsigned lds0=(unsigned)(uintptr_t)shm;
  float*wsf=(float*)(shm+LDS_WS)+wid*64;
  const bf16*ksrc=Kh+(long)lane*KVP+wid*8;
  const bf16*vsrc=Vh+(long)(16*(wid&3)+(lane>>2))*KVP+(wid>>2)*32+(lane&3)*8;
  const unsigned kdst=lds0+LDS_K+wid*1024, vdst=lds0+LDS_V+wid*1024;
  #define DMA_K(t,slot) glds16(ksrc+(long)(t)*KVBLK*KVP,(unsigned)__builtin_amdgcn_readfirstlane(kdst+(slot)))
  #define DMA_V(t,slot) glds16(vsrc+(long)(t)*KVBLK*KVP,(unsigned)__builtin_amdgcn_readfirstlane(vdst+(slot)))
  const int vb0=(int)(lds0+LDS_V)+((lane>>4)&1)*32+(lane&3)*8+(4*hi+((lane&15)>>2))*64;
  const char*Kbase=shm+LDS_K; bf16x8 kf[8];
  const lds_cptr shm3=(lds_cptr)shm; const lds_cptr kp0=shm3+LDS_K+hi*1024+r32*16; const lds_cptr vp0=shm3+LDS_V+((lane>>4)&1)*32+(lane&3)*8+(4*hi+((lane&15)>>2))*64;
  DMA_K(0,0);DMA_V(0,0);DMA_K(1,SLOTB);
  bf16x8 qr[4];
  { float qv[4][8]; float ss=0.f;
    #pragma unroll
    for(int d0=0;d0<4;++d0){ const f32x4 a=*reinterpret_cast<const f32x4*>(&Qw[(long)r32*QP+d0*16+hi*8]), c=*reinterpret_cast<const f32x4*>(&Qw[(long)r32*QP+d0*16+hi*8+4]);
      qv[d0][0]=a[0];qv[d0][1]=a[1];qv[d0][2]=a[2];qv[d0][3]=a[3];qv[d0][4]=c[0];qv[d0][5]=c[1];qv[d0][6]=c[2];qv[d0][7]=c[3];
      #pragma unroll
      for(int j=0;j<8;++j)ss+=qv[d0][j]*qv[d0][j]; }
    ss+=__shfl_xor(ss,32);
    const float rs=__builtin_amdgcn_rsqf(ss*(1.f/64.f)+1e-6f);
    const int qpos=qpos0+wid*QBLK+r32; const int prow=qpos>>6, pcol=qpos&63;
    #pragma unroll
    for(int d0=0;d0<4;++d0){
      const f32x4 g0=*reinterpret_cast<const f32x4*>(&qg[d0*16+hi*8]), g1=*reinterpret_cast<const f32x4*>(&qg[d0*16+hi*8+4]);
      float y[8]; y[0]=qv[d0][0]*rs*g0[0];y[1]=qv[d0][1]*rs*g0[1];y[2]=qv[d0][2]*rs*g0[2];y[3]=qv[d0][3]*rs*g0[3];y[4]=qv[d0][4]*rs*g1[0];y[5]=qv[d0][5]*rs*g1[1];y[6]=qv[d0][6]*rs*g1[2];y[7]=qv[d0][7]*rs*g1[3];
      if(rope){ const float*tb=ropetab+(d0<2?prow:(128+pcol))*32+((d0&1)*8+hi*4);
        const f32x4 cs=*reinterpret_cast<const f32x4*>(tb), sn=*reinterpret_cast<const f32x4*>(tb+16);
        #pragma unroll
        for(int p=0;p<4;++p){ const float x1=y[2*p],x2=y[2*p+1]; y[2*p]=x1*cs[p]-x2*sn[p]; y[2*p+1]=x1*sn[p]+x2*cs[p]; } }
      u32x4 w; w[0]=cvtpk_s(y[0]*C2,y[1]*C2); w[1]=cvtpk_s(y[2]*C2,y[3]*C2); w[2]=cvtpk_s(y[4]*C2,y[5]*C2); w[3]=cvtpk_s(y[6]*C2,y[7]*C2);
      qr[d0]=__builtin_bit_cast(bf16x8,w); } }
  float mhat=0.f,l_reg=0.f;f32x16 o[2];o[0]=f32x16{};o[1]=f32x16{};f32x16 negm=f32x16{};asm volatile("":"+v"(negm));
  #define CMASK(P0,P1,t) do{}while(0)
  bool resc=false;
  #define START(P0,P1) do{ const float rm=rowmax(P0,P1); resc=false; \
    { const float dl=rm; mhat=fadd_s(mhat,dl); \
      _Pragma("unroll") for(int r=0;r<16;++r){P0[r]=fsub_s(P0[r],dl);P1[r]=fsub_s(P1[r],dl);} \
      _Pragma("unroll") for(int r=0;r<16;++r)negm[r]=-mhat; asm volatile("":"+v"(negm)); } \
    _Pragma("unroll") for(int r=0;r<16;++r)P0[r]=__builtin_amdgcn_exp2f(P0[r]); }while(0)
  #define RESC() do{ if(resc){ asm volatile("s_waitcnt lgkmcnt(0)":::"memory"); \
      _Pragma("unroll") for(int d_=0;d_<2;++d_) _Pragma("unroll") for(int r=0;r<16;++r)o[d_][r]*=wsf[crow(r,hi)]; } }while(0)
  f32x16 pA0,pA1,pB0,pB1;
  int sl_prev=0,sl_cur=0,sl_next=SLOTB;
  #define ROT() do{sl_prev=sl_cur;sl_cur=sl_next;sl_next=(sl_next==(NSLOT-1)*SLOTB)?0:sl_next+SLOTB;}while(0)
  DMA_K(2,2*SLOTB);
  WAIT_BAR(3);
  qkt(pA0,pA1,Kbase,qr,negm,r32,hi);asm volatile("s_nop 15\n\ts_nop 7":"+v"(pA0),"+v"(pA1));CMASK(pA0,pA1,0);
  START(pA0,pA1);
  _Pragma("unroll") for(int r=0;r<16;++r)pA1[r]=__builtin_amdgcn_exp2f(pA1[r]);
  WAIT_BAR(0);
  DMA_K(3,0);DMA_V(1,SLOTB);
  ROT();
  kload8(kf,kp0+sl_cur);
  WAIT_BAR(2);
  s16x4 vlo[8],vhi[8]; u32x4 pw0,pw1,pw2,pw3;
  #define PKW(P,B) cvtpk_s(P[B],P[B+1])
  #define PAF(k) __builtin_bit_cast(bf16x8,pw##k)
  #define VFR(i) (bf16x8){vlo[i][0],vlo[i][1],vlo[i][2],vlo[i][3],vhi[i][0],vhi[i][1],vhi[i][2],vhi[i][3]}
  #define PIN(x) asm volatile("":"+v"(x))
  #define MX3(a,b,c) __builtin_fmaxf(__builtin_fmaxf((a),(b)),(c))
  #define GAPA(MF,A0,A1,A2,A3,W0,W1,PW) do{ MF; sacc+=A0; sacc+=A1; sacc+=A2; sacc+=A3; PIN(sacc); W0; W1; PIN(PW); SBAR(); }while(0)
  #define EX(v) __builtin_amdgcn_exp2f(v)
  #define GAPB(MF,X,B) do{ MF; X[B]=EX(X[B]); X[B+1]=EX(X[B+1]); X[B+2]=EX(X[B+2]); X[B+3]=EX(X[B+3]); PIN(X); SBAR(); }while(0)
  #define VRD(i) do{ vlo[i]=vtr(vp_+(((i)>>2)*4096+((i)&3)*1024)); vhi[i]=vtr(vp_+(((i)>>2)*4096+((i)&3)*1024+512)); }while(0)
  #define KRD(G,j) do{ if(G){ kload2(kf,kp0+sl_next,j); SBAR(); } }while(0)
  #define STEP(C0,C1,P0,P1,t,GK,GV,GL) do{ SBAR(); \
    const lds_cptr vp_=vp0+sl_prev; \
    VRD(0); SBAR(); float sacc=(P0[0]+P0[1]); \
    GAPA(C0=__builtin_amdgcn_mfma_f32_32x32x16_bf16(kf[0],qr[0],negm,0,0,0), P0[2],P0[3],P0[4],P0[5],     pw0[0]=PKW(P0,0), pw0[1]=PKW(P0,2), pw0); \
    VRD(4); SBAR(); GAPA(C1=__builtin_amdgcn_mfma_f32_32x32x16_bf16(kf[1],qr[0],negm,0,0,0), P0[6],P0[7],P0[8],P0[9],     pw0[2]=PKW(P0,4), pw0[3]=PKW(P0,6), pw0); \
    VRD(1); SBAR(); GAPA(C0=__builtin_amdgcn_mfma_f32_32x32x16_bf16(kf[2],qr[1],C0,0,0,0),   P0[10],P0[11],P0[12],P0[13], pw1[0]=PKW(P0,8), pw1[1]=PKW(P0,10), pw1); \
    VRD(5); SBAR(); GAPA(C1=__builtin_amdgcn_mfma_f32_32x32x16_bf16(kf[3],qr[1],C1,0,0,0),   P0[14],P0[15],P1[0],P1[1],   pw1[2]=PKW(P0,12),pw1[3]=PKW(P0,14), pw1); \
    VRD(2); SBAR(); GAPA(C0=__builtin_amdgcn_mfma_f32_32x32x16_bf16(kf[4],qr[2],C0,0,0,0),   P1[2],P1[3],P1[4],P1[5],     pw2[0]=PKW(P1,0), pw2[1]=PKW(P1,2), pw2); \
    VRD(6); SBAR(); GAPA(C1=__builtin_amdgcn_mfma_f32_32x32x16_bf16(kf[5],qr[2],C1,0,0,0),   P1[6],P1[7],P1[8],P1[9],     pw2[2]=PKW(P1,4), pw2[3]=PKW(P1,6), pw2); \
    VRD(3); SBAR(); GAPA(C0=__builtin_amdgcn_mfma_f32_32x32x16_bf16(kf[6],qr[3],C0,0,0,0),   P1[10],P1[11],P1[12],P1[13], pw3[0]=PKW(P1,8), pw3[1]=PKW(P1,10), pw3); \
    VRD(7); SBAR(); GAPA(C1=__builtin_amdgcn_mfma_f32_32x32x16_bf16(kf[7],qr[3],C1,0,0,0),   P1[14],P1[15],0.f,0.f,       pw3[2]=PKW(P1,12),pw3[3]=PKW(P1,14), pw3); \
    l_reg+=sacc; \
    if(GK){DMA_K((t)+3,sl_cur);} if(GV){DMA_V((t)+1,sl_next);} \
    CMASK(C0,C1,t); \
    { float a=MX3(C0[0],C0[1],C1[0]),b=MX3(C0[2],C0[3],C1[1]); a=MX3(a,C1[2],C1[3]); \
      _Pragma("unroll") for(int r=4;r<16;r+=4){a=MX3(a,C0[r],C0[r+1]);b=MX3(b,C0[r+2],C0[r+3]);a=MX3(a,C1[r],C1[r+1]);b=MX3(b,C1[r+2],C1[r+3]);} \
      float rm=__builtin_fmaxf(a,b); { auto rr=__builtin_amdgcn_permlane32_swap(__float_as_uint(rm),__float_as_uint(rm),false,false); rm=__builtin_fmaxf(__uint_as_float(rr[0]),__uint_as_float(rr[1])); } \
      resc=false; \
      if(__builtin_expect(__any(rm>(float)THRL),0)){ const float dl=__builtin_fmaxf(rm,0.f); mhat+=dl; \
        _Pragma("unroll") for(int r=0;r<16;++r){C0[r]-=dl;C1[r]-=dl;} \
        _Pragma("unroll") for(int r=0;r<16;++r)negm[r]=-mhat; asm volatile("":"+v"(negm)); \
        const float f=__builtin_amdgcn_exp2f(-dl); l_reg*=f; if(hi==0)wsf[r32]=f; resc=true; } } \
    SBAR(); \
    GAPB(o[0]=__builtin_amdgcn_mfma_f32_32x32x16_bf16(PAF(0),VFR(0),o[0],0,0,0), C0,0); \
    GAPB(o[1]=__builtin_amdgcn_mfma_f32_32x32x16_bf16(PAF(0),VFR(4),o[1],0,0,0), C0,4); \
    KRD(GL,0); GAPB(o[0]=__builtin_amdgcn_mfma_f32_32x32x16_bf16(PAF(1),VFR(1),o[0],0,0,0), C0,8); \
    KRD(GL,1); GAPB(o[1]=__builtin_amdgcn_mfma_f32_32x32x16_bf16(PAF(1),VFR(5),o[1],0,0,0), C0,12); \
    KRD(GL,2); GAPB(o[0]=__builtin_amdgcn_mfma_f32_32x32x16_bf16(PAF(2),VFR(2),o[0],0,0,0), C1,0); \
    KRD(GL,3); GAPB(o[1]=__builtin_amdgcn_mfma_f32_32x32x16_bf16(PAF(2),VFR(6),o[1],0,0,0), C1,4); \
    GAPB(o[0]=__builtin_amdgcn_mfma_f32_32x32x16_bf16(PAF(3),VFR(3),o[0],0,0,0), C1,8); \
    GAPB(o[1]=__builtin_amdgcn_mfma_f32_32x32x16_bf16(PAF(3),VFR(7),o[1],0,0,0), C1,12); \
    }while(0)
  int t=1;
  #undef CMASK
  #define CMASK(P0,P1,t) do{}while(0)
  for(;t+5<NT;t+=2){
    STEP(pB0,pB1,pA0,pA1,t,true,true,true);     WAIT_BAR(2); RESC(); ROT();
    STEP(pA0,pA1,pB0,pB1,t+1,true,true,true);   WAIT_BAR(2); RESC(); ROT();
  }
  #undef CMASK
  #define CMASK(P0,P1,t) do{}while(0)
  #define ENDW(tt) do{ if((tt)+3<NT){WAIT_BAR(2);} else if((tt)+2<NT){WAIT_BAR(1);} else {WAIT_BAR(0);} }while(0)
  for(;t+1<NT;t+=2){
    STEP(pB0,pB1,pA0,pA1,t,(t+3<NT),(t+1<NT),(t+1<NT));       ENDW(t);   RESC(); ROT();
    STEP(pA0,pA1,pB0,pB1,t+1,(t+4<NT),(t+2<NT),(t+2<NT));     ENDW(t+1); RESC(); ROT();
  }
  STEP(pB0,pB1,pA0,pA1,NT-1,false,false,false); RESC();
  { float sacc=pB0[0]+pB0[1]; _Pragma("unroll") for(int r=2;r<16;++r)sacc+=pB0[r]; _Pragma("unroll") for(int r=0;r<16;++r)sacc+=pB1[r]; l_reg+=sacc;
    pw0=(u32x4){PKW(pB0,0),PKW(pB0,2),PKW(pB0,4),PKW(pB0,6)};pw1=(u32x4){PKW(pB0,8),PKW(pB0,10),PKW(pB0,12),PKW(pB0,14)};pw2=(u32x4){PKW(pB1,0),PKW(pB1,2),PKW(pB1,4),PKW(pB1,6)};pw3=(u32x4){PKW(pB1,8),PKW(pB1,10),PKW(pB1,12),PKW(pB1,14)};
    SBAR(); pv(o,vb0+sl_cur,PAF(0),PAF(1),PAF(2),PAF(3)); }
  #undef PKW
  #undef PAF
  #undef VFR
  #undef PIN
  #undef MX3
  #undef GAPA
  #undef GAPB
  #undef EX
  #undef VRD
  #undef KRD
  #undef STEP
  #undef ENDW
  {auto rr=__builtin_amdgcn_permlane32_swap(__float_as_uint(l_reg),__float_as_uint(l_reg),false,false);l_reg=__uint_as_float(rr[0])+__uint_as_float(rr[1]);}
  if(hi==0)wsf[32+r32]=l_reg;asm volatile("s_waitcnt lgkmcnt(0)":::"memory");
  float rli[16];
  #pragma unroll
  for(int r=0;r<16;++r)rli[r]=__builtin_amdgcn_rcpf(wsf[32+crow(r,hi)]);
  bf16*Ow=O+(long)(qrow0+wid*QBLK)*OP+512+h*D;
  { bf16*stg=(bf16*)(shm+LDS_OST)+wid*2048;
    #pragma unroll
    for(int r=0;r<16;++r){const int orow=crow(r,hi);
      #pragma unroll
      for(int d0=0;d0<2;++d0)stg[orow*64+d0*32+r32]=__float2bfloat16(o[d0][r]*rli[r]);}
    asm volatile("s_waitcnt lgkmcnt(0)":::"memory");
    #pragma unroll
    for(int i=0;i<4;++i){const int row=i*8+(lane>>3),ch=lane&7; const u32x4 v=*(const u32x4*)(stg+row*64+ch*8); ATTN_STORE16(Ow+(long)row*OP+ch*8,v);} }
  asm volatile("s_waitcnt lgkmcnt(0)\n\ts_barrier":::"memory");
  #undef DMA_K
  #undef DMA_V
  #undef CMASK
  #undef START
  #undef RESC
  #undef ROT
}
constexpr int ATTN_LDS_BYTES=LDS_BYTES;
#undef SBAR
#undef WAIT_BAR
}
enum {
    I_X = 0, I_C, I_CTX, I_CCTX,
    I0_WMOD, I0_BMOD, I0_NMIX, I0_NFFN, I0_WIN, I0_CONVW, I0_CONVB, I0_WI, I0_BI, I0_WR, I0_BR, I0_LAM, I0_QG, I0_KG, I0_WOUT, I0_ROUTER, I0_WEG, I0_WEU, I0_WED,
    I1_WMOD, I1_BMOD, I1_NMIX, I1_NFFN, I1_MU, I1_WR, I1_WK, I1_WV, I1_W0, I1_W1, I1_W2, I1_A0, I1_A1, I1_A2, I1_G1, I1_G2, I1_KK, I1_KA, I1_RK, I1_GNG, I1_GNB, I1_WO, I1_ROUTER, I1_WEG, I1_WEU, I1_WED,
    N_IN
};
static_assert(N_IN == 49, "49 inputs");
struct KArgs { const float* in[N_IN]; float* out; unsigned char* ws; int ph_lo, ph_hi; };
#define KAREF const __attribute__((address_space(4))) KArgs&
__device__ __forceinline__ const __attribute__((address_space(4))) KArgs* ka_launder(const __attribute__((address_space(4))) KArgs* p) { asm volatile("" : "+s"(p)); return p; }

constexpr size_t MiB = 1u << 20;
constexpr size_t WS_CTL = 0;
constexpr size_t WS_BMIX = 1 * MiB;
constexpr size_t WS_B2 = 9 * MiB;
constexpr size_t ZERO_BYTES = 12 * MiB;
constexpr size_t WS_WIN = 12 * MiB;
constexpr size_t WS_WOUT = 16 * MiB;
constexpr size_t WS_WO = 18 * MiB;
constexpr size_t WS_WGATE = 20 * MiB;
constexpr size_t WS_ADA = 20 * MiB + 512 * 1024;
constexpr size_t WS_ROPE = 21 * MiB;
constexpr size_t WS_HLAST = 21 * MiB + 64 * 1024;
constexpr size_t WS_CARRY = 21 * MiB + 128 * 1024;
constexpr size_t WS_AFFL = 22 * MiB;
constexpr size_t WS_AFFC = 24 * MiB;
constexpr size_t WS_SRCROW = 25 * MiB;
constexpr size_t WS_GROW = 26 * MiB;
constexpr size_t WS_SLOTL = 27 * MiB;
constexpr size_t WS_SLOTC = 29 * MiB;
constexpr size_t WS_CTXS = 30 * MiB;
constexpr size_t WS_MOEW1 = 34 * MiB;
constexpr size_t WS_MOEW2 = 162 * MiB;
constexpr size_t WS_ACT = 226 * MiB;
constexpr size_t WS_END = WS_ACT + 749 * MiB;
constexpr size_t A_H = 0, A_XA = 66 * MiB, A_GA = 99 * MiB, A_QR = 132 * MiB, A_KR = 198 * MiB, A_KN = 215 * MiB, A_VB = 224 * MiB, A_HF = 233 * MiB, A_YCAT = 299 * MiB;
constexpr size_t A_H2 = 0, A_XE = 66 * MiB, A_HID = 202 * MiB, A_YE = 474 * MiB;
constexpr size_t A_XMIX = 0, A_RKV = 396 * MiB, A_LG = 594 * MiB, A_LWA = A_LG + (size_t)TT * 256 * 2;
constexpr size_t A_SD = 0, A_AD = 132 * MiB, A_G = 264 * MiB, A_YD0 = 660 * MiB, A_YD1 = 594 * MiB, A_O = 0;
constexpr size_t ROWB = (size_t)TT * DM * 2;

constexpr int RING_OFF = 0, RING_BYTES = 131072;
constexpr int LDSCTL_OFF = RING_BYTES, MISC_OFF = LDSCTL_OFF + 320;
constexpr int LDS_BYTES = 147456;

#define RLX_AGENT __ATOMIC_RELAXED, __HIP_MEMORY_SCOPE_AGENT
#define LDS_WAIT() asm volatile("s_waitcnt lgkmcnt(0)" ::: "memory")
#define VM_WAIT() asm volatile("s_waitcnt vmcnt(0)" ::: "memory")

#define XB_TMO      128
#define XB_XCNT(j)  (256  + 64 * (j))
#define XB_XSUB(j)  (1280 + 64 * (j))
#define XB_XGEN(j)  (2304 + 64 * (j))
#define XB_TOP      3328
#define XB_TOPGEN   3392
#define XCD_BAR_WORDS 3456
#define XB_SPIN_CAP (1u << 18)
__device__ __forceinline__ unsigned xb_ld(unsigned* p)              { return __hip_atomic_load(p, __ATOMIC_RELAXED, __HIP_MEMORY_SCOPE_AGENT); }
__device__ __forceinline__ unsigned xb_add(unsigned* p, unsigned v) { return __hip_atomic_fetch_add(p, v, __ATOMIC_RELAXED, __HIP_MEMORY_SCOPE_AGENT); }
__device__ __forceinline__ unsigned xb_xcc_id() { return (unsigned)__builtin_amdgcn_s_getreg((3 << 11) | 20) & 0xFu; }
#define XB_SPIN(cond, bar) do { unsigned _sp = 0; while (cond) { __builtin_amdgcn_s_sleep(1); \
    if ((++_sp & 255u) == 0u) { if (xb_ld(&(bar)[XB_TMO])) break; if (_sp > XB_SPIN_CAP) { atomicAdd(&(bar)[XB_TMO], 1u); break; } } } } while (0)
struct XcdBarrier { unsigned* bar; unsigned x; volatile LAS unsigned* st; };
__device__ __forceinline__ XcdBarrier xcd_barrier_post(unsigned* bar, volatile LAS unsigned* st) {
    XcdBarrier b; b.bar = bar; b.x = xb_xcc_id(); b.st = st;
    if (threadIdx.x == 0) (void)xb_add(&bar[XB_XCNT(b.x)], 1u);
    return b;
}
__device__ __forceinline__ void xcd_barrier_complete(unsigned* bar, unsigned x, unsigned& nloc, unsigned& nx) {
    const unsigned G = gridDim.x * gridDim.y * gridDim.z;
    unsigned sum, cnt, mine, sp = 0u;
    for (;;) {
        sum = 0u; cnt = 0u; mine = 0u;
#pragma unroll
        for (unsigned j = 0; j < 16; ++j) { const unsigned c = xb_ld(&bar[XB_XCNT(j)]); sum += c; cnt += (c > 0u) ? 1u : 0u; mine = (j == x) ? c : mine; }
        if (sum == G) break;
        __builtin_amdgcn_s_sleep(1);
        if ((++sp & 255u) == 0u) { if (xb_ld(&bar[XB_TMO])) break; if (sp > XB_SPIN_CAP) { atomicAdd(&bar[XB_TMO], 1u); break; } }
    }
    nloc = mine > 0u ? mine : 1u; nx = cnt > 0u ? cnt : 1u;
}
__device__ __forceinline__ void xcd_barrier(const XcdBarrier& b) {
    asm volatile("s_waitcnt vmcnt(0)" ::: "memory");
    __syncthreads();
    if (threadIdx.x == 0) {
        unsigned* bar = b.bar;
        __builtin_amdgcn_s_waitcnt(0);
        unsigned nloc = b.st[0], nx = b.st[1];
        if (nloc == 0u) { xcd_barrier_complete(bar, b.x, nloc, nx); b.st[0] = nloc; b.st[1] = nx; }
        const unsigned old = xb_add(&bar[XB_XSUB(b.x)], 1u);
        const unsigned gen = old / nloc;
        if (old + 1u == (gen + 1u) * nloc) {
            __builtin_amdgcn_fence(__ATOMIC_RELEASE, "agent");
            asm volatile("s_waitcnt vmcnt(0)" ::: "memory");
            const unsigned og = xb_add(&bar[XB_TOP], 1u);
            const unsigned tg = og / nx;
            if (og + 1u == (tg + 1u) * nx) xb_add(&bar[XB_TOPGEN], 1u);
            else XB_SPIN(xb_ld(&bar[XB_TOPGEN]) == tg, bar);
            __builtin_amdgcn_fence(__ATOMIC_ACQUIRE, "agent");
            xb_add(&bar[XB_XGEN(b.x)], 1u);
            asm volatile("s_waitcnt vmcnt(0)" ::: "memory");
        } else {
            XB_SPIN(xb_ld(&bar[XB_XGEN(b.x)]) == gen, bar);
            __builtin_amdgcn_fence(__ATOMIC_ACQUIRE, "agent");
            asm volatile("s_waitcnt vmcnt(0)" ::: "memory");
        }
    }
    __syncthreads();
}

__device__ __forceinline__ const float* ada_ptr(const unsigned char* ws, int layer, int r, int chunk) { return (const float*)(ws + WS_ADA) + (size_t)(layer * 5 + r) * 6144 + chunk * 1024; }
__device__ __forceinline__ int kv_row(int m) { return m < TL ? ((m >> 13) * KVL + (m & 8191)) : (((m - TL) >> 8) * KVL + SEQ + ((m - TL) & 255)); }
__device__ __forceinline__ int mod_row(int m) { return m < TL ? (m >> 13) : 4; }
__device__ __forceinline__ int block_excl_scan(int v, LAS int* tmp, int& total) {
    const int lane = threadIdx.x & 63, w = threadIdx.x >> 6;
    int inc = v;
#pragma unroll
    for (int o = 1; o < 64; o <<= 1) { const int t = __shfl_up(inc, o); if (lane >= o) inc += t; }
    if (lane == 63) tmp[w] = inc;
    __syncthreads();
    int base = 0, tot = 0;
#pragma unroll
    for (int i = 0; i < 8; ++i) { const int t = tmp[i]; if (i < w) base += t; tot += t; }
    __syncthreads();
    total = tot;
    return base + inc - v;
}
__device__ __forceinline__ void tr_item(const float* W, int Krows, int ldw, bf16_t* dst, long drow0, int ldd, int dk0, LAS float* scr, int k0, int n0, int lane) {
    float ld[32];
#pragma unroll
    for (int i = 0; i < 32; ++i) { const int k = k0 + 2 * i + (lane >> 5); ld[i] = (k < Krows) ? W[(size_t)k * ldw + n0 + (lane & 31)] : 0.f; }
#pragma unroll
    for (int i = 0; i < 32; ++i) scr[(2 * i + (lane >> 5)) * 33 + (lane & 31)] = ld[i];
    LDS_WAIT(); asm volatile("" ::: "memory");
    const int c = lane & 7;
#pragma unroll
    for (int j = 0; j < 4; ++j) { const int n = (lane >> 3) + 8 * j; const LAS float* s = scr + (8 * c) * 33 + n;
        u32x4 o; o.x = cvt_pk_bf16(s[0 * 33], s[1 * 33]); o.y = cvt_pk_bf16(s[2 * 33], s[3 * 33]); o.z = cvt_pk_bf16(s[4 * 33], s[5 * 33]); o.w = cvt_pk_bf16(s[6 * 33], s[7 * 33]);
        *(u32x4*)(dst + (size_t)(drow0 + n) * ldd + dk0 + k0 + 8 * c) = o; }
    LDS_WAIT(); asm volatile("" ::: "memory");
}
__device__ __forceinline__ void tr_item_fp8(const float* W, int ldw, unsigned char* dst, long drow0, int ldd, LAS float* scr, int k0, int n0, int lane, float scale) {
    float ld[32];
#pragma unroll
    for (int i = 0; i < 32; ++i) ld[i] = W[(size_t)(k0 + 2 * i + (lane >> 5)) * ldw + n0 + (lane & 31)];
#pragma unroll
    for (int i = 0; i < 32; ++i) scr[(2 * i + (lane >> 5)) * 33 + (lane & 31)] = ld[i] * scale;
    LDS_WAIT(); asm volatile("" ::: "memory");
    const int c = lane & 7;
#pragma unroll
    for (int j = 0; j < 4; ++j) { const int n = (lane >> 3) + 8 * j; const LAS float* s = scr + (8 * c) * 33 + n;
        u32x2 o; o.x = pk_fp8x4(s[0 * 33], s[1 * 33], s[2 * 33], s[3 * 33]); o.y = pk_fp8x4(s[4 * 33], s[5 * 33], s[6 * 33], s[7 * 33]);
        *(u32x2*)(dst + (size_t)(drow0 + n) * ldd + k0 + 8 * c) = o; }
    LDS_WAIT(); asm volatile("" ::: "memory");
}
constexpr float W8_SCALE = 32.0f;
__device__ __forceinline__ void moe_convert(KAREF A, int layer, LAS unsigned char* lds, int gw, int ngw, int wave, int lane) {
    LAS float* scr = (LAS float*)(lds + RING_OFF + wave * 16384);
    const float* WG = A.in[layer ? I1_WEG : I0_WEG]; const float* WU = A.in[layer ? I1_WEU : I0_WEU]; const float* WD = A.in[layer ? I1_WED : I0_WED];
    unsigned char* B1 = A.ws + WS_MOEW1; unsigned char* B2 = A.ws + WS_MOEW2;
    constexpr int I_GU = 32 * 1024, I_D = 16 * 1024;
    for (int it = gw; it < I_GU + I_D; it += ngw) {
        if (it < I_GU) { const int mi = it >> 10, e = mi >> 1, which = mi & 1, w = it & 1023, kb = w >> 6, nb = w & 63, n0 = 32 * nb;
            tr_item_fp8((which ? WU : WG) + (size_t)e * DM * FF, FF, B1 + (size_t)e * 4096 * DM, (long)((n0 >> 7) * 256 + (n0 & 127) + which * 128), DM, scr, 64 * kb, n0, lane, W8_SCALE); }
        else { const int r = it - I_GU, e = r >> 10, w = r & 1023, kb = w >> 5, nb = w & 31;
            tr_item_fp8(WD + (size_t)e * FF * DM, DM, B2 + (size_t)e * DM * FF, (long)(32 * nb), FF, scr, 64 * kb, 32 * nb, lane, W8_SCALE); }
    }
}
__device__ __forceinline__ void moe_convert_pipe(KAREF A, int layer, LAS unsigned char* lds, int gw, int ngw, int wave, int lane) {
    LAS float* scr = (LAS float*)(lds + RING_OFF + wave * 16384);
    const float* WG = A.in[layer ? I1_WEG : I0_WEG]; const float* WU = A.in[layer ? I1_WEU : I0_WEU]; const float* WD = A.in[layer ? I1_WED : I0_WED];
    unsigned char* B1 = A.ws + WS_MOEW1; unsigned char* B2 = A.ws + WS_MOEW2;
    constexpr int I_GU = 32 * 1024, I_D = 16 * 1024, NI = I_GU + I_D;
#define MC_DECODE(IT) const int it_ = (IT) < NI ? (IT) : NI - 1; const float* W_; int ldw_, k0_, n0_, ldd_; unsigned char* dst_; long drow_; \
        if (it_ < I_GU) { const int mi = it_ >> 10, e = mi >> 1, which = mi & 1, w = it_ & 1023, kb = w >> 6, nb = w & 63; n0_ = 32 * nb; k0_ = 64 * kb; W_ = (which ? WU : WG) + (size_t)e * DM * FF; ldw_ = FF; \
            dst_ = B1 + (size_t)e * 4096 * DM; drow_ = (long)((n0_ >> 7) * 256 + (n0_ & 127) + which * 128); ldd_ = DM; } \
        else { const int r = it_ - I_GU, e = r >> 10, w = r & 1023, kb = w >> 5, nb = w & 31; n0_ = 32 * nb; k0_ = 64 * kb; W_ = WD + (size_t)e * FF * DM; ldw_ = DM; dst_ = B2 + (size_t)e * DM * FF; drow_ = (long)n0_; ldd_ = FF; }
#define MC_LOAD(LD, IT) do { MC_DECODE(IT) (void)dst_; (void)drow_; (void)ldd_; \
        _Pragma("unroll") for (int i = 0; i < 32; ++i) LD[i] = W_[(size_t)(k0_ + 2 * i + (lane >> 5)) * ldw_ + n0_ + (lane & 31)]; } while (0)
#define MC_FINISH(LD, IT) do { MC_DECODE(IT) (void)W_; (void)ldw_; \
        _Pragma("unroll") for (int i = 0; i < 32; ++i) scr[(2 * i + (lane >> 5)) * 33 + (lane & 31)] = LD[i] * W8_SCALE; \
        LDS_WAIT(); asm volatile("" ::: "memory"); \
        { const int c = lane & 7; \
          _Pragma("unroll") for (int j = 0; j < 4; ++j) { const int n = (lane >> 3) + 8 * j; const LAS float* sp = scr + (8 * c) * 33 + n; \
              u32x2 o; o.x = pk_fp8x4(sp[0 * 33], sp[1 * 33], sp[2 * 33], sp[3 * 33]); o.y = pk_fp8x4(sp[4 * 33], sp[5 * 33], sp[6 * 33], sp[7 * 33]); \
              *(u32x2*)(dst_ + (size_t)(drow_ + n) * ldd_ + k0_ + 8 * c) = o; } } \
        LDS_WAIT(); asm volatile("" ::: "memory"); } while (0)
    float ldA[32], ldB[32];
    if (gw < NI) MC_LOAD(ldA, gw);
#pragma unroll 1
    for (int it = gw; it < NI; it += 2 * ngw) {
        MC_LOAD(ldB, it + ngw);
        MC_FINISH(ldA, it);
        MC_LOAD(ldA, it + 2 * ngw);
        if (it + ngw < NI) MC_FINISH(ldB, it + ngw);
    }
#undef MC_DECODE
#undef MC_LOAD
#undef MC_FINISH
}
__device__ __forceinline__ void p0_prologue(KAREF A, LAS unsigned char* lds, int G) {
    const int tid = threadIdx.x, lane = tid & 63, wave = __builtin_amdgcn_readfirstlane(tid >> 6);
    const int gw = blockIdx.x * 8 + wave, ngw = G * 8;
    LAS float* scr = (LAS float*)(lds + RING_OFF + wave * 16384);
    unsigned char* ws = A.ws;
    bf16_t* BMIX = (bf16_t*)(ws + WS_BMIX); bf16_t* B2 = (bf16_t*)(ws + WS_B2);
    constexpr int NJ = 19;
    for (int it = gw; ; it += ngw) {
        int r = it; const float* W = nullptr; int Kr = 0, N = 0, ldd = 0, dk0 = 0; long drow = 0; bf16_t* dst = nullptr; bool found = false;
#define JOB(Wp, KR, NN, DST, DROW, LDD, DK0) if (!found) { const int cnt = (((KR) + 63) / 64) * ((NN) / 32); if (r < cnt) { W = (Wp); Kr = (KR); N = (NN); dst = (DST); drow = (DROW); ldd = (LDD); dk0 = (DK0); found = true; } else r -= cnt; }
        JOB(A.in[I0_WIN], DM, 1792, (bf16_t*)(ws + WS_WIN), 0, DM, 0)
        JOB(A.in[I0_WOUT], DM, DM, (bf16_t*)(ws + WS_WOUT), 0, DM, 0)
        JOB(A.in[I1_WR], DM, DM, BMIX, 0, DM, 0)
        JOB(A.in[I1_WK], DM, DM, BMIX, 1024, DM, 0)
        JOB(A.in[I1_WV], DM, DM, BMIX, 2048, DM, 0)
        JOB(A.in[I1_G1], DM, 160, BMIX, 3072, DM, 0)
        JOB(A.in[I1_W1], DM, 64, BMIX, 3328, DM, 0)
        JOB(A.in[I1_W1] + DM * 64, DM, 64, BMIX, 3328 + 64, DM, 0)
        JOB(A.in[I1_A1], DM, 64, BMIX, 3584, DM, 0)
        JOB(A.in[I1_A1] + DM * 64, DM, 64, BMIX, 3584 + 64, DM, 0)
        JOB(A.in[I1_W2], 64, DM, B2, 0, 256, 0)
        JOB(A.in[I1_W2] + 64 * DM, 64, DM, B2, 1024, 256, 64)
        JOB(A.in[I1_A2], 64, DM, B2, 2048, 256, 128)
        JOB(A.in[I1_A2] + 64 * DM, 64, DM, B2, 3072, 256, 192)
        JOB(A.in[I1_G2], 160, DM, B2, 4096, 256, 0)
        JOB(A.in[I1_WO], DM, DM, (bf16_t*)(ws + WS_WO), 0, DM, 0)
#undef JOB
        if (!found) {
            if (r >= 128) break;
            const int pair = r >> 2, which = (r >> 1) & 1, nb = r & 1;
            W = A.in[which ? I0_WR : I0_WI] + (size_t)pair * 64 * 64; Kr = 64; N = 64; dst = (bf16_t*)(ws + WS_WGATE); drow = (long)pair * 128 + which * 64 + 32 * nb; ldd = 64; dk0 = 0;
            tr_item(W, Kr, N, dst, drow, ldd, dk0, scr, 0, 32 * nb, lane);
            continue;
        }
        const int nblk = N / 32, kb = r / nblk, nb = r % nblk;
        tr_item(W, Kr, N, dst, drow + 32 * nb, ldd, dk0, scr, 64 * kb, 32 * nb, lane);
    }
    (void)NJ;
    moe_convert(A, 0, lds, gw, ngw, wave, lane);
    __syncthreads();
    if (blockIdx.x < 192) {
        const int layer = blockIdx.x / 96, cb = blockIdx.x % 96, col = cb * 64 + lane;
        LAS float* sil = (LAS float*)(lds);
        LAS float* part = (LAS float*)(lds + 32768);
        for (int i = tid; i < 5 * 1024; i += 512) { const int rr = i >> 10, k = i & 1023; const float v = rr < 4 ? A.in[I_C][rr * 1024 + k] : A.in[I_CCTX][k]; sil[i] = v / (1.0f + expf(-v)); }
        __syncthreads();
        const float* wm = A.in[layer ? I1_WMOD : I0_WMOD];
        float acc[5] = {0.f, 0.f, 0.f, 0.f, 0.f};
        for (int k = wave * 128; k < wave * 128 + 128; ++k) { const float wv = wm[(size_t)k * 6144 + col];
#pragma unroll
            for (int rr = 0; rr < 5; ++rr) acc[rr] += sil[rr * 1024 + k] * wv; }
#pragma unroll
        for (int rr = 0; rr < 5; ++rr) part[(wave * 5 + rr) * 64 + lane] = acc[rr];
        __syncthreads();
        if (tid < 320) { const int rr = tid >> 6, l = tid & 63; float s = 0.f;
#pragma unroll
            for (int w = 0; w < 8; ++w) s += part[(w * 5 + rr) * 64 + l];
            ((float*)(ws + WS_ADA))[(size_t)(layer * 5 + rr) * 6144 + cb * 64 + l] = s + A.in[layer ? I1_BMOD : I0_BMOD][cb * 64 + l]; }
        __syncthreads();
    }
    if (blockIdx.x == G - 1) {
        float* tab = (float*)(ws + WS_ROPE);
        for (int i = tid; i < 192 * 16; i += 512) {
            const int pos = i >> 4, f = i & 15; const int p = pos < 128 ? pos : pos - 128;
            double inv = 1.0; for (int q = 0; q < f; ++q) inv *= 0.5623413251903491;
            const float invf = (float)inv;
            const float angf = (float)p * invf;
            double x = (double)angf; const double n = rint(x * 0.15915494309189535); x -= n * 6.283185307179586477;
            const double x2 = x * x; double sn = 0.0, cs = 0.0;
            for (int t = 27; t >= 1; t -= 2) sn = sn * x2 * (-1.0 / ((double)(t + 1) * (double)(t + 2))) + 1.0;
            for (int t = 26; t >= 0; t -= 2) cs = cs * x2 * (-1.0 / ((double)(t + 1) * (double)(t + 2))) + 1.0;
            tab[pos * 32 + f] = (float)cs; tab[pos * 32 + 16 + f] = (float)(sn * x);
        }
    }
}
__device__ __forceinline__ void norm_mod_row(const float* xr, const float* gain, const float* sh, const float* sc, bf16_t* orow, int lane) {
    f32x4 v[4]; float ss = 0.f;
#pragma unroll
    for (int j = 0; j < 4; ++j) { v[j] = *(const f32x4*)(xr + 4 * (lane + 64 * j)); ss += (v[j].x * v[j].x + v[j].y * v[j].y) + (v[j].z * v[j].z + v[j].w * v[j].w); }
    const float rs = __builtin_amdgcn_rsqf(wave_sum(ss) * (1.f / DM) + 1e-6f);
#pragma unroll
    for (int j = 0; j < 4; ++j) { const int col = 4 * (lane + 64 * j);
        const f32x4 g = *(const f32x4*)(gain + col), a = *(const f32x4*)(sc + col), b = *(const f32x4*)(sh + col);
        const f32x4 y = v[j] * rs * g * (a + 1.0f) + b;
        u32x2 w; w.x = cvt_pk_bf16(y.x, y.y); w.y = cvt_pk_bf16(y.z, y.w);
        *(u32x2*)(orow + col) = w; }
}
__device__ __forceinline__ const float* xs_row(KAREF A, int m) { return m < TL ? A.out + (size_t)m * DM : (const float*)(A.ws + WS_CTXS) + (size_t)(m - TL) * DM; }
__device__ __forceinline__ float* xs_row_w(KAREF A, int m) { return m < TL ? A.out + (size_t)m * DM : (float*)(A.ws + WS_CTXS) + (size_t)(m - TL) * DM; }

__device__ __forceinline__ void p1_norm0(KAREF A, int G) {
    const int lane = threadIdx.x & 63, wave = threadIdx.x >> 6, gw = blockIdx.x * 8 + wave, ngw = G * 8;
    bf16_t* H = (bf16_t*)(A.ws + WS_ACT + A_H);
    f32x4 gq[4], aq[4], bq[4], vn[4]; int rcur = -1;
#pragma unroll
    for (int j = 0; j < 4; ++j) gq[j] = *(const f32x4*)(A.in[I0_NMIX] + 4 * (lane + 64 * j));
#define P1_ROW(M) ((M) < TL ? A.in[I_X] + (size_t)(M) * DM : A.in[I_CTX] + (size_t)((M) - TL) * DM)
    { const int m0 = gw < TT ? gw : 0; const float* x0 = P1_ROW(m0);
#pragma unroll
      for (int j = 0; j < 4; ++j) vn[j] = *(const f32x4*)(x0 + 4 * (lane + 64 * j)); }
    for (int m = gw; m < TT; m += ngw) {
        const int r = mod_row(m);
        if (r != rcur) { const float* sh = ada_ptr(A.ws, 0, r, 0); const float* sc = ada_ptr(A.ws, 0, r, 1); rcur = r;
#pragma unroll
            for (int j = 0; j < 4; ++j) { bq[j] = *(const f32x4*)(sh + 4 * (lane + 64 * j)); aq[j] = *(const f32x4*)(sc + 4 * (lane + 64 * j)); } }
        f32x4 v[4]; float ss = 0.f;
#pragma unroll
        for (int j = 0; j < 4; ++j) v[j] = vn[j];
        { const int mn = m + ngw < TT ? m + ngw : m; const float* xn = P1_ROW(mn);
#pragma unroll
          for (int j = 0; j < 4; ++j) vn[j] = *(const f32x4*)(xn + 4 * (lane + 64 * j)); }
#pragma unroll
        for (int j = 0; j < 4; ++j) ss += (v[j].x * v[j].x + v[j].y * v[j].y) + (v[j].z * v[j].z + v[j].w * v[j].w);
        const float rs = __builtin_amdgcn_rsqf(wave_sum(ss) * (1.f / DM) + 1e-6f);
#pragma unroll
        for (int j = 0; j < 4; ++j) { const int col = 4 * (lane + 64 * j); const f32x4 y = v[j] * rs * gq[j] * (aq[j] + 1.0f) + bq[j];
            u32x2 w; w.x = cvt_pk_bf16(y.x, y.y); w.y = cvt_pk_bf16(y.z, y.w);
            *(u32x2*)(H + (size_t)m * DM + col) = w; }
    }
#undef P1_ROW
}

struct EpiWin {
    static constexpr bool PERM = true;
    bf16_t* XA; bf16_t* GA; float* QR; float* KR; bf16_t* VB;
    __device__ __forceinline__ void operator()(const f32x4 (&acc)[2][2][4][2], const pg8::Unit& u, int wr, int wc, int fr, int fq) const {
        const int row0 = u.pm * 256 + wr * 64 + fr, tile = u.pn;
#pragma unroll
        for (int ai = 0; ai < 2; ++ai)
#pragma unroll
            for (int m = 0; m < 4; ++m) { const int row = row0 + ai * 128 + m * 16;
#pragma unroll
                for (int bj = 0; bj < 2; ++bj) { const int colt = bj * 128 + wc * 32 + 8 * fq; const f32x4 v0 = acc[ai][bj][m][0], v1 = acc[ai][bj][m][1];
                    u32x4 w; w.x = cvt_pk_bf16(v0[0], v0[1]); w.y = cvt_pk_bf16(v0[2], v0[3]); w.z = cvt_pk_bf16(v1[0], v1[1]); w.w = cvt_pk_bf16(v1[2], v1[3]);
                    if (tile < 2) *(u32x4*)(XA + (size_t)row * 512 + tile * 256 + colt) = w;
                    else if (tile < 4) *(u32x4*)(GA + (size_t)row * 512 + (tile - 2) * 256 + colt) = w;
                    else if (tile < 6) { float* p = QR + (size_t)row * 512 + (tile - 4) * 256 + colt; *(f32x4*)p = v0; *(f32x4*)(p + 4) = v1; }
                    else if (bj == 0) { float* p = KR + (size_t)row * 128 + colt; *(f32x4*)p = v0; *(f32x4*)(p + 4) = v1; }
                    else *(u32x4*)(VB + (size_t)kv_row(row) * 128 + (colt - 128)) = w; } }
    }
};

__device__ __forceinline__ void p5_ctx_outproj(KAREF A, int G) {
    const int tid = threadIdx.x, lane = tid & 63, wave = tid >> 6, fr = lane & 15, fq = lane >> 4;
    const bf16_t* Y = (const bf16_t*)(A.ws + WS_ACT + A_YCAT) + (size_t)TL * DM; const bf16_t* W = (const bf16_t*)(A.ws + WS_WOUT);
    const float* gate = ada_ptr(A.ws, 0, 4, 2); const float* src = A.in[I_CTX]; float* dst = (float*)(A.ws + WS_CTXS);
    for (int tile = blockIdx.x; tile < (TC / 64) * (DM / 64); tile += G) {
        const int r0 = (tile >> 4) * 64 + (wave >> 1) * 16, c0 = (tile & 15) * 64 + (wave & 1) * 32;
        const bf16_t* ap = Y + (size_t)(r0 + fr) * DM + 8 * fq; const bf16_t* bp0 = W + (size_t)(c0 + fr) * DM + 8 * fq; const bf16_t* bp1 = bp0 + (size_t)16 * DM;
        f32x4 acc0 = (f32x4){0.f, 0.f, 0.f, 0.f}, acc1 = acc0;
#pragma unroll 8
        for (int k0 = 0; k0 < DM; k0 += 32) { const bf16x8 a = *(const bf16x8*)(ap + k0), b0 = *(const bf16x8*)(bp0 + k0), b1 = *(const bf16x8*)(bp1 + k0);
            acc0 = __builtin_amdgcn_mfma_f32_16x16x32_bf16(a, b0, acc0, 0, 0, 0); acc1 = __builtin_amdgcn_mfma_f32_16x16x32_bf16(a, b1, acc1, 0, 0, 0); }
        const float g0 = gate[c0 + fr], g1 = gate[c0 + 16 + fr];
#pragma unroll
        for (int r = 0; r < 4; ++r) { const size_t o = (size_t)(r0 + 4 * fq + r) * DM + c0 + fr; dst[o] = src[o] + g0 * acc0[r]; dst[o + 16] = src[o + 16] + g1 * acc1[r]; }
    }
}

__device__ __forceinline__ void p3_kprep(KAREF A, int G) {
    const int lane = threadIdx.x & 63, wave = threadIdx.x >> 6, gw = blockIdx.x * 8 + wave, ngw = G * 8;
    const float* KR = (const float*)(A.ws + WS_ACT + A_KR); bf16_t* KN = (bf16_t*)(A.ws + WS_ACT + A_KN); const float* tab = (const float*)(A.ws + WS_ROPE);
    const int head = lane >> 5, p = lane & 31;
    const float g0 = A.in[I0_KG][2 * p], g1 = A.in[I0_KG][2 * p + 1];
    for (int m0 = gw; m0 < TT; m0 += 4 * ngw) {
        f32x2 v[4]; float cs[4], sn[4]; int mm[4]; bool ok[4];
#pragma unroll
        for (int q = 0; q < 4; ++q) { const int m = m0 + q * ngw; ok[q] = m < TT; mm[q] = ok[q] ? m : m0; v[q] = *(const f32x2*)(KR + (size_t)mm[q] * 128 + head * 64 + 2 * p);
            cs[q] = 1.f; sn[q] = 0.f;
            if (mm[q] < TL) { const int t = mm[q] & 8191; const float* tb = tab + (p < 16 ? (t >> 6) : 128 + (t & 63)) * 32 + (p & 15); cs[q] = tb[0]; sn[q] = tb[16]; } }
#pragma unroll
        for (int q = 0; q < 4; ++q) {
            float ss = v[q].x * v[q].x + v[q].y * v[q].y;
#pragma unroll
            for (int o = 1; o < 32; o <<= 1) ss += __shfl_xor(ss, o);
            const float rs = __builtin_amdgcn_rsqf(ss * (1.f / 64.f) + 1e-6f);
            const float x1 = v[q].x * rs * g0, x2 = v[q].y * rs * g1;
            const float y0 = x1 * cs[q] - x2 * sn[q], y1 = x1 * sn[q] + x2 * cs[q];
            if (ok[q]) *(unsigned*)(KN + (size_t)kv_row(mm[q]) * 128 + head * 64 + 2 * p) = cvt_pk_bf16(y0, y1); }
    }
}

constexpr int L_XCF = 0, L_XCB = 17408, L_WG = 26624, L_AB = 45056, L_SC = 78336, L_CAR = 82432, L_PAR = 82944;
template <int MODE>
__device__ __forceinline__ void lru_dir(KAREF A, LAS unsigned char* lds, int d, int n, int seqrow0, int L, int t_begin, int t_end, float h0, float& h_end, float& a_prod) {
    const int tid = threadIdx.x, lane = tid & 63, wid = tid >> 6;
    LAS float* XCF = (LAS float*)(lds + L_XCF);
    LAS bf16_t* XCB = (LAS bf16_t*)(lds + L_XCB);
    LAS bf16_t* WGl = (LAS bf16_t*)(lds + L_WG);
    LAS f32x2* AB = (LAS f32x2*)(lds + L_AB);
    LAS f32x2* SC = (LAS f32x2*)(lds + L_SC);
    LAS float* CAR = (LAS float*)(lds + L_CAR);
    LAS float* PAR = (LAS float*)(lds + L_PAR);
    const bf16_t* XA = (const bf16_t*)(A.ws + WS_ACT + A_XA); const bf16_t* GA = (const bf16_t*)(A.ws + WS_ACT + A_GA);
    float* HF = (float*)(A.ws + WS_ACT + A_HF); bf16_t* YCAT = (bf16_t*)(A.ws + WS_ACT + A_YCAT);
    __syncthreads();
    { const bf16_t* src = (const bf16_t*)(A.ws + WS_WGATE) + (size_t)(d * 8 + n) * 128 * 64; const int row = tid >> 2, part = tid & 3;
      const u32x4 w0 = *(const u32x4*)(src + row * 64 + part * 16), w1 = *(const u32x4*)(src + row * 64 + part * 16 + 8);
      *(LAS u32x4*)(WGl + row * 72 + part * 16) = w0; *(LAS u32x4*)(WGl + row * 72 + part * 16 + 8) = w1; }
    if (tid < 64) { const int c = tid, ch = 64 * n + c;
#pragma unroll
        for (int j = 0; j < 4; ++j) PAR[j * 64 + c] = A.in[I0_CONVW][j * 512 + ch];
        PAR[256 + c] = A.in[I0_CONVB][ch]; PAR[320 + c] = A.in[I0_BI][d * 512 + ch]; PAR[384 + c] = A.in[I0_BR][d * 512 + ch];
        const float lam = A.in[I0_LAM][d * 512 + ch]; PAR[448 + c] = -8.0f * log1pf(expf(-lam));
        CAR[c] = h0; }
    __syncthreads();
    const int nsub = (t_end - t_begin) >> 6; float ap = 1.f, hfin = 0.f; int par = 0;
#define LRU_BAR() do { LDS_WAIT(); __builtin_amdgcn_s_barrier(); asm volatile("" ::: "memory"); } while (0)
    u32x4 xw[4];
#define LRU_PREFETCH(SI) do { const int t0_ = t_begin + (d ? nsub - 1 - (SI) : (SI)) * 64; _Pragma("unroll") for (int j = 0; j < 4; ++j) { const int ts = t0_ + (tid >> 3) + j - 2; \
        xw[j] = (ts >= 0 && ts < L) ? *(const u32x4*)(XA + (size_t)(seqrow0 + ts) * 512 + 64 * n + (tid & 7) * 8) : (u32x4){0u, 0u, 0u, 0u}; } } while (0)
    LRU_PREFETCH(0);
    float cw8[4][8], cb8[8];
    { const int ch8 = (tid & 7) * 8;
#pragma unroll
      for (int i = 0; i < 8; ++i) { cb8[i] = PAR[256 + ch8 + i];
#pragma unroll
          for (int j = 0; j < 4; ++j) cw8[j][i] = PAR[j * 64 + ch8 + i]; } }
    for (int si = 0; si < nsub; ++si) {
        const int t0 = t_begin + (d ? nsub - 1 - si : si) * 64;
        { const int tt = tid >> 3, ch8 = (tid & 7) * 8; float a8[8];
#pragma unroll
          for (int i = 0; i < 8; ++i) a8[i] = cb8[i];
#pragma unroll
          for (int j = 0; j < 4; ++j) {
              { const u32x4 w = xw[j];
                  a8[0] += cw8[j][0] * bflo(w.x); a8[1] += cw8[j][1] * bfhi(w.x); a8[2] += cw8[j][2] * bflo(w.y); a8[3] += cw8[j][3] * bfhi(w.y);
                  a8[4] += cw8[j][4] * bflo(w.z); a8[5] += cw8[j][5] * bfhi(w.z); a8[6] += cw8[j][6] * bflo(w.w); a8[7] += cw8[j][7] * bfhi(w.w); } }
          *(LAS f32x4*)(XCF + tt * 68 + ch8) = (f32x4){a8[0], a8[1], a8[2], a8[3]}; *(LAS f32x4*)(XCF + tt * 68 + ch8 + 4) = (f32x4){a8[4], a8[5], a8[6], a8[7]};
          u32x4 o; o.x = cvt_pk_bf16(a8[0], a8[1]); o.y = cvt_pk_bf16(a8[2], a8[3]); o.z = cvt_pk_bf16(a8[4], a8[5]); o.w = cvt_pk_bf16(a8[6], a8[7]);
          *(LAS u32x4*)(XCB + tt * 72 + ch8) = o; }
        if (si + 1 < nsub) LRU_PREFETCH(si + 1);
        LRU_BAR();
        { const int mt = wid & 3, half = wid >> 2, fr = lane & 15, fq = lane >> 4;
          const bf16x8 a0 = *(const LAS bf16x8*)(XCB + (mt * 16 + fr) * 72 + 8 * fq), a1 = *(const LAS bf16x8*)(XCB + (mt * 16 + fr) * 72 + 32 + 8 * fq);
#pragma unroll
          for (int q = 0; q < 2; ++q) { const int cbase = 32 * half + 16 * q, c = cbase + fr;
              const bf16x8 bi0 = *(const LAS bf16x8*)(WGl + (cbase + fr) * 72 + 8 * fq), bi1 = *(const LAS bf16x8*)(WGl + (cbase + fr) * 72 + 32 + 8 * fq);
              const bf16x8 br0 = *(const LAS bf16x8*)(WGl + (64 + cbase + fr) * 72 + 8 * fq), br1 = *(const LAS bf16x8*)(WGl + (64 + cbase + fr) * 72 + 32 + 8 * fq);
              f32x4 gi = __builtin_amdgcn_mfma_f32_16x16x32_bf16(a0, bi0, (f32x4){0.f, 0.f, 0.f, 0.f}, 0, 0, 0); gi = __builtin_amdgcn_mfma_f32_16x16x32_bf16(a1, bi1, gi, 0, 0, 0);
              f32x4 gr = __builtin_amdgcn_mfma_f32_16x16x32_bf16(a0, br0, (f32x4){0.f, 0.f, 0.f, 0.f}, 0, 0, 0); gr = __builtin_amdgcn_mfma_f32_16x16x32_bf16(a1, br1, gr, 0, 0, 0);
              const float bic = PAR[320 + c], brc = PAR[384 + c], lsl = PAR[448 + c];
#pragma unroll
              for (int j = 0; j < 4; ++j) { const int tt = mt * 16 + 4 * fq + j; const float xcv = XCF[tt * 68 + c];
                  const float ig = sigm(gi[j] + bic), rg = sigm(gr[j] + brc), la = rg * lsl, av = fexp(la);
                  const float bb = __builtin_amdgcn_sqrtf(fmaxf(1.0f - av * av, 0.f)) * ig * xcv;
                  AB[tt * 65 + c] = (f32x2){av, bb}; } } }
        LRU_BAR();
        { const int c = tid & 63, sc = wid; float av[8], bv[8]; float Al = 1.f, Hl = 0.f;
#pragma unroll
          for (int i = 0; i < 8; ++i) { const int p = 8 * sc + i, tt = d ? 63 - p : p; const f32x2 ab = AB[tt * 65 + c]; av[i] = ab.x; bv[i] = ab.y; Hl = ab.x * Hl + ab.y; Al *= ab.x; }
          SC[sc * 64 + c] = (f32x2){Al, Hl};
          float hfv[8], gav[8];
          if (MODE == 2) {
#pragma unroll
              for (int i = 0; i < 8; ++i) { const int p = 8 * sc + i, tt = d ? 63 - p : p; const size_t row = (size_t)(seqrow0 + t0 + tt);
                  hfv[i] = __hip_atomic_load(HF + row * 512 + 64 * n + c, RLX_AGENT); gav[i] = bf2f(GA[row * 512 + 64 * n + c]); } }
          LRU_BAR();
          float h = CAR[par * 64 + c]; float apl = 1.f;
#pragma unroll
          for (int s2 = 0; s2 < 8; ++s2) { const f32x2 t = SC[s2 * 64 + c]; if (s2 < sc) h = t.x * h + t.y; apl *= t.x; }
          if (MODE == 0) { h = Al * h + Hl; }
          else {
#pragma unroll
              for (int i = 0; i < 8; ++i) { h = av[i] * h + bv[i]; const int p = 8 * sc + i, tt = d ? 63 - p : p; const size_t row = (size_t)(seqrow0 + t0 + tt);
                  if (MODE == 1) HF[row * 512 + 64 * n + c] = h;
                  else { const float hf = hfv[i]; const float g = gav[i];
                      const float y = (h + hf) * gelu_tanh(g); YCAT[row * 1024 + 64 * n + c] = (bf16_t)(cvt_pk_bf16(y, 0.f) & 0xffffu); } } }
          if (sc == 7) { CAR[(par ^ 1) * 64 + c] = h; ap *= apl; hfin = h; }
          par ^= 1; }
    }
#undef LRU_PREFETCH
#undef LRU_BAR
    h_end = hfin; a_prod = ap;
}
__device__ __forceinline__ void p3_lru_pass1(KAREF A, LAS unsigned char* lds, int G) {
    const int tid = threadIdx.x, c = tid & 63;
    f32x2* CARRY = (f32x2*)(A.ws + WS_CARRY); float* HLAST = (float*)(A.ws + WS_HLAST);
    for (int u = blockIdx.x; u < 256 + 32; u += G) {
        float he, ap;
        if (u < 256) { const int b = u >> 6, n = (u >> 3) & 7, s = u & 7;
#pragma unroll 1
            for (int d = 0; d < 2; ++d) { lru_dir<0>(A, lds, d, n, b * SEQ, SEQ, s * 1024, s * 1024 + 1024, 0.f, he, ap);
                if (tid >= 448) CARRY[(size_t)((b * 8 + s) * 2 + d) * 512 + 64 * n + c] = (f32x2){ap, he}; } }
        else { const int v = u - 256, b = v >> 3, n = v & 7;
            lru_dir<1>(A, lds, 0, n, TL + b * CTXL, CTXL, 0, CTXL, 0.f, he, ap);
            if (tid >= 448) HLAST[(b * 2 + 0) * 512 + 64 * n + c] = he;
            VM_WAIT(); __syncthreads();
            lru_dir<2>(A, lds, 1, n, TL + b * CTXL, CTXL, 0, CTXL, 0.f, he, ap);
            if (tid >= 448) HLAST[(b * 2 + 1) * 512 + 64 * n + c] = he; }
    }
}
__device__ __forceinline__ void p4_lru_pass2(KAREF A, LAS unsigned char* lds, int G) {
    const int tid = threadIdx.x, c = tid & 63;
    const f32x2* CARRY = (const f32x2*)(A.ws + WS_CARRY); const float* HLAST = (const float*)(A.ws + WS_HLAST);
    for (int u = blockIdx.x; u < 256; u += G) {
        const int b = u >> 6, n = (u >> 3) & 7, s = u & 7; float he, ap;
        float hf0 = HLAST[(b * 2 + 0) * 512 + 64 * n + c], hb0 = HLAST[(b * 2 + 1) * 512 + 64 * n + c];
        for (int s2 = 0; s2 < s; ++s2) { const f32x2 t = CARRY[(size_t)((b * 8 + s2) * 2 + 0) * 512 + 64 * n + c]; hf0 = t.x * hf0 + t.y; }
        for (int s2 = 7; s2 > s; --s2) { const f32x2 t = CARRY[(size_t)((b * 8 + s2) * 2 + 1) * 512 + 64 * n + c]; hb0 = t.x * hb0 + t.y; }
        lru_dir<1>(A, lds, 0, n, b * SEQ, SEQ, s * 1024, s * 1024 + 1024, hf0, he, ap);
        VM_WAIT(); __syncthreads();
        lru_dir<2>(A, lds, 1, n, b * SEQ, SEQ, s * 1024, s * 1024 + 1024, hb0, he, ap);
    }
}

struct EpiResid {
    static constexpr bool PERM = false;
    const float* src_lat; const float* src_ctx; float* dst_lat; float* dst_ctx; const float* gate;
    __device__ __forceinline__ void operator()(const f32x4 (&acc)[2][2][4][2], const pg8::Unit& u, int wr, int wc, int fr, int fq) const {
        const int row0 = u.pm * 256 + wr * 64 + fr, col0 = u.pn * 256 + wc * 32 + 4 * fq;
        const bool lat = u.pm < TL / 256; const int r = lat ? (u.pm >> 5) : 4;
        const float* src = lat ? src_lat + (size_t)row0 * DM : src_ctx + (size_t)(row0 - TL) * DM; float* dst = lat ? dst_lat + (size_t)row0 * DM : dst_ctx + (size_t)(row0 - TL) * DM;
        f32x4 gv[2][2];
#pragma unroll
        for (int bj = 0; bj < 2; ++bj)
#pragma unroll
            for (int n = 0; n < 2; ++n) gv[bj][n] = *(const f32x4*)(gate + (size_t)r * 6144 + col0 + bj * 128 + n * 16);
        f32x4 sv[4][4];
#define ER_LOAD(slot, st) do { const size_t off_ = (size_t)(((st) >> 2) * 128 + ((st) & 3) * 16) * DM + col0; _Pragma("unroll") for (int bj = 0; bj < 2; ++bj) _Pragma("unroll") for (int n = 0; n < 2; ++n) sv[slot][bj * 2 + n] = *(const f32x4*)(src + off_ + bj * 128 + n * 16); } while (0)
        ER_LOAD(0, 0); ER_LOAD(1, 1); ER_LOAD(2, 2); ER_LOAD(3, 3);
#pragma unroll
        for (int st = 0; st < 8; ++st) { const int ai = st >> 2, m = st & 3; const size_t off = (size_t)(ai * 128 + m * 16) * DM + col0;
            f32x4 o[4];
#pragma unroll
            for (int bj = 0; bj < 2; ++bj)
#pragma unroll
                for (int n = 0; n < 2; ++n) o[bj * 2 + n] = sv[st & 3][bj * 2 + n] + gv[bj][n] * acc[ai][bj][m][n];
            if (st + 4 < 8) ER_LOAD(st & 3, st + 4);
#pragma unroll
            for (int bj = 0; bj < 2; ++bj)
#pragma unroll
                for (int n = 0; n < 2; ++n) *(f32x4*)(dst + off + bj * 128 + n * 16) = o[bj * 2 + n];
            asm volatile("" ::: "memory"); }
#undef ER_LOAD
    }
};
__device__ __forceinline__ void p4_attention(KAREF A, char* lds, int G) {
    const float* QR = (const float*)(A.ws + WS_ACT + A_QR); const attn_body::bf16* KN = (const attn_body::bf16*)(A.ws + WS_ACT + A_KN); const attn_body::bf16* VB = (const attn_body::bf16*)(A.ws + WS_ACT + A_VB);
    attn_body::bf16* YC = (attn_body::bf16*)(A.ws + WS_ACT + A_YCAT); const float* tab = (const float*)(A.ws + WS_ROPE); const float* qg = A.in[I0_QG];
    const int vcu = (G % 8 == 0) ? (int)((blockIdx.x % 8) * (G / 8) + blockIdx.x / 8) : (int)blockIdx.x;
    for (int u = vcu; u < 1024 + 32; u += G) {
        if (u < 1024) { const int bh = u >> 5, qb = u & 31, b = bh >> 3, h = bh & 7;
            attn_body::attn_unit<8>(b * SEQ + qb * 256, h, b * KVL, KVL / 64, 1, qb * 256, QR, qg, tab, KN, VB, YC, lds); }
        else { const int v = u - 1024, b = v >> 3, h = v & 7;
            attn_body::attn_unit<8>(TL + b * CTXL, h, b * KVL + SEQ, CTXL / 64, 0, 0, QR, qg, tab, KN, VB, YC, lds); }
    }
}

__device__ __forceinline__ void p6_norm_router(KAREF A, LAS unsigned char* lds, int G, int layer, int nrows) {
    const int tid = threadIdx.x, lane = tid & 63, wave = tid >> 6, gw = blockIdx.x * 8 + wave, ngw = G * 8;
    LAS float* RT = (LAS float*)lds;
    const float* router = A.in[layer ? I1_ROUTER : I0_ROUTER];
    for (int i = tid; i < 16 * 1024; i += 512) { const int k = i >> 4, e = i & 15; RT[e * 1024 + k] = router[i]; }
    __syncthreads();
    bf16_t* H2 = (bf16_t*)(A.ws + WS_ACT + A_H2); float* AFFL = (float*)(A.ws + WS_AFFL); float* AFFC = (float*)(A.ws + WS_AFFC);
    const float* gain = A.in[layer ? I1_NFFN : I0_NFFN];
    f32x4 gq[4], vn[4];
#pragma unroll
    for (int j = 0; j < 4; ++j) gq[j] = *(const f32x4*)(gain + 4 * (lane + 64 * j));
    { const float* x0 = xs_row(A, gw < nrows ? gw : 0);
#pragma unroll
      for (int j = 0; j < 4; ++j) vn[j] = *(const f32x4*)(x0 + 4 * (lane + 64 * j)); }
    f32x4 aq[4], bq[4]; int rcur = -1;
    for (int m = gw; m < nrows; m += ngw) {
        const int r = mod_row(m);
        if (r != rcur) { const float* sh = ada_ptr(A.ws, layer, r, 3); const float* sc = ada_ptr(A.ws, layer, r, 4); rcur = r;
#pragma unroll
            for (int j = 0; j < 4; ++j) { aq[j] = *(const f32x4*)(sc + 4 * (lane + 64 * j)); bq[j] = *(const f32x4*)(sh + 4 * (lane + 64 * j)); } }
        f32x4 v[4]; float ss = 0.f;
#pragma unroll
        for (int j = 0; j < 4; ++j) v[j] = vn[j];
        { const float* xn = xs_row(A, m + ngw < nrows ? m + ngw : m);
#pragma unroll
          for (int j = 0; j < 4; ++j) vn[j] = *(const f32x4*)(xn + 4 * (lane + 64 * j)); }
#pragma unroll
        for (int j = 0; j < 4; ++j) ss += (v[j].x * v[j].x + v[j].y * v[j].y) + (v[j].z * v[j].z + v[j].w * v[j].w);
        const float rs = __builtin_amdgcn_rsqf(wave_sum(ss) * (1.f / DM) + 1e-6f);
        float pe[16];
#pragma unroll
        for (int e = 0; e < 16; ++e) pe[e] = 0.f;
#pragma unroll
        for (int j = 0; j < 4; ++j) { const int col = 4 * (lane + 64 * j);
            const f32x4 y = v[j] * rs * gq[j] * (aq[j] + 1.0f) + bq[j];
            u32x2 w; w.x = cvt_pk_bf16(y.x, y.y); w.y = cvt_pk_bf16(y.z, y.w);
            *(u32x2*)(H2 + (size_t)m * DM + col) = w;
#pragma unroll
            for (int e = 0; e < 16; ++e) { const f32x4 rw = *(const LAS f32x4*)(RT + e * 1024 + col); pe[e] += (y.x * rw.x + y.y * rw.y) + (y.z * rw.z + y.w * rw.w); } }
#pragma unroll
        for (int i = 0; i < 8; ++i) { const bool up = (lane & 32) != 0; const float send = up ? pe[i] : pe[i + 8], keep = up ? pe[i + 8] : pe[i]; pe[i] = keep + __shfl_xor(send, 32); }
#pragma unroll
        for (int i = 0; i < 4; ++i) { const bool up = (lane & 16) != 0; const float send = up ? pe[i] : pe[i + 4], keep = up ? pe[i + 4] : pe[i]; pe[i] = keep + __shfl_xor(send, 16); }
#pragma unroll
        for (int i = 0; i < 2; ++i) { const bool up = (lane & 8) != 0; const float send = up ? pe[i] : pe[i + 2], keep = up ? pe[i + 2] : pe[i]; pe[i] = keep + __shfl_xor(send, 8); }
        { const bool up = (lane & 4) != 0; const float send = up ? pe[0] : pe[1], keep = up ? pe[1] : pe[0]; pe[0] = keep + __shfl_xor(send, 4); }
        float lg = pe[0]; lg += __shfl_xor(lg, 2); lg += __shfl_xor(lg, 1);
        float mx = lg;
#pragma unroll
        for (int o = 4; o < 64; o <<= 1) mx = fmaxf(mx, __shfl_xor(mx, o));
        const float ex = expf(lg - mx); float sm = ex;
#pragma unroll
        for (int o = 4; o < 64; o <<= 1) sm += __shfl_xor(sm, o);
        const float aff = ex / sm; const int e = (lane >> 2) & 15;
        if ((lane & 3) == 0) { if (m < TL) AFFL[(size_t)((m >> 13) * 16 + e) * SEQ + (m & 8191)] = aff; else { const int j = m - TL; AFFC[(size_t)((j >> 8) * 16 + e) * CTXL + (j & 255)] = aff; } }
    }
}

__device__ __forceinline__ void topk_unit(const float* aff, int N, int cap, int src_row0, int xe_row0, int* SRCROW, float* GROW, int* slotmap, LAS unsigned char* lds) {
    const int tid = threadIdx.x;
    LAS unsigned* keys = (LAS unsigned*)lds;
    LAS unsigned* hist = (LAS unsigned*)(lds + 32768);
    LAS unsigned* ctl = (LAS unsigned*)(lds + 32768 + 1024);
    LAS int* tmp = (LAS int*)(lds + 32768 + 1024 + 64);
    __syncthreads();
    for (int i = tid; i < N; i += 512) keys[i] = __float_as_uint(aff[i]);
    if (tid == 0) { ctl[0] = 0u; ctl[1] = (unsigned)cap; }
    unsigned mask = 0u;
#pragma unroll 1
    for (int shift = 24; shift >= 0; shift -= 8) {
        if (tid < 256) hist[tid] = 0u;
        __syncthreads();
        const unsigned prefix = ctl[0];
        for (int i = tid; i < N; i += 512) { const unsigned k = keys[i]; if ((k & mask) == prefix) __hip_atomic_fetch_add(&hist[(k >> shift) & 255u], 1u, __ATOMIC_RELAXED, __HIP_MEMORY_SCOPE_WORKGROUP); }
        __syncthreads();
        { const unsigned need = ctl[1]; const int hv = tid < 256 ? (int)hist[255 - tid] : 0; int tot_; const int above = block_excl_scan(hv, tmp, tot_);
          if (tid < 256 && (unsigned)above < need && need <= (unsigned)(above + hv)) { ctl[0] = prefix | ((unsigned)(255 - tid) << shift); ctl[1] = need - (unsigned)above; } }
        mask |= 0xffu << shift;
        __syncthreads();
    }
    const unsigned tau = ctl[0]; const int need_eq = (int)ctl[1];
    const int per = N >= 512 ? N / 512 : 1; const int base = tid * per; const bool act = base < N;
    int neq = 0;
    if (act) for (int i = 0; i < per; ++i) neq += (keys[base + i] == tau) ? 1 : 0;
    int tot; int eqrank = block_excl_scan(neq, tmp, tot);
    int nsel = 0;
    if (act) { int er = eqrank; for (int i = 0; i < per; ++i) { const unsigned k = keys[base + i]; if (k > tau) ++nsel; else if (k == tau) { if (er < need_eq) ++nsel; ++er; } } }
    int slot = block_excl_scan(nsel, tmp, tot);
    if (act) { int er = eqrank; for (int i = 0; i < per; ++i) { const unsigned k = keys[base + i]; bool sel = false; if (k > tau) sel = true; else if (k == tau) { sel = er < need_eq; ++er; }
            if (sel) { SRCROW[xe_row0 + slot] = src_row0 + base + i; GROW[xe_row0 + slot] = __uint_as_float(k); slotmap[base + i] = xe_row0 + slot; ++slot; } else slotmap[base + i] = -1; } }
}
__device__ __forceinline__ void p7_topk(KAREF A, LAS unsigned char* lds, int G, bool with_ctx) {
    int* SRCROW = (int*)(A.ws + WS_SRCROW); float* GROW = (float*)(A.ws + WS_GROW);
    const int nun = with_ctx ? 128 : 64;
    for (int u = blockIdx.x; u < nun; u += G) {
        if (u < 64) { const int b = u >> 4, e = u & 15; topk_unit((const float*)(A.ws + WS_AFFL) + (size_t)u * SEQ, SEQ, CAPL, b * SEQ, (b * 16 + e) * CAPL, SRCROW, GROW, (int*)(A.ws + WS_SLOTL) + (size_t)u * SEQ, lds); }
        else { const int v = u - 64, b = v >> 4, e = v & 15; topk_unit((const float*)(A.ws + WS_AFFC) + (size_t)v * CTXL, CTXL, CAPC, TL + b * CTXL, XE_CTX0 + e * 256 + b * CAPC, SRCROW, GROW, (int*)(A.ws + WS_SLOTC) + (size_t)v * CTXL, lds); }
    }
}

__device__ __forceinline__ void p8_gather(KAREF A, int G, bool with_ctx) {
    const int lane = threadIdx.x & 63, wave = threadIdx.x >> 6, gw = blockIdx.x * 8 + wave, ngw = G * 8;
    const int* SRCROW = (const int*)(A.ws + WS_SRCROW); const bf16_t* H2 = (const bf16_t*)(A.ws + WS_ACT + A_H2); unsigned char* XE = A.ws + WS_ACT + A_XE;
    const int nr = with_ctx ? XE_CTX0 + NE * 128 : XE_CTX0;
    for (int i0 = gw; i0 < nr; i0 += 4 * ngw) {
        int xr[4], src[4]; bool ok[4];
#pragma unroll
        for (int q = 0; q < 4; ++q) { const int i = i0 + q * ngw; ok[q] = i < nr; const int ic = ok[q] ? i : i0; xr[q] = ic; if (ic >= XE_CTX0) { const int j = ic - XE_CTX0; xr[q] = XE_CTX0 + (j >> 7) * 256 + (j & 127); } }
#pragma unroll
        for (int q = 0; q < 4; ++q) src[q] = SRCROW[xr[q]];
        u32x4 a[4], b[4];
#pragma unroll
        for (int q = 0; q < 4; ++q) { a[q] = *(const u32x4*)(H2 + (size_t)src[q] * DM + 16 * lane); b[q] = *(const u32x4*)(H2 + (size_t)src[q] * DM + 16 * lane + 8); }
#pragma unroll
        for (int q = 0; q < 4; ++q) if (ok[q]) {
            u32x4 o; o.x = pk_fp8x4(bflo(a[q].x), bfhi(a[q].x), bflo(a[q].y), bfhi(a[q].y)); o.y = pk_fp8x4(bflo(a[q].z), bfhi(a[q].z), bflo(a[q].w), bfhi(a[q].w));
            o.z = pk_fp8x4(bflo(b[q].x), bfhi(b[q].x), bflo(b[q].y), bfhi(b[q].y)); o.w = pk_fp8x4(bflo(b[q].z), bfhi(b[q].z), bflo(b[q].w), bfhi(b[q].w));
            *(u32x4*)(XE + (size_t)xr[q] * DM + 16 * lane) = o; }
    }
}

struct MoeOrder1 {
    int G, c, nun;
    __device__ bool next(int i, pg8::Unit& u) const {
        const long L = (long)i * G + c; if (L >= nun) return false;
        if (L < 4096) { const int e = (int)(L >> 8), j = (int)(L & 255), x = j & 7, sI = j >> 3, rt = (x & 1) * 8 + (sI & 7), pnl = (x >> 1) * 4 + (sI >> 3);
            u.am = ((rt >> 2) * 16 + e) * 4 + (rt & 3); u.bn = e * 16 + pnl; }
        else { const int j = (int)L - 4096, e = j >> 4, pnl = j & 15; u.am = XE_CTX0 / 256 + e; u.bn = e * 16 + pnl; }
        u.pm = u.am; u.pn = u.bn & 15; return true;
    }
    __device__ __forceinline__ void a_ready(const pg8::Unit&) const {}
    __device__ __forceinline__ void done(const pg8::Unit&) const {}
};
struct MoeOrder2 {
    int G, c, nun;
    __device__ bool next(int i, pg8::Unit& u) const {
        const long L = (long)i * G + c; if (L >= nun) return false;
        if (L < 1024) { const int e4 = (int)(L >> 8), j = (int)(L & 255), v = (j & 7) * 32 + (j >> 3), e = 4 * e4 + (v >> 6), w = v & 63, rt = w >> 2, pnl = w & 3;
            u.am = ((rt >> 2) * 16 + e) * 4 + (rt & 3); u.bn = e * 4 + pnl; }
        else { const int j = (int)L - 1024, e = j >> 2, pnl = j & 3; u.am = XE_CTX0 / 256 + e; u.bn = e * 4 + pnl; }
        u.pm = u.am; u.pn = u.bn & 3; return true;
    }
    __device__ __forceinline__ void a_ready(const pg8::Unit&) const {}
    __device__ __forceinline__ void done(const pg8::Unit&) const {}
};
struct EpiSwiGLU {
    static constexpr bool PERM = true;
    unsigned char* HID;
    __device__ __forceinline__ void operator()(const f32x4 (&acc)[2][2][4][2], const pg8::Unit& u, int wr, int wc, int fr, int fq) const {
        const int row0 = u.pm * 256 + wr * 64 + fr, col0 = u.pn * 128 + wc * 32 + 8 * fq; constexpr float is = 1.0f / W8_SCALE;
#pragma unroll
        for (int ai = 0; ai < 2; ++ai)
#pragma unroll
            for (int m = 0; m < 4; ++m) { const f32x4 g0 = acc[ai][0][m][0] * is, g1 = acc[ai][0][m][1] * is, u0 = acc[ai][1][m][0] * is, u1 = acc[ai][1][m][1] * is;
                u32x2 w; w.x = pk_fp8x4(silu_f(g0[0]) * u0[0], silu_f(g0[1]) * u0[1], silu_f(g0[2]) * u0[2], silu_f(g0[3]) * u0[3]);
                w.y = pk_fp8x4(silu_f(g1[0]) * u1[0], silu_f(g1[1]) * u1[1], silu_f(g1[2]) * u1[2], silu_f(g1[3]) * u1[3]);
                *(u32x2*)(HID + (size_t)(row0 + ai * 128 + m * 16) * FF + col0) = w; }
    }
};
struct EpiDown {
    static constexpr bool PERM = true;
    bf16_t* YE; const float* GROW;
    __device__ __forceinline__ void operator()(const f32x4 (&acc)[2][2][4][2], const pg8::Unit& u, int wr, int wc, int fr, int fq) const {
        const int row0 = u.pm * 256 + wr * 64 + fr, col0 = u.pn * 256 + wc * 32 + 8 * fq;
#pragma unroll
        for (int ai = 0; ai < 2; ++ai)
#pragma unroll
            for (int m = 0; m < 4; ++m) { const int row = row0 + ai * 128 + m * 16; const float gt = GROW[row] * (1.0f / W8_SCALE);
#pragma unroll
                for (int bj = 0; bj < 2; ++bj) { const f32x4 v0 = acc[ai][bj][m][0] * gt, v1 = acc[ai][bj][m][1] * gt;
                    u32x4 w; w.x = cvt_pk_bf16(v0[0], v0[1]); w.y = cvt_pk_bf16(v0[2], v0[3]); w.z = cvt_pk_bf16(v1[0], v1[1]); w.w = cvt_pk_bf16(v1[2], v1[3]);
                    *(u32x4*)(YE + (size_t)row * DM + col0 + bj * 128) = w; } }
    }
};

__device__ __forceinline__ void p11_combine(KAREF A, int G, int layer, int nrows) {
    const int lane = threadIdx.x & 63, wave = threadIdx.x >> 6, gw = blockIdx.x * 8 + wave, ngw = G * 8;
    const bf16_t* YE = (const bf16_t*)(A.ws + WS_ACT + A_YE); const int* SLOTL = (const int*)(A.ws + WS_SLOTL); const int* SLOTC = (const int*)(A.ws + WS_SLOTC);
#define CB_SLOT(M, DST) do { const int m_ = (M); DST = -1; if (lane < 16) { if (m_ < TL) DST = SLOTL[(size_t)((m_ >> 13) * 16 + lane) * SEQ + (m_ & 8191)]; else { const int j_ = m_ - TL; DST = SLOTC[(size_t)((j_ >> 8) * 16 + lane) * CTXL + (j_ & 255)]; } } } while (0)
    int smn; f32x4 xn[4], g[4]; int rcur = -1;
    { const int m0 = gw < nrows ? gw : 0; CB_SLOT(m0, smn); const float* x0 = xs_row(A, m0);
#pragma unroll
      for (int j = 0; j < 4; ++j) xn[j] = *(const f32x4*)(x0 + 4 * (lane + 64 * j)); }
    for (int m = gw; m < nrows; m += ngw) {
        const int sm = smn; f32x4 x[4];
#pragma unroll
        for (int j = 0; j < 4; ++j) x[j] = xn[j];
        unsigned long long bal = __ballot(sm >= 0);
        bool ok[4]; int xr[4];
#pragma unroll
        for (int q = 0; q < 4; ++q) { ok[q] = bal != 0ull; const int e = ok[q] ? __builtin_ctzll(bal) : 0; if (ok[q]) bal &= bal - 1; const int rr = __builtin_amdgcn_readlane(sm, e); xr[q] = ok[q] ? rr : 0; }
        u32x2 w[4][4];
#pragma unroll
        for (int q = 0; q < 4; ++q)
#pragma unroll
            for (int j = 0; j < 4; ++j) w[q][j] = *(const u32x2*)(YE + (size_t)xr[q] * DM + 4 * (lane + 64 * j));
        { const int r = mod_row(m); if (r != rcur) { const float* gt = ada_ptr(A.ws, layer, r, 5); rcur = r;
#pragma unroll
            for (int j = 0; j < 4; ++j) g[j] = *(const f32x4*)(gt + 4 * (lane + 64 * j)); } }
        { const int mn = m + ngw < nrows ? m + ngw : m; CB_SLOT(mn, smn); const float* xp = xs_row(A, mn);
#pragma unroll
          for (int j = 0; j < 4; ++j) xn[j] = *(const f32x4*)(xp + 4 * (lane + 64 * j)); }
        f32x4 acc[4];
#pragma unroll
        for (int j = 0; j < 4; ++j) acc[j] = (f32x4){0.f, 0.f, 0.f, 0.f};
#pragma unroll
        for (int q = 0; q < 4; ++q) if (ok[q]) {
#pragma unroll
            for (int j = 0; j < 4; ++j) acc[j] += (f32x4){bflo(w[q][j].x), bfhi(w[q][j].x), bflo(w[q][j].y), bfhi(w[q][j].y)}; }
        while (bal) { const int e = __builtin_ctzll(bal); bal &= bal - 1; const int rr = __builtin_amdgcn_readlane(sm, e);
#pragma unroll
            for (int j = 0; j < 4; ++j) { const u32x2 ww = *(const u32x2*)(YE + (size_t)rr * DM + 4 * (lane + 64 * j)); acc[j] += (f32x4){bflo(ww.x), bfhi(ww.x), bflo(ww.y), bfhi(ww.y)}; } }
        float* xr_ = xs_row_w(A, m);
#pragma unroll
        for (int j = 0; j < 4; ++j) { const int col = 4 * (lane + 64 * j); *(f32x4*)(xr_ + col) = x[j] + g[j] * acc[j]; }
    }
#undef CB_SLOT
}
__device__ __forceinline__ void l1_h_row(const float* xr, const float* gain, const float* sh, const float* sc, int lane, f32x4 (&h)[4]) {
    f32x4 v[4]; float ss = 0.f;
#pragma unroll
    for (int j = 0; j < 4; ++j) { v[j] = *(const f32x4*)(xr + 4 * (lane + 64 * j)); ss += (v[j].x * v[j].x + v[j].y * v[j].y) + (v[j].z * v[j].z + v[j].w * v[j].w); }
    const float rs = __builtin_amdgcn_rsqf(wave_sum(ss) * (1.f / DM) + 1e-6f);
#pragma unroll
    for (int j = 0; j < 4; ++j) { const int col = 4 * (lane + 64 * j); const f32x4 g = *(const f32x4*)(gain + col), a = *(const f32x4*)(sc + col), b = *(const f32x4*)(sh + col); h[j] = v[j] * rs * g * (a + 1.0f) + b; }
}
__device__ __forceinline__ void l1_h_from_raw(const f32x4 (&v)[4], const LAS float* gainl, const f32x4 (&shq)[4], const f32x4 (&scq)[4], int lane, f32x4 (&h)[4]) {
    float ss = 0.f;
#pragma unroll
    for (int j = 0; j < 4; ++j) ss += (v[j].x * v[j].x + v[j].y * v[j].y) + (v[j].z * v[j].z + v[j].w * v[j].w);
    const float rs = __builtin_amdgcn_rsqf(wave_sum(ss) * (1.f / DM) + 1e-6f);
#pragma unroll
    for (int j = 0; j < 4; ++j) { const f32x4 g = *(const LAS f32x4*)(gainl + 4 * (lane + 64 * j)); h[j] = v[j] * rs * g * (scq[j] + 1.0f) + shq[j]; }
}
__device__ __forceinline__ void p12_l1_prep(KAREF A, LAS unsigned char* lds, int G) {
    const int tid = threadIdx.x, lane = tid & 63, wave = tid >> 6, gw = blockIdx.x * 8 + wave, ngw = G * 8;
    bf16_t* XMIX = (bf16_t*)(A.ws + WS_ACT + A_XMIX);
    LAS float* mul = (LAS float*)lds; LAS float* gainl = mul + 6 * DM;
    for (int i = tid; i < 6 * DM; i += 512) mul[i] = A.in[I1_MU][i];
    for (int i = tid; i < DM; i += 512) gainl[i] = A.in[I1_NMIX][i];
    __syncthreads();
    const int m_lo = (int)(((long)gw * TT) / ngw), m_hi = (int)(((long)(gw + 1) * TT) / ngw);
    f32x4 hp[4], hc[4], hn[4], vn[4], shq[4], scq[4]; bool have = false; int rcur = -1;
#define L1_RAW(DST, M) do { const float* p_ = xs_row(A, (M) < TT ? (M) : TT - 1); _Pragma("unroll") for (int j = 0; j < 4; ++j) DST[j] = *(const f32x4*)(p_ + 4 * (lane + 64 * j)); } while (0)
    if (m_lo < m_hi) L1_RAW(vn, m_lo + 1);
    for (int m = m_lo; m < m_hi; ++m) {
        const int r = mod_row(m);
        if (r != rcur) { const float* sh = ada_ptr(A.ws, 1, r, 0); const float* sc = ada_ptr(A.ws, 1, r, 1); rcur = r;
#pragma unroll
            for (int j = 0; j < 4; ++j) { shq[j] = *(const f32x4*)(sh + 4 * (lane + 64 * j)); scq[j] = *(const f32x4*)(sc + 4 * (lane + 64 * j)); } }
        const int t = m < TL ? (m & 8191) : ((m - TL) & 255), Ls = m < TL ? SEQ : CTXL;
        f32x4 vnn[4]; L1_RAW(vnn, m + 2);
        if (!have || t == 0) {
            f32x4 vv[4]; L1_RAW(vv, m); l1_h_from_raw(vv, gainl, shq, scq, lane, hc);
            if (t > 0) { L1_RAW(vv, m - 1); l1_h_from_raw(vv, gainl, shq, scq, lane, hp); } else {
#pragma unroll
                for (int j = 0; j < 4; ++j) hp[j] = (f32x4){0.f, 0.f, 0.f, 0.f}; }
            have = true; }
        if (t < Ls - 1) l1_h_from_raw(vn, gainl, shq, scq, lane, hn); else {
#pragma unroll
            for (int j = 0; j < 4; ++j) hn[j] = (f32x4){0.f, 0.f, 0.f, 0.f}; }
#pragma unroll
        for (int j = 0; j < 4; ++j) { const int col = 4 * (lane + 64 * j); const f32x4 xx = (hp[j] + hn[j]) * 0.5f - hc[j];
#pragma unroll
            for (int q = 0; q < 6; ++q) { const f32x4 mq = *(const LAS f32x4*)(mul + q * DM + col); const f32x4 y = hc[j] + xx * mq;
                u32x2 w; w.x = cvt_pk_bf16(y.x, y.y); w.y = cvt_pk_bf16(y.z, y.w);
                *(u32x2*)(XMIX + (size_t)q * TT * DM + (size_t)m * DM + col) = w; }
            hp[j] = hc[j]; hc[j] = hn[j]; vn[j] = vnn[j]; }
    }
#undef L1_RAW
}

struct MixOrder {
    int G, c;
    __device__ bool next(int i, pg8::Unit& u) const {
        const long L = (long)i * G + c; if (L >= 132 * 15) return false;
        const int wgid = (int)L; const int grp = wgid / (8 * 15), w = wgid % (8 * 15), fm = grp * 8, gsz = (132 - fm) < 8 ? (132 - fm) : 8;
        u.pm = fm + w % gsz; u.pn = w / gsz;
        const int sel = u.pn < 4 ? 0 : u.pn < 8 ? 2 : u.pn < 12 ? 3 : u.pn == 12 ? 5 : u.pn == 13 ? 1 : 4;
        u.am = sel * 132 + u.pm; u.bn = u.pn; return true;
    }
    __device__ __forceinline__ void a_ready(const pg8::Unit&) const {}
    __device__ __forceinline__ void done(const pg8::Unit&) const {}
};
struct EpiMix {
    static constexpr bool PERM = true;
    bf16_t* RKV; bf16_t* LG; bf16_t* LWA;
    __device__ __forceinline__ void operator()(const f32x4 (&acc)[2][2][4][2], const pg8::Unit& u, int wr, int wc, int fr, int fq) const {
        const int row0 = u.pm * 256 + wr * 64 + fr, tile = u.pn;
#pragma unroll
        for (int ai = 0; ai < 2; ++ai)
#pragma unroll
            for (int m = 0; m < 4; ++m) { const int row = row0 + ai * 128 + m * 16;
#pragma unroll
                for (int bj = 0; bj < 2; ++bj) { const int colt = bj * 128 + wc * 32 + 8 * fq; f32x4 v0 = acc[ai][bj][m][0], v1 = acc[ai][bj][m][1];
                    if (tile == 12) {
#pragma unroll
                        for (int i = 0; i < 4; ++i) { v0[i] = sigm(v0[i]); v1[i] = sigm(v1[i]); } }
                    if (tile == 13) {
#pragma unroll
                        for (int i = 0; i < 4; ++i) { v0[i] = tanh_f(v0[i]); v1[i] = tanh_f(v1[i]); } }
                    u32x4 w; w.x = cvt_pk_bf16(v0[0], v0[1]); w.y = cvt_pk_bf16(v0[2], v0[3]); w.z = cvt_pk_bf16(v1[0], v1[1]); w.w = cvt_pk_bf16(v1[2], v1[3]);
                    if (tile < 12) *(u32x4*)(RKV + (size_t)(tile >> 2) * TT * DM + (size_t)row * DM + (tile & 3) * 256 + colt) = w;
                    else if (tile == 12) *(u32x4*)(LG + (size_t)row * 256 + colt) = w;
                    else if (bj == 0) *(u32x4*)(LWA + (size_t)row * 256 + (tile - 13) * 128 + colt) = w; } }
    }
};
struct LoraOrder {
    int G, c;
    __device__ bool next(int i, pg8::Unit& u) const {
        const long L = (long)i * G + c; if (L >= 132 * 20) return false;
        const int wgid = (int)L; const int grp = wgid / (8 * 20), w = wgid % (8 * 20), fm = grp * 8, gsz = (132 - fm) < 8 ? (132 - fm) : 8;
        u.pm = fm + w % gsz; u.pn = w / gsz; u.am = (u.pn < 16 ? 132 : 0) + u.pm; u.bn = u.pn; return true;
    }
    __device__ __forceinline__ void a_ready(const pg8::Unit&) const {}
    __device__ __forceinline__ void done(const pg8::Unit&) const {}
};
struct EpiLora {
    static constexpr bool PERM = true;
    bf16_t* SD; bf16_t* AD; bf16_t* Gg; const float* w0; const float* a0;
    __device__ __forceinline__ void operator()(const f32x4 (&acc)[2][2][4][2], const pg8::Unit& u, int wr, int wc, int fr, int fq) const {
        const int row0 = u.pm * 256 + wr * 64 + fr, tile = u.pn, kind = tile >> 2;
        bf16_t* dst = kind < 2 ? SD + (size_t)kind * TT * DM : kind < 4 ? AD + (size_t)(kind - 2) * TT * DM : Gg;
        const float* bias = kind < 2 ? w0 + kind * DM : a0 + (kind - 2) * DM;
#pragma unroll
        for (int ai = 0; ai < 2; ++ai)
#pragma unroll
            for (int m = 0; m < 4; ++m) { const int row = row0 + ai * 128 + m * 16;
#pragma unroll
                for (int bj = 0; bj < 2; ++bj) { const int col = (tile & 3) * 256 + bj * 128 + wc * 32 + 8 * fq;
                    f32x4 v0 = acc[ai][bj][m][0], v1 = acc[ai][bj][m][1];
                    if (kind < 4) { v0 += *(const f32x4*)(bias + col); v1 += *(const f32x4*)(bias + col + 4);
#pragma unroll
                        for (int i = 0; i < 4; ++i) { v0[i] = sigm(v0[i]); v1[i] = sigm(v1[i]); } }
                    u32x4 w; w.x = cvt_pk_bf16(v0[0], v0[1]); w.y = cvt_pk_bf16(v0[2], v0[3]); w.z = cvt_pk_bf16(v1[0], v1[1]); w.w = cvt_pk_bf16(v1[2], v1[3]);
                    *(u32x4*)(dst + (size_t)row * DM + col) = w; }
                asm volatile("" ::: "memory"); }
    }
};

#define MFMA16(a, b, c) __builtin_amdgcn_mfma_f32_16x16x32_bf16((a), (b), (c), 0, 0, 0)
__device__ __forceinline__ void p14_lora2(KAREF A, LAS unsigned char* lds, int G) {
    const int tid = threadIdx.x, lane = tid & 63, wave = __builtin_amdgcn_readfirstlane(tid >> 6), fr = lane & 15, fq = lane >> 4, mw = wave & 3, nw = wave >> 2;
    LAS bf16_t* stg = (LAS bf16_t*)(lds + wave * 9216);
    const bf16_t* LG = (const bf16_t*)(A.ws + WS_ACT + A_LG); const bf16_t* LWA = (const bf16_t*)(A.ws + WS_ACT + A_LWA); const bf16_t* B2 = (const bf16_t*)(A.ws + WS_B2);
    for (int u = blockIdx.x; u < (TT / 128) * 20; u += G) {
        const int rt = u / 20, rem = u - rt * 20, kind = rem >> 2, cb = rem & 3;
        const bf16_t* Ap = (kind < 4 ? LWA + 64 * kind : LG) + (size_t)(rt * 128 + mw * 32 + fr) * 256 + 8 * fq;
        const bf16_t* Bp = B2 + (size_t)(kind * 1024 + cb * 256 + nw * 128 + fr) * 256 + (kind < 4 ? 64 * kind : 0) + 8 * fq;
        const int nk = kind < 4 ? 2 : 5;
        f32x4 acc[2][8];
#pragma unroll
        for (int mt = 0; mt < 2; ++mt)
#pragma unroll
            for (int nt = 0; nt < 8; ++nt) acc[mt][nt] = (f32x4){0.f, 0.f, 0.f, 0.f};
#pragma unroll
        for (int ks = 0; ks < 5; ++ks) if (ks < nk) {
            const bf16x8 a0 = *(const bf16x8*)(Ap + ks * 32), a1 = *(const bf16x8*)(Ap + 16 * 256 + ks * 32);
#pragma unroll
            for (int nt = 0; nt < 8; ++nt) { const bf16x8 bb = *(const bf16x8*)(Bp + (size_t)nt * 16 * 256 + ks * 32); acc[0][nt] = MFMA16(a0, bb, acc[0][nt]); acc[1][nt] = MFMA16(a1, bb, acc[1][nt]); } }
        const float* bias = kind < 2 ? A.in[I1_W0] + kind * DM : A.in[I1_A0] + (kind - 2) * DM;
#pragma unroll
        for (int nt = 0; nt < 8; ++nt) { const int cl = nt * 16 + fr; const float bv = kind < 4 ? bias[cb * 256 + nw * 128 + cl] : 0.f;
#pragma unroll
            for (int mt = 0; mt < 2; ++mt)
#pragma unroll
                for (int r = 0; r < 4; ++r) { float v = acc[mt][nt][r] + bv; if (kind < 4) v = sigm(v); stg[(mt * 16 + 4 * fq + r) * 136 + cl] = (bf16_t)(cvt_pk_bf16_c(v, 0.f) & 0xffffu); } }
        LDS_WAIT();
        bf16_t* dst = (kind < 2 ? (bf16_t*)(A.ws + WS_ACT + A_SD) + (size_t)kind * TT * DM : kind < 4 ? (bf16_t*)(A.ws + WS_ACT + A_AD) + (size_t)(kind - 2) * TT * DM : (bf16_t*)(A.ws + WS_ACT + A_G))
                      + (size_t)(rt * 128 + mw * 32) * DM + cb * 256 + nw * 128;
#pragma unroll
        for (int i = 0; i < 8; ++i) { const int row = 4 * i + (lane >> 4), ch = lane & 15; *(u32x4*)(dst + (size_t)row * DM + 8 * ch) = *(const LAS u32x4*)(stg + row * 136 + 8 * ch); }
        LDS_WAIT();
    }
}

#define DPP_ADD(x, ctrl) ((x) + __builtin_bit_cast(float, __builtin_amdgcn_update_dpp(0, __builtin_bit_cast(int, (x)), (ctrl), 0xf, 0xf, true)))
constexpr int CH = 32, NCHUNK = (CTXL + SEQ) / CH;
__device__ __forceinline__ int wkv_row(int b, int d, int i) { return i < CTXL ? TL + b * CTXL + (d ? CTXL - 1 - i : i) : b * SEQ + (d ? SEQ - 1 - (i - CTXL) : (i - CTXL)); }
__device__ __forceinline__ void unpack8(const u32x4 w, float (&f)[8]) { f[0] = bflo(w.x); f[1] = bfhi(w.x); f[2] = bflo(w.y); f[3] = bfhi(w.y); f[4] = bflo(w.z); f[5] = bfhi(w.z); f[6] = bflo(w.w); f[7] = bfhi(w.w); }
__device__ __forceinline__ u32x4 pack8(const float (&f)[8]) { u32x4 w; w.x = cvt_pk_bf16_c(f[0], f[1]); w.y = cvt_pk_bf16_c(f[2], f[3]); w.z = cvt_pk_bf16_c(f[4], f[5]); w.w = cvt_pk_bf16_c(f[6], f[7]); return w; }
#define DPP_MOV(x, ctrl) __builtin_bit_cast(float, __builtin_amdgcn_update_dpp(0, __builtin_bit_cast(int, (x)), (ctrl), 0xf, 0xf, true))
__device__ __forceinline__ void wkv_decay(const float (&sd)[8], float (&base)[8], int lane, float (&e)[8], float (&em1)[8], float (&einv)[8]) {
    const int jl = lane & 7;
#pragma unroll
    for (int i = 0; i < 8; ++i) { const float lw = -0.6065306597126334f * sd[i]; float x = lw;
        { const float t = DPP_MOV(x, 0x111); if (jl >= 1) x += t; } { const float t = DPP_MOV(x, 0x112); if (jl >= 2) x += t; } { const float t = DPP_MOV(x, 0x114); if (jl >= 4) x += t; }
        const float cs = base[i] + x; e[i] = fexp(cs); em1[i] = fexp(cs - lw); einv[i] = __builtin_amdgcn_rcpf(e[i]);
        base[i] += __shfl(x, lane | 7); }
}
__device__ __forceinline__ float sum_groups(float x) {
    x += DPP_MOV(x, 0x128);
    { auto r = __builtin_amdgcn_permlane16_swap(__float_as_uint(x), __float_as_uint(x), false, false); x = __uint_as_float(r[0]) + __uint_as_float(r[1]); }
    { auto r = __builtin_amdgcn_permlane32_swap(__float_as_uint(x), __float_as_uint(x), false, false); x = __uint_as_float(r[0]) + __uint_as_float(r[1]); }
    return x;
}
__device__ __forceinline__ bf16x8 frag(const LAS bf16_t* M, int pitch, int row0, int k0, int lane) { return *(const LAS bf16x8*)(M + (row0 + (lane & 15)) * pitch + k0 + 8 * (lane >> 4)); }

constexpr size_t WS_TOTG = WS_ACT + 724 * MiB;
constexpr size_t WS_BON = 25 * MiB;
constexpr size_t A_TBUF = 330 * MiB;
__device__ __forceinline__ void p15_tbuild(KAREF A, LAS unsigned char* lds, int gw, int ngw, int cp_lo, int cp_hi) {
    const int tid = threadIdx.x, lane = tid & 63, wave = tid >> 6;
    LAS unsigned char* wl = lds + wave * 16384;
    LAS bf16_t* AH = (LAS bf16_t*)wl; LAS bf16_t* BH = (LAS bf16_t*)(wl + 4096); LAS float* LL = (LAS float*)(wl + 8192);
    const bf16_t* Rr = (const bf16_t*)(A.ws + WS_ACT + A_RKV); const bf16_t* Kk = Rr + (size_t)TT * DM; bf16_t* TB = (bf16_t*)(A.ws + WS_ACT + A_TBUF);
    const bf16_t* SDb = (const bf16_t*)(A.ws + WS_ACT + A_SD); const bf16_t* ADb = (const bf16_t*)(A.ws + WS_ACT + A_AD);
    const int jl = lane & 7, c8 = 8 * (lane >> 3), fr = lane & 15, fq = lane >> 4;
    static_assert(NCHUNK % 2 == 0, "pairs stay inside one chain");
    const int ncp = cp_hi - cp_lo, NQ = 128 * ncp;
#define TB_PAIR(q) (((q) / ncp) * (NCHUNK / 2) + cp_lo + (q) % ncp)
    u32x4 gk[4], gs[4], ga[4], gr[4];
#define TB_ROWLOAD(q, TASK) do { const int tk_ = (TASK); const int ch_ = tk_ / NCHUNK, cu_ = tk_ - ch_ * NCHUNK, d_ = ch_ & 1; \
        const size_t ro_ = (size_t)wkv_row(ch_ >> 5, d_, cu_ * CH + 8 * (q) + jl) * DM + ((ch_ >> 1) & 15) * 64 + c8, do_ = (size_t)d_ * TT * DM; \
        gk[q] = *(const u32x4*)(Kk + ro_); gs[q] = *(const u32x4*)(SDb + do_ + ro_); ga[q] = *(const u32x4*)(ADb + do_ + ro_); gr[q] = *(const u32x4*)(Rr + ro_); } while (0)
    if (gw < NQ) { const int p0 = TB_PAIR(gw); TB_ROWLOAD(0, 2 * p0); TB_ROWLOAD(1, 2 * p0); TB_ROWLOAD(2, 2 * p0); TB_ROWLOAD(3, 2 * p0); }
    for (int q = gw; q < NQ; q += ngw) {
        const int p = TB_PAIR(q); const int pn = (q + ngw < NQ) ? TB_PAIR(q + ngw) : p;
        const int chain = (2 * p) / NCHUNK, b = chain >> 5, h = (chain >> 1) & 15, d = chain & 1, hc = h * 64 + c8;
        float kkw[8]; { const f32x4 t0 = *(const f32x4*)(A.in[I1_KK] + hc), t1 = *(const f32x4*)(A.in[I1_KK] + hc + 4); kkw[0] = t0.x; kkw[1] = t0.y; kkw[2] = t0.z; kkw[3] = t0.w; kkw[4] = t1.x; kkw[5] = t1.y; kkw[6] = t1.z; kkw[7] = t1.w; }
        float kaw[8], rkw[8]; { const f32x4 t0 = *(const f32x4*)(A.in[I1_KA] + hc), t1 = *(const f32x4*)(A.in[I1_KA] + hc + 4), u0 = *(const f32x4*)(A.in[I1_RK] + hc), u1 = *(const f32x4*)(A.in[I1_RK] + hc + 4);
            kaw[0] = t0.x; kaw[1] = t0.y; kaw[2] = t0.z; kaw[3] = t0.w; kaw[4] = t1.x; kaw[5] = t1.y; kaw[6] = t1.z; kaw[7] = t1.w; rkw[0] = u0.x; rkw[1] = u0.y; rkw[2] = u0.z; rkw[3] = u0.w; rkw[4] = u1.x; rkw[5] = u1.y; rkw[6] = u1.z; rkw[7] = u1.w; }
#define TB_STEP(q, TASKN) do { float kf[8], sf[8], af[8], rf[8], e[8], em1[8], einv[8], ah[8], bh[8]; unpack8(gk[q], kf); unpack8(gs[q], sf); unpack8(ga[q], af); unpack8(gr[q], rf); \
            asm volatile("" : "+v"(sf[0]), "+v"(sf[1]), "+v"(sf[2]), "+v"(sf[3]), "+v"(sf[4]), "+v"(sf[5]), "+v"(sf[6]), "+v"(sf[7])); \
            asm volatile("" : "+v"(kf[0]), "+v"(kf[1]), "+v"(kf[2]), "+v"(kf[3]), "+v"(kf[4]), "+v"(kf[5]), "+v"(kf[6]), "+v"(kf[7])); \
            asm volatile("" : "+v"(af[0]), "+v"(af[1]), "+v"(af[2]), "+v"(af[3]), "+v"(af[4]), "+v"(af[5]), "+v"(af[6]), "+v"(af[7])); \
            asm volatile("" : "+v"(rf[0]), "+v"(rf[1]), "+v"(rf[2]), "+v"(rf[3]), "+v"(rf[4]), "+v"(rf[5]), "+v"(rf[6]), "+v"(rf[7])); \
            TB_ROWLOAD(q, TASKN);                                         \
            wkv_decay(sf, base, lane, e, em1, einv); \
            if (lat) { float bq = 0.f; \
_Pragma("unroll") \
                for (int i = 0; i < 8; ++i) bq += rf[i] * kf[i] * ((af[i] - 1.0f) * kaw[i] + 1.0f) * rkw[i]; \
                bq = sum_groups(bq); \
                if ((lane >> 3) == 0) ((float*)(A.ws + WS_BON))[((size_t)d * TL + wkv_row(b, d, chunk * CH + 8 * (q) + jl)) * 16 + h] = bq; } \
            float ssq = 0.f; \
_Pragma("unroll") \
            for (int i = 0; i < 8; ++i) { kf[i] *= kkw[i]; ssq += kf[i] * kf[i]; } \
            const float rs = __builtin_amdgcn_rsqf(fmaxf(sum_groups(ssq), 1e-24f)); \
_Pragma("unroll") \
            for (int i = 0; i < 8; ++i) { const float kk = kf[i] * rs; ah[i] = -kk * em1[i]; bh[i] = kk * af[i] * einv[i]; } \
            *(LAS u32x4*)(AH + (8 * (q) + jl) * 64 + c8) = pack8(ah); *(LAS u32x4*)(BH + (8 * (q) + jl) * 64 + c8) = pack8(bh); \
            if ((q) < 3 && jl == 0) { float* tg = (float*)(A.ws + WS_TOTG) + ((size_t)task * 3 + (q)) * 64 + c8; *(f32x4*)tg = (f32x4){base[0], base[1], base[2], base[3]}; *(f32x4*)(tg + 4) = (f32x4){base[4], base[5], base[6], base[7]}; } } while (0)
#define TB_TASK(HALF, TASKN) do { const int task = 2 * p + (HALF), chunk = task - chain * NCHUNK; const bool lat = chunk >= CTXL / CH; const int taskn = (TASKN); \
            float base[8]; \
_Pragma("unroll") \
            for (int i = 0; i < 8; ++i) base[i] = 0.f; \
            TB_STEP(0, taskn); TB_STEP(1, taskn); TB_STEP(2, taskn); TB_STEP(3, taskn); \
            LDS_WAIT(); \
            LAS float* LLh = LL + (HALF) * 1024; \
_Pragma("unroll") \
            for (int mt = 0; mt < 2; ++mt) \
_Pragma("unroll") \
                for (int nt = 0; nt < 2; ++nt) { f32x4 acc = (f32x4){0.f, 0.f, 0.f, 0.f}; \
_Pragma("unroll") \
                    for (int ks = 0; ks < 2; ++ks) acc = MFMA16(frag(AH, 64, mt * 16, ks * 32, lane), frag(BH, 64, nt * 16, ks * 32, lane), acc); \
_Pragma("unroll") \
                    for (int r = 0; r < 4; ++r) { const int j = mt * 16 + 4 * fq + r, m = nt * 16 + fr; LLh[j * 32 + m] = (m < j) ? acc[r] : 0.f; } } \
            LDS_WAIT(); } while (0)
        TB_TASK(0, 2 * p + 1);
        TB_TASK(1, 2 * pn);
#undef TB_TASK
#undef TB_STEP
        { const int c = lane & 31; const LAS float* Lm = LL + (lane >> 5) * 1024; float t[32];
#pragma unroll
          for (int i = 0; i < 32; ++i) { float s0 = (c == i) ? 1.f : 0.f, s1 = 0.f;
#pragma unroll
              for (int m4 = 0; m4 < (i + 3) / 4; ++m4) { const f32x4 l = *(const LAS f32x4*)(Lm + i * 32 + 4 * m4);
                  if (4 * m4 + 0 < i) s0 += l.x * t[4 * m4 + 0]; if (4 * m4 + 1 < i) s1 += l.y * t[4 * m4 + 1]; if (4 * m4 + 2 < i) s0 += l.z * t[4 * m4 + 2]; if (4 * m4 + 3 < i) s1 += l.w * t[4 * m4 + 3]; }
              t[i] = s0 + s1; }
          bf16_t* dst = TB + (size_t)(2 * p + (lane >> 5)) * 1024 + c;
#pragma unroll
          for (int i = 0; i < 32; ++i) dst[i * 32] = (bf16_t)(cvt_pk_bf16_c(t[i], 0.f) & 0xffffu); }
        LDS_WAIT();
    }
#undef TB_ROWLOAD
#undef TB_PAIR
}
constexpr int R3_AH = 0, R3_RH = 4608, R3_T = 9216, R3_PV = 11776, R3_BYTES = 12032;
constexpr int R2_BH = 0, R2_KH = 4608, R2_VH = 9216, R2_BT = 13824, R2_KT = 18944, R2_VT = 24064, R2_LAK = 29184, R2_MRB = 31744, R2_MRK = 34304, R2_BYTES = 36864;
constexpr int R3_OFF = 0, R2_OFF = 3 * R3_BYTES, CHN_OFF = R2_OFF + 2 * R2_BYTES, CHN_BYTES = 4864, YS_OFF = RING_BYTES + 2048, YS_BYTES = 4608;
static_assert(CHN_OFF + 4 * CHN_BYTES <= RING_BYTES && YS_OFF + 2 * YS_BYTES <= LDS_BYTES, "chain LDS map");
constexpr int TB_CP_FIRST = 96;
constexpr int CHAIN_MID_IT = 2 * TB_CP_FIRST - 4;
__device__ __forceinline__ void p16_chain(KAREF A, LAS unsigned char* lds, int G, int variant, unsigned* handoff, const unsigned nhelp) {
    if (variant & 8) return;
    const int nch = (variant & 16) ? 16 : NCHUNK;
    const bool do_prep = !(variant & 2), do_state = !(variant & 1), do_store = (variant == 0);
    const int tid = threadIdx.x, lane = tid & 63, wave = __builtin_amdgcn_readfirstlane(tid >> 6), fr = lane & 15, fq = lane >> 4;
    const bf16_t* R = (const bf16_t*)(A.ws + WS_ACT + A_RKV); const bf16_t* Kk = R + (size_t)TT * DM; const bf16_t* V = Kk + (size_t)TT * DM; const bf16_t* TB = (const bf16_t*)(A.ws + WS_ACT + A_TBUF);
#define R3P(c) (lds + R3_OFF + ((c) % 3) * R3_BYTES)
#define R2P(c) (lds + R2_OFF + ((c) & 1) * R2_BYTES)
    for (int chain = blockIdx.x; chain < 128; chain += G) {
        const int b = chain >> 5, h = (chain >> 1) & 15, d = chain & 1;
        const bf16_t* SD = (const bf16_t*)(A.ws + WS_ACT + A_SD) + (size_t)d * TT * DM; const bf16_t* AD = (const bf16_t*)(A.ws + WS_ACT + A_AD) + (size_t)d * TT * DM;
        bf16_t* YD = (bf16_t*)(A.ws + WS_ACT + (d ? A_YD1 : A_YD0));
        __syncthreads();
        if (wave >= 4) {
            const int pw = wave - 4, jl = lane & 7, c8 = 8 * (lane >> 3), hc = h * 64 + c8, ptid = pw * 64 + lane;
            float kkw[8], kaw[8];
            { const f32x4 t0 = *(const f32x4*)(A.in[I1_KK] + hc), t1 = *(const f32x4*)(A.in[I1_KK] + hc + 4), u0 = *(const f32x4*)(A.in[I1_KA] + hc), u1 = *(const f32x4*)(A.in[I1_KA] + hc + 4);
              kkw[0] = t0.x; kkw[1] = t0.y; kkw[2] = t0.z; kkw[3] = t0.w; kkw[4] = t1.x; kkw[5] = t1.y; kkw[6] = t1.z; kkw[7] = t1.w; kaw[0] = u0.x; kaw[1] = u0.y; kaw[2] = u0.z; kaw[3] = u0.w; kaw[4] = u1.x; kaw[5] = u1.y; kaw[6] = u1.z; kaw[7] = u1.w; }
            struct PrepRegs { u32x4 gr, gk, gv, gs, ga; f32x4 gb0, gb1; u32x2 gt; } SA, SB;
#define PREP_LOAD(S, cn) do { const size_t ro = (size_t)wkv_row(b, d, (cn) * CH + 8 * pw + jl) * DM + hc; S.gr = *(const u32x4*)(R + ro); S.gk = *(const u32x4*)(Kk + ro); S.gv = *(const u32x4*)(V + ro); S.gs = *(const u32x4*)(SD + ro); S.ga = *(const u32x4*)(AD + ro); \
            { const float* tg = (const float*)(A.ws + WS_TOTG) + (((size_t)chain * NCHUNK + (cn)) * 3 + (pw > 0 ? pw - 1 : 0)) * 64 + c8; S.gb0 = *(const f32x4*)tg; S.gb1 = *(const f32x4*)(tg + 4); } \
            S.gt = *(const u32x2*)(TB + ((size_t)chain * NCHUNK + (cn)) * 1024 + 4 * ptid); } while (0)
            PREP_LOAD(SA, 0); PREP_LOAD(SB, 1);
#define PREP_ITER(IT, S) do { const int it = (IT); const int c1 = it + 1, c2 = it + 2; \
                if (it == CHAIN_MID_IT && nhelp) { if (lane == 0) { unsigned sp_ = 0; while (xb_ld(handoff) < nhelp) { __builtin_amdgcn_s_sleep(2); if (++sp_ > (1u << 22)) break; } } __builtin_amdgcn_fence(__ATOMIC_ACQUIRE, "agent"); } \
                if (c1 >= 0 && c1 < NCHUNK && do_prep) {                        \
                    LAS unsigned char* o3 = R3P(c1); LAS unsigned char* o2 = R2P(c1); \
                    const LAS bf16_t* AH = (const LAS bf16_t*)(o3 + R3_AH); const LAS bf16_t* RH = (const LAS bf16_t*)(o3 + R3_RH); const LAS bf16_t* BH = (const LAS bf16_t*)(o2 + R2_BH); const LAS bf16_t* KH = (const LAS bf16_t*)(o2 + R2_KH); \
                    const int mt = pw >> 1, nt = pw & 1; \
                    f32x4 a0 = (f32x4){0.f, 0.f, 0.f, 0.f}, a1 = a0, a2 = a0; \
_Pragma("unroll") \
                    for (int ks = 0; ks < 2; ++ks) { const bf16x8 fa = frag(AH, 72, mt * 16, ks * 32, lane), fr_ = frag(RH, 72, mt * 16, ks * 32, lane), fb = frag(BH, 72, nt * 16, ks * 32, lane), fk = frag(KH, 72, nt * 16, ks * 32, lane); \
                        a0 = MFMA16(fa, fk, a0); a1 = MFMA16(fr_, fb, a1); a2 = MFMA16(fr_, fk, a2); } \
_Pragma("unroll") \
                    for (int r = 0; r < 4; ++r) { const int j = mt * 16 + 4 * fq + r, m = nt * 16 + fr; \
                        ((LAS bf16_t*)(o2 + R2_LAK))[j * 40 + m] = (bf16_t)(cvt_pk_bf16_c((m < j) ? a0[r] : 0.f, 0.f) & 0xffffu); \
                        ((LAS bf16_t*)(o2 + R2_MRB))[j * 40 + m] = (bf16_t)(cvt_pk_bf16_c((m <= j) ? a1[r] : 0.f, 0.f) & 0xffffu); \
                        ((LAS bf16_t*)(o2 + R2_MRK))[j * 40 + m] = (bf16_t)(cvt_pk_bf16_c((m <= j) ? a2[r] : 0.f, 0.f) & 0xffffu); } \
                } \
                if (c2 < NCHUNK && do_prep) {                                   \
                    LAS unsigned char* o3 = R3P(c2); LAS unsigned char* o2 = R2P(c2); \
                    float rf[8], kf[8], sf[8], af[8], base[8], e[8], em1[8], einv[8], o1[8], o2v[8]; \
_Pragma("unroll") \
                    for (int i = 0; i < 8; ++i) base[i] = 0.f; \
                    if (pw > 0) { base[0] = S.gb0.x; base[1] = S.gb0.y; base[2] = S.gb0.z; base[3] = S.gb0.w; base[4] = S.gb1.x; base[5] = S.gb1.y; base[6] = S.gb1.z; base[7] = S.gb1.w; } \
                    unpack8(S.gs, sf); unpack8(S.gk, kf); unpack8(S.ga, af); unpack8(S.gr, rf); \
                    *(LAS u32x4*)((LAS bf16_t*)(o2 + R2_VH) + (8 * pw + jl) * 72 + c8) = S.gv; \
                    *(LAS u32x2*)((LAS bf16_t*)(o3 + R3_T) + (ptid >> 3) * 40 + 4 * (ptid & 7)) = S.gt; \
                    asm volatile("" : "+v"(sf[0]), "+v"(sf[1]), "+v"(sf[2]), "+v"(sf[3]), "+v"(sf[4]), "+v"(sf[5]), "+v"(sf[6]), "+v"(sf[7])); \
                    asm volatile("" : "+v"(kf[0]), "+v"(kf[1]), "+v"(kf[2]), "+v"(kf[3]), "+v"(kf[4]), "+v"(kf[5]), "+v"(kf[6]), "+v"(kf[7])); \
                    asm volatile("" : "+v"(af[0]), "+v"(af[1]), "+v"(af[2]), "+v"(af[3]), "+v"(af[4]), "+v"(af[5]), "+v"(af[6]), "+v"(af[7])); \
                    asm volatile("" : "+v"(rf[0]), "+v"(rf[1]), "+v"(rf[2]), "+v"(rf[3]), "+v"(rf[4]), "+v"(rf[5]), "+v"(rf[6]), "+v"(rf[7])); \
                    PREP_LOAD(S, (c2 + 2 < NCHUNK ? c2 + 2 : NCHUNK - 1)); \
                    wkv_decay(sf, base, lane, e, em1, einv); \
                    float ssq = 0.f; \
_Pragma("unroll") \
                    for (int i = 0; i < 8; ++i) { const float kv = kf[i] * kkw[i]; ssq += kv * kv; } \
                    const float rs = __builtin_amdgcn_rsqf(fmaxf(sum_groups(ssq), 1e-24f)); const int j = 8 * pw + jl; \
_Pragma("unroll") \
                    for (int i = 0; i < 8; ++i) { const float kk = kf[i] * kkw[i] * rs; o1[i] = -kk * em1[i]; o2v[i] = kk * af[i] * einv[i]; } \
                    *(LAS u32x4*)((LAS bf16_t*)(o3 + R3_AH) + j * 72 + c8) = pack8(o1); *(LAS u32x4*)((LAS bf16_t*)(o2 + R2_BH) + j * 72 + c8) = pack8(o2v); \
_Pragma("unroll") \
                    for (int i = 0; i < 8; ++i) { o1[i] = kf[i] * ((af[i] - 1.0f) * kaw[i] + 1.0f) * einv[i]; o2v[i] = rf[i] * e[i]; } \
                    *(LAS u32x4*)((LAS bf16_t*)(o2 + R2_KH) + j * 72 + c8) = pack8(o1); *(LAS u32x4*)((LAS bf16_t*)(o3 + R3_RH) + j * 72 + c8) = pack8(o2v); \
                    if (j == 31) { *(LAS f32x4*)((LAS float*)(o3 + R3_PV) + c8) = (f32x4){e[0], e[1], e[2], e[3]}; *(LAS f32x4*)((LAS float*)(o3 + R3_PV) + c8 + 4) = (f32x4){e[4], e[5], e[6], e[7]}; } \
                } \
                LDS_WAIT(); __builtin_amdgcn_s_barrier(); asm volatile("" ::: "memory"); \
            } while (0)
            {
#pragma unroll 1
              for (int it2 = -2; it2 + 1 < nch; it2 += 2) { PREP_ITER(it2, SA); PREP_ITER(it2 + 1, SB); } }
#undef PREP_ITER
#undef PREP_LOAD
        } else {
            LAS bf16_t* XT = (LAS bf16_t*)(lds + CHN_OFF + wave * CHN_BYTES); LAS bf16_t* ZT = XT + 16 * 72; LAS bf16_t* UT = ZT + 16 * 40;
#define Y_FLUSH(chunk) do { if ((chunk) >= CTXL / CH && do_store) { const LAS bf16_t* YSf = (const LAS bf16_t*)(lds + YS_OFF + ((chunk) & 1) * YS_BYTES); const int st = wave * 64 + lane, row = st >> 3, cch = st & 7; const u32x4 yv = *(const LAS u32x4*)(YSf + row * 72 + 8 * cch); \
                *(u32x4*)(YD + (size_t)wkv_row(b, d, (chunk) * CH + row) * DM + h * 64 + 8 * cch) = yv; } } while (0)
            f32x4 X[4];
#pragma unroll
            for (int mt = 0; mt < 4; ++mt) X[mt] = (f32x4){0.f, 0.f, 0.f, 0.f};
#pragma unroll 1
            for (int it = -2; it < nch; ++it) {
                if (it >= 1) Y_FLUSH(it - 1);
                if (it >= 0 && do_state) {
                    const LAS unsigned char* o3 = R3P(it); const LAS unsigned char* o2 = R2P(it); LAS bf16_t* YS = (LAS bf16_t*)(lds + YS_OFF + (it & 1) * YS_BYTES);
                    const LAS bf16_t* AH = (const LAS bf16_t*)(o3 + R3_AH); const LAS bf16_t* LAK = (const LAS bf16_t*)(o2 + R2_LAK); const LAS bf16_t* TT_ = (const LAS bf16_t*)(o3 + R3_T); const LAS bf16_t* VT = (const LAS bf16_t*)(o2 + R2_VT);
                    const LAS bf16_t* RH = (const LAS bf16_t*)(o3 + R3_RH); const LAS bf16_t* MRB = (const LAS bf16_t*)(o2 + R2_MRB); const LAS bf16_t* MRK = (const LAS bf16_t*)(o2 + R2_MRK);
                    const LAS bf16_t* BT = (const LAS bf16_t*)(o2 + R2_BT); const LAS bf16_t* KT = (const LAS bf16_t*)(o2 + R2_KT); const LAS float* PV = (const LAS float*)(o3 + R3_PV);
#pragma unroll
                    for (int mt = 0; mt < 4; ++mt) { u32x2 w; w.x = cvt_pk_bf16_c(X[mt][0], X[mt][1]); w.y = cvt_pk_bf16_c(X[mt][2], X[mt][3]); *(LAS u32x2*)(XT + fr * 72 + mt * 16 + 4 * fq) = w; }
                    LDS_WAIT();
                    const bf16x8 x0 = frag(XT, 72, 0, 0, lane), x1 = frag(XT, 72, 0, 32, lane), vt = frag(VT, 40, 16 * wave, 0, lane);
                    f32x4 Z0 = (f32x4){0.f, 0.f, 0.f, 0.f}, Z1 = Z0;
                    Z0 = MFMA16(frag(AH, 72, 0, 0, lane), x0, Z0); Z0 = MFMA16(frag(AH, 72, 0, 32, lane), x1, Z0); Z0 = MFMA16(frag(LAK, 40, 0, 0, lane), vt, Z0);
                    Z1 = MFMA16(frag(AH, 72, 16, 0, lane), x0, Z1); Z1 = MFMA16(frag(AH, 72, 16, 32, lane), x1, Z1); Z1 = MFMA16(frag(LAK, 40, 16, 0, lane), vt, Z1);
                    { u32x2 w; w.x = cvt_pk_bf16_c(Z0[0], Z0[1]); w.y = cvt_pk_bf16_c(Z0[2], Z0[3]); *(LAS u32x2*)(ZT + fr * 40 + 4 * fq) = w; w.x = cvt_pk_bf16_c(Z1[0], Z1[1]); w.y = cvt_pk_bf16_c(Z1[2], Z1[3]); *(LAS u32x2*)(ZT + fr * 40 + 16 + 4 * fq) = w; }
                    LDS_WAIT();
                    const bf16x8 zt = frag(ZT, 40, 0, 0, lane);
                    const f32x4 zero4 = (f32x4){0.f, 0.f, 0.f, 0.f}; const f32x4 U0 = MFMA16(frag(TT_, 40, 0, 0, lane), zt, zero4), U1 = MFMA16(frag(TT_, 40, 16, 0, lane), zt, zero4);
                    { u32x2 w; w.x = cvt_pk_bf16_c(U0[0], U0[1]); w.y = cvt_pk_bf16_c(U0[2], U0[3]); *(LAS u32x2*)(UT + fr * 40 + 4 * fq) = w; w.x = cvt_pk_bf16_c(U1[0], U1[1]); w.y = cvt_pk_bf16_c(U1[2], U1[3]); *(LAS u32x2*)(UT + fr * 40 + 16 + 4 * fq) = w; }
                    LDS_WAIT();
                    const bf16x8 ut = frag(UT, 40, 0, 0, lane);
                    if (it >= CTXL / CH && do_store) {
#pragma unroll
                        for (int mt = 0; mt < 2; ++mt) { f32x4 Y = (f32x4){0.f, 0.f, 0.f, 0.f};
                            Y = MFMA16(frag(RH, 72, mt * 16, 0, lane), x0, Y); Y = MFMA16(frag(RH, 72, mt * 16, 32, lane), x1, Y); Y = MFMA16(frag(MRB, 40, mt * 16, 0, lane), ut, Y); Y = MFMA16(frag(MRK, 40, mt * 16, 0, lane), vt, Y);
#pragma unroll
                            for (int r = 0; r < 4; ++r) YS[(mt * 16 + 4 * fq + r) * 72 + 16 * wave + fr] = (bf16_t)(cvt_pk_bf16_c(Y[r], 0.f) & 0xffffu); } }
#pragma unroll
                    for (int mt = 0; mt < 4; ++mt) { X[mt] = MFMA16(frag(BT, 40, mt * 16, 0, lane), ut, X[mt]); X[mt] = MFMA16(frag(KT, 40, mt * 16, 0, lane), vt, X[mt]);
                        const f32x4 p = *(const LAS f32x4*)(PV + mt * 16 + 4 * fq); X[mt] = X[mt] * p; }
                }
                if (it + 1 >= 0 && it + 1 < NCHUNK) {
                    LAS unsigned char* opn = R2P(it + 1);
                    const LAS bf16_t* BHn = (const LAS bf16_t*)(opn + R2_BH); const LAS bf16_t* KHn = (const LAS bf16_t*)(opn + R2_KH); const LAS bf16_t* VHn = (const LAS bf16_t*)(opn + R2_VH);
                    u32x4 tb, tk, tv; unsigned short eb[8], ek[8], ev[8];
#pragma unroll
                    for (int i = 0; i < 8; ++i) { eb[i] = BHn[(8 * wave + i) * 72 + lane]; ek[i] = KHn[(8 * wave + i) * 72 + lane]; ev[i] = VHn[(8 * wave + i) * 72 + lane]; }
                    tb.x = eb[0] | ((unsigned)eb[1] << 16); tb.y = eb[2] | ((unsigned)eb[3] << 16); tb.z = eb[4] | ((unsigned)eb[5] << 16); tb.w = eb[6] | ((unsigned)eb[7] << 16);
                    tk.x = ek[0] | ((unsigned)ek[1] << 16); tk.y = ek[2] | ((unsigned)ek[3] << 16); tk.z = ek[4] | ((unsigned)ek[5] << 16); tk.w = ek[6] | ((unsigned)ek[7] << 16);
                    tv.x = ev[0] | ((unsigned)ev[1] << 16); tv.y = ev[2] | ((unsigned)ev[3] << 16); tv.z = ev[4] | ((unsigned)ev[5] << 16); tv.w = ev[6] | ((unsigned)ev[7] << 16);
                    *(LAS u32x4*)((LAS bf16_t*)(opn + R2_BT) + lane * 40 + 8 * wave) = tb; *(LAS u32x4*)((LAS bf16_t*)(opn + R2_KT) + lane * 40 + 8 * wave) = tk; *(LAS u32x4*)((LAS bf16_t*)(opn + R2_VT) + lane * 40 + 8 * wave) = tv; }
                LDS_WAIT(); __builtin_amdgcn_s_barrier(); asm volatile("" ::: "memory");
            }
            Y_FLUSH(NCHUNK - 1);
#undef Y_FLUSH
        }
    }
#undef R3P
#undef R2P
}

__device__ __forceinline__ void p16_readout(KAREF A, int G) {
    const int lane = threadIdx.x & 63, wave = threadIdx.x >> 6, gw = blockIdx.x * 8 + wave, ngw = G * 8;
    const bf16_t* V = (const bf16_t*)(A.ws + WS_ACT + A_RKV) + 2 * (size_t)TT * DM; const bf16_t* Gg = (const bf16_t*)(A.ws + WS_ACT + A_G);
    const bf16_t* Y0 = (const bf16_t*)(A.ws + WS_ACT + A_YD0); const bf16_t* Y1 = (const bf16_t*)(A.ws + WS_ACT + A_YD1); bf16_t* O = (bf16_t*)(A.ws + WS_ACT + A_O);
    const float* BON = (const float*)(A.ws + WS_BON);
    const int c0 = 16 * lane;
    float gng[16], gnb[16];
#pragma unroll
    for (int i = 0; i < 16; ++i) { gng[i] = A.in[I1_GNG][c0 + i]; gnb[i] = A.in[I1_GNB][c0 + i]; }
    u32x4 nq[8]; float nb0, nb1;
#define RO_LOAD(M) do { const size_t o_ = (size_t)(M) * DM + c0; nq[0] = *(const u32x4*)(Y0 + o_); nq[1] = *(const u32x4*)(Y0 + o_ + 8); nq[2] = *(const u32x4*)(Y1 + o_); nq[3] = *(const u32x4*)(Y1 + o_ + 8); \
        nq[4] = *(const u32x4*)(V + o_); nq[5] = *(const u32x4*)(V + o_ + 8); nq[6] = *(const u32x4*)(Gg + o_); nq[7] = *(const u32x4*)(Gg + o_ + 8); \
        nb0 = BON[(size_t)(M) * 16 + (lane >> 2)]; nb1 = BON[((size_t)TL + (M)) * 16 + (lane >> 2)]; } while (0)
    RO_LOAD(gw < TL ? gw : 0);
    for (int m = gw; m < TL; m += ngw) {
        const size_t o = (size_t)m * DM + c0;
        float y[16], rr[16], vv[16], gg[16];
#define UP16(dst, w0, w1) do { dst[0] = bflo(w0.x); dst[1] = bfhi(w0.x); dst[2] = bflo(w0.y); dst[3] = bfhi(w0.y); dst[4] = bflo(w0.z); dst[5] = bfhi(w0.z); dst[6] = bflo(w0.w); dst[7] = bfhi(w0.w); \
        dst[8] = bflo(w1.x); dst[9] = bfhi(w1.x); dst[10] = bflo(w1.y); dst[11] = bfhi(w1.y); dst[12] = bflo(w1.z); dst[13] = bfhi(w1.z); dst[14] = bflo(w1.w); dst[15] = bfhi(w1.w); } while (0)
        UP16(y, nq[0], nq[1]); UP16(rr, nq[2], nq[3]); UP16(vv, nq[4], nq[5]); UP16(gg, nq[6], nq[7]);
#undef UP16
        const float bs = nb0 + nb1;
        { const int mn = m + ngw < TL ? m + ngw : m; RO_LOAD(mn); }
        float s = 0.f;
#pragma unroll
        for (int i = 0; i < 16; ++i) { y[i] += rr[i]; s += y[i]; }
        s += __shfl_xor(s, 1); s += __shfl_xor(s, 2);
        const float mean = s * (1.f / 64.f); float q = 0.f;
#pragma unroll
        for (int i = 0; i < 16; ++i) { const float dlt = y[i] - mean; q += dlt * dlt; }
        q += __shfl_xor(q, 1); q += __shfl_xor(q, 2);
        const float rstd = __builtin_amdgcn_rsqf(q * (1.f / 64.f) + 64e-5f);
        unsigned w[8];
#pragma unroll
        for (int i = 0; i < 8; ++i) { const float o0 = ((y[2 * i] - mean) * rstd * gng[2 * i] + gnb[2 * i] + bs * vv[2 * i]) * gg[2 * i], o1 = ((y[2 * i + 1] - mean) * rstd * gng[2 * i + 1] + gnb[2 * i + 1] + bs * vv[2 * i + 1]) * gg[2 * i + 1];
            w[i] = cvt_pk_bf16(o0, o1); }
        *(u32x4*)(O + o) = (u32x4){w[0], w[1], w[2], w[3]}; *(u32x4*)(O + o + 8) = (u32x4){w[4], w[5], w[6], w[7]};
    }
#undef RO_LOAD
}
#if defined(DBG_WKV)
__device__ __forceinline__ float rowsum16(float x) { x = DPP_ADD(x, 0xB1); x = DPP_ADD(x, 0x4E); x = DPP_ADD(x, 0x141); x = DPP_ADD(x, 0x140); return x; }
constexpr int WKV_TB = 32, WKV_STEP_F = 6 * 64, WKV_BUF_F = WKV_TB * WKV_STEP_F;
__device__ __forceinline__ void p15_wkv_old(KAREF A, LAS unsigned char* lds, int G) {
    const int tid = threadIdx.x, lane = tid & 63, wid = tid >> 6;
    LAS float* BUF = (LAS float*)lds;
    LAS float* YB = (LAS float*)(lds + 2 * WKV_BUF_F * 4);
    const bf16_t* R = (const bf16_t*)(A.ws + WS_ACT + A_RKV); const bf16_t* Kk = R + (size_t)TT * DM; const bf16_t* V = Kk + (size_t)TT * DM;
    for (int u = blockIdx.x; u < 256; u += G) {
        const int chain = u >> 1, half = u & 1, b = chain >> 5, h = (chain >> 1) & 15, d = chain & 1;
        const bf16_t* SD = (const bf16_t*)(A.ws + WS_ACT + A_SD) + (size_t)d * TT * DM; const bf16_t* AD = (const bf16_t*)(A.ws + WS_ACT + A_AD) + (size_t)d * TT * DM;
        bf16_t* YD = (bf16_t*)(A.ws + WS_MOEW1) + (size_t)d * TL * DM;
        const int ls = tid >> 4, lc = 4 * (tid & 15), hc = h * 64 + lc;
        const f32x4 kkw = *(const f32x4*)(A.in[I1_KK] + hc), kaw = *(const f32x4*)(A.in[I1_KA] + hc);
        u32x2 gr, gk, gv, gs, ga;
#define WKV_LOAD(blk) do { const size_t ro = (size_t)wkv_row(b, d, (blk) * WKV_TB + ls) * DM + hc; gr = *(const u32x2*)(R + ro); gk = *(const u32x2*)(Kk + ro); gv = *(const u32x2*)(V + ro); gs = *(const u32x2*)(SD + ro); ga = *(const u32x2*)(AD + ro); } while (0)
#define WKV_STORE(bufi) do { LAS float* dst = BUF + (bufi) * WKV_BUF_F + ls * WKV_STEP_F + lc; \
        const f32x4 kf = (f32x4){bflo(gk.x), bfhi(gk.x), bflo(gk.y), bfhi(gk.y)}, af = (f32x4){bflo(ga.x), bfhi(ga.x), bflo(ga.y), bfhi(ga.y)}, sf = (f32x4){bflo(gs.x), bfhi(gs.x), bflo(gs.y), bfhi(gs.y)}; \
        const f32x4 kkv = kf * kkw; float ssq = (kkv.x * kkv.x + kkv.y * kkv.y) + (kkv.z * kkv.z + kkv.w * kkv.w); ssq = rowsum16(ssq); \
        const f32x4 kkn = kkv * __builtin_amdgcn_rsqf(fmaxf(ssq, 1e-24f)); \
        f32x4 wd; wd.x = fexp(-0.6065306597126334f * sf.x); wd.y = fexp(-0.6065306597126334f * sf.y); wd.z = fexp(-0.6065306597126334f * sf.z); wd.w = fexp(-0.6065306597126334f * sf.w); \
        *(LAS f32x4*)(dst) = wd; *(LAS f32x4*)(dst + 64) = -kkn; *(LAS f32x4*)(dst + 128) = kkn * af; *(LAS f32x4*)(dst + 192) = kf * ((af - 1.0f) * kaw + 1.0f); \
        *(LAS f32x4*)(dst + 256) = (f32x4){bflo(gr.x), bfhi(gr.x), bflo(gr.y), bfhi(gr.y)}; *(LAS f32x4*)(dst + 320) = (f32x4){bflo(gv.x), bfhi(gv.x), bflo(gv.y), bfhi(gv.y)}; } while (0)
        __syncthreads();
        WKV_LOAD(0); WKV_STORE(0);
        __syncthreads();
        const int g = lane >> 4, j = lane & 15, vrow = 32 * half + 4 * wid + g;
        float S0 = 0.f, S1 = 0.f, S2 = 0.f, S3 = 0.f;
        constexpr int NBLK = (CTXL + SEQ) / WKV_TB;
#pragma unroll 1
        for (int blk = 0; blk < NBLK; ++blk) {
            const int cur = blk & 1;
            if (blk + 1 < NBLK) WKV_LOAD(blk + 1);
            const LAS float* bp = BUF + cur * WKV_BUF_F + 4 * j;
#pragma unroll 1
            for (int t8 = 0; t8 < WKV_TB; t8 += 8) {
                float yv[8];
#pragma unroll
                for (int tt = 0; tt < 8; ++tt) {
                    const LAS float* sp = bp + (t8 + tt) * WKV_STEP_F;
                    const f32x4 w4 = *(const LAS f32x4*)(sp), a4 = *(const LAS f32x4*)(sp + 64), b4 = *(const LAS f32x4*)(sp + 128), k4 = *(const LAS f32x4*)(sp + 192), r4 = *(const LAS f32x4*)(sp + 256);
                    const float v1 = BUF[cur * WKV_BUF_F + (t8 + tt) * WKV_STEP_F + 320 + vrow];
                    float sa = (S0 * a4.x + S1 * a4.y) + (S2 * a4.z + S3 * a4.w);
                    const float t0 = S0 * w4.x + v1 * k4.x, t1 = S1 * w4.y + v1 * k4.y, t2 = S2 * w4.z + v1 * k4.z, t3 = S3 * w4.w + v1 * k4.w;
                    sa = rowsum16(sa);
                    S0 = sa * b4.x + t0; S1 = sa * b4.y + t1; S2 = sa * b4.z + t2; S3 = sa * b4.w + t3;
                    yv[tt] = (S0 * r4.x + S1 * r4.y) + (S2 * r4.z + S3 * r4.w);
                }
#pragma unroll
                for (int tt = 0; tt < 8; ++tt) { const float y = rowsum16(yv[tt]); if (j == 0) YB[(t8 + tt) * 32 + 4 * wid + g] = y; }
            }
            __syncthreads();
            if (blk * WKV_TB >= CTXL) {
                const int m = wkv_row(b, d, blk * WKV_TB + ls); const int r2 = 2 * (tid & 15);
                *(unsigned*)(YD + (size_t)m * DM + h * 64 + 32 * half + r2) = cvt_pk_bf16(YB[ls * 32 + r2], YB[ls * 32 + r2 + 1]); }
            if (blk + 1 < NBLK) WKV_STORE(cur ^ 1);
            __syncthreads();
        }
#undef WKV_LOAD
#undef WKV_STORE
    }
}

#endif
constexpr int N_PHASES = 25;
__global__ void __launch_bounds__(512, 2) fwd_kernel(KArgs A_unused) {
    const __attribute__((address_space(4))) KArgs* kp = (const __attribute__((address_space(4))) KArgs*)__builtin_amdgcn_kernarg_segment_ptr();
    extern __shared__ __attribute__((aligned(16))) unsigned char lds_raw[];
    LAS unsigned char* lds = (LAS unsigned char*)lds_raw;
    const int G = gridDim.x, tid = threadIdx.x;
    for (int u = tid; u < (LDS_BYTES - LDSCTL_OFF) / 4; u += 512) ((LAS unsigned*)(lds + LDSCTL_OFF))[u] = 0u;
    __syncthreads();
    const int lo = kp->ph_lo, hi = kp->ph_hi;
    const bool use_bar = (hi - lo) > 1;
    XcdBarrier bar; bar.bar = (unsigned*)(kp->ws + WS_CTL) + 4096; bar.x = 0; bar.st = (volatile LAS unsigned*)(lds + MISC_OFF) + 8;
    if (use_bar) bar = xcd_barrier_post((unsigned*)(kp->ws + WS_CTL) + 4096, (volatile LAS unsigned*)(lds + MISC_OFF) + 8);
#ifndef ONLY_PHASE
#define ONLY_PHASE -1
#endif
#ifndef DBG_STOP
#define DBG_STOP 99
#endif
#define IN(k) ((ONLY_PHASE < 0 || ONLY_PHASE == (k)) && (k) < DBG_STOP && lo <= (k) && (k) < hi)
#ifndef DBG_REP
#define DBG_REP -1
#endif
#ifndef DBG_VAR
#define DBG_VAR 0
#endif
#ifndef DBG_REPN
#define DBG_REPN 2
#endif
#define REPEAT(k) for (int rep_ = 0; rep_ < ((k) == DBG_REP ? DBG_REPN : 1); ++rep_)
#if defined(DBG_TIME)
#define TSTAMP(k) do { if (blockIdx.x == 0 && tid == 0 && ((k) == DBG_TIME || (k) == DBG_TIME + 1)) ((unsigned long long*)(kp->ws + WS_CTL))[1100 + ((k) - DBG_TIME)] = wall_clock64(); } while (0)
#else
#define TSTAMP(k) do {} while (0)
#endif
#define SEAM(k) do { if (IN(k) && IN((k) + 1)) xcd_barrier(bar); } while (0)

    if (IN(0)) REPEAT(0) { TSTAMP(0); __syncthreads(); KAREF A = *ka_launder(kp); unsigned char* ws = A.ws; unsigned char* act = ws + WS_ACT; (void)act; p0_prologue(A, lds, G); } SEAM(0);
    if (IN(1)) REPEAT(1) { TSTAMP(1); __syncthreads(); KAREF A = *ka_launder(kp); unsigned char* ws = A.ws; unsigned char* act = ws + WS_ACT; (void)act; p1_norm0(A, G); } SEAM(1);
    if (IN(2)) REPEAT(2) { TSTAMP(2); __syncthreads(); KAREF A = *ka_launder(kp); unsigned char* ws = A.ws; unsigned char* act = ws + WS_ACT; (void)act;
        pg8::Gemm g{(const bf16_t*)(act + A_H), (const bf16_t*)(ws + WS_WIN), DM}; pg8::StaticOrder S; S.init(TT, 1792, G, (int)blockIdx.x);
        EpiWin E{(bf16_t*)(act + A_XA), (bf16_t*)(act + A_GA), (float*)(act + A_QR), (float*)(act + A_KR), (bf16_t*)(act + A_VB)};
        pg8::gemm_phase<EpiWin, pg8::StaticOrder, true, true>(lds + RING_OFF, g, S, E);
    } SEAM(2);
    if (IN(3)) REPEAT(3) { TSTAMP(3); __syncthreads(); KAREF A = *ka_launder(kp); unsigned char* ws = A.ws; unsigned char* act = ws + WS_ACT; (void)act; p3_kprep(A, G); p3_lru_pass1(A, lds, G); } SEAM(3);
    if (IN(4)) REPEAT(4) { TSTAMP(4); __syncthreads(); KAREF A = *ka_launder(kp); unsigned char* ws = A.ws; unsigned char* act = ws + WS_ACT; (void)act; p4_lru_pass2(A, lds, G); __syncthreads(); p4_attention(A, (char*)lds_raw + RING_OFF, G); } SEAM(4);
    if (IN(5)) REPEAT(5) { TSTAMP(5); __syncthreads(); KAREF A = *ka_launder(kp); unsigned char* ws = A.ws; unsigned char* act = ws + WS_ACT; (void)act;
        pg8::Gemm g{(const bf16_t*)(act + A_YCAT), (const bf16_t*)(ws + WS_WOUT), DM}; pg8::StaticOrder S; S.init(TL, DM, G, (int)blockIdx.x);
        EpiResid E{A.in[I_X], A.in[I_CTX], A.out, (float*)(ws + WS_CTXS), ada_ptr(ws, 0, 0, 2)};
        pg8::gemm_phase<EpiResid, pg8::StaticOrder, true, true>(lds + RING_OFF, g, S, E);
        p5_ctx_outproj(A, G);
    } SEAM(5);
    if (IN(6)) REPEAT(6) { TSTAMP(6); __syncthreads(); KAREF A = *ka_launder(kp); unsigned char* ws = A.ws; unsigned char* act = ws + WS_ACT; (void)act; p6_norm_router(A, lds, G, 0, TT); } SEAM(6);
    if (IN(7)) REPEAT(7) { TSTAMP(7); __syncthreads(); KAREF A = *ka_launder(kp); unsigned char* ws = A.ws; unsigned char* act = ws + WS_ACT; (void)act; p7_topk(A, lds, G, true); } SEAM(7);
    if (IN(8)) REPEAT(8) { TSTAMP(8); __syncthreads(); KAREF A = *ka_launder(kp); unsigned char* ws = A.ws; unsigned char* act = ws + WS_ACT; (void)act; p8_gather(A, G, true); } SEAM(8);
    if (IN(9)) REPEAT(9) { TSTAMP(9); __syncthreads(); KAREF A = *ka_launder(kp); unsigned char* ws = A.ws; unsigned char* act = ws + WS_ACT; (void)act;
        int k8 = DM / 2; asm volatile("" : "+s"(k8));
        pg8::Gemm g{(const bf16_t*)(act + A_XE), (const bf16_t*)(ws + WS_MOEW1), k8}; MoeOrder1 S{G, (int)blockIdx.x, 4096 + 256};
        EpiSwiGLU E{act + A_HID};
        pg8::gemm_phase<EpiSwiGLU, MoeOrder1, true, true, true>(lds + RING_OFF, g, S, E);
    } SEAM(9);
    if (IN(10)) REPEAT(10) { TSTAMP(10); __syncthreads(); KAREF A = *ka_launder(kp); unsigned char* ws = A.ws; unsigned char* act = ws + WS_ACT; (void)act;
        int k8 = FF / 2; asm volatile("" : "+s"(k8));
        pg8::Gemm g{(const bf16_t*)(act + A_HID), (const bf16_t*)(ws + WS_MOEW2), k8}; MoeOrder2 S{G, (int)blockIdx.x, 1024 + 64};
        EpiDown E{(bf16_t*)(act + A_YE), (const float*)(ws + WS_GROW)};
        pg8::gemm_phase<EpiDown, MoeOrder2, true, true, true>(lds + RING_OFF, g, S, E);
    } SEAM(10);
    if (IN(11)) REPEAT(11) { TSTAMP(11); __syncthreads(); KAREF A = *ka_launder(kp); unsigned char* ws = A.ws; unsigned char* act = ws + WS_ACT; (void)act; p11_combine(A, G, 0, TT); } SEAM(11);
    if (IN(12)) REPEAT(12) { TSTAMP(12); __syncthreads(); KAREF A = *ka_launder(kp); unsigned char* ws = A.ws; unsigned char* act = ws + WS_ACT; (void)act; p12_l1_prep(A, lds, G);
    } SEAM(12);
    if (IN(13)) REPEAT(13) { TSTAMP(13); __syncthreads(); KAREF A = *ka_launder(kp); unsigned char* ws = A.ws; unsigned char* act = ws + WS_ACT; (void)act;
        pg8::Gemm g{(const bf16_t*)(act + A_XMIX), (const bf16_t*)(ws + WS_BMIX), DM}; MixOrder S{G, (int)blockIdx.x};
        EpiMix E{(bf16_t*)(act + A_RKV), (bf16_t*)(act + A_LG), (bf16_t*)(act + A_LWA)};
        pg8::gemm_phase<EpiMix, MixOrder, true, true>(lds + RING_OFF, g, S, E);
    } SEAM(13);
    if (IN(14)) REPEAT(14) { TSTAMP(14); __syncthreads(); KAREF A = *ka_launder(kp); unsigned char* ws = A.ws; unsigned char* act = ws + WS_ACT; (void)act;
        int k2 = 256; asm volatile("" : "+s"(k2));
        pg8::Gemm g{(const bf16_t*)(act + A_LG), (const bf16_t*)(ws + WS_B2), k2}; LoraOrder S{G, (int)blockIdx.x};
        EpiLora E{(bf16_t*)(act + A_SD), (bf16_t*)(act + A_AD), (bf16_t*)(act + A_G), A.in[I1_W0], A.in[I1_A0]};
        pg8::gemm_phase<EpiLora, LoraOrder, true, true>(lds + RING_OFF, g, S, E);
    } SEAM(14);
    if (IN(15)) REPEAT(15) { TSTAMP(15); __syncthreads(); KAREF A = *ka_launder(kp); unsigned char* ws = A.ws; unsigned char* act = ws + WS_ACT; (void)act; p15_tbuild(A, lds, (int)blockIdx.x * 8 + (tid >> 6), G * 8, 0, (use_bar && G > 128) ? TB_CP_FIRST : NCHUNK / 2); } SEAM(15);
    if (IN(16)) REPEAT(16) { TSTAMP(16); __syncthreads(); KAREF A = *ka_launder(kp); unsigned char* ws = A.ws; unsigned char* act = ws + WS_ACT; (void)act; (void)ws;
        unsigned* handoff = (unsigned*)(ws + WS_CTL) + 16384; const bool split = use_bar && G > 128;
        if ((int)blockIdx.x < 128) p16_chain(A, lds, G, 0, handoff, split ? (unsigned)(G - 128) : 0u);
        else { const int wave = tid >> 6;
            if (split) { p15_tbuild(A, lds, ((int)blockIdx.x - 128) * 8 + wave, (G - 128) * 8, TB_CP_FIRST, NCHUNK / 2);
                asm volatile("s_waitcnt vmcnt(0)" ::: "memory"); __syncthreads();
                if (tid == 0) { __builtin_amdgcn_fence(__ATOMIC_RELEASE, "agent"); (void)xb_add(handoff, 1u); } }
            moe_convert_pipe(A, 1, lds, ((int)blockIdx.x - 128) * 8 + wave, (G - 128) * 8, wave, tid & 63); }
#if defined(DBG_WKV)
        __syncthreads(); p15_wkv_old(A, lds, G);
#endif
    } SEAM(16);
    if (IN(17)) REPEAT(17) { TSTAMP(17); __syncthreads(); KAREF A = *ka_launder(kp); unsigned char* ws = A.ws; unsigned char* act = ws + WS_ACT; (void)act; p16_readout(A, G);
    } SEAM(17);
    if (IN(18)) REPEAT(18) { TSTAMP(18); __syncthreads(); KAREF A = *ka_launder(kp); unsigned char* ws = A.ws; unsigned char* act = ws + WS_ACT; (void)act;
        pg8::Gemm g{(const bf16_t*)(act + A_O), (const bf16_t*)(ws + WS_WO), DM}; pg8::StaticOrder S; S.init(TL, DM, G, (int)blockIdx.x);
        EpiResid E{A.out, A.out, A.out, A.out, ada_ptr(ws, 1, 0, 2)};
        pg8::gemm_phase<EpiResid, pg8::StaticOrder, true, true>(lds + RING_OFF, g, S, E);
    } SEAM(18);
    if (IN(19)) REPEAT(19) { TSTAMP(19); __syncthreads(); KAREF A = *ka_launder(kp); unsigned char* ws = A.ws; unsigned char* act = ws + WS_ACT; (void)act; p6_norm_router(A, lds, G, 1, TL); } SEAM(19);
    if (IN(20)) REPEAT(20) { TSTAMP(20); __syncthreads(); KAREF A = *ka_launder(kp); unsigned char* ws = A.ws; unsigned char* act = ws + WS_ACT; (void)act; p7_topk(A, lds, G, false); } SEAM(20);
    if (IN(21)) REPEAT(21) { TSTAMP(21); __syncthreads(); KAREF A = *ka_launder(kp); unsigned char* ws = A.ws; unsigned char* act = ws + WS_ACT; (void)act; p8_gather(A, G, false); } SEAM(21);
    if (IN(22)) REPEAT(22) { TSTAMP(22); __syncthreads(); KAREF A = *ka_launder(kp); unsigned char* ws = A.ws; unsigned char* act = ws + WS_ACT; (void)act;
        int k8 = DM / 2; asm volatile("" : "+s"(k8));
        pg8::Gemm g{(const bf16_t*)(act + A_XE), (const bf16_t*)(ws + WS_MOEW1), k8}; MoeOrder1 S{G, (int)blockIdx.x, 4096};
        EpiSwiGLU E{act + A_HID};
        pg8::gemm_phase<EpiSwiGLU, MoeOrder1, true, true, true>(lds + RING_OFF, g, S, E);
    } SEAM(22);
    if (IN(23)) REPEAT(23) { TSTAMP(23); __syncthreads(); KAREF A = *ka_launder(kp); unsigned char* ws = A.ws; unsigned char* act = ws + WS_ACT; (void)act;
        int k8 = FF / 2; asm volatile("" : "+s"(k8));
        pg8::Gemm g{(const bf16_t*)(act + A_HID), (const bf16_t*)(ws + WS_MOEW2), k8}; MoeOrder2 S{G, (int)blockIdx.x, 1024};
        EpiDown E{(bf16_t*)(act + A_YE), (const float*)(ws + WS_GROW)};
        pg8::gemm_phase<EpiDown, MoeOrder2, true, true, true>(lds + RING_OFF, g, S, E);
    } SEAM(23);
    if (IN(24)) REPEAT(24) { TSTAMP(24); __syncthreads(); KAREF A = *ka_launder(kp); unsigned char* ws = A.ws; unsigned char* act = ws + WS_ACT; (void)act; p11_combine(A, G, 1, TL); }
#undef IN
#undef SEAM
}

#ifndef N_LAUNCH_MODE
#define N_LAUNCH_MODE 0
#endif
extern "C" void kernel_launch(void* const* d_in, const int* in_sizes, int n_in, void* d_out, int out_size, void* d_ws, size_t ws_size, hipStream_t stream) {
    static int grid = 0;
    if (grid == 0) {
        if (n_in != N_IN || in_sizes[0] != TL * DM || out_size != TL * DM || ws_size < WS_END) {
            fprintf(stderr, "kernel_launch: unexpected shapes (n_in %d, in0 %d, out %d, ws %zu < %zu?); nothing launched\n", n_in, n_in > 0 ? in_sizes[0] : -1, out_size, ws_size, (size_t)WS_END); grid = -1; return; }
        int dev = 0, cus = 0, per_cu = 0;
        if (hipGetDevice(&dev) != hipSuccess || hipDeviceGetAttribute(&cus, hipDeviceAttributeMultiprocessorCount, dev) != hipSuccess) { grid = -1; return; }
        if (hipFuncSetAttribute((const void*)fwd_kernel, hipFuncAttributeMaxDynamicSharedMemorySize, LDS_BYTES) != hipSuccess) { fprintf(stderr, "kernel_launch: hipFuncSetAttribute failed\n"); grid = -1; return; }
        if (hipOccupancyMaxActiveBlocksPerMultiprocessor(&per_cu, (const void*)fwd_kernel, 512, LDS_BYTES) != hipSuccess || per_cu < 1) { fprintf(stderr, "kernel_launch: occupancy query says %d\n", per_cu); }
        (void)hipGetLastError();
        grid = cus;
    }
    if (grid < 0) return;
    (void)hipMemsetAsync((char*)d_ws, 0, ZERO_BYTES, stream);
    KArgs a{};
    for (int i = 0; i < N_IN; ++i) a.in[i] = (const float*)d_in[i];
    a.out = (float*)d_out; a.ws = (unsigned char*)d_ws;
#if N_LAUNCH_MODE == 1
    for (int p = 0; p < N_PHASES; ++p) { a.ph_lo = p; a.ph_hi = p + 1; hipLaunchKernelGGL(fwd_kernel, dim3(grid), dim3(512), LDS_BYTES, stream, a); }
#else
    a.ph_lo = 0; a.ph_hi = N_PHASES; hipLaunchKernelGGL(fwd_kernel, dim3(grid), dim3(512), LDS_BYTES, stream, a);
#endif
}
```

```cpp
#include <hip/hip_runtime.h>
#include <cstdio>
#include <cstdint>

#define GAS __attribute__((address_space(1)))
#define LAS __attribute__((address_space(3)))
typedef unsigned short bf16_t;
typedef short bf16x8 __attribute__((ext_vector_type(8)));
typedef short s16x4 __attribute__((ext_vector_type(4)));
typedef float f32x16 __attribute__((ext_vector_type(16)));
typedef float f32x4 __attribute__((ext_vector_type(4)));
typedef float f32x2 __attribute__((ext_vector_type(2)));
typedef unsigned u32x4 __attribute__((ext_vector_type(4)));
typedef unsigned u32x2 __attribute__((ext_vector_type(2)));

constexpr int NB = 4, SEQ = 8192, CTXL = 256, DM = 1024;
constexpr int TL = NB * SEQ, TC = NB * CTXL, TT = TL + TC;
constexpr int KVL = SEQ + CTXL;
constexpr int NE = 16, FF = 2048, CAPL = 1024, CAPC = 32;
constexpr int XE_CTX0 = NB * NE * CAPL;
constexpr int XE_ROWS = XE_CTX0 + NE * 256;

typedef float f32x2_cv __attribute__((ext_vector_type(2))); typedef __bf16 bf16x2_cv __attribute__((ext_vector_type(2)));
__device__ __forceinline__ unsigned cvt_pk_bf16_c(float lo, float hi) { const f32x2_cv v = {lo, hi}; const bf16x2_cv b = __builtin_convertvector(v, bf16x2_cv); return __builtin_bit_cast(unsigned, b); }
__device__ __forceinline__ unsigned cvt_pk_bf16(float lo, float hi) { unsigned r; asm volatile("v_cvt_pk_bf16_f32 %0, %1, %2" : "=v"(r) : "v"(lo), "v"(hi)); return r; }
__device__ __forceinline__ unsigned pk_fp8x4(float a, float b, float c, float d) { unsigned w; asm volatile("v_cvt_pk_fp8_f32 %0, %1, %2\n\tv_cvt_pk_fp8_f32 %0, %3, %4 op_sel:[0,0,1]" : "=&v"(w) : "v"(a), "v"(b), "v"(c), "v"(d)); return w; }
__device__ __forceinline__ float bflo(unsigned w) { return __uint_as_float(w << 16); }
__device__ __forceinline__ float bfhi(unsigned w) { return __uint_as_float(w & 0xffff0000u); }
__device__ __forceinline__ float bf2f(bf16_t b) { return __uint_as_float(((unsigned)b) << 16); }
__device__ __forceinline__ float wave_sum(float v) {
#pragma unroll
    for (int o = 1; o < 64; o <<= 1) v += __shfl_xor(v, o);
    return v;
}
__device__ __forceinline__ float fexp(float x) { return __builtin_amdgcn_exp2f(x * 1.4426950408889634f); }
__device__ __forceinline__ float sigm(float x) { return __builtin_amdgcn_rcpf(1.0f + __builtin_amdgcn_exp2f(-1.4426950408889634f * x)); }
__device__ __forceinline__ float tanh_f(float x) { return 1.0f - 2.0f * __builtin_amdgcn_rcpf(1.0f + __builtin_amdgcn_exp2f(2.8853900817779268f * x)); }
__device__ __forceinline__ float gelu_tanh(float x) { const float u = 0.7978845608028654f * (x + 0.044715f * x * x * x); return x * sigm(2.0f * u); }
__device__ __forceinline__ float silu_f(float x) { return x * sigm(x); }

namespace pg8 {
#define PG8_LAS __attribute__((address_space(3)))
constexpr int BM = 256, BK = 64, HALF = 128, HTB = HALF * BK * 2  , STAGE_BYTES = 8 * HTB, NXCD = 8, WGM = 8;
__host__ __device__ __forceinline__ int lds_byte(int r, int c) { const int st = (r >> 4) * 2 + (c >> 5), rr = r & 15, cc = c & 31, ob = rr * 64 + cc * 2; return st * 1024 + (ob ^ (((ob >> 9) & 1) << 5)); }
__host__ __device__ __forceinline__ void stage_rc(int b, int& R, int& C) { const int st = b / 1024, sb = b % 1024, swz = sb ^ (((sb >> 9) & 1) << 5); R = (st >> 1) * 16 + swz / 64; C = (st & 1) * 32 + (swz % 64) / 2; }
__host__ __device__ __forceinline__ int perm32(int rho) { const int n = rho >> 4, i = rho & 15; return 8 * (i >> 2) + 4 * n + (i & 3); }

struct Unit { int pm, pn, am, bn; };
struct Gemm { const bf16_t* A; const bf16_t* Bt; int K; };

struct StaticOrder {
    int nM, nN, nwg, G, c;
    __device__ void init(int M, int N, int G_, int c_) { nM = M / BM; nN = N / BM; nwg = nM * nN; G = G_; c = c_; }
    __device__ bool next(int i, Unit& u) const {
        const long L = (long)i * G + c; if (L >= nwg) return false;
        int wgid = (int)L; { const int q = nwg / NXCD, r = nwg % NXCD, xcd = wgid % NXCD, off = wgid / NXCD; wgid = (xcd < r ? xcd * (q + 1) : r * (q + 1) + (xcd - r) * q) + off; }
        const int nig = WGM * nN, gid = wgid / nig, fm = gid * WGM, gsz = (nM - fm) < WGM ? (nM - fm) : WGM;
        u.pm = fm + ((wgid % nig) % gsz); u.pn = (wgid % nig) / gsz; u.am = u.pm; u.bn = u.pn; return true;
    }
    __device__ __forceinline__ void a_ready(const Unit&) const {}
    __device__ __forceinline__ void done(const Unit&) const {}
};

typedef int v8i_t __attribute__((ext_vector_type(8)));
template <class Epi, class Sched, bool ALIGN_EPI = false, bool SP2 = false, bool FP8 = false>
__device__ __forceinline__ void gemm_phase(PG8_LAS unsigned char* lds, const Gemm g, const Sched& S, const Epi& E) {
    const int tid = threadIdx.x, wid = __builtin_amdgcn_readfirstlane(tid >> 6), lane = tid & 63, wr = wid >> 2, wc = wid & 3, fr = lane & 15, fq = lane >> 4;
    const int K = g.K, nt = K / BK;
    unsigned voffA[2], voffB[2];
#pragma unroll
    for (int i = 0; i < 2; ++i) { int R, C; stage_rc(tid * 16 + i * 8192, R, C); const int Rb = Epi::PERM ? ((R & ~31) + perm32(R & 31)) : R;
        voffA[i] = (unsigned)(R * K + C) * 2u; voffB[i] = (unsigned)(Rb * K + C) * 2u; }
    const size_t kstep = (size_t)(BK * 2);
    const size_t hstep = (size_t)HALF * K * 2;
    const size_t tstep = 2 * hstep;
    const unsigned ldsw = (unsigned)wid * 1024u;
    const int aoff = lds_byte(wr * 64 + fr, fq * 8), boff = lds_byte(wc * 32 + fr, fq * 8);
#define PG8_SA(b, h) (((b) * 2 + (h)) * HTB)
#define PG8_SB(b, h) ((4 + (b) * 2 + (h)) * HTB)
#define PG8_STAGE(bufoff, gbase, voff) do { _Pragma("unroll") for (int _i = 0; _i < 2; ++_i) \
        __builtin_amdgcn_global_load_lds((const unsigned*)((const char*)(gbase) + (voff)[_i]), (PG8_LAS unsigned*)(lds + (bufoff) + ldsw + _i * 8192), 16, 0, 0); } while (0)
#define PG8_LD8(p) __builtin_bit_cast(v8i_t, __builtin_shufflevector(*(const PG8_LAS u32x4*)(p), *(const PG8_LAS u32x4*)((p) + 1024), 0, 1, 2, 3, 4, 5, 6, 7))
#define PG8_LDA(dst, b, h) do { if constexpr (FP8) { _Pragma("unroll") for (int m = 0; m < 4; ++m) dst##8[m] = PG8_LD8(lds + PG8_SA(b, h) + aoff + m * 2048); } \
        else { _Pragma("unroll") for (int m = 0; m < 4; ++m) _Pragma("unroll") for (int k = 0; k < 2; ++k) dst[m][k] = *(const PG8_LAS bf16x8*)(lds + PG8_SA(b, h) + aoff + m * 2048 + k * 1024); } } while (0)
#define PG8_LDB(dst, b, h) do { if constexpr (FP8) { _Pragma("unroll") for (int n = 0; n < 2; ++n) dst##8[n] = PG8_LD8(lds + PG8_SB(b, h) + boff + n * 2048); } \
        else { _Pragma("unroll") for (int n = 0; n < 2; ++n) _Pragma("unroll") for (int k = 0; k < 2; ++k) dst[n][k] = *(const PG8_LAS bf16x8*)(lds + PG8_SB(b, h) + boff + n * 2048 + k * 1024); } } while (0)
#define PG8_MMA(ai, bj, At, Bt) do { __builtin_amdgcn_s_setprio(1); _Pragma("unroll") for (int m = 0; m < 4; ++m) _Pragma("unroll") for (int n = 0; n < 2; ++n) { \
        if constexpr (FP8) asm volatile("v_mfma_scale_f32_16x16x128_f8f6f4 %0, %1, %2, %0, %3, %3 op_sel_hi:[0,0,0]" : "+v"(acc[ai][bj][m][n]) : "v"(Bt##8[n]), "v"(At##8[m]), "v"(sc8));   \
        else { _Pragma("unroll") for (int k = 0; k < 2; ++k) acc[ai][bj][m][n] = __builtin_amdgcn_mfma_f32_16x16x32_bf16(Bt[n][k], At[m][k], acc[ai][bj][m][n], 0, 0, 0); } } __builtin_amdgcn_s_setprio(0); } while (0)
#define PG8_WAIT_V(n) asm volatile("s_waitcnt vmcnt(" #n ")" ::: "memory")
#define PG8_WAIT_L(n) asm volatile("s_waitcnt lgkmcnt(" #n ")" ::: "memory")
#define PG8_BAR __builtin_amdgcn_s_barrier()
#define PG8_SCHED __builtin_amdgcn_sched_barrier(0)
    Unit cur, nxt; int ui = 0;
    if (!S.next(0, cur)) return;
    f32x4 acc[2][2][4][2];
#pragma unroll
    for (int a = 0; a < 2; ++a)
#pragma unroll
        for (int b = 0; b < 2; ++b)
#pragma unroll
            for (int m = 0; m < 4; ++m)
#pragma unroll
                for (int n = 0; n < 2; ++n) acc[a][b][m][n] = (f32x4){0.f, 0.f, 0.f, 0.f};
    bf16x8 At[4][2], B0[2][2], B1[2][2]; v8i_t At8[4], B08[2], B18[2]; const unsigned sc8 = 0x7f7f7f7fu; (void)At; (void)B0; (void)B1; (void)At8; (void)B08; (void)B18; (void)sc8;
    const char* cA = (const char*)g.A + (size_t)cur.am * tstep; const char* cB = (const char*)g.Bt + (size_t)cur.bn * tstep;
    S.a_ready(cur);
    if constexpr (SP2) {
        PG8_STAGE(PG8_SB(0, 0), cB, voffB); PG8_STAGE(PG8_SB(0, 1), cB + hstep, voffB); PG8_STAGE(PG8_SA(0, 0), cA, voffA); PG8_STAGE(PG8_SA(0, 1), cA + hstep, voffA);
        if (wr == 1) PG8_BAR;
        PG8_WAIT_V(2); PG8_BAR;
        PG8_STAGE(PG8_SB(1, 0), cB + kstep, voffB); PG8_STAGE(PG8_SA(1, 0), cA + kstep, voffA); PG8_STAGE(PG8_SB(1, 1), cB + hstep + kstep, voffB);
        PG8_WAIT_V(6); PG8_BAR;
    } else {
        PG8_STAGE(PG8_SB(0, 0), cB, voffB); PG8_STAGE(PG8_SA(0, 0), cA, voffA); PG8_STAGE(PG8_SB(0, 1), cB + hstep, voffB); PG8_STAGE(PG8_SA(0, 1), cA + hstep, voffA);
        if (wr == 1) PG8_BAR;
        PG8_WAIT_V(4); PG8_BAR;
        PG8_STAGE(PG8_SB(1, 0), cB + kstep, voffB); PG8_STAGE(PG8_SA(1, 0), cA + kstep, voffA); PG8_STAGE(PG8_SB(1, 1), cB + hstep + kstep, voffB);
        PG8_WAIT_V(6); PG8_BAR;
    }
    for (;;) {
        const bool has_next = S.next(ui + 1, nxt);
        const char* nA = has_next ? (const char*)g.A + (size_t)nxt.am * tstep : cA; const char* nB = has_next ? (const char*)g.Bt + (size_t)nxt.bn * tstep : cB;
        for (int t = 0; t < nt; t += 2) {
            const bool last = (t == nt - 2);
            const char* a1 = cA + (size_t)(t + 1) * kstep;
            const char* a2 = last ? nA : cA + (size_t)(t + 2) * kstep; const char* b2 = last ? nB : cB + (size_t)(t + 2) * kstep;
            const char* a3 = a2 + kstep; const char* b3 = b2 + kstep;
            if (last && has_next) S.a_ready(nxt);
            if constexpr (SP2) {
            PG8_LDB(B0, 0, 0); PG8_LDB(B1, 0, 1); PG8_SCHED; PG8_LDA(At, 0, 0); PG8_STAGE(PG8_SA(1, 1), a1 + hstep, voffA);
            PG8_WAIT_V(8); PG8_WAIT_L(0); PG8_BAR; PG8_MMA(0, 0, At, B0); PG8_MMA(0, 1, At, B1); PG8_BAR; PG8_SCHED;
            PG8_LDA(At, 0, 1); PG8_STAGE(PG8_SB(0, 0), b2, voffB); PG8_STAGE(PG8_SB(0, 1), b2 + hstep, voffB); PG8_STAGE(PG8_SA(0, 0), a2, voffA);
            PG8_WAIT_V(8); PG8_WAIT_L(0); PG8_BAR; PG8_MMA(1, 0, At, B0); PG8_MMA(1, 1, At, B1); PG8_BAR; PG8_SCHED;
            PG8_LDB(B0, 1, 0); PG8_LDB(B1, 1, 1); PG8_SCHED; PG8_LDA(At, 1, 0); PG8_STAGE(PG8_SA(0, 1), a2 + hstep, voffA);
            PG8_WAIT_V(8); PG8_WAIT_L(0); PG8_BAR; PG8_MMA(0, 0, At, B0); PG8_MMA(0, 1, At, B1); PG8_BAR; PG8_SCHED;
            PG8_LDA(At, 1, 1); PG8_STAGE(PG8_SB(1, 0), b3, voffB); PG8_STAGE(PG8_SB(1, 1), b3 + hstep, voffB); PG8_STAGE(PG8_SA(1, 0), a3, voffA);
            PG8_WAIT_V(8); PG8_WAIT_L(0); PG8_BAR; PG8_MMA(1, 0, At, B0); PG8_MMA(1, 1, At, B1); PG8_BAR; PG8_SCHED;
            } else {
            PG8_LDB(B0, 0, 0); PG8_SCHED; PG8_LDA(At, 0, 0); PG8_STAGE(PG8_SA(1, 1), a1 + hstep, voffA);
            PG8_WAIT_L(8); PG8_BAR; PG8_WAIT_L(0); PG8_MMA(0, 0, At, B0); PG8_BAR; PG8_SCHED;
            PG8_LDB(B1, 0, 1); PG8_STAGE(PG8_SB(0, 0), b2, voffB);
            PG8_BAR; PG8_WAIT_L(0); PG8_MMA(0, 1, At, B1); PG8_BAR;
            PG8_LDA(At, 0, 1); PG8_STAGE(PG8_SA(0, 0), a2, voffA);
            PG8_BAR; PG8_WAIT_L(0); PG8_MMA(1, 0, At, B0); PG8_BAR; PG8_SCHED;
            PG8_STAGE(PG8_SB(0, 1), b2 + hstep, voffB);
            PG8_WAIT_V(6); PG8_BAR; PG8_MMA(1, 1, At, B1); PG8_BAR;
            PG8_LDB(B0, 1, 0); PG8_SCHED; PG8_LDA(At, 1, 0); PG8_STAGE(PG8_SA(0, 1), a2 + hstep, voffA);
            PG8_WAIT_L(8); PG8_BAR; PG8_WAIT_L(0); PG8_MMA(0, 0, At, B0); PG8_BAR; PG8_SCHED;
            PG8_LDB(B1, 1, 1); PG8_STAGE(PG8_SB(1, 0), b3, voffB);
            PG8_BAR; PG8_WAIT_L(0); PG8_MMA(0, 1, At, B1); PG8_BAR;
            PG8_LDA(At, 1, 1); PG8_STAGE(PG8_SA(1, 0), a3, voffA);
            PG8_BAR; PG8_WAIT_L(0); PG8_MMA(1, 0, At, B0); PG8_BAR; PG8_SCHED;
            PG8_STAGE(PG8_SB(1, 1), b3 + hstep, voffB);
            PG8_WAIT_V(6); PG8_BAR; PG8_MMA(1, 1, At, B1); PG8_BAR;
            }
        }
        if constexpr (FP8) asm volatile("s_nop 15\n\ts_nop 7" ::: "memory");
        if constexpr (ALIGN_EPI) { if (wr == 0) PG8_BAR; }
        E(acc, cur, wr, wc, fr, fq); S.done(cur);
        if (!has_next) break;
#pragma unroll
        for (int a = 0; a < 2; ++a)
#pragma unroll
            for (int b = 0; b < 2; ++b)
#pragma unroll
                for (int m = 0; m < 4; ++m)
#pragma unroll
                    for (int n = 0; n < 2; ++n) acc[a][b][m][n] = (f32x4){0.f, 0.f, 0.f, 0.f};
        cur = nxt; cA = nA; cB = nB; ++ui;
        if constexpr (ALIGN_EPI) { if (wr == 1) PG8_BAR; }
    }
    PG8_WAIT_V(0);
    if constexpr (!ALIGN_EPI) { if (wr == 0) PG8_BAR; }
    PG8_BAR;
#undef PG8_SA
#undef PG8_SB
#undef PG8_STAGE
#undef PG8_LDA
#undef PG8_LDB
#undef PG8_MMA
#undef PG8_LD8
#undef PG8_WAIT_V
#undef PG8_WAIT_L
#undef PG8_BAR
#undef PG8_SCHED
}
}
#include <hip/hip_bf16.h>
namespace attn_body {
using bf16=__hip_bfloat16;
using bf16x8=__attribute__((ext_vector_type(8)))short;
using s16x4=__attribute__((ext_vector_type(4)))short;
using f32x16=__attribute__((ext_vector_type(16)))float;
using u32x4=__attribute__((ext_vector_type(4)))unsigned;
constexpr int D=64,KVP=128,OP=1024,QP=512;
constexpr int NW=8,QBLK=32,QB=QBLK*NW,KVBLK=64;
constexpr int ATTN_UNIT_ROWS=QB;
__device__ __forceinline__ int crow(int r,int hi){return (r&3)+8*(r>>2)+4*hi;}
#define SBAR() __builtin_amdgcn_sched_barrier(0)
constexpr int NSLOT=3, SLOTB=8192;
constexpr int LDS_K=0, LDS_V=NSLOT*SLOTB, LDS_WS=2*NSLOT*SLOTB, LDS_OST=LDS_WS+NW*64*4, LDS_BYTES=LDS_OST+NW*4096;
constexpr float C2=0.125f*1.4426950408889634f;
__device__ __forceinline__ void glds16(const void*gsrc,unsigned lds_dst){unsigned keep;
  asm volatile("s_mov_b32 %0, m0\n\ts_mov_b32 m0, %2\n\ts_nop 0\n\tglobal_load_lds_dwordx4 %1, off\n\ts_mov_b32 m0, %0":"=&s"(keep):"v"(gsrc),"s"(lds_dst):"memory");}
__device__ __forceinline__ float max3f(float a,float b,float c){float r;asm("v_max3_f32 %0, %1, %2, %3":"=v"(r):"v"(a),"v"(b),"v"(c));return r;}
__device__ __forceinline__ float max2f(float a,float b){float r;asm("v_max_f32_e32 %0, %1, %2":"=v"(r):"v"(a),"v"(b));return r;}
__device__ __forceinline__ float fadd_s(float a,float b){float r;asm("v_add_f32_e32 %0, %1, %2":"=v"(r):"v"(a),"v"(b));return r;}
__device__ __forceinline__ float fsub_s(float a,float b){float r;asm("v_sub_f32_e32 %0, %1, %2":"=v"(r):"v"(a),"v"(b));return r;}
typedef float f32x2_t __attribute__((ext_vector_type(2))); typedef __bf16 bf16x2_t __attribute__((ext_vector_type(2)));
__device__ __forceinline__ unsigned cvtpk_s(float lo,float hi){f32x2_t v={lo,hi};bf16x2_t b=__builtin_convertvector(v,bf16x2_t);return __builtin_bit_cast(unsigned,b);}
#define WAIT_BAR(N) asm volatile("s_waitcnt vmcnt(" #N ") lgkmcnt(0)\n\ts_barrier":::"memory")

__device__ __forceinline__ void qkt(f32x16&p0,f32x16&p1,const char*Kslot,const bf16x8*qr,const f32x16&negm,int r32,int hi){
  const char*kb=Kslot+hi*1024+r32*16;
  #pragma unroll
  for(int d0=0;d0<4;++d0){
    const bf16x8 b0=*reinterpret_cast<const bf16x8*>(kb+d0*2048);
    const bf16x8 b1=*reinterpret_cast<const bf16x8*>(kb+d0*2048+512);
    if(d0==0){p0=__builtin_amdgcn_mfma_f32_32x32x16_bf16(b0,qr[0],negm,0,0,0);p1=__builtin_amdgcn_mfma_f32_32x32x16_bf16(b1,qr[0],negm,0,0,0);}
    else{p0=__builtin_amdgcn_mfma_f32_32x32x16_bf16(b0,qr[d0],p0,0,0,0);p1=__builtin_amdgcn_mfma_f32_32x32x16_bf16(b1,qr[d0],p1,0,0,0);}}
}
typedef __attribute__((address_space(3))) const char* lds_cptr;
typedef short v4i16_t __attribute__((ext_vector_type(4)));
__device__ __forceinline__ void kload8(bf16x8*kf,lds_cptr kp){
  kf[0]=*(const __attribute__((address_space(3))) bf16x8*)(kp);      kf[1]=*(const __attribute__((address_space(3))) bf16x8*)(kp+512);
  kf[2]=*(const __attribute__((address_space(3))) bf16x8*)(kp+2048); kf[3]=*(const __attribute__((address_space(3))) bf16x8*)(kp+2560);
  kf[4]=*(const __attribute__((address_space(3))) bf16x8*)(kp+4096); kf[5]=*(const __attribute__((address_space(3))) bf16x8*)(kp+4608);
  kf[6]=*(const __attribute__((address_space(3))) bf16x8*)(kp+6144); kf[7]=*(const __attribute__((address_space(3))) bf16x8*)(kp+6656);
}
__device__ __forceinline__ void kload2(bf16x8*kf,lds_cptr kp,int j){ kf[2*j]=*(const __attribute__((address_space(3))) bf16x8*)(kp+j*2048); kf[2*j+1]=*(const __attribute__((address_space(3))) bf16x8*)(kp+j*2048+512); }
__device__ __forceinline__ s16x4 vtr(lds_cptr p){ return __builtin_bit_cast(s16x4,__builtin_amdgcn_ds_read_tr16_b64_v4i16((__attribute__((address_space(3))) v4i16_t*)p)); }
__device__ __forceinline__ float rowmax(const f32x16&p0,const f32x16&p1){
  float a=max3f(p0[0],p0[1],p1[0]),b=max3f(p0[2],p0[3],p1[1]);a=max3f(a,p1[2],p1[3]);
  #pragma unroll
  for(int r=4;r<16;r+=4){a=max3f(a,p0[r],p0[r+1]);b=max3f(b,p0[r+2],p0[r+3]);a=max3f(a,p1[r],p1[r+1]);b=max3f(b,p1[r+2],p1[r+3]);}
  const float m=max2f(a,b);
  auto rr=__builtin_amdgcn_permlane32_swap(__float_as_uint(m),__float_as_uint(m),false,false);
  return max2f(__uint_as_float(rr[0]),__uint_as_float(rr[1]));
}
__device__ __forceinline__ void pv(f32x16*o,int vb,bf16x8 pa0,bf16x8 pa1,bf16x8 pa2,bf16x8 pa3){
  #pragma unroll
  for(int d0=0;d0<2;++d0){s16x4 lo[4],hi[4];
    #pragma unroll
    for(int ks=0;ks<4;++ks){
      asm volatile("ds_read_b64_tr_b16 %0,%1 offset:%c2":"=&v"(lo[ks]):"v"(vb),"i"(d0*4096+ks*1024):"memory");
      asm volatile("ds_read_b64_tr_b16 %0,%1 offset:%c2":"=&v"(hi[ks]):"v"(vb),"i"(d0*4096+ks*1024+512):"memory");}
    asm volatile("s_waitcnt lgkmcnt(0)":::"memory");SBAR();
    #define PK(k) (bf16x8){lo[k][0],lo[k][1],lo[k][2],lo[k][3],hi[k][0],hi[k][1],hi[k][2],hi[k][3]}
    o[d0]=__builtin_amdgcn_mfma_f32_32x32x16_bf16(pa0,PK(0),o[d0],0,0,0);
    o[d0]=__builtin_amdgcn_mfma_f32_32x32x16_bf16(pa1,PK(1),o[d0],0,0,0);
    o[d0]=__builtin_amdgcn_mfma_f32_32x32x16_bf16(pa2,PK(2),o[d0],0,0,0);
    o[d0]=__builtin_amdgcn_mfma_f32_32x32x16_bf16(pa3,PK(3),o[d0],0,0,0);
    #undef PK
  }
}

#ifndef ATTN_STORE16
#define ATTN_STORE16(p,v) (*(u32x4*)(p)=(v))
#endif
template<int THRL> __device__ __forceinline__ void attn_unit(int qrow0,int h,int kvrow0,int NT,int rope,int qpos0,const float*QRAW,const float*qg,const float*ropetab,const bf16*__restrict__ K,const bf16*__restrict__ V,bf16*O,char*shm){
  const int tid=threadIdx.x,lane=tid&63,r32=lane&31,hi=lane>>5; const int wid=__builtin_amdgcn_readfirstlane(tid>>6);
  const float*Qw=QRAW+(long)(qrow0+wid*QBLK)*QP+h*D;
  const bf16*Kh=K+(long)kvrow0*KVP+(h>>2)*D,*Vh=V+(long)kvrow0*KVP+(h>>2)*D;
  const unsigned lds0=(unsigned)(uintptr_t)shm;
  float*wsf=(float*)(shm+LDS_WS)+wid*64;
  const bf16*ksrc=Kh+(long)lane*KVP+wid*8;
  const bf16*vsrc=Vh+(long)(16*(wid&3)+(lane>>2))*KVP+(wid>>2)*32+(lane&3)*8;
  const unsigned kdst=lds0+LDS_K+wid*1024, vdst=lds0+LDS_V+wid*1024;
  #define DMA_K(t,slot) glds16(ksrc+(long)(t)*KVBLK*KVP,(unsigned)__builtin_amdgcn_readfirstlane(kdst+(slot)))
  #define DMA_V(t,slot) glds16(vsrc+(long)(t)*KVBLK*KVP,(unsigned)__builtin_amdgcn_readfirstlane(vdst+(slot)))
  const int vb0=(int)(lds0+LDS_V)+((lane>>4)&1)*32+(lane&3)*8+(4*hi+((lane&15)>>2))*64;
  const char*Kbase=shm+LDS_K; bf16x8 kf[8];
  const lds_cptr shm3=(lds_cptr)shm; const lds_cptr kp0=shm3+LDS_K+hi*1024+r32*16; const lds_cptr vp0=shm3+LDS_V+((lane>>4)&1)*32+(lane&3)*8+(4*hi+((lane&15)>>2))*64;
  DMA_K(0,0);DMA_V(0,0);DMA_K(1,SLOTB);
  bf16x8 qr[4];
  { float qv[4][8]; float ss=0.f;
    #pragma unroll
    for(int d0=0;d0<4;++d0){ const f32x4 a=*reinterpret_cast<const f32x4*>(&Qw[(long)r32*QP+d0*16+hi*8]), c=*reinterpret_cast<const f32x4*>(&Qw[(long)r32*QP+d0*16+hi*8+4]);
      qv[d0][0]=a[0];qv[d0][1]=a[1];qv[d0][2]=a[2];qv[d0][3]=a[3];qv[d0][4]=c[0];qv[d0][5]=c[1];qv[d0][6]=c[2];qv[d0][7]=c[3];
      #pragma unroll
      for(int j=0;j<8;++j)ss+=qv[d0][j]*qv[d0][j]; }
    ss+=__shfl_xor(ss,32);
    const float rs=__builtin_amdgcn_rsqf(ss*(1.f/64.f)+1e-6f);
    const int qpos=qpos0+wid*QBLK+r32; const int prow=qpos>>6, pcol=qpos&63;
    #pragma unroll
    for(int d0=0;d0<4;++d0){
      const f32x4 g0=*reinterpret_cast<const f32x4*>(&qg[d0*16+hi*8]), g1=*reinterpret_cast<const f32x4*>(&qg[d0*16+hi*8+4]);
      float y[8]; y[0]=qv[d0][0]*rs*g0[0];y[1]=qv[d0][1]*rs*g0[1];y[2]=qv[d0][2]*rs*g0[2];y[3]=qv[d0][3]*rs*g0[3];y[4]=qv[d0][4]*rs*g1[0];y[5]=qv[d0][5]*rs*g1[1];y[6]=qv[d0][6]*rs*g1[2];y[7]=qv[d0][7]*rs*g1[3];
      if(rope){ const float*tb=ropetab+(d0<2?prow:(128+pcol))*32+((d0&1)*8+hi*4);
        const f32x4 cs=*reinterpret_cast<const f32x4*>(tb), sn=*reinterpret_cast<const f32x4*>(tb+16);
        #pragma unroll
        for(int p=0;p<4;++p){ const float x1=y[2*p],x2=y[2*p+1]; y[2*p]=x1*cs[p]-x2*sn[p]; y[2*p+1]=x1*sn[p]+x2*cs[p]; } }
      u32x4 w; w[0]=cvtpk_s(y[0]*C2,y[1]*C2); w[1]=cvtpk_s(y[2]*C2,y[3]*C2); w[2]=cvtpk_s(y[4]*C2,y[5]*C2); w[3]=cvtpk_s(y[6]*C2,y[7]*C2);
      qr[d0]=__builtin_bit_cast(bf16x8,w); } }
  float mhat=0.f,l_reg=0.f;f32x16 o[2];o[0]=f32x16{};o[1]=f32x16{};f32x16 negm=f32x16{};asm volatile("":"+v"(negm));
  #define CMASK(P0,P1,t) do{}while(0)
  bool resc=false;
  #define START(P0,P1) do{ const float rm=rowmax(P0,P1); resc=false; \
    { const float dl=rm; mhat=fadd_s(mhat,dl); \
      _Pragma("unroll") for(int r=0;r<16;++r){P0[r]=fsub_s(P0[r],dl);P1[r]=fsub_s(P1[r],dl);} \
      _Pragma("unroll") for(int r=0;r<16;++r)negm[r]=-mhat; asm volatile("":"+v"(negm)); } \
    _Pragma("unroll") for(int r=0;r<16;++r)P0[r]=__builtin_amdgcn_exp2f(P0[r]); }while(0)
  #define RESC() do{ if(resc){ asm volatile("s_waitcnt lgkmcnt(0)":::"memory"); \
      _Pragma("unroll") for(int d_=0;d_<2;++d_) _Pragma("unroll") for(int r=0;r<16;++r)o[d_][r]*=wsf[crow(r,hi)]; } }while(0)
  f32x16 pA0,pA1,pB0,pB1;
  int sl_prev=0,sl_cur=0,sl_next=SLOTB;
  #define ROT() do{sl_prev=sl_cur;sl_cur=sl_next;sl_next=(sl_next==(NSLOT-1)*SLOTB)?0:sl_next+SLOTB;}while(0)
  DMA_K(2,2*SLOTB);
  WAIT_BAR(3);
  qkt(pA0,pA1,Kbase,qr,negm,r32,hi);asm volatile("s_nop 15\n\ts_nop 7":"+v"(pA0),"+v"(pA1));CMASK(pA0,pA1,0);
  START(pA0,pA1);
  _Pragma("unroll") for(int r=0;r<16;++r)pA1[r]=__builtin_amdgcn_exp2f(pA1[r]);
  WAIT_BAR(0);
  DMA_K(3,0);DMA_V(1,SLOTB);
  ROT();
  kload8(kf,kp0+sl_cur);
  WAIT_BAR(2);
  s16x4 vlo[8],vhi[8]; u32x4 pw0,pw1,pw2,pw3;
  #define PKW(P,B) cvtpk_s(P[B],P[B+1])
  #define PAF(k) __builtin_bit_cast(bf16x8,pw##k)
  #define VFR(i) (bf16x8){vlo[i][0],vlo[i][1],vlo[i][2],vlo[i][3],vhi[i][0],vhi[i][1],vhi[i][2],vhi[i][3]}
  #define PIN(x) asm volatile("":"+v"(x))
  #define MX3(a,b,c) __builtin_fmaxf(__builtin_fmaxf((a),(b)),(c))
  #define GAPA(MF,A0,A1,A2,A3,W0,W1,PW) do{ MF; sacc+=A0; sacc+=A1; sacc+=A2; sacc+=A3; PIN(sacc); W0; W1; PIN(PW); SBAR(); }while(0)
  #define EX(v) __builtin_amdgcn_exp2f(v)
  #define GAPB(MF,X,B) do{ MF; X[B]=EX(X[B]); X[B+1]=EX(X[B+1]); X[B+2]=EX(X[B+2]); X[B+3]=EX(X[B+3]); PIN(X); SBAR(); }while(0)
  #define VRD(i) do{ vlo[i]=vtr(vp_+(((i)>>2)*4096+((i)&3)*1024)); vhi[i]=vtr(vp_+(((i)>>2)*4096+((i)&3)*1024+512)); }while(0)
  #define KRD(G,j) do{ if(G){ kload2(kf,kp0+sl_next,j); SBAR(); } }while(0)
  #define STEP(C0,C1,P0,P1,t,GK,GV,GL) do{ SBAR(); \
    const lds_cptr vp_=vp0+sl_prev; \
    VRD(0); SBAR(); float sacc=(P0[0]+P0[1]); \
    GAPA(C0=__builtin_amdgcn_mfma_f32_32x32x16_bf16(kf[0],qr[0],negm,0,0,0), P0[2],P0[3],P0[4],P0[5],     pw0[0]=PKW(P0,0), pw0[1]=PKW(P0,2), pw0); \
    VRD(4); SBAR(); GAPA(C1=__builtin_amdgcn_mfma_f32_32x32x16_bf16(kf[1],qr[0],negm,0,0,0), P0[6],P0[7],P0[8],P0[9],     pw0[2]=PKW(P0,4), pw0[3]=PKW(P0,6), pw0); \
    VRD(1); SBAR(); GAPA(C0=__builtin_amdgcn_mfma_f32_32x32x16_bf16(kf[2],qr[1],C0,0,0,0),   P0[10],P0[11],P0[12],P0[13], pw1[0]=PKW(P0,8), pw1[1]=PKW(P0,10), pw1); \
    VRD(5); SBAR(); GAPA(C1=__builtin_amdgcn_mfma_f32_32x32x16_bf16(kf[3],qr[1],C1,0,0,0),   P0[14],P0[15],P1[0],P1[1],   pw1[2]=PKW(P0,12),pw1[3]=PKW(P0,14), pw1); \
    VRD(2); SBAR(); GAPA(C0=__builtin_amdgcn_mfma_f32_32x32x16_bf16(kf[4],qr[2],C0,0,0,0),   P1[2],P1[3],P1[4],P1[5],     pw2[0]=PKW(P1,0), pw2[1]=PKW(P1,2), pw2); \
    VRD(6); SBAR(); GAPA(C1=__builtin_amdgcn_mfma_f32_32x32x16_bf16(kf[5],qr[2],C1,0,0,0),   P1[6],P1[7],P1[8],P1[9],     pw2[2]=PKW(P1,4), pw2[3]=PKW(P1,6), pw2); \
    VRD(3); SBAR(); GAPA(C0=__builtin_amdgcn_mfma_f32_32x32x16_bf16(kf[6],qr[3],C0,0,0,0),   P1[10],P1[11],P1[12],P1[13], pw3[0]=PKW(P1,8), pw3[1]=PKW(P1,10), pw3); \
    VRD(7); SBAR(); GAPA(C1=__builtin_amdgcn_mfma_f32_32x32x16_bf16(kf[7],qr[3],C1,0,0,0),   P1[14],P1[15],0.f,0.f,       pw3[2]=PKW(P1,12),pw3[3]=PKW(P1,14), pw3); \
    l_reg+=sacc; \
    if(GK){DMA_K((t)+3,sl_cur);} if(GV){DMA_V((t)+1,sl_next);} \
    CMASK(C0,C1,t); \
    { float a=MX3(C0[0],C0[1],C1[0]),b=MX3(C0[2],C0[3],C1[1]); a=MX3(a,C1[2],C1[3]); \
      _Pragma("unroll") for(int r=4;r<16;r+=4){a=MX3(a,C0[r],C0[r+1]);b=MX3(b,C0[r+2],C0[r+3]);a=MX3(a,C1[r],C1[r+1]);b=MX3(b,C1[r+2],C1[r+3]);} \
      float rm=__builtin_fmaxf(a,b); { auto rr=__builtin_amdgcn_permlane32_swap(__float_as_uint(rm),__float_as_uint(rm),false,false); rm=__builtin_fmaxf(__uint_as_float(rr[0]),__uint_as_float(rr[1])); } \
      resc=false; \
      if(__builtin_expect(__any(rm>(float)THRL),0)){ const float dl=__builtin_fmaxf(rm,0.f); mhat+=dl; \
        _Pragma("unroll") for(int r=0;r<16;++r){C0[r]-=dl;C1[r]-=dl;} \
        _Pragma("unroll") for(int r=0;r<16;++r)negm[r]=-mhat; asm volatile("":"+v"(negm)); \
        const float f=__builtin_amdgcn_exp2f(-dl); l_reg*=f; if(hi==0)wsf[r32]=f; resc=true; } } \
    SBAR(); \
    GAPB(o[0]=__builtin_amdgcn_mfma_f32_32x32x16_bf16(PAF(0),VFR(0),o[0],0,0,0), C0,0); \
    GAPB(o[1]=__builtin_amdgcn_mfma_f32_32x32x16_bf16(PAF(0),VFR(4),o[1],0,0,0), C0,4); \
    KRD(GL,0); GAPB(o[0]=__builtin_amdgcn_mfma_f32_32x32x16_bf16(PAF(1),VFR(1),o[0],0,0,0), C0,8); \
    KRD(GL,1); GAPB(o[1]=__builtin_amdgcn_mfma_f32_32x32x16_bf16(PAF(1),VFR(5),o[1],0,0,0), C0,12); \
    KRD(GL,2); GAPB(o[0]=__builtin_amdgcn_mfma_f32_32x32x16_bf16(PAF(2),VFR(2),o[0],0,0,0), C1,0); \
    KRD(GL,3); GAPB(o[1]=__builtin_amdgcn_mfma_f32_32x32x16_bf16(PAF(2),VFR(6),o[1],0,0,0), C1,4); \
    GAPB(o[0]=__builtin_amdgcn_mfma_f32_32x32x16_bf16(PAF(3),VFR(3),o[0],0,0,0), C1,8); \
    GAPB(o[1]=__builtin_amdgcn_mfma_f32_32x32x16_bf16(PAF(3),VFR(7),o[1],0,0,0), C1,12); \
    }while(0)
  int t=1;
  #undef CMASK
  #define CMASK(P0,P1,t) do{}while(0)
  for(;t+5<NT;t+=2){
    STEP(pB0,pB1,pA0,pA1,t,true,true,true);     WAIT_BAR(2); RESC(); ROT();
    STEP(pA0,pA1,pB0,pB1,t+1,true,true,true);   WAIT_BAR(2); RESC(); ROT();
  }
  #undef CMASK
  #define CMASK(P0,P1,t) do{}while(0)
  #define ENDW(tt) do{ if((tt)+3<NT){WAIT_BAR(2);} else if((tt)+2<NT){WAIT_BAR(1);} else {WAIT_BAR(0);} }while(0)
  for(;t+1<NT;t+=2){
    STEP(pB0,pB1,pA0,pA1,t,(t+3<NT),(t+1<NT),(t+1<NT));       ENDW(t);   RESC(); ROT();
    STEP(pA0,pA1,pB0,pB1,t+1,(t+4<NT),(t+2<NT),(t+2<NT));     ENDW(t+1); RESC(); ROT();
  }
  STEP(pB0,pB1,pA0,pA1,NT-1,false,false,false); RESC();
  { float sacc=pB0[0]+pB0[1]; _Pragma("unroll") for(int r=2;r<16;++r)sacc+=pB0[r]; _Pragma("unroll") for(int r=0;r<16;++r)sacc+=pB1[r]; l_reg+=sacc;
    pw0=(u32x4){PKW(pB0,0),PKW(pB0,2),PKW(pB0,4),PKW(pB0,6)};pw1=(u32x4){PKW(pB0,8),PKW(pB0,10),PKW(pB0,12),PKW(pB0,14)};pw2=(u32x4){PKW(pB1,0),PKW(pB1,2),PKW(pB1,4),PKW(pB1,6)};pw3=(u32x4){PKW(pB1,8),PKW(pB1,10),PKW(pB1,12),PKW(pB1,14)};
    SBAR(); pv(o,vb0+sl_cur,PAF(0),PAF(1),PAF(2),PAF(3)); }
  #undef PKW
  #undef PAF
  #undef VFR
  #undef PIN
  #undef MX3
  #undef GAPA
  #undef GAPB
  #undef EX
  #undef VRD
  #undef KRD
  #undef STEP
  #undef ENDW
  {auto rr=__builtin_amdgcn_permlane32_swap(__float_as_uint(l_reg),__float_as_uint(l_reg),false,false);l_reg=__uint_as_float(rr[0])+__uint_as_float(rr[1]);}
  if(hi==0)wsf[32+r32]=l_reg;asm volatile("s_waitcnt lgkmcnt(0)":::"memory");
  float rli[16];
  #pragma unroll
  for(int r=0;r<16;++r)rli[r]=__builtin_amdgcn_rcpf(wsf[32+crow(r,hi)]);
  bf16*Ow=O+(long)(qrow0+wid*QBLK)*OP+512+h*D;
  { bf16*stg=(bf16*)(shm+LDS_OST)+wid*2048;
    #pragma unroll
    for(int r=0;r<16;++r){const int orow=crow(r,hi);
      #pragma unroll
      for(int d0=0;d0<2;++d0)stg[orow*64+d0*32+r32]=__float2bfloat16(o[d0][r]*rli[r]);}
    asm volatile("s_waitcnt lgkmcnt(0)":::"memory");
    #pragma unroll
    for(int i=0;i<4;++i){const int row=i*8+(lane>>3),ch=lane&7; const u32x4 v=*(const u32x4*)(stg+row*64+ch*8); ATTN_STORE16(Ow+(long)row*OP+ch*8,v);} }
  asm volatile("s_waitcnt lgkmcnt(0)\n\ts_barrier":::"memory");
  #undef DMA_K
  #undef DMA_V
  #undef CMASK
  #undef START
  #undef RESC
  #undef ROT
}
constexpr int ATTN_LDS_BYTES=LDS_BYTES;
#undef SBAR
#undef WAIT_BAR
}
enum {
    I_X = 0, I_C, I_CTX, I_CCTX,
    I0_WMOD, I0_BMOD, I0_NMIX, I0_NFFN, I0_WIN, I0_CONVW, I0_CONVB, I0_WI, I0_BI, I0_WR, I0_BR, I0_LAM, I0_QG, I0_KG, I0_WOUT, I0_ROUTER, I0_WEG, I0_WEU, I0_WED,
    I1_WMOD, I1_BMOD, I1_NMIX, I1_NFFN, I1_MU, I1_WR, I1_WK, I1_WV, I1_W0, I1_W1, I1_W2, I1_A0, I1_A1, I1_A2, I1_G1, I1_G2, I1_KK, I1_KA, I1_RK, I1_GNG, I1_GNB, I1_WO, I1_ROUTER, I1_WEG, I1_WEU, I1_WED,
    N_IN
};
static_assert(N_IN == 49, "49 inputs");
struct KArgs { const float* in[N_IN]; float* out; unsigned char* ws; int ph_lo, ph_hi; };
#define KAREF const __attribute__((address_space(4))) KArgs&
__device__ __forceinline__ const __attribute__((address_space(4))) KArgs* ka_launder(const __attribute__((address_space(4))) KArgs* p) { asm volatile("" : "+s"(p)); return p; }

constexpr size_t MiB = 1u << 20;
constexpr size_t WS_CTL = 0;
constexpr size_t WS_BMIX = 1 * MiB;
constexpr size_t WS_B2 = 9 * MiB;
constexpr size_t ZERO_BYTES = 12 * MiB;
constexpr size_t WS_WIN = 12 * MiB;
constexpr size_t WS_WOUT = 16 * MiB;
constexpr size_t WS_WO = 18 * MiB;
constexpr size_t WS_WGATE = 20 * MiB;
constexpr size_t WS_ADA = 20 * MiB + 512 * 1024;
constexpr size_t WS_ROPE = 21 * MiB;
constexpr size_t WS_HLAST = 21 * MiB + 64 * 1024;
constexpr size_t WS_CARRY = 21 * MiB + 128 * 1024;
constexpr size_t WS_AFFL = 22 * MiB;
constexpr size_t WS_AFFC = 24 * MiB;
constexpr size_t WS_SRCROW = 25 * MiB;
constexpr size_t WS_GROW = 26 * MiB;
constexpr size_t WS_SLOTL = 27 * MiB;
constexpr size_t WS_SLOTC = 29 * MiB;
constexpr size_t WS_CTXS = 30 * MiB;
constexpr size_t WS_MOEW1 = 34 * MiB;
constexpr size_t WS_MOEW2 = 162 * MiB;
constexpr size_t WS_ACT = 226 * MiB;
constexpr size_t WS_END = WS_ACT + 749 * MiB;
constexpr size_t A_H = 0, A_XA = 66 * MiB, A_GA = 99 * MiB, A_QR = 132 * MiB, A_KR = 198 * MiB, A_KN = 215 * MiB, A_VB = 224 * MiB, A_HF = 233 * MiB, A_YCAT = 299 * MiB;
constexpr size_t A_H2 = 0, A_XE = 66 * MiB, A_HID = 202 * MiB, A_YE = 474 * MiB;
constexpr size_t A_XMIX = 0, A_RKV = 396 * MiB, A_LG = 594 * MiB, A_LWA = A_LG + (size_t)TT * 256 * 2;
constexpr size_t A_SD = 0, A_AD = 132 * MiB, A_G = 264 * MiB, A_YD0 = 660 * MiB, A_YD1 = 594 * MiB, A_O = 0;
constexpr size_t ROWB = (size_t)TT * DM * 2;

constexpr int RING_OFF = 0, RING_BYTES = 131072;
constexpr int LDSCTL_OFF = RING_BYTES, MISC_OFF = LDSCTL_OFF + 320;
constexpr int LDS_BYTES = 147456;

#define RLX_AGENT __ATOMIC_RELAXED, __HIP_MEMORY_SCOPE_AGENT
#define LDS_WAIT() asm volatile("s_waitcnt lgkmcnt(0)" ::: "memory")
#define VM_WAIT() asm volatile("s_waitcnt vmcnt(0)" ::: "memory")

#define XB_TMO      128
#define XB_XCNT(j)  (256  + 64 * (j))
#define XB_XSUB(j)  (1280 + 64 * (j))
#define XB_XGEN(j)  (2304 + 64 * (j))
#define XB_TOP      3328
#define XB_TOPGEN   3392
#define XCD_BAR_WORDS 3456
#define XB_SPIN_CAP (1u << 18)
__device__ __forceinline__ unsigned xb_ld(unsigned* p)              { return __hip_atomic_load(p, __ATOMIC_RELAXED, __HIP_MEMORY_SCOPE_AGENT); }
__device__ __forceinline__ unsigned xb_add(unsigned* p, unsigned v) { return __hip_atomic_fetch_add(p, v, __ATOMIC_RELAXED, __HIP_MEMORY_SCOPE_AGENT); }
__device__ __forceinline__ unsigned xb_xcc_id() { return (unsigned)__builtin_amdgcn_s_getreg((3 << 11) | 20) & 0xFu; }
#define XB_SPIN(cond, bar) do { unsigned _sp = 0; while (cond) { __builtin_amdgcn_s_sleep(1); \
    if ((++_sp & 255u) == 0u) { if (xb_ld(&(bar)[XB_TMO])) break; if (_sp > XB_SPIN_CAP) { atomicAdd(&(bar)[XB_TMO], 1u); break; } } } } while (0)
struct XcdBarrier { unsigned* bar; unsigned x; volatile LAS unsigned* st; };
__device__ __forceinline__ XcdBarrier xcd_barrier_post(unsigned* bar, volatile LAS unsigned* st) {
    XcdBarrier b; b.bar = bar; b.x = xb_xcc_id(); b.st = st;
    if (threadIdx.x == 0) (void)xb_add(&bar[XB_XCNT(b.x)], 1u);
    return b;
}
__device__ __forceinline__ void xcd_barrier_complete(unsigned* bar, unsigned x, unsigned& nloc, unsigned& nx) {
    const unsigned G = gridDim.x * gridDim.y * gridDim.z;
    unsigned sum, cnt, mine, sp = 0u;
    for (;;) {
        sum = 0u; cnt = 0u; mine = 0u;
#pragma unroll
        for (unsigned j = 0; j < 16; ++j) { const unsigned c = xb_ld(&bar[XB_XCNT(j)]); sum += c; cnt += (c > 0u) ? 1u : 0u; mine = (j == x) ? c : mine; }
        if (sum == G) break;
        __builtin_amdgcn_s_sleep(1);
        if ((++sp & 255u) == 0u) { if (xb_ld(&bar[XB_TMO])) break; if (sp > XB_SPIN_CAP) { atomicAdd(&bar[XB_TMO], 1u); break; } }
    }
    nloc = mine > 0u ? mine : 1u; nx = cnt > 0u ? cnt : 1u;
}
__device__ __forceinline__ void xcd_barrier(const XcdBarrier& b) {
    asm volatile("s_waitcnt vmcnt(0)" ::: "memory");
    __syncthreads();
    if (threadIdx.x == 0) {
        unsigned* bar = b.bar;
        __builtin_amdgcn_s_waitcnt(0);
        unsigned nloc = b.st[0], nx = b.st[1];
        if (nloc == 0u) { xcd_barrier_complete(bar, b.x, nloc, nx); b.st[0] = nloc; b.st[1] = nx; }
        const unsigned old = xb_add(&bar[XB_XSUB(b.x)], 1u);
        const unsigned gen = old / nloc;
        if (old + 1u == (gen + 1u) * nloc) {
            __builtin_amdgcn_fence(__ATOMIC_RELEASE, "agent");
            asm volatile("s_waitcnt vmcnt(0)" ::: "memory");
            const unsigned og = xb_add(&bar[XB_TOP], 1u);
            const unsigned tg = og / nx;
            if (og + 1u == (tg + 1u) * nx) xb_add(&bar[XB_TOPGEN], 1u);
            else XB_SPIN(xb_ld(&bar[XB_TOPGEN]) == tg, bar);
            __builtin_amdgcn_fence(__ATOMIC_ACQUIRE, "agent");
            xb_add(&bar[XB_XGEN(b.x)], 1u);
            asm volatile("s_waitcnt vmcnt(0)" ::: "memory");
        } else {
            XB_SPIN(xb_ld(&bar[XB_XGEN(b.x)]) == gen, bar);
            __builtin_amdgcn_fence(__ATOMIC_ACQUIRE, "agent");
            asm volatile("s_waitcnt vmcnt(0)" ::: "memory");
        }
    }
    __syncthreads();
}

__device__ __forceinline__ const float* ada_ptr(const unsigned char* ws, int layer, int r, int chunk) { return (const float*)(ws + WS_ADA) + (size_t)(layer * 5 + r) * 6144 + chunk * 1024; }
__device__ __forceinline__ int kv_row(int m) { return m < TL ? ((m >> 13) * KVL + (m & 8191)) : (((m - TL) >> 8) * KVL + SEQ + ((m - TL) & 255)); }
__device__ __forceinline__ int mod_row(int m) { return m < TL ? (m >> 13) : 4; }
__device__ __forceinline__ int block_excl_scan(int v, LAS int* tmp, int& total) {
    const int lane = threadIdx.x & 63, w = threadIdx.x >> 6;
    int inc = v;
#pragma unroll
    for (int o = 1; o < 64; o <<= 1) { const int t = __shfl_up(inc, o); if (lane >= o) inc += t; }
    if (lane == 63) tmp[w] = inc;
    __syncthreads();
    int base = 0, tot = 0;
#pragma unroll
    for (int i = 0; i < 8; ++i) { const int t = tmp[i]; if (i < w) base += t; tot += t; }
    __syncthreads();
    total = tot;
    return base + inc - v;
}
__device__ __forceinline__ void tr_item(const float* W, int Krows, int ldw, bf16_t* dst, long drow0, int ldd, int dk0, LAS float* scr, int k0, int n0, int lane) {
    float ld[32];
#pragma unroll
    for (int i = 0; i < 32; ++i) { const int k = k0 + 2 * i + (lane >> 5); ld[i] = (k < Krows) ? W[(size_t)k * ldw + n0 + (lane & 31)] : 0.f; }
#pragma unroll
    for (int i = 0; i < 32; ++i) scr[(2 * i + (lane >> 5)) * 33 + (lane & 31)] = ld[i];
    LDS_WAIT(); asm volatile("" ::: "memory");
    const int c = lane & 7;
#pragma unroll
    for (int j = 0; j < 4; ++j) { const int n = (lane >> 3) + 8 * j; const LAS float* s = scr + (8 * c) * 33 + n;
        u32x4 o; o.x = cvt_pk_bf16(s[0 * 33], s[1 * 33]); o.y = cvt_pk_bf16(s[2 * 33], s[3 * 33]); o.z = cvt_pk_bf16(s[4 * 33], s[5 * 33]); o.w = cvt_pk_bf16(s[6 * 33], s[7 * 33]);
        *(u32x4*)(dst + (size_t)(drow0 + n) * ldd + dk0 + k0 + 8 * c) = o; }
    LDS_WAIT(); asm volatile("" ::: "memory");
}
__device__ __forceinline__ void tr_item_fp8(const float* W, int ldw, unsigned char* dst, long drow0, int ldd, LAS float* scr, int k0, int n0, int lane, float scale) {
    float ld[32];
#pragma unroll
    for (int i = 0; i < 32; ++i) ld[i] = W[(size_t)(k0 + 2 * i + (lane >> 5)) * ldw + n0 + (lane & 31)];
#pragma unroll
    for (int i = 0; i < 32; ++i) scr[(2 * i + (lane >> 5)) * 33 + (lane & 31)] = ld[i] * scale;
    LDS_WAIT(); asm volatile("" ::: "memory");
    const int c = lane & 7;
#pragma unroll
    for (int j = 0; j < 4; ++j) { const int n = (lane >> 3) + 8 * j; const LAS float* s = scr + (8 * c) * 33 + n;
        u32x2 o; o.x = pk_fp8x4(s[0 * 33], s[1 * 33], s[2 * 33], s[3 * 33]); o.y = pk_fp8x4(s[4 * 33], s[5 * 33], s[6 * 33], s[7 * 33]);
        *(u32x2*)(dst + (size_t)(drow0 + n) * ldd + k0 + 8 * c) = o; }
    LDS_WAIT(); asm volatile("" ::: "memory");
}
constexpr float W8_SCALE = 32.0f;
__device__ __forceinline__ void moe_convert(KAREF A, int layer, LAS unsigned char* lds, int gw, int ngw, int wave, int lane) {
    LAS float* scr = (LAS float*)(lds + RING_OFF + wave * 16384);
    const float* WG = A.in[layer ? I1_WEG : I0_WEG]; const float* WU = A.in[layer ? I1_WEU : I0_WEU]; const float* WD = A.in[layer ? I1_WED : I0_WED];
    unsigned char* B1 = A.ws + WS_MOEW1; unsigned char* B2 = A.ws + WS_MOEW2;
    constexpr int I_GU = 32 * 1024, I_D = 16 * 1024;
    for (int it = gw; it < I_GU + I_D; it += ngw) {
        if (it < I_GU) { const int mi = it >> 10, e = mi >> 1, which = mi & 1, w = it & 1023, kb = w >> 6, nb = w & 63, n0 = 32 * nb;
            tr_item_fp8((which ? WU : WG) + (size_t)e * DM * FF, FF, B1 + (size_t)e * 4096 * DM, (long)((n0 >> 7) * 256 + (n0 & 127) + which * 128), DM, scr, 64 * kb, n0, lane, W8_SCALE); }
        else { const int r = it - I_GU, e = r >> 10, w = r & 1023, kb = w >> 5, nb = w & 31;
            tr_item_fp8(WD + (size_t)e * FF * DM, DM, B2 + (size_t)e * DM * FF, (long)(32 * nb), FF, scr, 64 * kb, 32 * nb, lane, W8_SCALE); }
    }
}
__device__ __forceinline__ void p0_prologue(KAREF A, LAS unsigned char* lds, int G) {
    const int tid = threadIdx.x, lane = tid & 63, wave = __builtin_amdgcn_readfirstlane(tid >> 6);
    const int gw = blockIdx.x * 8 + wave, ngw = G * 8;
    LAS float* scr = (LAS float*)(lds + RING_OFF + wave * 16384);
    unsigned char* ws = A.ws;
    bf16_t* BMIX = (bf16_t*)(ws + WS_BMIX); bf16_t* B2 = (bf16_t*)(ws + WS_B2);
    constexpr int NJ = 19;
    for (int it = gw; ; it += ngw) {
        int r = it; const float* W = nullptr; int Kr = 0, N = 0, ldd = 0, dk0 = 0; long drow = 0; bf16_t* dst = nullptr; bool found = false;
#define JOB(Wp, KR, NN, DST, DROW, LDD, DK0) if (!found) { const int cnt = (((KR) + 63) / 64) * ((NN) / 32); if (r < cnt) { W = (Wp); Kr = (KR); N = (NN); dst = (DST); drow = (DROW); ldd = (LDD); dk0 = (DK0); found = true; } else r -= cnt; }
        JOB(A.in[I0_WIN], DM, 1792, (bf16_t*)(ws + WS_WIN), 0, DM, 0)
        JOB(A.in[I0_WOUT], DM, DM, (bf16_t*)(ws + WS_WOUT), 0, DM, 0)
        JOB(A.in[I1_WR], DM, DM, BMIX, 0, DM, 0)
        JOB(A.in[I1_WK], DM, DM, BMIX, 1024, DM, 0)
        JOB(A.in[I1_WV], DM, DM, BMIX, 2048, DM, 0)
        JOB(A.in[I1_G1], DM, 160, BMIX, 3072, DM, 0)
        JOB(A.in[I1_W1], DM, 64, BMIX, 3328, DM, 0)
        JOB(A.in[I1_W1] + DM * 64, DM, 64, BMIX, 3328 + 64, DM, 0)
        JOB(A.in[I1_A1], DM, 64, BMIX, 3584, DM, 0)
        JOB(A.in[I1_A1] + DM * 64, DM, 64, BMIX, 3584 + 64, DM, 0)
        JOB(A.in[I1_W2], 64, DM, B2, 0, 256, 0)
        JOB(A.in[I1_W2] + 64 * DM, 64, DM, B2, 1024, 256, 64)
        JOB(A.in[I1_A2], 64, DM, B2, 2048, 256, 128)
        JOB(A.in[I1_A2] + 64 * DM, 64, DM, B2, 3072, 256, 192)
        JOB(A.in[I1_G2], 160, DM, B2, 4096, 256, 0)
        JOB(A.in[I1_WO], DM, DM, (bf16_t*)(ws + WS_WO), 0, DM, 0)
#undef JOB
        if (!found) {
            if (r >= 128) break;
            const int pair = r >> 2, which = (r >> 1) & 1, nb = r & 1;
            W = A.in[which ? I0_WR : I0_WI] + (size_t)pair * 64 * 64; Kr = 64; N = 64; dst = (bf16_t*)(ws + WS_WGATE); drow = (long)pair * 128 + which * 64 + 32 * nb; ldd = 64; dk0 = 0;
            tr_item(W, Kr, N, dst, drow, ldd, dk0, scr, 0, 32 * nb, lane);
            continue;
        }
        const int nblk = N / 32, kb = r / nblk, nb = r % nblk;
        tr_item(W, Kr, N, dst, drow + 32 * nb, ldd, dk0, scr, 64 * kb, 32 * nb, lane);
    }
    (void)NJ;
    moe_convert(A, 0, lds, gw, ngw, wave, lane);
    __syncthreads();
    if (blockIdx.x < 192) {
        const int layer = blockIdx.x / 96, cb = blockIdx.x % 96, col = cb * 64 + lane;
        LAS float* sil = (LAS float*)(lds);
        LAS float* part = (LAS float*)(lds + 32768);
        for (int i = tid; i < 5 * 1024; i += 512) { const int rr = i >> 10, k = i & 1023; const float v = rr < 4 ? A.in[I_C][rr * 1024 + k] : A.in[I_CCTX][k]; sil[i] = v / (1.0f + expf(-v)); }
        __syncthreads();
        const float* wm = A.in[layer ? I1_WMOD : I0_WMOD];
        float acc[5] = {0.f, 0.f, 0.f, 0.f, 0.f};
        for (int k = wave * 128; k < wave * 128 + 128; ++k) { const float wv = wm[(size_t)k * 6144 + col];
#pragma unroll
            for (int rr = 0; rr < 5; ++rr) acc[rr] += sil[rr * 1024 + k] * wv; }
#pragma unroll
        for (int rr = 0; rr < 5; ++rr) part[(wave * 5 + rr) * 64 + lane] = acc[rr];
        __syncthreads();
        if (tid < 320) { const int rr = tid >> 6, l = tid & 63; float s = 0.f;
#pragma unroll
            for (int w = 0; w < 8; ++w) s += part[(w * 5 + rr) * 64 + l];
            ((float*)(ws + WS_ADA))[(size_t)(layer * 5 + rr) * 6144 + cb * 64 + l] = s + A.in[layer ? I1_BMOD : I0_BMOD][cb * 64 + l]; }
        __syncthreads();
    }
    if (blockIdx.x == G - 1) {
        float* tab = (float*)(ws + WS_ROPE);
        for (int i = tid; i < 192 * 16; i += 512) {
            const int pos = i >> 4, f = i & 15; const int p = pos < 128 ? pos : pos - 128;
            double inv = 1.0; for (int q = 0; q < f; ++q) inv *= 0.5623413251903491;
            const float invf = (float)inv;
            const float angf = (float)p * invf;
            double x = (double)angf; const double n = rint(x * 0.15915494309189535); x -= n * 6.283185307179586477;
            const double x2 = x * x; double sn = 0.0, cs = 0.0;
            for (int t = 27; t >= 1; t -= 2) sn = sn * x2 * (-1.0 / ((double)(t + 1) * (double)(t + 2))) + 1.0;
            for (int t = 26; t >= 0; t -= 2) cs = cs * x2 * (-1.0 / ((double)(t + 1) * (double)(t + 2))) + 1.0;
            tab[pos * 32 + f] = (float)cs; tab[pos * 32 + 16 + f] = (float)(sn * x);
        }
    }
}
__device__ __forceinline__ void norm_mod_row(const float* xr, const float* gain, const float* sh, const float* sc, bf16_t* orow, int lane) {
    f32x4 v[4]; float ss = 0.f;
#pragma unroll
    for (int j = 0; j < 4; ++j) { v[j] = *(const f32x4*)(xr + 4 * (lane + 64 * j)); ss += (v[j].x * v[j].x + v[j].y * v[j].y) + (v[j].z * v[j].z + v[j].w * v[j].w); }
    const float rs = __builtin_amdgcn_rsqf(wave_sum(ss) * (1.f / DM) + 1e-6f);
#pragma unroll
    for (int j = 0; j < 4; ++j) { const int col = 4 * (lane + 64 * j);
        const f32x4 g = *(const f32x4*)(gain + col), a = *(const f32x4*)(sc + col), b = *(const f32x4*)(sh + col);
        const f32x4 y = v[j] * rs * g * (a + 1.0f) + b;
        u32x2 w; w.x = cvt_pk_bf16(y.x, y.y); w.y = cvt_pk_bf16(y.z, y.w);
        *(u32x2*)(orow + col) = w; }
}
__device__ __forceinline__ const float* xs_row(KAREF A, int m) { return m < TL ? A.out + (size_t)m * DM : (const float*)(A.ws + WS_CTXS) + (size_t)(m - TL) * DM; }
__device__ __forceinline__ float* xs_row_w(KAREF A, int m) { return m < TL ? A.out + (size_t)m * DM : (float*)(A.ws + WS_CTXS) + (size_t)(m - TL) * DM; }

__device__ __forceinline__ void p1_norm0(KAREF A, int G) {
    const int lane = threadIdx.x & 63, wave = threadIdx.x >> 6, gw = blockIdx.x * 8 + wave, ngw = G * 8;
    bf16_t* H = (bf16_t*)(A.ws + WS_ACT + A_H);
    f32x4 gq[4], aq[4], bq[4], vn[4]; int rcur = -1;
#pragma unroll
    for (int j = 0; j < 4; ++j) gq[j] = *(const f32x4*)(A.in[I0_NMIX] + 4 * (lane + 64 * j));
#define P1_ROW(M) ((M) < TL ? A.in[I_X] + (size_t)(M) * DM : A.in[I_CTX] + (size_t)((M) - TL) * DM)
    { const int m0 = gw < TT ? gw : 0; const float* x0 = P1_ROW(m0);
#pragma unroll
      for (int j = 0; j < 4; ++j) vn[j] = *(const f32x4*)(x0 + 4 * (lane + 64 * j)); }
    for (int m = gw; m < TT; m += ngw) {
        const int r = mod_row(m);
        if (r != rcur) { const float* sh = ada_ptr(A.ws, 0, r, 0); const float* sc = ada_ptr(A.ws, 0, r, 1); rcur = r;
#pragma unroll
            for (int j = 0; j < 4; ++j) { bq[j] = *(const f32x4*)(sh + 4 * (lane + 64 * j)); aq[j] = *(const f32x4*)(sc + 4 * (lane + 64 * j)); } }
        f32x4 v[4]; float ss = 0.f;
#pragma unroll
        for (int j = 0; j < 4; ++j) v[j] = vn[j];
        { const int mn = m + ngw < TT ? m + ngw : m; const float* xn = P1_ROW(mn);
#pragma unroll
          for (int j = 0; j < 4; ++j) vn[j] = *(const f32x4*)(xn + 4 * (lane + 64 * j)); }
#pragma unroll
        for (int j = 0; j < 4; ++j) ss += (v[j].x * v[j].x + v[j].y * v[j].y) + (v[j].z * v[j].z + v[j].w * v[j].w);
        const float rs = __builtin_amdgcn_rsqf(wave_sum(ss) * (1.f / DM) + 1e-6f);
#pragma unroll
        for (int j = 0; j < 4; ++j) { const int col = 4 * (lane + 64 * j); const f32x4 y = v[j] * rs * gq[j] * (aq[j] + 1.0f) + bq[j];
            u32x2 w; w.x = cvt_pk_bf16(y.x, y.y); w.y = cvt_pk_bf16(y.z, y.w);
            *(u32x2*)(H + (size_t)m * DM + col) = w; }
    }
#undef P1_ROW
}

struct EpiWin {
    static constexpr bool PERM = true;
    bf16_t* XA; bf16_t* GA; float* QR; float* KR; bf16_t* VB;
    __device__ __forceinline__ void operator()(const f32x4 (&acc)[2][2][4][2], const pg8::Unit& u, int wr, int wc, int fr, int fq) const {
        const int row0 = u.pm * 256 + wr * 64 + fr, tile = u.pn;
#pragma unroll
        for (int ai = 0; ai < 2; ++ai)
#pragma unroll
            for (int m = 0; m < 4; ++m) { const int row = row0 + ai * 128 + m * 16;
#pragma unroll
                for (int bj = 0; bj < 2; ++bj) { const int colt = bj * 128 + wc * 32 + 8 * fq; const f32x4 v0 = acc[ai][bj][m][0], v1 = acc[ai][bj][m][1];
                    u32x4 w; w.x = cvt_pk_bf16(v0[0], v0[1]); w.y = cvt_pk_bf16(v0[2], v0[3]); w.z = cvt_pk_bf16(v1[0], v1[1]); w.w = cvt_pk_bf16(v1[2], v1[3]);
                    if (tile < 2) *(u32x4*)(XA + (size_t)row * 512 + tile * 256 + colt) = w;
                    else if (tile < 4) *(u32x4*)(GA + (size_t)row * 512 + (tile - 2) * 256 + colt) = w;
                    else if (tile < 6) { float* p = QR + (size_t)row * 512 + (tile - 4) * 256 + colt; *(f32x4*)p = v0; *(f32x4*)(p + 4) = v1; }
                    else if (bj == 0) { float* p = KR + (size_t)row * 128 + colt; *(f32x4*)p = v0; *(f32x4*)(p + 4) = v1; }
                    else *(u32x4*)(VB + (size_t)kv_row(row) * 128 + (colt - 128)) = w; } }
    }
};

__device__ __forceinline__ void p5_ctx_outproj(KAREF A, int G) {
    const int tid = threadIdx.x, lane = tid & 63, wave = tid >> 6, fr = lane & 15, fq = lane >> 4;
    const bf16_t* Y = (const bf16_t*)(A.ws + WS_ACT + A_YCAT) + (size_t)TL * DM; const bf16_t* W = (const bf16_t*)(A.ws + WS_WOUT);
    const float* gate = ada_ptr(A.ws, 0, 4, 2); const float* src = A.in[I_CTX]; float* dst = (float*)(A.ws + WS_CTXS);
    for (int tile = blockIdx.x; tile < (TC / 64) * (DM / 64); tile += G) {
        const int r0 = (tile >> 4) * 64 + (wave >> 1) * 16, c0 = (tile & 15) * 64 + (wave & 1) * 32;
        const bf16_t* ap = Y + (size_t)(r0 + fr) * DM + 8 * fq; const bf16_t* bp0 = W + (size_t)(c0 + fr) * DM + 8 * fq; const bf16_t* bp1 = bp0 + (size_t)16 * DM;
        f32x4 acc0 = (f32x4){0.f, 0.f, 0.f, 0.f}, acc1 = acc0;
#pragma unroll 8
        for (int k0 = 0; k0 < DM; k0 += 32) { const bf16x8 a = *(const bf16x8*)(ap + k0), b0 = *(const bf16x8*)(bp0 + k0), b1 = *(const bf16x8*)(bp1 + k0);
            acc0 = __builtin_amdgcn_mfma_f32_16x16x32_bf16(a, b0, acc0, 0, 0, 0); acc1 = __builtin_amdgcn_mfma_f32_16x16x32_bf16(a, b1, acc1, 0, 0, 0); }
        const float g0 = gate[c0 + fr], g1 = gate[c0 + 16 + fr];
#pragma unroll
        for (int r = 0; r < 4; ++r) { const size_t o = (size_t)(r0 + 4 * fq + r) * DM + c0 + fr; dst[o] = src[o] + g0 * acc0[r]; dst[o + 16] = src[o + 16] + g1 * acc1[r]; }
    }
}

__device__ __forceinline__ void p3_kprep(KAREF A, int G) {
    const int lane = threadIdx.x & 63, wave = threadIdx.x >> 6, gw = blockIdx.x * 8 + wave, ngw = G * 8;
    const float* KR = (const float*)(A.ws + WS_ACT + A_KR); bf16_t* KN = (bf16_t*)(A.ws + WS_ACT + A_KN); const float* tab = (const float*)(A.ws + WS_ROPE);
    const int head = lane >> 5, p = lane & 31;
    const float g0 = A.in[I0_KG][2 * p], g1 = A.in[I0_KG][2 * p + 1];
    for (int m0 = gw; m0 < TT; m0 += 4 * ngw) {
        f32x2 v[4]; float cs[4], sn[4]; int mm[4]; bool ok[4];
#pragma unroll
        for (int q = 0; q < 4; ++q) { const int m = m0 + q * ngw; ok[q] = m < TT; mm[q] = ok[q] ? m : m0; v[q] = *(const f32x2*)(KR + (size_t)mm[q] * 128 + head * 64 + 2 * p);
            cs[q] = 1.f; sn[q] = 0.f;
            if (mm[q] < TL) { const int t = mm[q] & 8191; const float* tb = tab + (p < 16 ? (t >> 6) : 128 + (t & 63)) * 32 + (p & 15); cs[q] = tb[0]; sn[q] = tb[16]; } }
#pragma unroll
        for (int q = 0; q < 4; ++q) {
            float ss = v[q].x * v[q].x + v[q].y * v[q].y;
#pragma unroll
            for (int o = 1; o < 32; o <<= 1) ss += __shfl_xor(ss, o);
            const float rs = __builtin_amdgcn_rsqf(ss * (1.f / 64.f) + 1e-6f);
            const float x1 = v[q].x * rs * g0, x2 = v[q].y * rs * g1;
            const float y0 = x1 * cs[q] - x2 * sn[q], y1 = x1 * sn[q] + x2 * cs[q];
            if (ok[q]) *(unsigned*)(KN + (size_t)kv_row(mm[q]) * 128 + head * 64 + 2 * p) = cvt_pk_bf16(y0, y1); }
    }
}

constexpr int L_XCF = 0, L_XCB = 17408, L_WG = 26624, L_AB = 45056, L_SC = 78336, L_CAR = 82432, L_PAR = 82944;
template <int MODE>
__device__ __forceinline__ void lru_dir(KAREF A, LAS unsigned char* lds, int d, int n, int seqrow0, int L, int t_begin, int t_end, float h0, float& h_end, float& a_prod) {
    const int tid = threadIdx.x, lane = tid & 63, wid = tid >> 6;
    LAS float* XCF = (LAS float*)(lds + L_XCF);
    LAS bf16_t* XCB = (LAS bf16_t*)(lds + L_XCB);
    LAS bf16_t* WGl = (LAS bf16_t*)(lds + L_WG);
    LAS f32x2* AB = (LAS f32x2*)(lds + L_AB);
    LAS f32x2* SC = (LAS f32x2*)(lds + L_SC);
    LAS float* CAR = (LAS float*)(lds + L_CAR);
    LAS float* PAR = (LAS float*)(lds + L_PAR);
    const bf16_t* XA = (const bf16_t*)(A.ws + WS_ACT + A_XA); const bf16_t* GA = (const bf16_t*)(A.ws + WS_ACT + A_GA);
    float* HF = (float*)(A.ws + WS_ACT + A_HF); bf16_t* YCAT = (bf16_t*)(A.ws + WS_ACT + A_YCAT);
    __syncthreads();
    { const bf16_t* src = (const bf16_t*)(A.ws + WS_WGATE) + (size_t)(d * 8 + n) * 128 * 64; const int row = tid >> 2, part = tid & 3;
      const u32x4 w0 = *(const u32x4*)(src + row * 64 + part * 16), w1 = *(const u32x4*)(src + row * 64 + part * 16 + 8);
      *(LAS u32x4*)(WGl + row * 72 + part * 16) = w0; *(LAS u32x4*)(WGl + row * 72 + part * 16 + 8) = w1; }
    if (tid < 64) { const int c = tid, ch = 64 * n + c;
#pragma unroll
        for (int j = 0; j < 4; ++j) PAR[j * 64 + c] = A.in[I0_CONVW][j * 512 + ch];
        PAR[256 + c] = A.in[I0_CONVB][ch]; PAR[320 + c] = A.in[I0_BI][d * 512 + ch]; PAR[384 + c] = A.in[I0_BR][d * 512 + ch];
        const float lam = A.in[I0_LAM][d * 512 + ch]; PAR[448 + c] = -8.0f * log1pf(expf(-lam));
        CAR[c] = h0; }
    __syncthreads();
    const int nsub = (t_end - t_begin) >> 6; float ap = 1.f, hfin = 0.f; int par = 0;
#define LRU_BAR() do { LDS_WAIT(); __builtin_amdgcn_s_barrier(); asm volatile("" ::: "memory"); } while (0)
    u32x4 xw[4];
#define LRU_PREFETCH(SI) do { const int t0_ = t_begin + (d ? nsub - 1 - (SI) : (SI)) * 64; _Pragma("unroll") for (int j = 0; j < 4; ++j) { const int ts = t0_ + (tid >> 3) + j - 2; \
        xw[j] = (ts >= 0 && ts < L) ? *(const u32x4*)(XA + (size_t)(seqrow0 + ts) * 512 + 64 * n + (tid & 7) * 8) : (u32x4){0u, 0u, 0u, 0u}; } } while (0)
    LRU_PREFETCH(0);
    float cw8[4][8], cb8[8];
    { const int ch8 = (tid & 7) * 8;
#pragma unroll
      for (int i = 0; i < 8; ++i) { cb8[i] = PAR[256 + ch8 + i];
#pragma unroll
          for (int j = 0; j < 4; ++j) cw8[j][i] = PAR[j * 64 + ch8 + i]; } }
    for (int si = 0; si < nsub; ++si) {
        const int t0 = t_begin + (d ? nsub - 1 - si : si) * 64;
        { const int tt = tid >> 3, ch8 = (tid & 7) * 8; float a8[8];
#pragma unroll
          for (int i = 0; i < 8; ++i) a8[i] = cb8[i];
#pragma unroll
          for (int j = 0; j < 4; ++j) {
              { const u32x4 w = xw[j];
                  a8[0] += cw8[j][0] * bflo(w.x); a8[1] += cw8[j][1] * bfhi(w.x); a8[2] += cw8[j][2] * bflo(w.y); a8[3] += cw8[j][3] * bfhi(w.y);
                  a8[4] += cw8[j][4] * bflo(w.z); a8[5] += cw8[j][5] * bfhi(w.z); a8[6] += cw8[j][6] * bflo(w.w); a8[7] += cw8[j][7] * bfhi(w.w); } }
          *(LAS f32x4*)(XCF + tt * 68 + ch8) = (f32x4){a8[0], a8[1], a8[2], a8[3]}; *(LAS f32x4*)(XCF + tt * 68 + ch8 + 4) = (f32x4){a8[4], a8[5], a8[6], a8[7]};
          u32x4 o; o.x = cvt_pk_bf16(a8[0], a8[1]); o.y = cvt_pk_bf16(a8[2], a8[3]); o.z = cvt_pk_bf16(a8[4], a8[5]); o.w = cvt_pk_bf16(a8[6], a8[7]);
          *(LAS u32x4*)(XCB + tt * 72 + ch8) = o; }
        if (si + 1 < nsub) LRU_PREFETCH(si + 1);
        LRU_BAR();
        { const int mt = wid & 3, half = wid >> 2, fr = lane & 15, fq = lane >> 4;
          const bf16x8 a0 = *(const LAS bf16x8*)(XCB + (mt * 16 + fr) * 72 + 8 * fq), a1 = *(const LAS bf16x8*)(XCB + (mt * 16 + fr) * 72 + 32 + 8 * fq);
#pragma unroll
          for (int q = 0; q < 2; ++q) { const int cbase = 32 * half + 16 * q, c = cbase + fr;
              const bf16x8 bi0 = *(const LAS bf16x8*)(WGl + (cbase + fr) * 72 + 8 * fq), bi1 = *(const LAS bf16x8*)(WGl + (cbase + fr) * 72 + 32 + 8 * fq);
              const bf16x8 br0 = *(const LAS bf16x8*)(WGl + (64 + cbase + fr) * 72 + 8 * fq), br1 = *(const LAS bf16x8*)(WGl + (64 + cbase + fr) * 72 + 32 + 8 * fq);
              f32x4 gi = __builtin_amdgcn_mfma_f32_16x16x32_bf16(a0, bi0, (f32x4){0.f, 0.f, 0.f, 0.f}, 0, 0, 0); gi = __builtin_amdgcn_mfma_f32_16x16x32_bf16(a1, bi1, gi, 0, 0, 0);
              f32x4 gr = __builtin_amdgcn_mfma_f32_16x16x32_bf16(a0, br0, (f32x4){0.f, 0.f, 0.f, 0.f}, 0, 0, 0); gr = __builtin_amdgcn_mfma_f32_16x16x32_bf16(a1, br1, gr, 0, 0, 0);
              const float bic = PAR[320 + c], brc = PAR[384 + c], lsl = PAR[448 + c];
#pragma unroll
              for (int j = 0; j < 4; ++j) { const int tt = mt * 16 + 4 * fq + j; const float xcv = XCF[tt * 68 + c];
                  const float ig = sigm(gi[j] + bic), rg = sigm(gr[j] + brc), la = rg * lsl, av = fexp(la);
                  const float bb = __builtin_amdgcn_sqrtf(fmaxf(1.0f - av * av, 0.f)) * ig * xcv;
                  AB[tt * 65 + c] = (f32x2){av, bb}; } } }
        LRU_BAR();
        { const int c = tid & 63, sc = wid; float av[8], bv[8]; float Al = 1.f, Hl = 0.f;
#pragma unroll
          for (int i = 0; i < 8; ++i) { const int p = 8 * sc + i, tt = d ? 63 - p : p; const f32x2 ab = AB[tt * 65 + c]; av[i] = ab.x; bv[i] = ab.y; Hl = ab.x * Hl + ab.y; Al *= ab.x; }
          SC[sc * 64 + c] = (f32x2){Al, Hl};
          float hfv[8], gav[8];
          if (MODE == 2) {
#pragma unroll
              for (int i = 0; i < 8; ++i) { const int p = 8 * sc + i, tt = d ? 63 - p : p; const size_t row = (size_t)(seqrow0 + t0 + tt);
                  hfv[i] = __hip_atomic_load(HF + row * 512 + 64 * n + c, RLX_AGENT); gav[i] = bf2f(GA[row * 512 + 64 * n + c]); } }
          LRU_BAR();
          float h = CAR[par * 64 + c]; float apl = 1.f;
#pragma unroll
          for (int s2 = 0; s2 < 8; ++s2) { const f32x2 t = SC[s2 * 64 + c]; if (s2 < sc) h = t.x * h + t.y; apl *= t.x; }
          if (MODE == 0) { h = Al * h + Hl; }
          else {
#pragma unroll
              for (int i = 0; i < 8; ++i) { h = av[i] * h + bv[i]; const int p = 8 * sc + i, tt = d ? 63 - p : p; const size_t row = (size_t)(seqrow0 + t0 + tt);
                  if (MODE == 1) HF[row * 512 + 64 * n + c] = h;
                  else { const float hf = hfv[i]; const float g = gav[i];
                      const float y = (h + hf) * gelu_tanh(g); YCAT[row * 1024 + 64 * n + c] = (bf16_t)(cvt_pk_bf16(y, 0.f) & 0xffffu); } } }
          if (sc == 7) { CAR[(par ^ 1) * 64 + c] = h; ap *= apl; hfin = h; }
          par ^= 1; }
    }
#undef LRU_PREFETCH
#undef LRU_BAR
    h_end = hfin; a_prod = ap;
}
__device__ __forceinline__ void p3_lru_pass1(KAREF A, LAS unsigned char* lds, int G) {
    const int tid = threadIdx.x, c = tid & 63;
    f32x2* CARRY = (f32x2*)(A.ws + WS_CARRY); float* HLAST = (float*)(A.ws + WS_HLAST);
    for (int u = blockIdx.x; u < 256 + 32; u += G) {
        float he, ap;
        if (u < 256) { const int b = u >> 6, n = (u >> 3) & 7, s = u & 7;
#pragma unroll 1
            for (int d = 0; d < 2; ++d) { lru_dir<0>(A, lds, d, n, b * SEQ, SEQ, s * 1024, s * 1024 + 1024, 0.f, he, ap);
                if (tid >= 448) CARRY[(size_t)((b * 8 + s) * 2 + d) * 512 + 64 * n + c] = (f32x2){ap, he}; } }
        else { const int v = u - 256, b = v >> 3, n = v & 7;
            lru_dir<1>(A, lds, 0, n, TL + b * CTXL, CTXL, 0, CTXL, 0.f, he, ap);
            if (tid >= 448) HLAST[(b * 2 + 0) * 512 + 64 * n + c] = he;
            VM_WAIT(); __syncthreads();
            lru_dir<2>(A, lds, 1, n, TL + b * CTXL, CTXL, 0, CTXL, 0.f, he, ap);
            if (tid >= 448) HLAST[(b * 2 + 1) * 512 + 64 * n + c] = he; }
    }
}
__device__ __forceinline__ void p4_lru_pass2(KAREF A, LAS unsigned char* lds, int G) {
    const int tid = threadIdx.x, c = tid & 63;
    const f32x2* CARRY = (const f32x2*)(A.ws + WS_CARRY); const float* HLAST = (const float*)(A.ws + WS_HLAST);
    for (int u = blockIdx.x; u < 256; u += G) {
        const int b = u >> 6, n = (u >> 3) & 7, s = u & 7; float he, ap;
        float hf0 = HLAST[(b * 2 + 0) * 512 + 64 * n + c], hb0 = HLAST[(b * 2 + 1) * 512 + 64 * n + c];
        for (int s2 = 0; s2 < s; ++s2) { const f32x2 t = CARRY[(size_t)((b * 8 + s2) * 2 + 0) * 512 + 64 * n + c]; hf0 = t.x * hf0 + t.y; }
        for (int s2 = 7; s2 > s; --s2) { const f32x2 t = CARRY[(size_t)((b * 8 + s2) * 2 + 1) * 512 + 64 * n + c]; hb0 = t.x * hb0 + t.y; }
        lru_dir<1>(A, lds, 0, n, b * SEQ, SEQ, s * 1024, s * 1024 + 1024, hf0, he, ap);
        VM_WAIT(); __syncthreads();
        lru_dir<2>(A, lds, 1, n, b * SEQ, SEQ, s * 1024, s * 1024 + 1024, hb0, he, ap);
    }
}

struct EpiResid {
    static constexpr bool PERM = false;
    const float* src_lat; const float* src_ctx; float* dst_lat; float* dst_ctx; const float* gate;
    __device__ __forceinline__ void operator()(const f32x4 (&acc)[2][2][4][2], const pg8::Unit& u, int wr, int wc, int fr, int fq) const {
        const int row0 = u.pm * 256 + wr * 64 + fr, col0 = u.pn * 256 + wc * 32 + 4 * fq;
        const bool lat = u.pm < TL / 256; const int r = lat ? (u.pm >> 5) : 4;
        const float* src = lat ? src_lat + (size_t)row0 * DM : src_ctx + (size_t)(row0 - TL) * DM; float* dst = lat ? dst_lat + (size_t)row0 * DM : dst_ctx + (size_t)(row0 - TL) * DM;
        f32x4 gv[2][2];
#pragma unroll
        for (int bj = 0; bj < 2; ++bj)
#pragma unroll
            for (int n = 0; n < 2; ++n) gv[bj][n] = *(const f32x4*)(gate + (size_t)r * 6144 + col0 + bj * 128 + n * 16);
        f32x4 sv[4][4];
#define ER_LOAD(slot, st) do { const size_t off_ = (size_t)(((st) >> 2) * 128 + ((st) & 3) * 16) * DM + col0; _Pragma("unroll") for (int bj = 0; bj < 2; ++bj) _Pragma("unroll") for (int n = 0; n < 2; ++n) sv[slot][bj * 2 + n] = *(const f32x4*)(src + off_ + bj * 128 + n * 16); } while (0)
        ER_LOAD(0, 0); ER_LOAD(1, 1); ER_LOAD(2, 2); ER_LOAD(3, 3);
#pragma unroll
        for (int st = 0; st < 8; ++st) { const int ai = st >> 2, m = st & 3; const size_t off = (size_t)(ai * 128 + m * 16) * DM + col0;
            f32x4 o[4];
#pragma unroll
            for (int bj = 0; bj < 2; ++bj)
#pragma unroll
                for (int n = 0; n < 2; ++n) o[bj * 2 + n] = sv[st & 3][bj * 2 + n] + gv[bj][n] * acc[ai][bj][m][n];
            if (st + 4 < 8) ER_LOAD(st & 3, st + 4);
#pragma unroll
            for (int bj = 0; bj < 2; ++bj)
#pragma unroll
                for (int n = 0; n < 2; ++n) *(f32x4*)(dst + off + bj * 128 + n * 16) = o[bj * 2 + n];
            asm volatile("" ::: "memory"); }
#undef ER_LOAD
    }
};
__device__ __forceinline__ void p4_attention(KAREF A, char* lds, int G) {
    const float* QR = (const float*)(A.ws + WS_ACT + A_QR); const attn_body::bf16* KN = (const attn_body::bf16*)(A.ws + WS_ACT + A_KN); const attn_body::bf16* VB = (const attn_body::bf16*)(A.ws + WS_ACT + A_VB);
    attn_body::bf16* YC = (attn_body::bf16*)(A.ws + WS_ACT + A_YCAT); const float* tab = (const float*)(A.ws + WS_ROPE); const float* qg = A.in[I0_QG];
    const int vcu = (G % 8 == 0) ? (int)((blockIdx.x % 8) * (G / 8) + blockIdx.x / 8) : (int)blockIdx.x;
    for (int u = vcu; u < 1024 + 32; u += G) {
        if (u < 1024) { const int bh = u >> 5, qb = u & 31, b = bh >> 3, h = bh & 7;
            attn_body::attn_unit<8>(b * SEQ + qb * 256, h, b * KVL, KVL / 64, 1, qb * 256, QR, qg, tab, KN, VB, YC, lds); }
        else { const int v = u - 1024, b = v >> 3, h = v & 7;
            attn_body::attn_unit<8>(TL + b * CTXL, h, b * KVL + SEQ, CTXL / 64, 0, 0, QR, qg, tab, KN, VB, YC, lds); }
    }
}

__device__ __forceinline__ void p6_norm_router(KAREF A, LAS unsigned char* lds, int G, int layer, int nrows) {
    const int tid = threadIdx.x, lane = tid & 63, wave = tid >> 6, gw = blockIdx.x * 8 + wave, ngw = G * 8;
    LAS float* RT = (LAS float*)lds;
    const float* router = A.in[layer ? I1_ROUTER : I0_ROUTER];
    for (int i = tid; i < 16 * 1024; i += 512) { const int k = i >> 4, e = i & 15; RT[e * 1024 + k] = router[i]; }
    __syncthreads();
    bf16_t* H2 = (bf16_t*)(A.ws + WS_ACT + A_H2); float* AFFL = (float*)(A.ws + WS_AFFL); float* AFFC = (float*)(A.ws + WS_AFFC);
    const float* gain = A.in[layer ? I1_NFFN : I0_NFFN];
    f32x4 gq[4], vn[4];
#pragma unroll
    for (int j = 0; j < 4; ++j) gq[j] = *(const f32x4*)(gain + 4 * (lane + 64 * j));
    { const float* x0 = xs_row(A, gw < nrows ? gw : 0);
#pragma unroll
      for (int j = 0; j < 4; ++j) vn[j] = *(const f32x4*)(x0 + 4 * (lane + 64 * j)); }
    f32x4 aq[4], bq[4]; int rcur = -1;
    for (int m = gw; m < nrows; m += ngw) {
        const int r = mod_row(m);
        if (r != rcur) { const float* sh = ada_ptr(A.ws, layer, r, 3); const float* sc = ada_ptr(A.ws, layer, r, 4); rcur = r;
#pragma unroll
            for (int j = 0; j < 4; ++j) { aq[j] = *(const f32x4*)(sc + 4 * (lane + 64 * j)); bq[j] = *(const f32x4*)(sh + 4 * (lane + 64 * j)); } }
        f32x4 v[4]; float ss = 0.f;
#pragma unroll
        for (int j = 0; j < 4; ++j) v[j] = vn[j];
        { const float* xn = xs_row(A, m + ngw < nrows ? m + ngw : m);
#pragma unroll
          for (int j = 0; j < 4; ++j) vn[j] = *(const f32x4*)(xn + 4 * (lane + 64 * j)); }
#pragma unroll
        for (int j = 0; j < 4; ++j) ss += (v[j].x * v[j].x + v[j].y * v[j].y) + (v[j].z * v[j].z + v[j].w * v[j].w);
        const float rs = __builtin_amdgcn_rsqf(wave_sum(ss) * (1.f / DM) + 1e-6f);
        float pe[16];
#pragma unroll
        for (int e = 0; e < 16; ++e) pe[e] = 0.f;
#pragma unroll
        for (int j = 0; j < 4; ++j) { const int col = 4 * (lane + 64 * j);
            const f32x4 y = v[j] * rs * gq[j] * (aq[j] + 1.0f) + bq[j];
            u32x2 w; w.x = cvt_pk_bf16(y.x, y.y); w.y = cvt_pk_bf16(y.z, y.w);
            *(u32x2*)(H2 + (size_t)m * DM + col) = w;
#pragma unroll
            for (int e = 0; e < 16; ++e) { const f32x4 rw = *(const LAS f32x4*)(RT + e * 1024 + col); pe[e] += (y.x * rw.x + y.y * rw.y) + (y.z * rw.z + y.w * rw.w); } }
#pragma unroll
        for (int i = 0; i < 8; ++i) { const bool up = (lane & 32) != 0; const float send = up ? pe[i] : pe[i + 8], keep = up ? pe[i + 8] : pe[i]; pe[i] = keep + __shfl_xor(send, 32); }
#pragma unroll
        for (int i = 0; i < 4; ++i) { const bool up = (lane & 16) != 0; const float send = up ? pe[i] : pe[i + 4], keep = up ? pe[i + 4] : pe[i]; pe[i] = keep + __shfl_xor(send, 16); }
#pragma unroll
        for (int i = 0; i < 2; ++i) { const bool up = (lane & 8) != 0; const float send = up ? pe[i] : pe[i + 2], keep = up ? pe[i + 2] : pe[i]; pe[i] = keep + __shfl_xor(send, 8); }
        { const bool up = (lane & 4) != 0; const float send = up ? pe[0] : pe[1], keep = up ? pe[1] : pe[0]; pe[0] = keep + __shfl_xor(send, 4); }
        float lg = pe[0]; lg += __shfl_xor(lg, 2); lg += __shfl_xor(lg, 1);
        float mx = lg;
#pragma unroll
        for (int o = 4; o < 64; o <<= 1) mx = fmaxf(mx, __shfl_xor(mx, o));
        const float ex = expf(lg - mx); float sm = ex;
#pragma unroll
        for (int o = 4; o < 64; o <<= 1) sm += __shfl_xor(sm, o);
        const float aff = ex / sm; const int e = (lane >> 2) & 15;
        if ((lane & 3) == 0) { if (m < TL) AFFL[(size_t)((m >> 13) * 16 + e) * SEQ + (m & 8191)] = aff; else { const int j = m - TL; AFFC[(size_t)((j >> 8) * 16 + e) * CTXL + (j & 255)] = aff; } }
    }
}

__device__ __forceinline__ void topk_unit(const float* aff, int N, int cap, int src_row0, int xe_row0, int* SRCROW, float* GROW, int* slotmap, LAS unsigned char* lds) {
    const int tid = threadIdx.x;
    LAS unsigned* keys = (LAS unsigned*)lds;
    LAS unsigned* hist = (LAS unsigned*)(lds + 32768);
    LAS unsigned* ctl = (LAS unsigned*)(lds + 32768 + 1024);
    LAS int* tmp = (LAS int*)(lds + 32768 + 1024 + 64);
    __syncthreads();
    for (int i = tid; i < N; i += 512) keys[i] = __float_as_uint(aff[i]);
    if (tid == 0) { ctl[0] = 0u; ctl[1] = (unsigned)cap; }
    unsigned mask = 0u;
#pragma unroll 1
    for (int shift = 24; shift >= 0; shift -= 8) {
        if (tid < 256) hist[tid] = 0u;
        __syncthreads();
        const unsigned prefix = ctl[0];
        for (int i = tid; i < N; i += 512) { const unsigned k = keys[i]; if ((k & mask) == prefix) __hip_atomic_fetch_add(&hist[(k >> shift) & 255u], 1u, __ATOMIC_RELAXED, __HIP_MEMORY_SCOPE_WORKGROUP); }
        __syncthreads();
        { const unsigned need = ctl[1]; const int hv = tid < 256 ? (int)hist[255 - tid] : 0; int tot_; const int above = block_excl_scan(hv, tmp, tot_);
          if (tid < 256 && (unsigned)above < need && need <= (unsigned)(above + hv)) { ctl[0] = prefix | ((unsigned)(255 - tid) << shift); ctl[1] = need - (unsigned)above; } }
        mask |= 0xffu << shift;
        __syncthreads();
    }
    const unsigned tau = ctl[0]; const int need_eq = (int)ctl[1];
    const int per = N >= 512 ? N / 512 : 1; const int base = tid * per; const bool act = base < N;
    int neq = 0;
    if (act) for (int i = 0; i < per; ++i) neq += (keys[base + i] == tau) ? 1 : 0;
    int tot; int eqrank = block_excl_scan(neq, tmp, tot);
    int nsel = 0;
    if (act) { int er = eqrank; for (int i = 0; i < per; ++i) { const unsigned k = keys[base + i]; if (k > tau) ++nsel; else if (k == tau) { if (er < need_eq) ++nsel; ++er; } } }
    int slot = block_excl_scan(nsel, tmp, tot);
    if (act) { int er = eqrank; for (int i = 0; i < per; ++i) { const unsigned k = keys[base + i]; bool sel = false; if (k > tau) sel = true; else if (k == tau) { sel = er < need_eq; ++er; }
            if (sel) { SRCROW[xe_row0 + slot] = src_row0 + base + i; GROW[xe_row0 + slot] = __uint_as_float(k); slotmap[base + i] = xe_row0 + slot; ++slot; } else slotmap[base + i] = -1; } }
}
__device__ __forceinline__ void p7_topk(KAREF A, LAS unsigned char* lds, int G, bool with_ctx) {
    int* SRCROW = (int*)(A.ws + WS_SRCROW); float* GROW = (float*)(A.ws + WS_GROW);
    const int nun = with_ctx ? 128 : 64;
    for (int u = blockIdx.x; u < nun; u += G) {
        if (u < 64) { const int b = u >> 4, e = u & 15; topk_unit((const float*)(A.ws + WS_AFFL) + (size_t)u * SEQ, SEQ, CAPL, b * SEQ, (b * 16 + e) * CAPL, SRCROW, GROW, (int*)(A.ws + WS_SLOTL) + (size_t)u * SEQ, lds); }
        else { const int v = u - 64, b = v >> 4, e = v & 15; topk_unit((const float*)(A.ws + WS_AFFC) + (size_t)v * CTXL, CTXL, CAPC, TL + b * CTXL, XE_CTX0 + e * 256 + b * CAPC, SRCROW, GROW, (int*)(A.ws + WS_SLOTC) + (size_t)v * CTXL, lds); }
    }
}

__device__ __forceinline__ void p8_gather(KAREF A, int G, bool with_ctx) {
    const int lane = threadIdx.x & 63, wave = threadIdx.x >> 6, gw = blockIdx.x * 8 + wave, ngw = G * 8;
    const int* SRCROW = (const int*)(A.ws + WS_SRCROW); const bf16_t* H2 = (const bf16_t*)(A.ws + WS_ACT + A_H2); unsigned char* XE = A.ws + WS_ACT + A_XE;
    const int nr = with_ctx ? XE_CTX0 + NE * 128 : XE_CTX0;
    for (int i0 = gw; i0 < nr; i0 += 4 * ngw) {
        int xr[4], src[4]; bool ok[4];
#pragma unroll
        for (int q = 0; q < 4; ++q) { const int i = i0 + q * ngw; ok[q] = i < nr; const int ic = ok[q] ? i : i0; xr[q] = ic; if (ic >= XE_CTX0) { const int j = ic - XE_CTX0; xr[q] = XE_CTX0 + (j >> 7) * 256 + (j & 127); } }
#pragma unroll
        for (int q = 0; q < 4; ++q) src[q] = SRCROW[xr[q]];
        u32x4 a[4], b[4];
#pragma unroll
        for (int q = 0; q < 4; ++q) { a[q] = *(const u32x4*)(H2 + (size_t)src[q] * DM + 16 * lane); b[q] = *(const u32x4*)(H2 + (size_t)src[q] * DM + 16 * lane + 8); }
#pragma unroll
        for (int q = 0; q < 4; ++q) if (ok[q]) {
            u32x4 o; o.x = pk_fp8x4(bflo(a[q].x), bfhi(a[q].x), bflo(a[q].y), bfhi(a[q].y)); o.y = pk_fp8x4(bflo(a[q].z), bfhi(a[q].z), bflo(a[q].w), bfhi(a[q].w));
            o.z = pk_fp8x4(bflo(b[q].x), bfhi(b[q].x), bflo(b[q].y), bfhi(b[q].y)); o.w = pk_fp8x4(bflo(b[q].z), bfhi(b[q].z), bflo(b[q].w), bfhi(b[q].w));
            *(u32x4*)(XE + (size_t)xr[q] * DM + 16 * lane) = o; }
    }
}

struct MoeOrder1 {
    int G, c, nun;
    __device__ bool next(int i, pg8::Unit& u) const {
        const long L = (long)i * G + c; if (L >= nun) return false;
        if (L < 4096) { const int e = (int)(L >> 8), j = (int)(L & 255), x = j & 7, sI = j >> 3, rt = (x & 1) * 8 + (sI & 7), pnl = (x >> 1) * 4 + (sI >> 3);
            u.am = ((rt >> 2) * 16 + e) * 4 + (rt & 3); u.bn = e * 16 + pnl; }
        else { const int j = (int)L - 4096, e = j >> 4, pnl = j & 15; u.am = XE_CTX0 / 256 + e; u.bn = e * 16 + pnl; }
        u.pm = u.am; u.pn = u.bn & 15; return true;
    }
    __device__ __forceinline__ void a_ready(const pg8::Unit&) const {}
    __device__ __forceinline__ void done(const pg8::Unit&) const {}
};
struct MoeOrder2 {
    int G, c, nun;
    __device__ bool next(int i, pg8::Unit& u) const {
        const long L = (long)i * G + c; if (L >= nun) return false;
        if (L < 1024) { const int e4 = (int)(L >> 8), j = (int)(L & 255), v = (j & 7) * 32 + (j >> 3), e = 4 * e4 + (v >> 6), w = v & 63, rt = w >> 2, pnl = w & 3;
            u.am = ((rt >> 2) * 16 + e) * 4 + (rt & 3); u.bn = e * 4 + pnl; }
        else { const int j = (int)L - 1024, e = j >> 2, pnl = j & 3; u.am = XE_CTX0 / 256 + e; u.bn = e * 4 + pnl; }
        u.pm = u.am; u.pn = u.bn & 3; return true;
    }
    __device__ __forceinline__ void a_ready(const pg8::Unit&) const {}
    __device__ __forceinline__ void done(const pg8::Unit&) const {}
};
struct EpiSwiGLU {
    static constexpr bool PERM = true;
    unsigned char* HID;
    __device__ __forceinline__ void operator()(const f32x4 (&acc)[2][2][4][2], const pg8::Unit& u, int wr, int wc, int fr, int fq) const {
        const int row0 = u.pm * 256 + wr * 64 + fr, col0 = u.pn * 128 + wc * 32 + 8 * fq; constexpr float is = 1.0f / W8_SCALE;
#pragma unroll
        for (int ai = 0; ai < 2; ++ai)
#pragma unroll
            for (int m = 0; m < 4; ++m) { const f32x4 g0 = acc[ai][0][m][0] * is, g1 = acc[ai][0][m][1] * is, u0 = acc[ai][1][m][0] * is, u1 = acc[ai][1][m][1] * is;
                u32x2 w; w.x = pk_fp8x4(silu_f(g0[0]) * u0[0], silu_f(g0[1]) * u0[1], silu_f(g0[2]) * u0[2], silu_f(g0[3]) * u0[3]);
                w.y = pk_fp8x4(silu_f(g1[0]) * u1[0], silu_f(g1[1]) * u1[1], silu_f(g1[2]) * u1[2], silu_f(g1[3]) * u1[3]);
                *(u32x2*)(HID + (size_t)(row0 + ai * 128 + m * 16) * FF + col0) = w; }
    }
};
struct EpiDown {
    static constexpr bool PERM = true;
    bf16_t* YE; const float* GROW;
    __device__ __forceinline__ void operator()(const f32x4 (&acc)[2][2][4][2], const pg8::Unit& u, int wr, int wc, int fr, int fq) const {
        const int row0 = u.pm * 256 + wr * 64 + fr, col0 = u.pn * 256 + wc * 32 + 8 * fq;
#pragma unroll
        for (int ai = 0; ai < 2; ++ai)
#pragma unroll
            for (int m = 0; m < 4; ++m) { const int row = row0 + ai * 128 + m * 16; const float gt = GROW[row] * (1.0f / W8_SCALE);
#pragma unroll
                for (int bj = 0; bj < 2; ++bj) { const f32x4 v0 = acc[ai][bj][m][0] * gt, v1 = acc[ai][bj][m][1] * gt;
                    u32x4 w; w.x = cvt_pk_bf16(v0[0], v0[1]); w.y = cvt_pk_bf16(v0[2], v0[3]); w.z = cvt_pk_bf16(v1[0], v1[1]); w.w = cvt_pk_bf16(v1[2], v1[3]);
                    *(u32x4*)(YE + (size_t)row * DM + col0 + bj * 128) = w; } }
    }
};

__device__ __forceinline__ void p11_combine(KAREF A, int G, int layer, int nrows) {
    const int lane = threadIdx.x & 63, wave = threadIdx.x >> 6, gw = blockIdx.x * 8 + wave, ngw = G * 8;
    const bf16_t* YE = (const bf16_t*)(A.ws + WS_ACT + A_YE); const int* SLOTL = (const int*)(A.ws + WS_SLOTL); const int* SLOTC = (const int*)(A.ws + WS_SLOTC);
#define CB_SLOT(M, DST) do { const int m_ = (M); DST = -1; if (lane < 16) { if (m_ < TL) DST = SLOTL[(size_t)((m_ >> 13) * 16 + lane) * SEQ + (m_ & 8191)]; else { const int j_ = m_ - TL; DST = SLOTC[(size_t)((j_ >> 8) * 16 + lane) * CTXL + (j_ & 255)]; } } } while (0)
    int smn; f32x4 xn[4], g[4]; int rcur = -1;
    { const int m0 = gw < nrows ? gw : 0; CB_SLOT(m0, smn); const float* x0 = xs_row(A, m0);
#pragma unroll
      for (int j = 0; j < 4; ++j) xn[j] = *(const f32x4*)(x0 + 4 * (lane + 64 * j)); }
    for (int m = gw; m < nrows; m += ngw) {
        const int sm = smn; f32x4 x[4];
#pragma unroll
        for (int j = 0; j < 4; ++j) x[j] = xn[j];
        unsigned long long bal = __ballot(sm >= 0);
        bool ok[4]; int xr[4];
#pragma unroll
        for (int q = 0; q < 4; ++q) { ok[q] = bal != 0ull; const int e = ok[q] ? __builtin_ctzll(bal) : 0; if (ok[q]) bal &= bal - 1; const int rr = __builtin_amdgcn_readlane(sm, e); xr[q] = ok[q] ? rr : 0; }
        u32x2 w[4][4];
#pragma unroll
        for (int q = 0; q < 4; ++q)
#pragma unroll
            for (int j = 0; j < 4; ++j) w[q][j] = *(const u32x2*)(YE + (size_t)xr[q] * DM + 4 * (lane + 64 * j));
        { const int r = mod_row(m); if (r != rcur) { const float* gt = ada_ptr(A.ws, layer, r, 5); rcur = r;
#pragma unroll
            for (int j = 0; j < 4; ++j) g[j] = *(const f32x4*)(gt + 4 * (lane + 64 * j)); } }
        { const int mn = m + ngw < nrows ? m + ngw : m; CB_SLOT(mn, smn); const float* xp = xs_row(A, mn);
#pragma unroll
          for (int j = 0; j < 4; ++j) xn[j] = *(const f32x4*)(xp + 4 * (lane + 64 * j)); }
        f32x4 acc[4];
#pragma unroll
        for (int j = 0; j < 4; ++j) acc[j] = (f32x4){0.f, 0.f, 0.f, 0.f};
#pragma unroll
        for (int q = 0; q < 4; ++q) if (ok[q]) {
#pragma unroll
            for (int j = 0; j < 4; ++j) acc[j] += (f32x4){bflo(w[q][j].x), bfhi(w[q][j].x), bflo(w[q][j].y), bfhi(w[q][j].y)}; }
        while (bal) { const int e = __builtin_ctzll(bal); bal &= bal - 1; const int rr = __builtin_amdgcn_readlane(sm, e);
#pragma unroll
            for (int j = 0; j < 4; ++j) { const u32x2 ww = *(const u32x2*)(YE + (size_t)rr * DM + 4 * (lane + 64 * j)); acc[j] += (f32x4){bflo(ww.x), bfhi(ww.x), bflo(ww.y), bfhi(ww.y)}; } }
        float* xr_ = xs_row_w(A, m);
#pragma unroll
        for (int j = 0; j < 4; ++j) { const int col = 4 * (lane + 64 * j); *(f32x4*)(xr_ + col) = x[j] + g[j] * acc[j]; }
    }
#undef CB_SLOT
}
__device__ __forceinline__ void l1_h_row(const float* xr, const float* gain, const float* sh, const float* sc, int lane, f32x4 (&h)[4]) {
    f32x4 v[4]; float ss = 0.f;
#pragma unroll
    for (int j = 0; j < 4; ++j) { v[j] = *(const f32x4*)(xr + 4 * (lane + 64 * j)); ss += (v[j].x * v[j].x + v[j].y * v[j].y) + (v[j].z * v[j].z + v[j].w * v[j].w); }
    const float rs = __builtin_amdgcn_rsqf(wave_sum(ss) * (1.f / DM) + 1e-6f);
#pragma unroll
    for (int j = 0; j < 4; ++j) { const int col = 4 * (lane + 64 * j); const f32x4 g = *(const f32x4*)(gain + col), a = *(const f32x4*)(sc + col), b = *(const f32x4*)(sh + col); h[j] = v[j] * rs * g * (a + 1.0f) + b; }
}
__device__ __forceinline__ void l1_h_from_raw(const f32x4 (&v)[4], const LAS float* gainl, const f32x4 (&shq)[4], const f32x4 (&scq)[4], int lane, f32x4 (&h)[4]) {
    float ss = 0.f;
#pragma unroll
    for (int j = 0; j < 4; ++j) ss += (v[j].x * v[j].x + v[j].y * v[j].y) + (v[j].z * v[j].z + v[j].w * v[j].w);
    const float rs = __builtin_amdgcn_rsqf(wave_sum(ss) * (1.f / DM) + 1e-6f);
#pragma unroll
    for (int j = 0; j < 4; ++j) { const f32x4 g = *(const LAS f32x4*)(gainl + 4 * (lane + 64 * j)); h[j] = v[j] * rs * g * (scq[j] + 1.0f) + shq[j]; }
}
__device__ __forceinline__ void p12_l1_prep(KAREF A, LAS unsigned char* lds, int G) {
    const int tid = threadIdx.x, lane = tid & 63, wave = tid >> 6, gw = blockIdx.x * 8 + wave, ngw = G * 8;
    bf16_t* XMIX = (bf16_t*)(A.ws + WS_ACT + A_XMIX);
    LAS float* mul = (LAS float*)lds; LAS float* gainl = mul + 6 * DM;
    for (int i = tid; i < 6 * DM; i += 512) mul[i] = A.in[I1_MU][i];
    for (int i = tid; i < DM; i += 512) gainl[i] = A.in[I1_NMIX][i];
    __syncthreads();
    const int m_lo = (int)(((long)gw * TT) / ngw), m_hi = (int)(((long)(gw + 1) * TT) / ngw);
    f32x4 hp[4], hc[4], hn[4], vn[4], shq[4], scq[4]; bool have = false; int rcur = -1;
#define L1_RAW(DST, M) do { const float* p_ = xs_row(A, (M) < TT ? (M) : TT - 1); _Pragma("unroll") for (int j = 0; j < 4; ++j) DST[j] = *(const f32x4*)(p_ + 4 * (lane + 64 * j)); } while (0)
    if (m_lo < m_hi) L1_RAW(vn, m_lo + 1);
    for (int m = m_lo; m < m_hi; ++m) {
        const int r = mod_row(m);
        if (r != rcur) { const float* sh = ada_ptr(A.ws, 1, r, 0); const float* sc = ada_ptr(A.ws, 1, r, 1); rcur = r;
#pragma unroll
            for (int j = 0; j < 4; ++j) { shq[j] = *(const f32x4*)(sh + 4 * (lane + 64 * j)); scq[j] = *(const f32x4*)(sc + 4 * (lane + 64 * j)); } }
        const int t = m < TL ? (m & 8191) : ((m - TL) & 255), Ls = m < TL ? SEQ : CTXL;
        f32x4 vnn[4]; L1_RAW(vnn, m + 2);
        if (!have || t == 0) {
            f32x4 vv[4]; L1_RAW(vv, m); l1_h_from_raw(vv, gainl, shq, scq, lane, hc);
            if (t > 0) { L1_RAW(vv, m - 1); l1_h_from_raw(vv, gainl, shq, scq, lane, hp); } else {
#pragma unroll
                for (int j = 0; j < 4; ++j) hp[j] = (f32x4){0.f, 0.f, 0.f, 0.f}; }
            have = true; }
        if (t < Ls - 1) l1_h_from_raw(vn, gainl, shq, scq, lane, hn); else {
#pragma unroll
            for (int j = 0; j < 4; ++j) hn[j] = (f32x4){0.f, 0.f, 0.f, 0.f}; }
#pragma unroll
        for (int j = 0; j < 4; ++j) { const int col = 4 * (lane + 64 * j); const f32x4 xx = (hp[j] + hn[j]) * 0.5f - hc[j];
#pragma unroll
            for (int q = 0; q < 6; ++q) { const f32x4 mq = *(const LAS f32x4*)(mul + q * DM + col); const f32x4 y = hc[j] + xx * mq;
                u32x2 w; w.x = cvt_pk_bf16(y.x, y.y); w.y = cvt_pk_bf16(y.z, y.w);
                *(u32x2*)(XMIX + (size_t)q * TT * DM + (size_t)m * DM + col) = w; }
            hp[j] = hc[j]; hc[j] = hn[j]; vn[j] = vnn[j]; }
    }
#undef L1_RAW
}

struct MixOrder {
    int G, c;
    __device__ bool next(int i, pg8::Unit& u) const {
        const long L = (long)i * G + c; if (L >= 132 * 15) return false;
        const int wgid = (int)L; const int grp = wgid / (8 * 15), w = wgid % (8 * 15), fm = grp * 8, gsz = (132 - fm) < 8 ? (132 - fm) : 8;
        u.pm = fm + w % gsz; u.pn = w / gsz;
        const int sel = u.pn < 4 ? 0 : u.pn < 8 ? 2 : u.pn < 12 ? 3 : u.pn == 12 ? 5 : u.pn == 13 ? 1 : 4;
        u.am = sel * 132 + u.pm; u.bn = u.pn; return true;
    }
    __device__ __forceinline__ void a_ready(const pg8::Unit&) const {}
    __device__ __forceinline__ void done(const pg8::Unit&) const {}
};
struct EpiMix {
    static constexpr bool PERM = true;
    bf16_t* RKV; bf16_t* LG; bf16_t* LWA;
    __device__ __forceinline__ void operator()(const f32x4 (&acc)[2][2][4][2], const pg8::Unit& u, int wr, int wc, int fr, int fq) const {
        const int row0 = u.pm * 256 + wr * 64 + fr, tile = u.pn;
#pragma unroll
        for (int ai = 0; ai < 2; ++ai)
#pragma unroll
            for (int m = 0; m < 4; ++m) { const int row = row0 + ai * 128 + m * 16;
#pragma unroll
                for (int bj = 0; bj < 2; ++bj) { const int colt = bj * 128 + wc * 32 + 8 * fq; f32x4 v0 = acc[ai][bj][m][0], v1 = acc[ai][bj][m][1];
                    if (tile == 12) {
#pragma unroll
                        for (int i = 0; i < 4; ++i) { v0[i] = sigm(v0[i]); v1[i] = sigm(v1[i]); } }
                    if (tile == 13) {
#pragma unroll
                        for (int i = 0; i < 4; ++i) { v0[i] = tanh_f(v0[i]); v1[i] = tanh_f(v1[i]); } }
                    u32x4 w; w.x = cvt_pk_bf16(v0[0], v0[1]); w.y = cvt_pk_bf16(v0[2], v0[3]); w.z = cvt_pk_bf16(v1[0], v1[1]); w.w = cvt_pk_bf16(v1[2], v1[3]);
                    if (tile < 12) *(u32x4*)(RKV + (size_t)(tile >> 2) * TT * DM + (size_t)row * DM + (tile & 3) * 256 + colt) = w;
                    else if (tile == 12) *(u32x4*)(LG + (size_t)row * 256 + colt) = w;
                    else if (bj == 0) *(u32x4*)(LWA + (size_t)row * 256 + (tile - 13) * 128 + colt) = w; } }
    }
};
struct LoraOrder {
    int G, c;
    __device__ bool next(int i, pg8::Unit& u) const {
        const long L = (long)i * G + c; if (L >= 132 * 20) return false;
        const int wgid = (int)L; const int grp = wgid / (8 * 20), w = wgid % (8 * 20), fm = grp * 8, gsz = (132 - fm) < 8 ? (132 - fm) : 8;
        u.pm = fm + w % gsz; u.pn = w / gsz; u.am = (u.pn < 16 ? 132 : 0) + u.pm; u.bn = u.pn; return true;
    }
    __device__ __forceinline__ void a_ready(const pg8::Unit&) const {}
    __device__ __forceinline__ void done(const pg8::Unit&) const {}
};
struct EpiLora {
    static constexpr bool PERM = true;
    bf16_t* SD; bf16_t* AD; bf16_t* Gg; const float* w0; const float* a0;
    __device__ __forceinline__ void operator()(const f32x4 (&acc)[2][2][4][2], const pg8::Unit& u, int wr, int wc, int fr, int fq) const {
        const int row0 = u.pm * 256 + wr * 64 + fr, tile = u.pn, kind = tile >> 2;
        bf16_t* dst = kind < 2 ? SD + (size_t)kind * TT * DM : kind < 4 ? AD + (size_t)(kind - 2) * TT * DM : Gg;
        const float* bias = kind < 2 ? w0 + kind * DM : a0 + (kind - 2) * DM;
#pragma unroll
        for (int ai = 0; ai < 2; ++ai)
#pragma unroll
            for (int m = 0; m < 4; ++m) { const int row = row0 + ai * 128 + m * 16;
#pragma unroll
                for (int bj = 0; bj < 2; ++bj) { const int col = (tile & 3) * 256 + bj * 128 + wc * 32 + 8 * fq;
                    f32x4 v0 = acc[ai][bj][m][0], v1 = acc[ai][bj][m][1];
                    if (kind < 4) { v0 += *(const f32x4*)(bias + col); v1 += *(const f32x4*)(bias + col + 4);
#pragma unroll
                        for (int i = 0; i < 4; ++i) { v0[i] = sigm(v0[i]); v1[i] = sigm(v1[i]); } }
                    u32x4 w; w.x = cvt_pk_bf16(v0[0], v0[1]); w.y = cvt_pk_bf16(v0[2], v0[3]); w.z = cvt_pk_bf16(v1[0], v1[1]); w.w = cvt_pk_bf16(v1[2], v1[3]);
                    *(u32x4*)(dst + (size_t)row * DM + col) = w; }
                asm volatile("" ::: "memory"); }
    }
};

#define MFMA16(a, b, c) __builtin_amdgcn_mfma_f32_16x16x32_bf16((a), (b), (c), 0, 0, 0)
__device__ __forceinline__ void p14_lora2(KAREF A, LAS unsigned char* lds, int G) {
    const int tid = threadIdx.x, lane = tid & 63, wave = __builtin_amdgcn_readfirstlane(tid >> 6), fr = lane & 15, fq = lane >> 4, mw = wave & 3, nw = wave >> 2;
    LAS bf16_t* stg = (LAS bf16_t*)(lds + wave * 9216);
    const bf16_t* LG = (const bf16_t*)(A.ws + WS_ACT + A_LG); const bf16_t* LWA = (const bf16_t*)(A.ws + WS_ACT + A_LWA); const bf16_t* B2 = (const bf16_t*)(A.ws + WS_B2);
    for (int u = blockIdx.x; u < (TT / 128) * 20; u += G) {
        const int rt = u / 20, rem = u - rt * 20, kind = rem >> 2, cb = rem & 3;
        const bf16_t* Ap = (kind < 4 ? LWA + 64 * kind : LG) + (size_t)(rt * 128 + mw * 32 + fr) * 256 + 8 * fq;
        const bf16_t* Bp = B2 + (size_t)(kind * 1024 + cb * 256 + nw * 128 + fr) * 256 + (kind < 4 ? 64 * kind : 0) + 8 * fq;
        const int nk = kind < 4 ? 2 : 5;
        f32x4 acc[2][8];
#pragma unroll
        for (int mt = 0; mt < 2; ++mt)
#pragma unroll
            for (int nt = 0; nt < 8; ++nt) acc[mt][nt] = (f32x4){0.f, 0.f, 0.f, 0.f};
#pragma unroll
        for (int ks = 0; ks < 5; ++ks) if (ks < nk) {
            const bf16x8 a0 = *(const bf16x8*)(Ap + ks * 32), a1 = *(const bf16x8*)(Ap + 16 * 256 + ks * 32);
#pragma unroll
            for (int nt = 0; nt < 8; ++nt) { const bf16x8 bb = *(const bf16x8*)(Bp + (size_t)nt * 16 * 256 + ks * 32); acc[0][nt] = MFMA16(a0, bb, acc[0][nt]); acc[1][nt] = MFMA16(a1, bb, acc[1][nt]); } }
        const float* bias = kind < 2 ? A.in[I1_W0] + kind * DM : A.in[I1_A0] + (kind - 2) * DM;
#pragma unroll
        for (int nt = 0; nt < 8; ++nt) { const int cl = nt * 16 + fr; const float bv = kind < 4 ? bias[cb * 256 + nw * 128 + cl] : 0.f;
#pragma unroll
            for (int mt = 0; mt < 2; ++mt)
#pragma unroll
                for (int r = 0; r < 4; ++r) { float v = acc[mt][nt][r] + bv; if (kind < 4) v = sigm(v); stg[(mt * 16 + 4 * fq + r) * 136 + cl] = (bf16_t)(cvt_pk_bf16_c(v, 0.f) & 0xffffu); } }
        LDS_WAIT();
        bf16_t* dst = (kind < 2 ? (bf16_t*)(A.ws + WS_ACT + A_SD) + (size_t)kind * TT * DM : kind < 4 ? (bf16_t*)(A.ws + WS_ACT + A_AD) + (size_t)(kind - 2) * TT * DM : (bf16_t*)(A.ws + WS_ACT + A_G))
                      + (size_t)(rt * 128 + mw * 32) * DM + cb * 256 + nw * 128;
#pragma unroll
        for (int i = 0; i < 8; ++i) { const int row = 4 * i + (lane >> 4), ch = lane & 15; *(u32x4*)(dst + (size_t)row * DM + 8 * ch) = *(const LAS u32x4*)(stg + row * 136 + 8 * ch); }
        LDS_WAIT();
    }
}

#define DPP_ADD(x, ctrl) ((x) + __builtin_bit_cast(float, __builtin_amdgcn_update_dpp(0, __builtin_bit_cast(int, (x)), (ctrl), 0xf, 0xf, true)))
constexpr int CH = 32, NCHUNK = (CTXL + SEQ) / CH;
__device__ __forceinline__ int wkv_row(int b, int d, int i) { return i < CTXL ? TL + b * CTXL + (d ? CTXL - 1 - i : i) : b * SEQ + (d ? SEQ - 1 - (i - CTXL) : (i - CTXL)); }
__device__ __forceinline__ void unpack8(const u32x4 w, float (&f)[8]) { f[0] = bflo(w.x); f[1] = bfhi(w.x); f[2] = bflo(w.y); f[3] = bfhi(w.y); f[4] = bflo(w.z); f[5] = bfhi(w.z); f[6] = bflo(w.w); f[7] = bfhi(w.w); }
__device__ __forceinline__ u32x4 pack8(const float (&f)[8]) { u32x4 w; w.x = cvt_pk_bf16_c(f[0], f[1]); w.y = cvt_pk_bf16_c(f[2], f[3]); w.z = cvt_pk_bf16_c(f[4], f[5]); w.w = cvt_pk_bf16_c(f[6], f[7]); return w; }
#define DPP_MOV(x, ctrl) __builtin_bit_cast(float, __builtin_amdgcn_update_dpp(0, __builtin_bit_cast(int, (x)), (ctrl), 0xf, 0xf, true))
__device__ __forceinline__ void wkv_decay(const float (&sd)[8], float (&base)[8], int lane, float (&e)[8], float (&em1)[8], float (&einv)[8]) {
    const int jl = lane & 7;
#pragma unroll
    for (int i = 0; i < 8; ++i) { const float lw = -0.6065306597126334f * sd[i]; float x = lw;
        { const float t = DPP_MOV(x, 0x111); if (jl >= 1) x += t; } { const float t = DPP_MOV(x, 0x112); if (jl >= 2) x += t; } { const float t = DPP_MOV(x, 0x114); if (jl >= 4) x += t; }
        const float cs = base[i] + x; e[i] = fexp(cs); em1[i] = fexp(cs - lw); einv[i] = __builtin_amdgcn_rcpf(e[i]);
        base[i] += __shfl(x, lane | 7); }
}
__device__ __forceinline__ float sum_groups(float x) {
    x += DPP_MOV(x, 0x128);
    { auto r = __builtin_amdgcn_permlane16_swap(__float_as_uint(x), __float_as_uint(x), false, false); x = __uint_as_float(r[0]) + __uint_as_float(r[1]); }
    { auto r = __builtin_amdgcn_permlane32_swap(__float_as_uint(x), __float_as_uint(x), false, false); x = __uint_as_float(r[0]) + __uint_as_float(r[1]); }
    return x;
}
__device__ __forceinline__ bf16x8 frag(const LAS bf16_t* M, int pitch, int row0, int k0, int lane) { return *(const LAS bf16x8*)(M + (row0 + (lane & 15)) * pitch + k0 + 8 * (lane >> 4)); }

constexpr size_t WS_TOTG = WS_ACT + 724 * MiB;
constexpr size_t WS_BON = 25 * MiB;
constexpr size_t A_TBUF = 330 * MiB;
__device__ __forceinline__ void p15_tbuild(KAREF A, LAS unsigned char* lds, int gw, int ngw, int cp_lo, int cp_hi) {
    const int tid = threadIdx.x, lane = tid & 63, wave = tid >> 6;
    LAS unsigned char* wl = lds + wave * 16384;
    LAS bf16_t* AH = (LAS bf16_t*)wl; LAS bf16_t* BH = (LAS bf16_t*)(wl + 4096); LAS float* LL = (LAS float*)(wl + 8192);
    const bf16_t* Rr = (const bf16_t*)(A.ws + WS_ACT + A_RKV); const bf16_t* Kk = Rr + (size_t)TT * DM; bf16_t* TB = (bf16_t*)(A.ws + WS_ACT + A_TBUF);
    const bf16_t* SDb = (const bf16_t*)(A.ws + WS_ACT + A_SD); const bf16_t* ADb = (const bf16_t*)(A.ws + WS_ACT + A_AD);
    const int jl = lane & 7, c8 = 8 * (lane >> 3), fr = lane & 15, fq = lane >> 4;
    static_assert(NCHUNK % 2 == 0, "pairs stay inside one chain");
    const int ncp = cp_hi - cp_lo, NQ = 128 * ncp;
#define TB_PAIR(q) (((q) / ncp) * (NCHUNK / 2) + cp_lo + (q) % ncp)
    u32x4 gk[4], gs[4], ga[4], gr[4];
#define TB_ROWLOAD(q, TASK) do { const int tk_ = (TASK); const int ch_ = tk_ / NCHUNK, cu_ = tk_ - ch_ * NCHUNK, d_ = ch_ & 1; \
        const size_t ro_ = (size_t)wkv_row(ch_ >> 5, d_, cu_ * CH + 8 * (q) + jl) * DM + ((ch_ >> 1) & 15) * 64 + c8, do_ = (size_t)d_ * TT * DM; \
        gk[q] = *(const u32x4*)(Kk + ro_); gs[q] = *(const u32x4*)(SDb + do_ + ro_); ga[q] = *(const u32x4*)(ADb + do_ + ro_); gr[q] = *(const u32x4*)(Rr + ro_); } while (0)
    if (gw < NQ) { const int p0 = TB_PAIR(gw); TB_ROWLOAD(0, 2 * p0); TB_ROWLOAD(1, 2 * p0); TB_ROWLOAD(2, 2 * p0); TB_ROWLOAD(3, 2 * p0); }
    for (int q = gw; q < NQ; q += ngw) {
        const int p = TB_PAIR(q); const int pn = (q + ngw < NQ) ? TB_PAIR(q + ngw) : p;
        const int chain = (2 * p) / NCHUNK, b = chain >> 5, h = (chain >> 1) & 15, d = chain & 1, hc = h * 64 + c8;
        float kkw[8]; { const f32x4 t0 = *(const f32x4*)(A.in[I1_KK] + hc), t1 = *(const f32x4*)(A.in[I1_KK] + hc + 4); kkw[0] = t0.x; kkw[1] = t0.y; kkw[2] = t0.z; kkw[3] = t0.w; kkw[4] = t1.x; kkw[5] = t1.y; kkw[6] = t1.z; kkw[7] = t1.w; }
        float kaw[8], rkw[8]; { const f32x4 t0 = *(const f32x4*)(A.in[I1_KA] + hc), t1 = *(const f32x4*)(A.in[I1_KA] + hc + 4), u0 = *(const f32x4*)(A.in[I1_RK] + hc), u1 = *(const f32x4*)(A.in[I1_RK] + hc + 4);
            kaw[0] = t0.x; kaw[1] = t0.y; kaw[2] = t0.z; kaw[3] = t0.w; kaw[4] = t1.x; kaw[5] = t1.y; kaw[6] = t1.z; kaw[7] = t1.w; rkw[0] = u0.x; rkw[1] = u0.y; rkw[2] = u0.z; rkw[3] = u0.w; rkw[4] = u1.x; rkw[5] = u1.y; rkw[6] = u1.z; rkw[7] = u1.w; }
#define TB_STEP(q, TASKN) do { float kf[8], sf[8], af[8], rf[8], e[8], em1[8], einv[8], ah[8], bh[8]; unpack8(gk[q], kf); unpack8(gs[q], sf); unpack8(ga[q], af); unpack8(gr[q], rf); \
            asm volatile("" : "+v"(sf[0]), "+v"(sf[1]), "+v"(sf[2]), "+v"(sf[3]), "+v"(sf[4]), "+v"(sf[5]), "+v"(sf[6]), "+v"(sf[7])); \
            asm volatile("" : "+v"(kf[0]), "+v"(kf[1]), "+v"(kf[2]), "+v"(kf[3]), "+v"(kf[4]), "+v"(kf[5]), "+v"(kf[6]), "+v"(kf[7])); \
            asm volatile("" : "+v"(af[0]), "+v"(af[1]), "+v"(af[2]), "+v"(af[3]), "+v"(af[4]), "+v"(af[5]), "+v"(af[6]), "+v"(af[7])); \
            asm volatile("" : "+v"(rf[0]), "+v"(rf[1]), "+v"(rf[2]), "+v"(rf[3]), "+v"(rf[4]), "+v"(rf[5]), "+v"(rf[6]), "+v"(rf[7])); \
            TB_ROWLOAD(q, TASKN);                                         \
            wkv_decay(sf, base, lane, e, em1, einv); \
            if (lat) { float bq = 0.f; \
_Pragma("unroll") \
                for (int i = 0; i < 8; ++i) bq += rf[i] * kf[i] * ((af[i] - 1.0f) * kaw[i] + 1.0f) * rkw[i]; \
                bq = sum_groups(bq); \
                if ((lane >> 3) == 0) ((float*)(A.ws + WS_BON))[((size_t)d * TL + wkv_row(b, d, chunk * CH + 8 * (q) + jl)) * 16 + h] = bq; } \
            float ssq = 0.f; \
_Pragma("unroll") \
            for (int i = 0; i < 8; ++i) { kf[i] *= kkw[i]; ssq += kf[i] * kf[i]; } \
            const float rs = __builtin_amdgcn_rsqf(fmaxf(sum_groups(ssq), 1e-24f)); \
_Pragma("unroll") \
            for (int i = 0; i < 8; ++i) { const float kk = kf[i] * rs; ah[i] = -kk * em1[i]; bh[i] = kk * af[i] * einv[i]; } \
            *(LAS u32x4*)(AH + (8 * (q) + jl) * 64 + c8) = pack8(ah); *(LAS u32x4*)(BH + (8 * (q) + jl) * 64 + c8) = pack8(bh); \
            if ((q) < 3 && jl == 0) { float* tg = (float*)(A.ws + WS_TOTG) + ((size_t)task * 3 + (q)) * 64 + c8; *(f32x4*)tg = (f32x4){base[0], base[1], base[2], base[3]}; *(f32x4*)(tg + 4) = (f32x4){base[4], base[5], base[6], base[7]}; } } while (0)
#define TB_TASK(HALF, TASKN) do { const int task = 2 * p + (HALF), chunk = task - chain * NCHUNK; const bool lat = chunk >= CTXL / CH; const int taskn = (TASKN); \
            float base[8]; \
_Pragma("unroll") \
            for (int i = 0; i < 8; ++i) base[i] = 0.f; \
            TB_STEP(0, taskn); TB_STEP(1, taskn); TB_STEP(2, taskn); TB_STEP(3, taskn); \
            LDS_WAIT(); \
            LAS float* LLh = LL + (HALF) * 1024; \
_Pragma("unroll") \
            for (int mt = 0; mt < 2; ++mt) \
_Pragma("unroll") \
                for (int nt = 0; nt < 2; ++nt) { f32x4 acc = (f32x4){0.f, 0.f, 0.f, 0.f}; \
_Pragma("unroll") \
                    for (int ks = 0; ks < 2; ++ks) acc = MFMA16(frag(AH, 64, mt * 16, ks * 32, lane), frag(BH, 64, nt * 16, ks * 32, lane), acc); \
_Pragma("unroll") \
                    for (int r = 0; r < 4; ++r) { const int j = mt * 16 + 4 * fq + r, m = nt * 16 + fr; LLh[j * 32 + m] = (m < j) ? acc[r] : 0.f; } } \
            LDS_WAIT(); } while (0)
        TB_TASK(0, 2 * p + 1);
        TB_TASK(1, 2 * pn);
#undef TB_TASK
#undef TB_STEP
        { const int c = lane & 31; const LAS float* Lm = LL + (lane >> 5) * 1024; float t[32];
#pragma unroll
          for (int i = 0; i < 32; ++i) { float s0 = (c == i) ? 1.f : 0.f, s1 = 0.f;
#pragma unroll
              for (int m4 = 0; m4 < (i + 3) / 4; ++m4) { const f32x4 l = *(const LAS f32x4*)(Lm + i * 32 + 4 * m4);
                  if (4 * m4 + 0 < i) s0 += l.x * t[4 * m4 + 0]; if (4 * m4 + 1 < i) s1 += l.y * t[4 * m4 + 1]; if (4 * m4 + 2 < i) s0 += l.z * t[4 * m4 + 2]; if (4 * m4 + 3 < i) s1 += l.w * t[4 * m4 + 3]; }
              t[i] = s0 + s1; }
          bf16_t* dst = TB + (size_t)(2 * p + (lane >> 5)) * 1024 + c;
#pragma unroll
          for (int i = 0; i < 32; ++i) dst[i * 32] = (bf16_t)(cvt_pk_bf16_c(t[i], 0.f) & 0xffffu); }
        LDS_WAIT();
    }
#undef TB_ROWLOAD
#undef TB_PAIR
}
constexpr int R3_AH = 0, R3_RH = 4608, R3_T = 9216, R3_PV = 11776, R3_BYTES = 12032;
constexpr int R2_BH = 0, R2_KH = 4608, R2_VH = 9216, R2_BT = 13824, R2_KT = 18944, R2_VT = 24064, R2_LAK = 29184, R2_MRB = 31744, R2_MRK = 34304, R2_BYTES = 36864;
constexpr int R3_OFF = 0, R2_OFF = 3 * R3_BYTES, CHN_OFF = R2_OFF + 2 * R2_BYTES, CHN_BYTES = 4864, YS_OFF = RING_BYTES + 2048, YS_BYTES = 4608;
static_assert(CHN_OFF + 4 * CHN_BYTES <= RING_BYTES && YS_OFF + 2 * YS_BYTES <= LDS_BYTES, "chain LDS map");
constexpr int TB_CP_FIRST = 96;
constexpr int CHAIN_MID_IT = 2 * TB_CP_FIRST - 5;
__device__ __forceinline__ void p16_chain(KAREF A, LAS unsigned char* lds, int G, int variant, unsigned* handoff, const unsigned nhelp) {
    if (variant & 8) return;
    const int nch = (variant & 16) ? 16 : NCHUNK;
    const bool do_prep = !(variant & 2), do_state = !(variant & 1), do_store = (variant == 0);
    const int tid = threadIdx.x, lane = tid & 63, wave = __builtin_amdgcn_readfirstlane(tid >> 6), fr = lane & 15, fq = lane >> 4;
    const bf16_t* R = (const bf16_t*)(A.ws + WS_ACT + A_RKV); const bf16_t* Kk = R + (size_t)TT * DM; const bf16_t* V = Kk + (size_t)TT * DM; const bf16_t* TB = (const bf16_t*)(A.ws + WS_ACT + A_TBUF);
#define R3P(c) (lds + R3_OFF + ((c) % 3) * R3_BYTES)
#define R2P(c) (lds + R2_OFF + ((c) & 1) * R2_BYTES)
    for (int chain = blockIdx.x; chain < 128; chain += G) {
        const int b = chain >> 5, h = (chain >> 1) & 15, d = chain & 1;
        const bf16_t* SD = (const bf16_t*)(A.ws + WS_ACT + A_SD) + (size_t)d * TT * DM; const bf16_t* AD = (const bf16_t*)(A.ws + WS_ACT + A_AD) + (size_t)d * TT * DM;
        bf16_t* YD = (bf16_t*)(A.ws + WS_ACT + (d ? A_YD1 : A_YD0));
        __syncthreads();
        if (wave >= 4) {
            const int pw = wave - 4, jl = lane & 7, c8 = 8 * (lane >> 3), hc = h * 64 + c8, ptid = pw * 64 + lane;
            float kkw[8], kaw[8];
            { const f32x4 t0 = *(const f32x4*)(A.in[I1_KK] + hc), t1 = *(const f32x4*)(A.in[I1_KK] + hc + 4), u0 = *(const f32x4*)(A.in[I1_KA] + hc), u1 = *(const f32x4*)(A.in[I1_KA] + hc + 4);
              kkw[0] = t0.x; kkw[1] = t0.y; kkw[2] = t0.z; kkw[3] = t0.w; kkw[4] = t1.x; kkw[5] = t1.y; kkw[6] = t1.z; kkw[7] = t1.w; kaw[0] = u0.x; kaw[1] = u0.y; kaw[2] = u0.z; kaw[3] = u0.w; kaw[4] = u1.x; kaw[5] = u1.y; kaw[6] = u1.z; kaw[7] = u1.w; }
            struct PrepRegs { u32x4 gr, gk, gv, gs, ga; f32x4 gb0, gb1; u32x2 gt; } SA, SB, SC;
#define PREP_LOAD(S, cn) do { const size_t ro = (size_t)wkv_row(b, d, (cn) * CH + 8 * pw + jl) * DM + hc; S.gr = *(const u32x4*)(R + ro); S.gk = *(const u32x4*)(Kk + ro); S.gv = *(const u32x4*)(V + ro); S.gs = *(const u32x4*)(SD + ro); S.ga = *(const u32x4*)(AD + ro); \
            { const float* tg = (const float*)(A.ws + WS_TOTG) + (((size_t)chain * NCHUNK + (cn)) * 3 + (pw > 0 ? pw - 1 : 0)) * 64 + c8; S.gb0 = *(const f32x4*)tg; S.gb1 = *(const f32x4*)(tg + 4); } \
            S.gt = *(const u32x2*)(TB + ((size_t)chain * NCHUNK + (cn)) * 1024 + 4 * ptid); } while (0)
            PREP_LOAD(SA, 0); PREP_LOAD(SB, 1); PREP_LOAD(SC, 2);
#define PREP_ITER(IT, S) do { const int it = (IT); const int c1 = it + 1, c2 = it + 2; \
                if (it == CHAIN_MID_IT && nhelp) { if (lane == 0) { unsigned sp_ = 0; while (xb_ld(handoff) < nhelp) { __builtin_amdgcn_s_sleep(2); if (++sp_ > (1u << 22)) break; } } __builtin_amdgcn_fence(__ATOMIC_ACQUIRE, "agent"); } \
                if (c1 >= 0 && c1 < NCHUNK && do_prep) {                        \
                    LAS unsigned char* o3 = R3P(c1); LAS unsigned char* o2 = R2P(c1); \
                    const LAS bf16_t* AH = (const LAS bf16_t*)(o3 + R3_AH); const LAS bf16_t* RH = (const LAS bf16_t*)(o3 + R3_RH); const LAS bf16_t* BH = (const LAS bf16_t*)(o2 + R2_BH); const LAS bf16_t* KH = (const LAS bf16_t*)(o2 + R2_KH); \
                    const int mt = pw >> 1, nt = pw & 1; \
                    f32x4 a0 = (f32x4){0.f, 0.f, 0.f, 0.f}, a1 = a0, a2 = a0; \
_Pragma("unroll") \
                    for (int ks = 0; ks < 2; ++ks) { const bf16x8 fa = frag(AH, 72, mt * 16, ks * 32, lane), fr_ = frag(RH, 72, mt * 16, ks * 32, lane), fb = frag(BH, 72, nt * 16, ks * 32, lane), fk = frag(KH, 72, nt * 16, ks * 32, lane); \
                        a0 = MFMA16(fa, fk, a0); a1 = MFMA16(fr_, fb, a1); a2 = MFMA16(fr_, fk, a2); } \
_Pragma("unroll") \
                    for (int r = 0; r < 4; ++r) { const int j = mt * 16 + 4 * fq + r, m = nt * 16 + fr; \
                        ((LAS bf16_t*)(o2 + R2_LAK))[j * 40 + m] = (bf16_t)(cvt_pk_bf16_c((m < j) ? a0[r] : 0.f, 0.f) & 0xffffu); \
                        ((LAS bf16_t*)(o2 + R2_MRB))[j * 40 + m] = (bf16_t)(cvt_pk_bf16_c((m <= j) ? a1[r] : 0.f, 0.f) & 0xffffu); \
                        ((LAS bf16_t*)(o2 + R2_MRK))[j * 40 + m] = (bf16_t)(cvt_pk_bf16_c((m <= j) ? a2[r] : 0.f, 0.f) & 0xffffu); } \
                } \
                if (c2 < NCHUNK && do_prep) {                                   \
                    LAS unsigned char* o3 = R3P(c2); LAS unsigned char* o2 = R2P(c2); \
                    float rf[8], kf[8], sf[8], af[8], base[8], e[8], em1[8], einv[8], o1[8], o2v[8]; \
_Pragma("unroll") \
                    for (int i = 0; i < 8; ++i) base[i] = 0.f; \
                    if (pw > 0) { base[0] = S.gb0.x; base[1] = S.gb0.y; base[2] = S.gb0.z; base[3] = S.gb0.w; base[4] = S.gb1.x; base[5] = S.gb1.y; base[6] = S.gb1.z; base[7] = S.gb1.w; } \
                    unpack8(S.gs, sf); unpack8(S.gk, kf); unpack8(S.ga, af); unpack8(S.gr, rf); \
                    *(LAS u32x4*)((LAS bf16_t*)(o2 + R2_VH) + (8 * pw + jl) * 72 + c8) = S.gv; \
                    *(LAS u32x2*)((LAS bf16_t*)(o3 + R3_T) + (ptid >> 3) * 40 + 4 * (ptid & 7)) = S.gt; \
                    asm volatile("" : "+v"(sf[0]), "+v"(sf[1]), "+v"(sf[2]), "+v"(sf[3]), "+v"(sf[4]), "+v"(sf[5]), "+v"(sf[6]), "+v"(sf[7])); \
                    asm volatile("" : "+v"(kf[0]), "+v"(kf[1]), "+v"(kf[2]), "+v"(kf[3]), "+v"(kf[4]), "+v"(kf[5]), "+v"(kf[6]), "+v"(kf[7])); \
                    asm volatile("" : "+v"(af[0]), "+v"(af[1]), "+v"(af[2]), "+v"(af[3]), "+v"(af[4]), "+v"(af[5]), "+v"(af[6]), "+v"(af[7])); \
                    asm volatile("" : "+v"(rf[0]), "+v"(rf[1]), "+v"(rf[2]), "+v"(rf[3]), "+v"(rf[4]), "+v"(rf[5]), "+v"(rf[6]), "+v"(rf[7])); \
                    PREP_LOAD(S, (c2 + 3 < NCHUNK ? c2 + 3 : NCHUNK - 1)); \
                    wkv_decay(sf, base, lane, e, em1, einv); \
                    float ssq = 0.f; \
_Pragma("unroll") \
                    for (int i = 0; i < 8; ++i) { const float kv = kf[i] * kkw[i]; ssq += kv * kv; } \
                    const float rs = __builtin_amdgcn_rsqf(fmaxf(sum_groups(ssq), 1e-24f)); const int j = 8 * pw + jl; \
_Pragma("unroll") \
                    for (int i = 0; i < 8; ++i) { const float kk = kf[i] * kkw[i] * rs; o1[i] = -kk * em1[i]; o2v[i] = kk * af[i] * einv[i]; } \
                    *(LAS u32x4*)((LAS bf16_t*)(o3 + R3_AH) + j * 72 + c8) = pack8(o1); *(LAS u32x4*)((LAS bf16_t*)(o2 + R2_BH) + j * 72 + c8) = pack8(o2v); \
_Pragma("unroll") \
                    for (int i = 0; i < 8; ++i) { o1[i] = kf[i] * ((af[i] - 1.0f) * kaw[i] + 1.0f) * einv[i]; o2v[i] = rf[i] * e[i]; } \
                    *(LAS u32x4*)((LAS bf16_t*)(o2 + R2_KH) + j * 72 + c8) = pack8(o1); *(LAS u32x4*)((LAS bf16_t*)(o3 + R3_RH) + j * 72 + c8) = pack8(o2v); \
                    if (j == 31) { *(LAS f32x4*)((LAS float*)(o3 + R3_PV) + c8) = (f32x4){e[0], e[1], e[2], e[3]}; *(LAS f32x4*)((LAS float*)(o3 + R3_PV) + c8 + 4) = (f32x4){e[4], e[5], e[6], e[7]}; } \
                } \
                LDS_WAIT(); __builtin_amdgcn_s_barrier(); asm volatile("" ::: "memory"); \
            } while (0)
            {
#pragma unroll 1
              for (int it3 = -2; it3 + 2 < nch; it3 += 3) { PREP_ITER(it3, SA); PREP_ITER(it3 + 1, SB); PREP_ITER(it3 + 2, SC); }
              static_assert((NCHUNK + 2) % 3 == 2, "two intervals remain after the triples");
              PREP_ITER(nch - 2, SA); PREP_ITER(nch - 1, SB); }
#undef PREP_ITER
#undef PREP_LOAD
        } else {
            LAS bf16_t* XT = (LAS bf16_t*)(lds + CHN_OFF + wave * CHN_BYTES); LAS bf16_t* ZT = XT + 16 * 72; LAS bf16_t* UT = ZT + 16 * 40;
#define Y_FLUSH(chunk) do { if ((chunk) >= CTXL / CH && do_store) { const LAS bf16_t* YSf = (const LAS bf16_t*)(lds + YS_OFF + ((chunk) & 1) * YS_BYTES); const int st = wave * 64 + lane, row = st >> 3, cch = st & 7; const u32x4 yv = *(const LAS u32x4*)(YSf + row * 72 + 8 * cch); \
                *(u32x4*)(YD + (size_t)wkv_row(b, d, (chunk) * CH + row) * DM + h * 64 + 8 * cch) = yv; } } while (0)
            f32x4 X[4];
#pragma unroll
            for (int mt = 0; mt < 4; ++mt) X[mt] = (f32x4){0.f, 0.f, 0.f, 0.f};
#pragma unroll 1
            for (int it = -2; it < nch; ++it) {
                if (it >= 1) Y_FLUSH(it - 1);
                if (it >= 0 && do_state) {
                    const LAS unsigned char* o3 = R3P(it); const LAS unsigned char* o2 = R2P(it); LAS bf16_t* YS = (LAS bf16_t*)(lds + YS_OFF + (it & 1) * YS_BYTES);
                    const LAS bf16_t* AH = (const LAS bf16_t*)(o3 + R3_AH); const LAS bf16_t* LAK = (const LAS bf16_t*)(o2 + R2_LAK); const LAS bf16_t* TT_ = (const LAS bf16_t*)(o3 + R3_T); const LAS bf16_t* VT = (const LAS bf16_t*)(o2 + R2_VT);
                    const LAS bf16_t* RH = (const LAS bf16_t*)(o3 + R3_RH); const LAS bf16_t* MRB = (const LAS bf16_t*)(o2 + R2_MRB); const LAS bf16_t* MRK = (const LAS bf16_t*)(o2 + R2_MRK);
                    const LAS bf16_t* BT = (const LAS bf16_t*)(o2 + R2_BT); const LAS bf16_t* KT = (const LAS bf16_t*)(o2 + R2_KT); const LAS float* PV = (const LAS float*)(o3 + R3_PV);
#pragma unroll
                    for (int mt = 0; mt < 4; ++mt) { u32x2 w; w.x = cvt_pk_bf16_c(X[mt][0], X[mt][1]); w.y = cvt_pk_bf16_c(X[mt][2], X[mt][3]); *(LAS u32x2*)(XT + fr * 72 + mt * 16 + 4 * fq) = w; }
                    LDS_WAIT();
                    const bf16x8 x0 = frag(XT, 72, 0, 0, lane), x1 = frag(XT, 72, 0, 32, lane), vt = frag(VT, 40, 16 * wave, 0, lane);
                    f32x4 Z0 = (f32x4){0.f, 0.f, 0.f, 0.f}, Z1 = Z0;
                    Z0 = MFMA16(frag(AH, 72, 0, 0, lane), x0, Z0); Z0 = MFMA16(frag(AH, 72, 0, 32, lane), x1, Z0); Z0 = MFMA16(frag(LAK, 40, 0, 0, lane), vt, Z0);
                    Z1 = MFMA16(frag(AH, 72, 16, 0, lane), x0, Z1); Z1 = MFMA16(frag(AH, 72, 16, 32, lane), x1, Z1); Z1 = MFMA16(frag(LAK, 40, 16, 0, lane), vt, Z1);
                    { u32x2 w; w.x = cvt_pk_bf16_c(Z0[0], Z0[1]); w.y = cvt_pk_bf16_c(Z0[2], Z0[3]); *(LAS u32x2*)(ZT + fr * 40 + 4 * fq) = w; w.x = cvt_pk_bf16_c(Z1[0], Z1[1]); w.y = cvt_pk_bf16_c(Z1[2], Z1[3]); *(LAS u32x2*)(ZT + fr * 40 + 16 + 4 * fq) = w; }
                    LDS_WAIT();
                    const bf16x8 zt = frag(ZT, 40, 0, 0, lane);
                    const f32x4 zero4 = (f32x4){0.f, 0.f, 0.f, 0.f}; const f32x4 U0 = MFMA16(frag(TT_, 40, 0, 0, lane), zt, zero4), U1 = MFMA16(frag(TT_, 40, 16, 0, lane), zt, zero4);
                    { u32x2 w; w.x = cvt_pk_bf16_c(U0[0], U0[1]); w.y = cvt_pk_bf16_c(U0[2], U0[3]); *(LAS u32x2*)(UT + fr * 40 + 4 * fq) = w; w.x = cvt_pk_bf16_c(U1[0], U1[1]); w.y = cvt_pk_bf16_c(U1[2], U1[3]); *(LAS u32x2*)(UT + fr * 40 + 16 + 4 * fq) = w; }
                    LDS_WAIT();
                    const bf16x8 ut = frag(UT, 40, 0, 0, lane);
                    if (it >= CTXL / CH && do_store) {
#pragma unroll
                        for (int mt = 0; mt < 2; ++mt) { f32x4 Y = (f32x4){0.f, 0.f, 0.f, 0.f};
                            Y = MFMA16(frag(RH, 72, mt * 16, 0, lane), x0, Y); Y = MFMA16(frag(RH, 72, mt * 16, 32, lane), x1, Y); Y = MFMA16(frag(MRB, 40, mt * 16, 0, lane), ut, Y); Y = MFMA16(frag(MRK, 40, mt * 16, 0, lane), vt, Y);
#pragma unroll
                            for (int r = 0; r < 4; ++r) YS[(mt * 16 + 4 * fq + r) * 72 + 16 * wave + fr] = (bf16_t)(cvt_pk_bf16_c(Y[r], 0.f) & 0xffffu); } }
#pragma unroll
                    for (int mt = 0; mt < 4; ++mt) { X[mt] = MFMA16(frag(BT, 40, mt * 16, 0, lane), ut, X[mt]); X[mt] = MFMA16(frag(KT, 40, mt * 16, 0, lane), vt, X[mt]);
                        const f32x4 p = *(const LAS f32x4*)(PV + mt * 16 + 4 * fq); X[mt] = X[mt] * p; }
                }
                if (it + 1 >= 0 && it + 1 < NCHUNK) {
                    LAS unsigned char* opn = R2P(it + 1);
                    const LAS bf16_t* BHn = (const LAS bf16_t*)(opn + R2_BH); const LAS bf16_t* KHn = (const LAS bf16_t*)(opn + R2_KH); const LAS bf16_t* VHn = (const LAS bf16_t*)(opn + R2_VH);
                    u32x4 tb, tk, tv; unsigned short eb[8], ek[8], ev[8];
#pragma unroll
                    for (int i = 0; i < 8; ++i) { eb[i] = BHn[(8 * wave + i) * 72 + lane]; ek[i] = KHn[(8 * wave + i) * 72 + lane]; ev[i] = VHn[(8 * wave + i) * 72 + lane]; }
                    tb.x = eb[0] | ((unsigned)eb[1] << 16); tb.y = eb[2] | ((unsigned)eb[3] << 16); tb.z = eb[4] | ((unsigned)eb[5] << 16); tb.w = eb[6] | ((unsigned)eb[7] << 16);
                    tk.x = ek[0] | ((unsigned)ek[1] << 16); tk.y = ek[2] | ((unsigned)ek[3] << 16); tk.z = ek[4] | ((unsigned)ek[5] << 16); tk.w = ek[6] | ((unsigned)ek[7] << 16);
                    tv.x = ev[0] | ((unsigned)ev[1] << 16); tv.y = ev[2] | ((unsigned)ev[3] << 16); tv.z = ev[4] | ((unsigned)ev[5] << 16); tv.w = ev[6] | ((unsigned)ev[7] << 16);
                    *(LAS u32x4*)((LAS bf16_t*)(opn + R2_BT) + lane * 40 + 8 * wave) = tb; *(LAS u32x4*)((LAS bf16_t*)(opn + R2_KT) + lane * 40 + 8 * wave) = tk; *(LAS u32x4*)((LAS bf16_t*)(opn + R2_VT) + lane * 40 + 8 * wave) = tv; }
                LDS_WAIT(); __builtin_amdgcn_s_barrier(); asm volatile("" ::: "memory");
            }
            Y_FLUSH(NCHUNK - 1);
#undef Y_FLUSH
        }
    }
#undef R3P
#undef R2P
}

__device__ __forceinline__ void p16_readout(KAREF A, int G) {
    const int lane = threadIdx.x & 63, wave = threadIdx.x >> 6, gw = blockIdx.x * 8 + wave, ngw = G * 8;
    const bf16_t* V = (const bf16_t*)(A.ws + WS_ACT + A_RKV) + 2 * (size_t)TT * DM; const bf16_t* Gg = (const bf16_t*)(A.ws + WS_ACT + A_G);
    const bf16_t* Y0 = (const bf16_t*)(A.ws + WS_ACT + A_YD0); const bf16_t* Y1 = (const bf16_t*)(A.ws + WS_ACT + A_YD1); bf16_t* O = (bf16_t*)(A.ws + WS_ACT + A_O);
    const float* BON = (const float*)(A.ws + WS_BON);
    const int c0 = 16 * lane;
    float gng[16], gnb[16];
#pragma unroll
    for (int i = 0; i < 16; ++i) { gng[i] = A.in[I1_GNG][c0 + i]; gnb[i] = A.in[I1_GNB][c0 + i]; }
    u32x4 nq[8]; float nb0, nb1;
#define RO_LOAD(M) do { const size_t o_ = (size_t)(M) * DM + c0; nq[0] = *(const u32x4*)(Y0 + o_); nq[1] = *(const u32x4*)(Y0 + o_ + 8); nq[2] = *(const u32x4*)(Y1 + o_); nq[3] = *(const u32x4*)(Y1 + o_ + 8); \
        nq[4] = *(const u32x4*)(V + o_); nq[5] = *(const u32x4*)(V + o_ + 8); nq[6] = *(const u32x4*)(Gg + o_); nq[7] = *(const u32x4*)(Gg + o_ + 8); \
        nb0 = BON[(size_t)(M) * 16 + (lane >> 2)]; nb1 = BON[((size_t)TL + (M)) * 16 + (lane >> 2)]; } while (0)
    RO_LOAD(gw < TL ? gw : 0);
    for (int m = gw; m < TL; m += ngw) {
        const size_t o = (size_t)m * DM + c0;
        float y[16], rr[16], vv[16], gg[16];
#define UP16(dst, w0, w1) do { dst[0] = bflo(w0.x); dst[1] = bfhi(w0.x); dst[2] = bflo(w0.y); dst[3] = bfhi(w0.y); dst[4] = bflo(w0.z); dst[5] = bfhi(w0.z); dst[6] = bflo(w0.w); dst[7] = bfhi(w0.w); \
        dst[8] = bflo(w1.x); dst[9] = bfhi(w1.x); dst[10] = bflo(w1.y); dst[11] = bfhi(w1.y); dst[12] = bflo(w1.z); dst[13] = bfhi(w1.z); dst[14] = bflo(w1.w); dst[15] = bfhi(w1.w); } while (0)
        UP16(y, nq[0], nq[1]); UP16(rr, nq[2], nq[3]); UP16(vv, nq[4], nq[5]); UP16(gg, nq[6], nq[7]);
#undef UP16
        const float bs = nb0 + nb1;
        { const int mn = m + ngw < TL ? m + ngw : m; RO_LOAD(mn); }
        float s = 0.f;
#pragma unroll
        for (int i = 0; i < 16; ++i) { y[i] += rr[i]; s += y[i]; }
        s += __shfl_xor(s, 1); s += __shfl_xor(s, 2);
        const float mean = s * (1.f / 64.f); float q = 0.f;
#pragma unroll
        for (int i = 0; i < 16; ++i) { const float dlt = y[i] - mean; q += dlt * dlt; }
        q += __shfl_xor(q, 1); q += __shfl_xor(q, 2);
        const float rstd = __builtin_amdgcn_rsqf(q * (1.f / 64.f) + 64e-5f);
        unsigned w[8];
#pragma unroll
        for (int i = 0; i < 8; ++i) { const float o0 = ((y[2 * i] - mean) * rstd * gng[2 * i] + gnb[2 * i] + bs * vv[2 * i]) * gg[2 * i], o1 = ((y[2 * i + 1] - mean) * rstd * gng[2 * i + 1] + gnb[2 * i + 1] + bs * vv[2 * i + 1]) * gg[2 * i + 1];
            w[i] = cvt_pk_bf16(o0, o1); }
        *(u32x4*)(O + o) = (u32x4){w[0], w[1], w[2], w[3]}; *(u32x4*)(O + o + 8) = (u32x4){w[4], w[5], w[6], w[7]};
    }
#undef RO_LOAD
}
#if defined(DBG_WKV)
__device__ __forceinline__ float rowsum16(float x) { x = DPP_ADD(x, 0xB1); x = DPP_ADD(x, 0x4E); x = DPP_ADD(x, 0x141); x = DPP_ADD(x, 0x140); return x; }
constexpr int WKV_TB = 32, WKV_STEP_F = 6 * 64, WKV_BUF_F = WKV_TB * WKV_STEP_F;
__device__ __forceinline__ void p15_wkv_old(KAREF A, LAS unsigned char* lds, int G) {
    const int tid = threadIdx.x, lane = tid & 63, wid = tid >> 6;
    LAS float* BUF = (LAS float*)lds;
    LAS float* YB = (LAS float*)(lds + 2 * WKV_BUF_F * 4);
    const bf16_t* R = (const bf16_t*)(A.ws + WS_ACT + A_RKV); const bf16_t* Kk = R + (size_t)TT * DM; const bf16_t* V = Kk + (size_t)TT * DM;
    for (int u = blockIdx.x; u < 256; u += G) {
        const int chain = u >> 1, half = u & 1, b = chain >> 5, h = (chain >> 1) & 15, d = chain & 1;
        const bf16_t* SD = (const bf16_t*)(A.ws + WS_ACT + A_SD) + (size_t)d * TT * DM; const bf16_t* AD = (const bf16_t*)(A.ws + WS_ACT + A_AD) + (size_t)d * TT * DM;
        bf16_t* YD = (bf16_t*)(A.ws + WS_MOEW1) + (size_t)d * TL * DM;
        const int ls = tid >> 4, lc = 4 * (tid & 15), hc = h * 64 + lc;
        const f32x4 kkw = *(const f32x4*)(A.in[I1_KK] + hc), kaw = *(const f32x4*)(A.in[I1_KA] + hc);
        u32x2 gr, gk, gv, gs, ga;
#define WKV_LOAD(blk) do { const size_t ro = (size_t)wkv_row(b, d, (blk) * WKV_TB + ls) * DM + hc; gr = *(const u32x2*)(R + ro); gk = *(const u32x2*)(Kk + ro); gv = *(const u32x2*)(V + ro); gs = *(const u32x2*)(SD + ro); ga = *(const u32x2*)(AD + ro); } while (0)
#define WKV_STORE(bufi) do { LAS float* dst = BUF + (bufi) * WKV_BUF_F + ls * WKV_STEP_F + lc; \
        const f32x4 kf = (f32x4){bflo(gk.x), bfhi(gk.x), bflo(gk.y), bfhi(gk.y)}, af = (f32x4){bflo(ga.x), bfhi(ga.x), bflo(ga.y), bfhi(ga.y)}, sf = (f32x4){bflo(gs.x), bfhi(gs.x), bflo(gs.y), bfhi(gs.y)}; \
        const f32x4 kkv = kf * kkw; float ssq = (kkv.x * kkv.x + kkv.y * kkv.y) + (kkv.z * kkv.z + kkv.w * kkv.w); ssq = rowsum16(ssq); \
        const f32x4 kkn = kkv * __builtin_amdgcn_rsqf(fmaxf(ssq, 1e-24f)); \
        f32x4 wd; wd.x = fexp(-0.6065306597126334f * sf.x); wd.y = fexp(-0.6065306597126334f * sf.y); wd.z = fexp(-0.6065306597126334f * sf.z); wd.w = fexp(-0.6065306597126334f * sf.w); \
        *(LAS f32x4*)(dst) = wd; *(LAS f32x4*)(dst + 64) = -kkn; *(LAS f32x4*)(dst + 128) = kkn * af; *(LAS f32x4*)(dst + 192) = kf * ((af - 1.0f) * kaw + 1.0f); \
        *(LAS f32x4*)(dst + 256) = (f32x4){bflo(gr.x), bfhi(gr.x), bflo(gr.y), bfhi(gr.y)}; *(LAS f32x4*)(dst + 320) = (f32x4){bflo(gv.x), bfhi(gv.x), bflo(gv.y), bfhi(gv.y)}; } while (0)
        __syncthreads();
        WKV_LOAD(0); WKV_STORE(0);
        __syncthreads();
        const int g = lane >> 4, j = lane & 15, vrow = 32 * half + 4 * wid + g;
        float S0 = 0.f, S1 = 0.f, S2 = 0.f, S3 = 0.f;
        constexpr int NBLK = (CTXL + SEQ) / WKV_TB;
#pragma unroll 1
        for (int blk = 0; blk < NBLK; ++blk) {
            const int cur = blk & 1;
            if (blk + 1 < NBLK) WKV_LOAD(blk + 1);
            const LAS float* bp = BUF + cur * WKV_BUF_F + 4 * j;
#pragma unroll 1
            for (int t8 = 0; t8 < WKV_TB; t8 += 8) {
                float yv[8];
#pragma unroll
                for (int tt = 0; tt < 8; ++tt) {
                    const LAS float* sp = bp + (t8 + tt) * WKV_STEP_F;
                    const f32x4 w4 = *(const LAS f32x4*)(sp), a4 = *(const LAS f32x4*)(sp + 64), b4 = *(const LAS f32x4*)(sp + 128), k4 = *(const LAS f32x4*)(sp + 192), r4 = *(const LAS f32x4*)(sp + 256);
                    const float v1 = BUF[cur * WKV_BUF_F + (t8 + tt) * WKV_STEP_F + 320 + vrow];
                    float sa = (S0 * a4.x + S1 * a4.y) + (S2 * a4.z + S3 * a4.w);
                    const float t0 = S0 * w4.x + v1 * k4.x, t1 = S1 * w4.y + v1 * k4.y, t2 = S2 * w4.z + v1 * k4.z, t3 = S3 * w4.w + v1 * k4.w;
                    sa = rowsum16(sa);
                    S0 = sa * b4.x + t0; S1 = sa * b4.y + t1; S2 = sa * b4.z + t2; S3 = sa * b4.w + t3;
                    yv[tt] = (S0 * r4.x + S1 * r4.y) + (S2 * r4.z + S3 * r4.w);
                }
#pragma unroll
                for (int tt = 0; tt < 8; ++tt) { const float y = rowsum16(yv[tt]); if (j == 0) YB[(t8 + tt) * 32 + 4 * wid + g] = y; }
            }
            __syncthreads();
            if (blk * WKV_TB >= CTXL) {
                const int m = wkv_row(b, d, blk * WKV_TB + ls); const int r2 = 2 * (tid & 15);
                *(unsigned*)(YD + (size_t)m * DM + h * 64 + 32 * half + r2) = cvt_pk_bf16(YB[ls * 32 + r2], YB[ls * 32 + r2 + 1]); }
            if (blk + 1 < NBLK) WKV_STORE(cur ^ 1);
            __syncthreads();
        }
#undef WKV_LOAD
#undef WKV_STORE
    }
}

#endif
constexpr int N_PHASES = 25;
__global__ void __launch_bounds__(512, 2) fwd_kernel(KArgs A_unused) {
    const __attribute__((address_space(4))) KArgs* kp = (const __attribute__((address_space(4))) KArgs*)__builtin_amdgcn_kernarg_segment_ptr();
    extern __shared__ __attribute__((aligned(16))) unsigned char lds_raw[];
    LAS unsigned char* lds = (LAS unsigned char*)lds_raw;
    const int G = gridDim.x, tid = threadIdx.x;
    for (int u = tid; u < (LDS_BYTES - LDSCTL_OFF) / 4; u += 512) ((LAS unsigned*)(lds + LDSCTL_OFF))[u] = 0u;
    __syncthreads();
    const int lo = kp->ph_lo, hi = kp->ph_hi;
    const bool use_bar = (hi - lo) > 1;
    XcdBarrier bar; bar.bar = (unsigned*)(kp->ws + WS_CTL) + 4096; bar.x = 0; bar.st = (volatile LAS unsigned*)(lds + MISC_OFF) + 8;
    if (use_bar) bar = xcd_barrier_post((unsigned*)(kp->ws + WS_CTL) + 4096, (volatile LAS unsigned*)(lds + MISC_OFF) + 8);
#ifndef ONLY_PHASE
#define ONLY_PHASE -1
#endif
#ifndef DBG_STOP
#define DBG_STOP 99
#endif
#define IN(k) ((ONLY_PHASE < 0 || ONLY_PHASE == (k)) && (k) < DBG_STOP && lo <= (k) && (k) < hi)
#ifndef DBG_REP
#define DBG_REP -1
#endif
#ifndef DBG_VAR
#define DBG_VAR 0
#endif
#ifndef DBG_REPN
#define DBG_REPN 2
#endif
#define REPEAT(k) for (int rep_ = 0; rep_ < ((k) == DBG_REP ? DBG_REPN : 1); ++rep_)
#if defined(DBG_TIME)
#define TSTAMP(k) do { if (blockIdx.x == 0 && tid == 0 && ((k) == DBG_TIME || (k) == DBG_TIME + 1)) ((unsigned long long*)(kp->ws + WS_CTL))[1100 + ((k) - DBG_TIME)] = wall_clock64(); } while (0)
#else
#define TSTAMP(k) do {} while (0)
#endif
#define SEAM(k) do { if (IN(k) && IN((k) + 1)) xcd_barrier(bar); } while (0)

    if (IN(0)) REPEAT(0) { TSTAMP(0); __syncthreads(); KAREF A = *ka_launder(kp); unsigned char* ws = A.ws; unsigned char* act = ws + WS_ACT; (void)act; p0_prologue(A, lds, G); } SEAM(0);
    if (IN(1)) REPEAT(1) { TSTAMP(1); __syncthreads(); KAREF A = *ka_launder(kp); unsigned char* ws = A.ws; unsigned char* act = ws + WS_ACT; (void)act; p1_norm0(A, G); } SEAM(1);
    if (IN(2)) REPEAT(2) { TSTAMP(2); __syncthreads(); KAREF A = *ka_launder(kp); unsigned char* ws = A.ws; unsigned char* act = ws + WS_ACT; (void)act;
        pg8::Gemm g{(const bf16_t*)(act + A_H), (const bf16_t*)(ws + WS_WIN), DM}; pg8::StaticOrder S; S.init(TT, 1792, G, (int)blockIdx.x);
        EpiWin E{(bf16_t*)(act + A_XA), (bf16_t*)(act + A_GA), (float*)(act + A_QR), (float*)(act + A_KR), (bf16_t*)(act + A_VB)};
        pg8::gemm_phase<EpiWin, pg8::StaticOrder, true, true>(lds + RING_OFF, g, S, E);
    } SEAM(2);
    if (IN(3)) REPEAT(3) { TSTAMP(3); __syncthreads(); KAREF A = *ka_launder(kp); unsigned char* ws = A.ws; unsigned char* act = ws + WS_ACT; (void)act; p3_kprep(A, G); p3_lru_pass1(A, lds, G); } SEAM(3);
    if (IN(4)) REPEAT(4) { TSTAMP(4); __syncthreads(); KAREF A = *ka_launder(kp); unsigned char* ws = A.ws; unsigned char* act = ws + WS_ACT; (void)act; p4_lru_pass2(A, lds, G); __syncthreads(); p4_attention(A, (char*)lds_raw + RING_OFF, G); } SEAM(4);
    if (IN(5)) REPEAT(5) { TSTAMP(5); __syncthreads(); KAREF A = *ka_launder(kp); unsigned char* ws = A.ws; unsigned char* act = ws + WS_ACT; (void)act;
        pg8::Gemm g{(const bf16_t*)(act + A_YCAT), (const bf16_t*)(ws + WS_WOUT), DM}; pg8::StaticOrder S; S.init(TL, DM, G, (int)blockIdx.x);
        EpiResid E{A.in[I_X], A.in[I_CTX], A.out, (float*)(ws + WS_CTXS), ada_ptr(ws, 0, 0, 2)};
        pg8::gemm_phase<EpiResid, pg8::StaticOrder, true, true>(lds + RING_OFF, g, S, E);
        p5_ctx_outproj(A, G);
    } SEAM(5);
    if (IN(6)) REPEAT(6) { TSTAMP(6); __syncthreads(); KAREF A = *ka_launder(kp); unsigned char* ws = A.ws; unsigned char* act = ws + WS_ACT; (void)act; p6_norm_router(A, lds, G, 0, TT); } SEAM(6);
    if (IN(7)) REPEAT(7) { TSTAMP(7); __syncthreads(); KAREF A = *ka_launder(kp); unsigned char* ws = A.ws; unsigned char* act = ws + WS_ACT; (void)act; p7_topk(A, lds, G, true); } SEAM(7);
    if (IN(8)) REPEAT(8) { TSTAMP(8); __syncthreads(); KAREF A = *ka_launder(kp); unsigned char* ws = A.ws; unsigned char* act = ws + WS_ACT; (void)act; p8_gather(A, G, true); } SEAM(8);
    if (IN(9)) REPEAT(9) { TSTAMP(9); __syncthreads(); KAREF A = *ka_launder(kp); unsigned char* ws = A.ws; unsigned char* act = ws + WS_ACT; (void)act;
        int k8 = DM / 2; asm volatile("" : "+s"(k8));
        pg8::Gemm g{(const bf16_t*)(act + A_XE), (const bf16_t*)(ws + WS_MOEW1), k8}; MoeOrder1 S{G, (int)blockIdx.x, 4096 + 256};
        EpiSwiGLU E{act + A_HID};
        pg8::gemm_phase<EpiSwiGLU, MoeOrder1, true, true, true>(lds + RING_OFF, g, S, E);
    } SEAM(9);
    if (IN(10)) REPEAT(10) { TSTAMP(10); __syncthreads(); KAREF A = *ka_launder(kp); unsigned char* ws = A.ws; unsigned char* act = ws + WS_ACT; (void)act;
        int k8 = FF / 2; asm volatile("" : "+s"(k8));
        pg8::Gemm g{(const bf16_t*)(act + A_HID), (const bf16_t*)(ws + WS_MOEW2), k8}; MoeOrder2 S{G, (int)blockIdx.x, 1024 + 64};
        EpiDown E{(bf16_t*)(act + A_YE), (const float*)(ws + WS_GROW)};
        pg8::gemm_phase<EpiDown, MoeOrder2, true, true, true>(lds + RING_OFF, g, S, E);
    } SEAM(10);
    if (IN(11)) REPEAT(11) { TSTAMP(11); __syncthreads(); KAREF A = *ka_launder(kp); unsigned char* ws = A.ws; unsigned char* act = ws + WS_ACT; (void)act; p11_combine(A, G, 0, TT); } SEAM(11);
    if (IN(12)) REPEAT(12) { TSTAMP(12); __syncthreads(); KAREF A = *ka_launder(kp); unsigned char* ws = A.ws; unsigned char* act = ws + WS_ACT; (void)act; p12_l1_prep(A, lds, G);
    } SEAM(12);
    if (IN(13)) REPEAT(13) { TSTAMP(13); __syncthreads(); KAREF A = *ka_launder(kp); unsigned char* ws = A.ws; unsigned char* act = ws + WS_ACT; (void)act;
        pg8::Gemm g{(const bf16_t*)(act + A_XMIX), (const bf16_t*)(ws + WS_BMIX), DM}; MixOrder S{G, (int)blockIdx.x};
        EpiMix E{(bf16_t*)(act + A_RKV), (bf16_t*)(act + A_LG), (bf16_t*)(act + A_LWA)};
        pg8::gemm_phase<EpiMix, MixOrder, true, true>(lds + RING_OFF, g, S, E);
    } SEAM(13);
    if (IN(14)) REPEAT(14) { TSTAMP(14); __syncthreads(); KAREF A = *ka_launder(kp); unsigned char* ws = A.ws; unsigned char* act = ws + WS_ACT; (void)act;
        int k2 = 256; asm volatile("" : "+s"(k2));
        pg8::Gemm g{(const bf16_t*)(act + A_LG), (const bf16_t*)(ws + WS_B2), k2}; LoraOrder S{G, (int)blockIdx.x};
        EpiLora E{(bf16_t*)(act + A_SD), (bf16_t*)(act + A_AD), (bf16_t*)(act + A_G), A.in[I1_W0], A.in[I1_A0]};
        pg8::gemm_phase<EpiLora, LoraOrder, true, true>(lds + RING_OFF, g, S, E);
    } SEAM(14);
    if (IN(15)) REPEAT(15) { TSTAMP(15); __syncthreads(); KAREF A = *ka_launder(kp); unsigned char* ws = A.ws; unsigned char* act = ws + WS_ACT; (void)act; p15_tbuild(A, lds, (int)blockIdx.x * 8 + (tid >> 6), G * 8, 0, (use_bar && G > 128) ? TB_CP_FIRST : NCHUNK / 2); } SEAM(15);
    if (IN(16)) REPEAT(16) { TSTAMP(16); __syncthreads(); KAREF A = *ka_launder(kp); unsigned char* ws = A.ws; unsigned char* act = ws + WS_ACT; (void)act; (void)ws;
        unsigned* handoff = (unsigned*)(ws + WS_CTL) + 16384; const bool split = use_bar && G > 128;
        if ((int)blockIdx.x < 128) p16_chain(A, lds, G, 0, handoff, split ? (unsigned)(G - 128) : 0u);
        else { const int wave = tid >> 6;
            if (split) { p15_tbuild(A, lds, ((int)blockIdx.x - 128) * 8 + wave, (G - 128) * 8, TB_CP_FIRST, NCHUNK / 2);
                asm volatile("s_waitcnt vmcnt(0)" ::: "memory"); __syncthreads();
                if (tid == 0) { __builtin_amdgcn_fence(__ATOMIC_RELEASE, "agent"); (void)xb_add(handoff, 1u); } }
            moe_convert(A, 1, lds, ((int)blockIdx.x - 128) * 8 + wave, (G - 128) * 8, wave, tid & 63); }
#if defined(DBG_WKV)
        __syncthreads(); p15_wkv_old(A, lds, G);
#endif
    } SEAM(16);
    if (IN(17)) REPEAT(17) { TSTAMP(17); __syncthreads(); KAREF A = *ka_launder(kp); unsigned char* ws = A.ws; unsigned char* act = ws + WS_ACT; (void)act; p16_readout(A, G);
    } SEAM(17);
    if (IN(18)) REPEAT(18) { TSTAMP(18); __syncthreads(); KAREF A = *ka_launder(kp); unsigned char* ws = A.ws; unsigned char* act = ws + WS_ACT; (void)act;
        pg8::Gemm g{(const bf16_t*)(act + A_O), (const bf16_t*)(ws + WS_WO), DM}; pg8::StaticOrder S; S.init(TL, DM, G, (int)blockIdx.x);
        EpiResid E{A.out, A.out, A.out, A.out, ada_ptr(ws, 1, 0, 2)};
        pg8::gemm_phase<EpiResid, pg8::StaticOrder, true, true>(lds + RING_OFF, g, S, E);
    } SEAM(18);
    if (IN(19)) REPEAT(19) { TSTAMP(19); __syncthreads(); KAREF A = *ka_launder(kp); unsigned char* ws = A.ws; unsigned char* act = ws + WS_ACT; (void)act; p6_norm_router(A, lds, G, 1, TL); } SEAM(19);
    if (IN(20)) REPEAT(20) { TSTAMP(20); __syncthreads(); KAREF A = *ka_launder(kp); unsigned char* ws = A.ws; unsigned char* act = ws + WS_ACT; (void)act; p7_topk(A, lds, G, false); } SEAM(20);
    if (IN(21)) REPEAT(21) { TSTAMP(21); __syncthreads(); KAREF A = *ka_launder(kp); unsigned char* ws = A.ws; unsigned char* act = ws + WS_ACT; (void)act; p8_gather(A, G, false); } SEAM(21);
    if (IN(22)) REPEAT(22) { TSTAMP(22); __syncthreads(); KAREF A = *ka_launder(kp); unsigned char* ws = A.ws; unsigned char* act = ws + WS_ACT; (void)act;
        int k8 = DM / 2; asm volatile("" : "+s"(k8));
        pg8::Gemm g{(const bf16_t*)(act + A_XE), (const bf16_t*)(ws + WS_MOEW1), k8}; MoeOrder1 S{G, (int)blockIdx.x, 4096};
        EpiSwiGLU E{act + A_HID};
        pg8::gemm_phase<EpiSwiGLU, MoeOrder1, true, true, true>(lds + RING_OFF, g, S, E);
    } SEAM(22);
    if (IN(23)) REPEAT(23) { TSTAMP(23); __syncthreads(); KAREF A = *ka_launder(kp); unsigned char* ws = A.ws; unsigned char* act = ws + WS_ACT; (void)act;
        int k8 = FF / 2; asm volatile("" : "+s"(k8));
        pg8::Gemm g{(const bf16_t*)(act + A_HID), (const bf16_t*)(ws + WS_MOEW2), k8}; MoeOrder2 S{G, (int)blockIdx.x, 1024};
        EpiDown E{(bf16_t*)(act + A_YE), (const float*)(ws + WS_GROW)};
        pg8::gemm_phase<EpiDown, MoeOrder2, true, true, true>(lds + RING_OFF, g, S, E);
    } SEAM(23);
    if (IN(24)) REPEAT(24) { TSTAMP(24); __syncthreads(); KAREF A = *ka_launder(kp); unsigned char* ws = A.ws; unsigned char* act = ws + WS_ACT; (void)act; p11_combine(A, G, 1, TL); }
#undef IN
#undef SEAM
}

#ifndef N_LAUNCH_MODE
#define N_LAUNCH_MODE 0
#endif
extern "C" void kernel_launch(void* const* d_in, const int* in_sizes, int n_in, void* d_out, int out_size, void* d_ws, size_t ws_size, hipStream_t stream) {
    static int grid = 0;
    if (grid == 0) {
        if (n_in != N_IN || in_sizes[0] != TL * DM || out_size != TL * DM || ws_size < WS_END) {
            fprintf(stderr, "kernel_launch: unexpected shapes (n_in %d, in0 %d, out %d, ws %zu < %zu?); nothing launched\n", n_in, n_in > 0 ? in_sizes[0] : -1, out_size, ws_size, (size_t)WS_END); grid = -1; return; }
        int dev = 0, cus = 0, per_cu = 0;
        if (hipGetDevice(&dev) != hipSuccess || hipDeviceGetAttribute(&cus, hipDeviceAttributeMultiprocessorCount, dev) != hipSuccess) { grid = -1; return; }
        if (hipFuncSetAttribute((const void*)fwd_kernel, hipFuncAttributeMaxDynamicSharedMemorySize, LDS_BYTES) != hipSuccess) { fprintf(stderr, "kernel_launch: hipFuncSetAttribute failed\n"); grid = -1; return; }
        if (hipOccupancyMaxActiveBlocksPerMultiprocessor(&per_cu, (const void*)fwd_kernel, 512, LDS_BYTES) != hipSuccess || per_cu < 1) { fprintf(stderr, "kernel_launch: occupancy query says %d\n", per_cu); }
        (void)hipGetLastError();
        grid = cus;
    }
    if (grid < 0) return;
    (void)hipMemsetAsync((char*)d_ws, 0, ZERO_BYTES, stream);
    KArgs a{};
    for (int i = 0; i < N_IN; ++i) a.in[i] = (const float*)d_in[i];
    a.out = (float*)d_out; a.ws = (unsigned char*)d_ws;
#if N_LAUNCH_MODE == 1
    for (int p = 0; p < N_PHASES; ++p) { a.ph_lo = p; a.ph_hi = p + 1; hipLaunchKernelGGL(fwd_kernel, dim3(grid), dim3(512), LDS_BYTES, stream, a); }
#else
    a.ph_lo = 0; a.ph_hi = N_PHASES; hipLaunchKernelGGL(fwd_kernel, dim3(grid), dim3(512), LDS_BYTES, stream, a);
#endif
}
```

```cpp
#include <hip/hip_runtime.h>
#include <cstdio>
#include <cstdint>

#define GAS __attribute__((address_space(1)))
#define LAS __attribute__((address_space(3)))
typedef unsigned short bf16_t;
typedef short bf16x8 __attribute__((ext_vector_type(8)));
typedef short s16x4 __attribute__((ext_vector_type(4)));
typedef float f32x16 __attribute__((ext_vector_type(16)));
typedef float f32x4 __attribute__((ext_vector_type(4)));
typedef float f32x2 __attribute__((ext_vector_type(2)));
typedef unsigned u32x4 __attribute__((ext_vector_type(4)));
typedef unsigned u32x2 __attribute__((ext_vector_type(2)));

constexpr int NB = 4, SEQ = 8192, CTXL = 256, DM = 1024;
constexpr int TL = NB * SEQ, TC = NB * CTXL, TT = TL + TC;
constexpr int KVL = SEQ + CTXL;
constexpr int NE = 16, FF = 2048, CAPL = 1024, CAPC = 32;
constexpr int XE_CTX0 = NB * NE * CAPL;
constexpr int XE_ROWS = XE_CTX0 + NE * 256;

typedef float f32x2_cv __attribute__((ext_vector_type(2))); typedef __bf16 bf16x2_cv __attribute__((ext_vector_type(2)));
__device__ __forceinline__ unsigned cvt_pk_bf16_c(float lo, float hi) { const f32x2_cv v = {lo, hi}; const bf16x2_cv b = __builtin_convertvector(v, bf16x2_cv); return __builtin_bit_cast(unsigned, b); }
__device__ __forceinline__ unsigned cvt_pk_bf16(float lo, float hi) { unsigned r; asm volatile("v_cvt_pk_bf16_f32 %0, %1, %2" : "=v"(r) : "v"(lo), "v"(hi)); return r; }
__device__ __forceinline__ unsigned pk_fp8x4(float a, float b, float c, float d) { unsigned w; asm volatile("v_cvt_pk_fp8_f32 %0, %1, %2\n\tv_cvt_pk_fp8_f32 %0, %3, %4 op_sel:[0,0,1]" : "=&v"(w) : "v"(a), "v"(b), "v"(c), "v"(d)); return w; }
__device__ __forceinline__ float bflo(unsigned w) { return __uint_as_float(w << 16); }
__device__ __forceinline__ float bfhi(unsigned w) { return __uint_as_float(w & 0xffff0000u); }
__device__ __forceinline__ float bf2f(bf16_t b) { return __uint_as_float(((unsigned)b) << 16); }
__device__ __forceinline__ float wave_sum(float v) {
#pragma unroll
    for (int o = 1; o < 64; o <<= 1) v += __shfl_xor(v, o);
    return v;
}
__device__ __forceinline__ float fexp(float x) { return __builtin_amdgcn_exp2f(x * 1.4426950408889634f); }
__device__ __forceinline__ float sigm(float x) { return __builtin_amdgcn_rcpf(1.0f + __builtin_amdgcn_exp2f(-1.4426950408889634f * x)); }
__device__ __forceinline__ float tanh_f(float x) { return 1.0f - 2.0f * __builtin_amdgcn_rcpf(1.0f + __builtin_amdgcn_exp2f(2.8853900817779268f * x)); }
__device__ __forceinline__ float gelu_tanh(float x) { const float u = 0.7978845608028654f * (x + 0.044715f * x * x * x); return x * sigm(2.0f * u); }
__device__ __forceinline__ float silu_f(float x) { return x * sigm(x); }

namespace pg8 {
#define PG8_LAS __attribute__((address_space(3)))
typedef __attribute__((address_space(3))) unsigned short PG8_LAS_US;
constexpr int BM = 256, BK = 64, HALF = 128, HTB = HALF * BK * 2  , STAGE_BYTES = 8 * HTB, NXCD = 8, WGM = 8;
__host__ __device__ __forceinline__ int lds_byte(int r, int c) { const int st = (r >> 4) * 2 + (c >> 5), rr = r & 15, cc = c & 31, ob = rr * 64 + cc * 2; return st * 1024 + (ob ^ (((ob >> 9) & 1) << 5)); }
__host__ __device__ __forceinline__ void stage_rc(int b, int& R, int& C) { const int st = b / 1024, sb = b % 1024, swz = sb ^ (((sb >> 9) & 1) << 5); R = (st >> 1) * 16 + swz / 64; C = (st & 1) * 32 + (swz % 64) / 2; }
__host__ __device__ __forceinline__ int perm32(int rho) { const int n = rho >> 4, i = rho & 15; return 8 * (i >> 2) + 4 * n + (i & 3); }

struct Unit { int pm, pn, am, bn; int nt = 0, koff = 0; };
struct Gemm { const bf16_t* A; const bf16_t* Bt; int K; const PG8_LAS_US* aidx = nullptr; };

struct StaticOrder {
    int nM, nN, nwg, G, c;
    __device__ void init(int M, int N, int G_, int c_) { nM = M / BM; nN = N / BM; nwg = nM * nN; G = G_; c = c_; }
    __device__ bool next(int i, Unit& u) const {
        const long L = (long)i * G + c; if (L >= nwg) return false;
        int wgid = (int)L; { const int q = nwg / NXCD, r = nwg % NXCD, xcd = wgid % NXCD, off = wgid / NXCD; wgid = (xcd < r ? xcd * (q + 1) : r * (q + 1) + (xcd - r) * q) + off; }
        const int nig = WGM * nN, gid = wgid / nig, fm = gid * WGM, gsz = (nM - fm) < WGM ? (nM - fm) : WGM;
        u.pm = fm + ((wgid % nig) % gsz); u.pn = (wgid % nig) / gsz; u.am = u.pm; u.bn = u.pn; return true;
    }
    __device__ __forceinline__ void a_ready(const Unit&) const {}
    __device__ __forceinline__ void done(const Unit&) const {}
};

typedef int v8i_t __attribute__((ext_vector_type(8)));
template <class Epi, class Sched, bool ALIGN_EPI = false, bool SP2 = false, bool FP8 = false, bool VARK = false, bool GATHA = false>
__device__ __forceinline__ void gemm_phase(PG8_LAS unsigned char* lds, const Gemm g, const Sched& S, const Epi& E) {
    const int tid = threadIdx.x, wid = __builtin_amdgcn_readfirstlane(tid >> 6), lane = tid & 63, wr = wid >> 2, wc = wid & 3, fr = lane & 15, fq = lane >> 4;
    const int K = g.K, nt = K / BK;
    unsigned voffA[2], voffB[2];
#pragma unroll
    for (int i = 0; i < 2; ++i) { int R, C; stage_rc(tid * 16 + i * 8192, R, C); const int Rb = Epi::PERM ? ((R & ~31) + perm32(R & 31)) : R;
        voffA[i] = (unsigned)(R * K + C) * 2u; voffB[i] = (unsigned)(Rb * K + C) * 2u; }
    const size_t kstep = (size_t)(BK * 2);
    const size_t hstep = (size_t)HALF * K * 2;
    const size_t tstep = 2 * hstep;
    const unsigned ldsw = (unsigned)wid * 1024u;
    const int aoff = lds_byte(wr * 64 + fr, fq * 8), boff = lds_byte(wc * 32 + fr, fq * 8);
#define PG8_SA(b, h) (((b) * 2 + (h)) * HTB)
#define PG8_SB(b, h) ((4 + (b) * 2 + (h)) * HTB)
#define PG8_STAGE(bufoff, gbase, voff) do { _Pragma("unroll") for (int _i = 0; _i < 2; ++_i) \
        __builtin_amdgcn_global_load_lds((const unsigned*)((const char*)(gbase) + (voff)[_i]), (PG8_LAS unsigned*)(lds + (bufoff) + ldsw + _i * 8192), 16, 0, 0); } while (0)
    unsigned gc[2][2], gn[2][2]; (void)gc; (void)gn;
#define PG8_GIDX(DST, UI) do { _Pragma("unroll") for (int i_ = 0; i_ < 2; ++i_) { int R_, C_; stage_rc(tid * 16 + i_ * 8192, R_, C_); _Pragma("unroll") for (int h_ = 0; h_ < 2; ++h_) { \
        const unsigned v_ = g.aidx[(UI) * 256 + h_ * 128 + R_]; DST[h_][i_] = v_ * (unsigned)(K * 2) + (unsigned)C_ * 2u; } } } while (0)
#define PG8_GSWITCH() do { if constexpr (GATHA) { _Pragma("unroll") for (int h_ = 0; h_ < 2; ++h_) _Pragma("unroll") for (int i_ = 0; i_ < 2; ++i_) gc[h_][i_] = last ? gn[h_][i_] : gc[h_][i_]; } } while (0)
#define PG8_STAGE_A(bufoff, base, h, ARR) do { if constexpr (GATHA) { PG8_STAGE(bufoff, base, ARR[h]); } else { PG8_STAGE(bufoff, (base) + ((h) ? hstep : 0), voffA); } } while (0)
#define PG8_LD8(p) __builtin_bit_cast(v8i_t, __builtin_shufflevector(*(const PG8_LAS u32x4*)(p), *(const PG8_LAS u32x4*)((p) + 1024), 0, 1, 2, 3, 4, 5, 6, 7))
#define PG8_LDA(dst, b, h) do { if constexpr (FP8) { _Pragma("unroll") for (int m = 0; m < 4; ++m) dst##8[m] = PG8_LD8(lds + PG8_SA(b, h) + aoff + m * 2048); } \
        else { _Pragma("unroll") for (int m = 0; m < 4; ++m) _Pragma("unroll") for (int k = 0; k < 2; ++k) dst[m][k] = *(const PG8_LAS bf16x8*)(lds + PG8_SA(b, h) + aoff + m * 2048 + k * 1024); } } while (0)
#define PG8_LDB(dst, b, h) do { if constexpr (FP8) { _Pragma("unroll") for (int n = 0; n < 2; ++n) dst##8[n] = PG8_LD8(lds + PG8_SB(b, h) + boff + n * 2048); } \
        else { _Pragma("unroll") for (int n = 0; n < 2; ++n) _Pragma("unroll") for (int k = 0; k < 2; ++k) dst[n][k] = *(const PG8_LAS bf16x8*)(lds + PG8_SB(b, h) + boff + n * 2048 + k * 1024); } } while (0)
#define PG8_MMA(ai, bj, At, Bt) do { __builtin_amdgcn_s_setprio(1); _Pragma("unroll") for (int m = 0; m < 4; ++m) _Pragma("unroll") for (int n = 0; n < 2; ++n) { \
        if constexpr (FP8) asm volatile("v_mfma_scale_f32_16x16x128_f8f6f4 %0, %1, %2, %0, %3, %3 op_sel_hi:[0,0,0]" : "+v"(acc[ai][bj][m][n]) : "v"(Bt##8[n]), "v"(At##8[m]), "v"(sc8));   \
        else { _Pragma("unroll") for (int k = 0; k < 2; ++k) acc[ai][bj][m][n] = __builtin_amdgcn_mfma_f32_16x16x32_bf16(Bt[n][k], At[m][k], acc[ai][bj][m][n], 0, 0, 0); } } __builtin_amdgcn_s_setprio(0); } while (0)
#define PG8_WAIT_V(n) asm volatile("s_waitcnt vmcnt(" #n ")" ::: "memory")
#define PG8_WAIT_L(n) asm volatile("s_waitcnt lgkmcnt(" #n ")" ::: "memory")
#define PG8_BAR __builtin_amdgcn_s_barrier()
#define PG8_SCHED __builtin_amdgcn_sched_barrier(0)
    Unit cur, nxt; int ui = 0;
    if (!S.next(0, cur)) return;
    f32x4 acc[2][2][4][2];
#pragma unroll
    for (int a = 0; a < 2; ++a)
#pragma unroll
        for (int b = 0; b < 2; ++b)
#pragma unroll
            for (int m = 0; m < 4; ++m)
#pragma unroll
                for (int n = 0; n < 2; ++n) acc[a][b][m][n] = (f32x4){0.f, 0.f, 0.f, 0.f};
    bf16x8 At[4][2], B0[2][2], B1[2][2]; v8i_t At8[4], B08[2], B18[2]; const unsigned sc8 = 0x7f7f7f7fu; (void)At; (void)B0; (void)B1; (void)At8; (void)B08; (void)B18; (void)sc8;
    const char* cA = GATHA ? (const char*)g.A : (const char*)g.A + (size_t)cur.am * tstep; const char* cB = (const char*)g.Bt + (size_t)cur.bn * tstep;
    if constexpr (GATHA) { PG8_GIDX(gc, 0); }
    if constexpr (VARK) { cA += cur.koff; cB += cur.koff; }
    S.a_ready(cur);
    if constexpr (SP2) {
        PG8_STAGE(PG8_SB(0, 0), cB, voffB); PG8_STAGE(PG8_SB(0, 1), cB + hstep, voffB); PG8_STAGE_A(PG8_SA(0, 0), cA, 0, gc); PG8_STAGE_A(PG8_SA(0, 1), cA, 1, gc);
        if (wr == 1) PG8_BAR;
        PG8_WAIT_V(2); PG8_BAR;
        PG8_STAGE(PG8_SB(1, 0), cB + kstep, voffB); PG8_STAGE_A(PG8_SA(1, 0), cA + kstep, 0, gc); PG8_STAGE(PG8_SB(1, 1), cB + hstep + kstep, voffB);
        PG8_WAIT_V(6); PG8_BAR;
    } else {
        PG8_STAGE(PG8_SB(0, 0), cB, voffB); PG8_STAGE_A(PG8_SA(0, 0), cA, 0, gc); PG8_STAGE(PG8_SB(0, 1), cB + hstep, voffB); PG8_STAGE_A(PG8_SA(0, 1), cA, 1, gc);
        if (wr == 1) PG8_BAR;
        PG8_WAIT_V(4); PG8_BAR;
        PG8_STAGE(PG8_SB(1, 0), cB + kstep, voffB); PG8_STAGE_A(PG8_SA(1, 0), cA + kstep, 0, gc); PG8_STAGE(PG8_SB(1, 1), cB + hstep + kstep, voffB);
        PG8_WAIT_V(6); PG8_BAR;
    }
    for (;;) {
        const bool has_next = S.next(ui + 1, nxt);
        if constexpr (GATHA) { PG8_GIDX(gn, has_next ? ui + 1 : ui); }
        const char* nA = GATHA ? (const char*)g.A : has_next ? (const char*)g.A + (size_t)nxt.am * tstep + (VARK ? nxt.koff : 0) : cA; const char* nB = has_next ? (const char*)g.Bt + (size_t)nxt.bn * tstep + (VARK ? nxt.koff : 0) : cB;
        const int ntu = VARK ? cur.nt : nt;
        for (int t = 0; t < ntu; t += 2) {
            const bool last = (t == ntu - 2);
            const char* a1 = cA + (size_t)(t + 1) * kstep;
            const char* a2 = last ? nA : cA + (size_t)(t + 2) * kstep; const char* b2 = last ? nB : cB + (size_t)(t + 2) * kstep;
            const char* a3 = a2 + kstep; const char* b3 = b2 + kstep;
            if (last && has_next) S.a_ready(nxt);
            if constexpr (SP2) {
            PG8_LDB(B0, 0, 0); PG8_LDB(B1, 0, 1); PG8_SCHED; PG8_LDA(At, 0, 0); PG8_STAGE_A(PG8_SA(1, 1), a1, 1, gc); PG8_GSWITCH();
            PG8_WAIT_V(8); PG8_WAIT_L(0); PG8_BAR; PG8_MMA(0, 0, At, B0); PG8_MMA(0, 1, At, B1); PG8_BAR; PG8_SCHED;
            PG8_LDA(At, 0, 1); PG8_STAGE(PG8_SB(0, 0), b2, voffB); PG8_STAGE(PG8_SB(0, 1), b2 + hstep, voffB); PG8_STAGE_A(PG8_SA(0, 0), a2, 0, gc);
            PG8_WAIT_V(8); PG8_WAIT_L(0); PG8_BAR; PG8_MMA(1, 0, At, B0); PG8_MMA(1, 1, At, B1); PG8_BAR; PG8_SCHED;
            PG8_LDB(B0, 1, 0); PG8_LDB(B1, 1, 1); PG8_SCHED; PG8_LDA(At, 1, 0); PG8_STAGE_A(PG8_SA(0, 1), a2, 1, gc);
            PG8_WAIT_V(8); PG8_WAIT_L(0); PG8_BAR; PG8_MMA(0, 0, At, B0); PG8_MMA(0, 1, At, B1); PG8_BAR; PG8_SCHED;
            PG8_LDA(At, 1, 1); PG8_STAGE(PG8_SB(1, 0), b3, voffB); PG8_STAGE(PG8_SB(1, 1), b3 + hstep, voffB); PG8_STAGE_A(PG8_SA(1, 0), a3, 0, gc);
            PG8_WAIT_V(8); PG8_WAIT_L(0); PG8_BAR; PG8_MMA(1, 0, At, B0); PG8_MMA(1, 1, At, B1); PG8_BAR; PG8_SCHED;
            } else {
            PG8_LDB(B0, 0, 0); PG8_SCHED; PG8_LDA(At, 0, 0); PG8_STAGE_A(PG8_SA(1, 1), a1, 1, gc); PG8_GSWITCH();
            PG8_WAIT_L(8); PG8_BAR; PG8_WAIT_L(0); PG8_MMA(0, 0, At, B0); PG8_BAR; PG8_SCHED;
            PG8_LDB(B1, 0, 1); PG8_STAGE(PG8_SB(0, 0), b2, voffB);
            PG8_BAR; PG8_WAIT_L(0); PG8_MMA(0, 1, At, B1); PG8_BAR;
            PG8_LDA(At, 0, 1); PG8_STAGE_A(PG8_SA(0, 0), a2, 0, gc);
            PG8_BAR; PG8_WAIT_L(0); PG8_MMA(1, 0, At, B0); PG8_BAR; PG8_SCHED;
            PG8_STAGE(PG8_SB(0, 1), b2 + hstep, voffB);
            PG8_WAIT_V(6); PG8_BAR; PG8_MMA(1, 1, At, B1); PG8_BAR;
            PG8_LDB(B0, 1, 0); PG8_SCHED; PG8_LDA(At, 1, 0); PG8_STAGE_A(PG8_SA(0, 1), a2, 1, gc);
            PG8_WAIT_L(8); PG8_BAR; PG8_WAIT_L(0); PG8_MMA(0, 0, At, B0); PG8_BAR; PG8_SCHED;
            PG8_LDB(B1, 1, 1); PG8_STAGE(PG8_SB(1, 0), b3, voffB);
            PG8_BAR; PG8_WAIT_L(0); PG8_MMA(0, 1, At, B1); PG8_BAR;
            PG8_LDA(At, 1, 1); PG8_STAGE_A(PG8_SA(1, 0), a3, 0, gc);
            PG8_BAR; PG8_WAIT_L(0); PG8_MMA(1, 0, At, B0); PG8_BAR; PG8_SCHED;
            PG8_STAGE(PG8_SB(1, 1), b3 + hstep, voffB);
            PG8_WAIT_V(6); PG8_BAR; PG8_MMA(1, 1, At, B1); PG8_BAR;
            }
        }
        if constexpr (FP8) asm volatile("s_nop 15\n\ts_nop 7" ::: "memory");
        if constexpr (ALIGN_EPI) { if (wr == 0) PG8_BAR; }
        E(acc, cur, wr, wc, fr, fq); S.done(cur);
        if (!has_next) break;
#pragma unroll
        for (int a = 0; a < 2; ++a)
#pragma unroll
            for (int b = 0; b < 2; ++b)
#pragma unroll
                for (int m = 0; m < 4; ++m)
#pragma unroll
                    for (int n = 0; n < 2; ++n) acc[a][b][m][n] = (f32x4){0.f, 0.f, 0.f, 0.f};
        cur = nxt; cA = nA; cB = nB; ++ui;
        if constexpr (ALIGN_EPI) { if (wr == 1) PG8_BAR; }
    }
    PG8_WAIT_V(0);
    if constexpr (!ALIGN_EPI) { if (wr == 0) PG8_BAR; }
    PG8_BAR;
#undef PG8_SA
#undef PG8_SB
#undef PG8_STAGE
#undef PG8_STAGE_A
#undef PG8_GSWITCH
#undef PG8_GIDX
#undef PG8_LDA
#undef PG8_LDB
#undef PG8_MMA
#undef PG8_LD8
#undef PG8_WAIT_V
#undef PG8_WAIT_L
#undef PG8_BAR
#undef PG8_SCHED
}
}
#include <hip/hip_bf16.h>
namespace attn_body {
using bf16=__hip_bfloat16;
using bf16x8=__attribute__((ext_vector_type(8)))short;
using s16x4=__attribute__((ext_vector_type(4)))short;
using f32x16=__attribute__((ext_vector_type(16)))float;
using u32x4=__attribute__((ext_vector_type(4)))unsigned;
constexpr int D=64,KVP=128,OP=1024,QP=512;
constexpr int NW=8,QBLK=32,QB=QBLK*NW,KVBLK=64;
constexpr int ATTN_UNIT_ROWS=QB;
__device__ __forceinline__ int crow(int r,int hi){return (r&3)+8*(r>>2)+4*hi;}
#define SBAR() __builtin_amdgcn_sched_barrier(0)
constexpr int NSLOT=3, SLOTB=8192;
constexpr int LDS_K=0, LDS_V=NSLOT*SLOTB, LDS_WS=2*NSLOT*SLOTB, LDS_OST=LDS_WS+NW*64*4, LDS_BYTES=LDS_OST+NW*4096;
constexpr float C2=0.125f*1.4426950408889634f;
__device__ __forceinline__ void glds16(const void*gsrc,unsigned lds_dst){unsigned keep;
  asm volatile("s_mov_b32 %0, m0\n\ts_mov_b32 m0, %2\n\ts_nop 0\n\tglobal_load_lds_dwordx4 %1, off\n\ts_mov_b32 m0, %0":"=&s"(keep):"v"(gsrc),"s"(lds_dst):"memory");}
__device__ __forceinline__ float max3f(float a,float b,float c){float r;asm("v_max3_f32 %0, %1, %2, %3":"=v"(r):"v"(a),"v"(b),"v"(c));return r;}
__device__ __forceinline__ float max2f(float a,float b){float r;asm("v_max_f32_e32 %0, %1, %2":"=v"(r):"v"(a),"v"(b));return r;}
__device__ __forceinline__ float fadd_s(float a,float b){float r;asm("v_add_f32_e32 %0, %1, %2":"=v"(r):"v"(a),"v"(b));return r;}
__device__ __forceinline__ float fsub_s(float a,float b){float r;asm("v_sub_f32_e32 %0, %1, %2":"=v"(r):"v"(a),"v"(b));return r;}
typedef float f32x2_t __attribute__((ext_vector_type(2))); typedef __bf16 bf16x2_t __attribute__((ext_vector_type(2)));
__device__ __forceinline__ unsigned cvtpk_s(float lo,float hi){f32x2_t v={lo,hi};bf16x2_t b=__builtin_convertvector(v,bf16x2_t);return __builtin_bit_cast(unsigned,b);}
#define WAIT_BAR(N) asm volatile("s_waitcnt vmcnt(" #N ") lgkmcnt(0)\n\ts_barrier":::"memory")

__device__ __forceinline__ void qkt(f32x16&p0,f32x16&p1,const char*Kslot,const bf16x8*qr,const f32x16&negm,int r32,int hi){
  const char*kb=Kslot+hi*1024+r32*16;
  #pragma unroll
  for(int d0=0;d0<4;++d0){
    const bf16x8 b0=*reinterpret_cast<const bf16x8*>(kb+d0*2048);
    const bf16x8 b1=*reinterpret_cast<const bf16x8*>(kb+d0*2048+512);
    if(d0==0){p0=__builtin_amdgcn_mfma_f32_32x32x16_bf16(b0,qr[0],negm,0,0,0);p1=__builtin_amdgcn_mfma_f32_32x32x16_bf16(b1,qr[0],negm,0,0,0);}
    else{p0=__builtin_amdgcn_mfma_f32_32x32x16_bf16(b0,qr[d0],p0,0,0,0);p1=__builtin_amdgcn_mfma_f32_32x32x16_bf16(b1,qr[d0],p1,0,0,0);}}
}
typedef __attribute__((address_space(3))) const char* lds_cptr;
typedef short v4i16_t __attribute__((ext_vector_type(4)));
__device__ __forceinline__ void kload8(bf16x8*kf,lds_cptr kp){
  kf[0]=*(const __attribute__((address_space(3))) bf16x8*)(kp);      kf[1]=*(const __attribute__((address_space(3))) bf16x8*)(kp+512);
  kf[2]=*(const __attribute__((address_space(3))) bf16x8*)(kp+2048); kf[3]=*(const __attribute__((address_space(3))) bf16x8*)(kp+2560);
  kf[4]=*(const __attribute__((address_space(3))) bf16x8*)(kp+4096); kf[5]=*(const __attribute__((address_space(3))) bf16x8*)(kp+4608);
  kf[6]=*(const __attribute__((address_space(3))) bf16x8*)(kp+6144); kf[7]=*(const __attribute__((address_space(3))) bf16x8*)(kp+6656);
}
__device__ __forceinline__ void kload2(bf16x8*kf,lds_cptr kp,int j){ kf[2*j]=*(const __attribute__((address_space(3))) bf16x8*)(kp+j*2048); kf[2*j+1]=*(const __attribute__((address_space(3))) bf16x8*)(kp+j*2048+512); }
__device__ __forceinline__ s16x4 vtr(lds_cptr p){ return __builtin_bit_cast(s16x4,__builtin_amdgcn_ds_read_tr16_b64_v4i16((__attribute__((address_space(3))) v4i16_t*)p)); }
__device__ __forceinline__ float rowmax(const f32x16&p0,const f32x16&p1){
  float a=max3f(p0[0],p0[1],p1[0]),b=max3f(p0[2],p0[3],p1[1]);a=max3f(a,p1[2],p1[3]);
  #pragma unroll
  for(int r=4;r<16;r+=4){a=max3f(a,p0[r],p0[r+1]);b=max3f(b,p0[r+2],p0[r+3]);a=max3f(a,p1[r],p1[r+1]);b=max3f(b,p1[r+2],p1[r+3]);}
  const float m=max2f(a,b);
  auto rr=__builtin_amdgcn_permlane32_swap(__float_as_uint(m),__float_as_uint(m),false,false);
  return max2f(__uint_as_float(rr[0]),__uint_as_float(rr[1]));
}
__device__ __forceinline__ void pv(f32x16*o,int vb,bf16x8 pa0,bf16x8 pa1,bf16x8 pa2,bf16x8 pa3){
  #pragma unroll
  for(int d0=0;d0<2;++d0){s16x4 lo[4],hi[4];
    #pragma unroll
    for(int ks=0;ks<4;++ks){
      asm volatile("ds_read_b64_tr_b16 %0,%1 offset:%c2":"=&v"(lo[ks]):"v"(vb),"i"(d0*4096+ks*1024):"memory");
      asm volatile("ds_read_b64_tr_b16 %0,%1 offset:%c2":"=&v"(hi[ks]):"v"(vb),"i"(d0*4096+ks*1024+512):"memory");}
    asm volatile("s_waitcnt lgkmcnt(0)":::"memory");SBAR();
    #define PK(k) (bf16x8){lo[k][0],lo[k][1],lo[k][2],lo[k][3],hi[k][0],hi[k][1],hi[k][2],hi[k][3]}
    o[d0]=__builtin_amdgcn_mfma_f32_32x32x16_bf16(pa0,PK(0),o[d0],0,0,0);
    o[d0]=__builtin_amdgcn_mfma_f32_32x32x16_bf16(pa1,PK(1),o[d0],0,0,0);
    o[d0]=__builtin_amdgcn_mfma_f32_32x32x16_bf16(pa2,PK(2),o[d0],0,0,0);
    o[d0]=__builtin_amdgcn_mfma_f32_32x32x16_bf16(pa3,PK(3),o[d0],0,0,0);
    #undef PK
  }
}

#ifndef ATTN_STORE16
#define ATTN_STORE16(p,v) (*(u32x4*)(p)=(v))
#endif
template<int THRL> __device__ __forceinline__ void attn_unit(int qrow0,int h,int kvrow0,int NT,int rope,int qpos0,const bf16*QRAW,const float*qg,const float*ropetab,const bf16*__restrict__ K,const bf16*__restrict__ V,bf16*O,char*shm){
  const int tid=threadIdx.x,lane=tid&63,r32=lane&31,hi=lane>>5; const int wid=__builtin_amdgcn_readfirstlane(tid>>6);
  const unsigned short*Qw=(const unsigned short*)QRAW+(long)(qrow0+wid*QBLK)*QP+h*D;
  const bf16*Kh=K+(long)kvrow0*KVP+(h>>2)*D,*Vh=V+(long)kvrow0*KVP+(h>>2)*D;
  const unsigned lds0=(unsigned)(uintptr_t)shm;
  float*wsf=(float*)(shm+LDS_WS)+wid*64;
  const bf16*ksrc=Kh+(long)lane*KVP+wid*8;
  const bf16*vsrc=Vh+(long)(16*(wid&3)+(lane>>2))*KVP+(wid>>2)*32+(lane&3)*8;
  const unsigned kdst=lds0+LDS_K+wid*1024, vdst=lds0+LDS_V+wid*1024;
  #define DMA_K(t,slot) glds16(ksrc+(long)(t)*KVBLK*KVP,(unsigned)__builtin_amdgcn_readfirstlane(kdst+(slot)))
  #define DMA_V(t,slot) glds16(vsrc+(long)(t)*KVBLK*KVP,(unsigned)__builtin_amdgcn_readfirstlane(vdst+(slot)))
  const int vb0=(int)(lds0+LDS_V)+((lane>>4)&1)*32+(lane&3)*8+(4*hi+((lane&15)>>2))*64;
  const char*Kbase=shm+LDS_K; bf16x8 kf[8];
  const lds_cptr shm3=(lds_cptr)shm; const lds_cptr kp0=shm3+LDS_K+hi*1024+r32*16; const lds_cptr vp0=shm3+LDS_V+((lane>>4)&1)*32+(lane&3)*8+(4*hi+((lane&15)>>2))*64;
  DMA_K(0,0);DMA_V(0,0);DMA_K(1,SLOTB);
  bf16x8 qr[4];
  { float qv[4][8]; float ss=0.f;
    #pragma unroll
    for(int d0=0;d0<4;++d0){ const u32x4 a=*reinterpret_cast<const u32x4*>(&Qw[(long)r32*QP+d0*16+hi*8]);
      qv[d0][0]=__uint_as_float(a[0]<<16);qv[d0][1]=__uint_as_float(a[0]&0xffff0000u);qv[d0][2]=__uint_as_float(a[1]<<16);qv[d0][3]=__uint_as_float(a[1]&0xffff0000u);
      qv[d0][4]=__uint_as_float(a[2]<<16);qv[d0][5]=__uint_as_float(a[2]&0xffff0000u);qv[d0][6]=__uint_as_float(a[3]<<16);qv[d0][7]=__uint_as_float(a[3]&0xffff0000u);
      #pragma unroll
      for(int j=0;j<8;++j)ss+=qv[d0][j]*qv[d0][j]; }
    ss+=__shfl_xor(ss,32);
    const float rs=__builtin_amdgcn_rsqf(ss*(1.f/64.f)+1e-6f);
    const int qpos=qpos0+wid*QBLK+r32; const int prow=qpos>>6, pcol=qpos&63;
    #pragma unroll
    for(int d0=0;d0<4;++d0){
      const f32x4 g0=*reinterpret_cast<const f32x4*>(&qg[d0*16+hi*8]), g1=*reinterpret_cast<const f32x4*>(&qg[d0*16+hi*8+4]);
      float y[8]; y[0]=qv[d0][0]*rs*g0[0];y[1]=qv[d0][1]*rs*g0[1];y[2]=qv[d0][2]*rs*g0[2];y[3]=qv[d0][3]*rs*g0[3];y[4]=qv[d0][4]*rs*g1[0];y[5]=qv[d0][5]*rs*g1[1];y[6]=qv[d0][6]*rs*g1[2];y[7]=qv[d0][7]*rs*g1[3];
      if(rope){ const float*tb=ropetab+(d0<2?prow:(128+pcol))*32+((d0&1)*8+hi*4);
        const f32x4 cs=*reinterpret_cast<const f32x4*>(tb), sn=*reinterpret_cast<const f32x4*>(tb+16);
        #pragma unroll
        for(int p=0;p<4;++p){ const float x1=y[2*p],x2=y[2*p+1]; y[2*p]=x1*cs[p]-x2*sn[p]; y[2*p+1]=x1*sn[p]+x2*cs[p]; } }
      u32x4 w; w[0]=cvtpk_s(y[0]*C2,y[1]*C2); w[1]=cvtpk_s(y[2]*C2,y[3]*C2); w[2]=cvtpk_s(y[4]*C2,y[5]*C2); w[3]=cvtpk_s(y[6]*C2,y[7]*C2);
      qr[d0]=__builtin_bit_cast(bf16x8,w); } }
  float mhat=0.f,l_reg=0.f;f32x16 o[2];o[0]=f32x16{};o[1]=f32x16{};f32x16 negm=f32x16{};asm volatile("":"+v"(negm));
  #define CMASK(P0,P1,t) do{}while(0)
  bool resc=false;
  #define START(P0,P1) do{ const float rm=rowmax(P0,P1); resc=false; \
    { const float dl=rm; mhat=fadd_s(mhat,dl); \
      _Pragma("unroll") for(int r=0;r<16;++r){P0[r]=fsub_s(P0[r],dl);P1[r]=fsub_s(P1[r],dl);} \
      _Pragma("unroll") for(int r=0;r<16;++r)negm[r]=-mhat; asm volatile("":"+v"(negm)); } \
    _Pragma("unroll") for(int r=0;r<16;++r)P0[r]=__builtin_amdgcn_exp2f(P0[r]); }while(0)
  #define RESC() do{ if(resc){ asm volatile("s_waitcnt lgkmcnt(0)":::"memory"); \
      _Pragma("unroll") for(int d_=0;d_<2;++d_) _Pragma("unroll") for(int r=0;r<16;++r)o[d_][r]*=wsf[crow(r,hi)]; } }while(0)
  f32x16 pA0,pA1,pB0,pB1;
  int sl_prev=0,sl_cur=0,sl_next=SLOTB;
  #define ROT() do{sl_prev=sl_cur;sl_cur=sl_next;sl_next=(sl_next==(NSLOT-1)*SLOTB)?0:sl_next+SLOTB;}while(0)
  DMA_K(2,2*SLOTB);
  WAIT_BAR(3);
  qkt(pA0,pA1,Kbase,qr,negm,r32,hi);asm volatile("s_nop 15\n\ts_nop 7":"+v"(pA0),"+v"(pA1));CMASK(pA0,pA1,0);
  START(pA0,pA1);
  _Pragma("unroll") for(int r=0;r<16;++r)pA1[r]=__builtin_amdgcn_exp2f(pA1[r]);
  WAIT_BAR(0);
  DMA_K(3,0);DMA_V(1,SLOTB);
  ROT();
  kload8(kf,kp0+sl_cur);
  WAIT_BAR(2);
  s16x4 vlo[8],vhi[8]; u32x4 pw0,pw1,pw2,pw3;
  #define PKW(P,B) cvtpk_s(P[B],P[B+1])
  #define PAF(k) __builtin_bit_cast(bf16x8,pw##k)
  #define VFR(i) (bf16x8){vlo[i][0],vlo[i][1],vlo[i][2],vlo[i][3],vhi[i][0],vhi[i][1],vhi[i][2],vhi[i][3]}
  #define PIN(x) asm volatile("":"+v"(x))
  #define MX3(a,b,c) __builtin_fmaxf(__builtin_fmaxf((a),(b)),(c))
  #define GAPA(MF,A0,A1,A2,A3,W0,W1,PW) do{ MF; sacc+=A0; sacc+=A1; sacc+=A2; sacc+=A3; PIN(sacc); W0; W1; PIN(PW); SBAR(); }while(0)
  #define EX(v) __builtin_amdgcn_exp2f(v)
  #define GAPB(MF,X,B) do{ MF; X[B]=EX(X[B]); X[B+1]=EX(X[B+1]); X[B+2]=EX(X[B+2]); X[B+3]=EX(X[B+3]); PIN(X); SBAR(); }while(0)
  #define VRD(i) do{ vlo[i]=vtr(vp_+(((i)>>2)*4096+((i)&3)*1024)); vhi[i]=vtr(vp_+(((i)>>2)*4096+((i)&3)*1024+512)); }while(0)
  #define KRD(G,j) do{ if(G){ kload2(kf,kp0+sl_next,j); SBAR(); } }while(0)
  #define STEP(C0,C1,P0,P1,t,GK,GV,GL) do{ SBAR(); \
    const lds_cptr vp_=vp0+sl_prev; \
    VRD(0); SBAR(); float sacc=(P0[0]+P0[1]); \
    GAPA(C0=__builtin_amdgcn_mfma_f32_32x32x16_bf16(kf[0],qr[0],negm,0,0,0), P0[2],P0[3],P0[4],P0[5],     pw0[0]=PKW(P0,0), pw0[1]=PKW(P0,2), pw0); \
    VRD(4); SBAR(); GAPA(C1=__builtin_amdgcn_mfma_f32_32x32x16_bf16(kf[1],qr[0],negm,0,0,0), P0[6],P0[7],P0[8],P0[9],     pw0[2]=PKW(P0,4), pw0[3]=PKW(P0,6), pw0); \
    VRD(1); SBAR(); GAPA(C0=__builtin_amdgcn_mfma_f32_32x32x16_bf16(kf[2],qr[1],C0,0,0,0),   P0[10],P0[11],P0[12],P0[13], pw1[0]=PKW(P0,8), pw1[1]=PKW(P0,10), pw1); \
    VRD(5); SBAR(); GAPA(C1=__builtin_amdgcn_mfma_f32_32x32x16_bf16(kf[3],qr[1],C1,0,0,0),   P0[14],P0[15],P1[0],P1[1],   pw1[2]=PKW(P0,12),pw1[3]=PKW(P0,14), pw1); \
    VRD(2); SBAR(); GAPA(C0=__builtin_amdgcn_mfma_f32_32x32x16_bf16(kf[4],qr[2],C0,0,0,0),   P1[2],P1[3],P1[4],P1[5],     pw2[0]=PKW(P1,0), pw2[1]=PKW(P1,2), pw2); \
    VRD(6); SBAR(); GAPA(C1=__builtin_amdgcn_mfma_f32_32x32x16_bf16(kf[5],qr[2],C1,0,0,0),   P1[6],P1[7],P1[8],P1[9],     pw2[2]=PKW(P1,4), pw2[3]=PKW(P1,6), pw2); \
    VRD(3); SBAR(); GAPA(C0=__builtin_amdgcn_mfma_f32_32x32x16_bf16(kf[6],qr[3],C0,0,0,0),   P1[10],P1[11],P1[12],P1[13], pw3[0]=PKW(P1,8), pw3[1]=PKW(P1,10), pw3); \
    VRD(7); SBAR(); GAPA(C1=__builtin_amdgcn_mfma_f32_32x32x16_bf16(kf[7],qr[3],C1,0,0,0),   P1[14],P1[15],0.f,0.f,       pw3[2]=PKW(P1,12),pw3[3]=PKW(P1,14), pw3); \
    l_reg+=sacc; \
    if(GK){DMA_K((t)+3,sl_cur);} if(GV){DMA_V((t)+1,sl_next);} \
    CMASK(C0,C1,t); \
    { float a=MX3(C0[0],C0[1],C1[0]),b=MX3(C0[2],C0[3],C1[1]); a=MX3(a,C1[2],C1[3]); \
      _Pragma("unroll") for(int r=4;r<16;r+=4){a=MX3(a,C0[r],C0[r+1]);b=MX3(b,C0[r+2],C0[r+3]);a=MX3(a,C1[r],C1[r+1]);b=MX3(b,C1[r+2],C1[r+3]);} \
      float rm=__builtin_fmaxf(a,b); { auto rr=__builtin_amdgcn_permlane32_swap(__float_as_uint(rm),__float_as_uint(rm),false,false); rm=__builtin_fmaxf(__uint_as_float(rr[0]),__uint_as_float(rr[1])); } \
      resc=false; \
      if(__builtin_expect(__any(rm>(float)THRL),0)){ const float dl=__builtin_fmaxf(rm,0.f); mhat+=dl; \
        _Pragma("unroll") for(int r=0;r<16;++r){C0[r]-=dl;C1[r]-=dl;} \
        _Pragma("unroll") for(int r=0;r<16;++r)negm[r]=-mhat; asm volatile("":"+v"(negm)); \
        const float f=__builtin_amdgcn_exp2f(-dl); l_reg*=f; if(hi==0)wsf[r32]=f; resc=true; } } \
    SBAR(); \
    GAPB(o[0]=__builtin_amdgcn_mfma_f32_32x32x16_bf16(PAF(0),VFR(0),o[0],0,0,0), C0,0); \
    GAPB(o[1]=__builtin_amdgcn_mfma_f32_32x32x16_bf16(PAF(0),VFR(4),o[1],0,0,0), C0,4); \
    KRD(GL,0); GAPB(o[0]=__builtin_amdgcn_mfma_f32_32x32x16_bf16(PAF(1),VFR(1),o[0],0,0,0), C0,8); \
    KRD(GL,1); GAPB(o[1]=__builtin_amdgcn_mfma_f32_32x32x16_bf16(PAF(1),VFR(5),o[1],0,0,0), C0,12); \
    KRD(GL,2); GAPB(o[0]=__builtin_amdgcn_mfma_f32_32x32x16_bf16(PAF(2),VFR(2),o[0],0,0,0), C1,0); \
    KRD(GL,3); GAPB(o[1]=__builtin_amdgcn_mfma_f32_32x32x16_bf16(PAF(2),VFR(6),o[1],0,0,0), C1,4); \
    GAPB(o[0]=__builtin_amdgcn_mfma_f32_32x32x16_bf16(PAF(3),VFR(3),o[0],0,0,0), C1,8); \
    GAPB(o[1]=__builtin_amdgcn_mfma_f32_32x32x16_bf16(PAF(3),VFR(7),o[1],0,0,0), C1,12); \
    }while(0)
  int t=1;
  #undef CMASK
  #define CMASK(P0,P1,t) do{}while(0)
  for(;t+5<NT;t+=2){
    STEP(pB0,pB1,pA0,pA1,t,true,true,true);     WAIT_BAR(2); RESC(); ROT();
    STEP(pA0,pA1,pB0,pB1,t+1,true,true,true);   WAIT_BAR(2); RESC(); ROT();
  }
  #undef CMASK
  #define CMASK(P0,P1,t) do{}while(0)
  #define ENDW(tt) do{ if((tt)+3<NT){WAIT_BAR(2);} else if((tt)+2<NT){WAIT_BAR(1);} else {WAIT_BAR(0);} }while(0)
  for(;t+1<NT;t+=2){
    STEP(pB0,pB1,pA0,pA1,t,(t+3<NT),(t+1<NT),(t+1<NT));       ENDW(t);   RESC(); ROT();
    STEP(pA0,pA1,pB0,pB1,t+1,(t+4<NT),(t+2<NT),(t+2<NT));     ENDW(t+1); RESC(); ROT();
  }
  STEP(pB0,pB1,pA0,pA1,NT-1,false,false,false); RESC();
  { float sacc=pB0[0]+pB0[1]; _Pragma("unroll") for(int r=2;r<16;++r)sacc+=pB0[r]; _Pragma("unroll") for(int r=0;r<16;++r)sacc+=pB1[r]; l_reg+=sacc;
    pw0=(u32x4){PKW(pB0,0),PKW(pB0,2),PKW(pB0,4),PKW(pB0,6)};pw1=(u32x4){PKW(pB0,8),PKW(pB0,10),PKW(pB0,12),PKW(pB0,14)};pw2=(u32x4){PKW(pB1,0),PKW(pB1,2),PKW(pB1,4),PKW(pB1,6)};pw3=(u32x4){PKW(pB1,8),PKW(pB1,10),PKW(pB1,12),PKW(pB1,14)};
    SBAR(); pv(o,vb0+sl_cur,PAF(0),PAF(1),PAF(2),PAF(3)); }
  #undef PKW
  #undef PAF
  #undef VFR
  #undef PIN
  #undef MX3
  #undef GAPA
  #undef GAPB
  #undef EX
  #undef VRD
  #undef KRD
  #undef STEP
  #undef ENDW
  {auto rr=__builtin_amdgcn_permlane32_swap(__float_as_uint(l_reg),__float_as_uint(l_reg),false,false);l_reg=__uint_as_float(rr[0])+__uint_as_float(rr[1]);}
  if(hi==0)wsf[32+r32]=l_reg;asm volatile("s_waitcnt lgkmcnt(0)":::"memory");
  float rli[16];
  #pragma unroll
  for(int r=0;r<16;++r)rli[r]=__builtin_amdgcn_rcpf(wsf[32+crow(r,hi)]);
  bf16*Ow=O+(long)(qrow0+wid*QBLK)*OP+512+h*D;
  { bf16*stg=(bf16*)(shm+LDS_OST)+wid*2048;
    #pragma unroll
    for(int r=0;r<16;++r){const int orow=crow(r,hi);
      #pragma unroll
      for(int d0=0;d0<2;++d0)stg[orow*64+d0*32+r32]=__float2bfloat16(o[d0][r]*rli[r]);}
    asm volatile("s_waitcnt lgkmcnt(0)":::"memory");
    #pragma unroll
    for(int i=0;i<4;++i){const int row=i*8+(lane>>3),ch=lane&7; const u32x4 v=*(const u32x4*)(stg+row*64+ch*8); ATTN_STORE16(Ow+(long)row*OP+ch*8,v);} }
  asm volatile("s_waitcnt lgkmcnt(0)\n\ts_barrier":::"memory");
  #undef DMA_K
  #undef DMA_V
  #undef CMASK
  #undef START
  #undef RESC
  #undef ROT
}
constexpr int ATTN_LDS_BYTES=LDS_BYTES;
#undef SBAR
#undef WAIT_BAR
}
enum {
    I_X = 0, I_C, I_CTX, I_CCTX,
    I0_WMOD, I0_BMOD, I0_NMIX, I0_NFFN, I0_WIN, I0_CONVW, I0_CONVB, I0_WI, I0_BI, I0_WR, I0_BR, I0_LAM, I0_QG, I0_KG, I0_WOUT, I0_ROUTER, I0_WEG, I0_WEU, I0_WED,
    I1_WMOD, I1_BMOD, I1_NMIX, I1_NFFN, I1_MU, I1_WR, I1_WK, I1_WV, I1_W0, I1_W1, I1_W2, I1_A0, I1_A1, I1_A2, I1_G1, I1_G2, I1_KK, I1_KA, I1_RK, I1_GNG, I1_GNB, I1_WO, I1_ROUTER, I1_WEG, I1_WEU, I1_WED,
    N_IN
};
static_assert(N_IN == 49, "49 inputs");
struct KArgs { const float* in[N_IN]; float* out; unsigned char* ws; int ph_lo, ph_hi; };
#define KAREF const __attribute__((address_space(4))) KArgs&
__device__ __forceinline__ const __attribute__((address_space(4))) KArgs* ka_launder(const __attribute__((address_space(4))) KArgs* p) { asm volatile("" : "+s"(p)); return p; }

constexpr size_t MiB = 1u << 20;
constexpr size_t WS_CTL = 0;
constexpr size_t WS_DELTA = 98 * MiB;
constexpr size_t WS_LWA = 194 * MiB;
constexpr size_t WS_BMIX16 = 5 * MiB;
constexpr size_t WS_BMIX = 1 * MiB;
constexpr size_t WS_B2 = 9 * MiB;
constexpr size_t ZERO_BYTES = 12 * MiB;
constexpr size_t WS_WIN = 12 * MiB;
constexpr size_t WS_WOUT = 16 * MiB;
constexpr size_t WS_WO = 18 * MiB;
constexpr size_t WS_WGATE = 20 * MiB;
constexpr size_t WS_ADA = 20 * MiB + 512 * 1024;
constexpr size_t WS_ROPE = 21 * MiB;
constexpr size_t WS_HLAST = 21 * MiB + 64 * 1024;
constexpr size_t WS_CARRY = 21 * MiB + 128 * 1024;
constexpr size_t WS_AFFL = 22 * MiB;
constexpr size_t WS_AFFC = 24 * MiB;
constexpr size_t WS_SRCROW = 25 * MiB;
constexpr size_t WS_GROW = 26 * MiB;
constexpr size_t WS_SLOTL = 27 * MiB;
constexpr size_t WS_SLOTC = 29 * MiB;
constexpr size_t WS_CTXS = 30 * MiB;
constexpr size_t WS_MOEW1 = 34 * MiB;
constexpr size_t WS_MOEW2 = 162 * MiB;
constexpr size_t WS_ACT = 226 * MiB;
constexpr size_t WS_END = WS_ACT + 749 * MiB;
constexpr size_t A_H = 0, A_XA = 66 * MiB, A_GA = 99 * MiB, A_QR = 132 * MiB, A_KR = 198 * MiB, A_KN = 215 * MiB, A_VB = 224 * MiB, A_HF = 233 * MiB, A_YCAT = 299 * MiB;
constexpr size_t A_H2 = 0, A_XE = 66 * MiB, A_HID = 202 * MiB, A_YE = 474 * MiB;
constexpr size_t A_XMIX = 0, A_XMIX16 = 132 * MiB, A_RKV = 396 * MiB, A_LG = 594 * MiB, A_LWA = A_LG + (size_t)TT * 256 * 2;
constexpr size_t A_SD = 0, A_AD = 132 * MiB, A_G = 264 * MiB, A_YD0 = 660 * MiB, A_YD1 = 594 * MiB, A_O = 0;
constexpr size_t ROWB = (size_t)TT * DM * 2;

constexpr int RING_OFF = 0, RING_BYTES = 131072;
constexpr int LDSCTL_OFF = RING_BYTES, MISC_OFF = LDSCTL_OFF + 320;
constexpr int LDS_BYTES = 147456;

#define RLX_AGENT __ATOMIC_RELAXED, __HIP_MEMORY_SCOPE_AGENT
#define LDS_WAIT() asm volatile("s_waitcnt lgkmcnt(0)" ::: "memory")
#define VM_WAIT() asm volatile("s_waitcnt vmcnt(0)" ::: "memory")

#define XB_TMO      128
#define XB_XCNT(j)  (256  + 64 * (j))
#define XB_XSUB(j)  (1280 + 64 * (j))
#define XB_XGEN(j)  (2304 + 64 * (j))
#define XB_TOP      3328
#define XB_TOPGEN   3392
#define XCD_BAR_WORDS 3456
#define XB_SPIN_CAP (1u << 18)
__device__ __forceinline__ unsigned xb_ld(unsigned* p)              { return __hip_atomic_load(p, __ATOMIC_RELAXED, __HIP_MEMORY_SCOPE_AGENT); }
__device__ __forceinline__ unsigned xb_add(unsigned* p, unsigned v) { return __hip_atomic_fetch_add(p, v, __ATOMIC_RELAXED, __HIP_MEMORY_SCOPE_AGENT); }
__device__ __forceinline__ unsigned xb_xcc_id() { return (unsigned)__builtin_amdgcn_s_getreg((3 << 11) | 20) & 0xFu; }
#define XB_SPIN(cond, bar) do { unsigned _sp = 0; while (cond) { __builtin_amdgcn_s_sleep(1); \
    if ((++_sp & 255u) == 0u) { if (xb_ld(&(bar)[XB_TMO])) break; if (_sp > XB_SPIN_CAP) { atomicAdd(&(bar)[XB_TMO], 1u); break; } } } } while (0)
struct XcdBarrier { unsigned* bar; unsigned x; volatile LAS unsigned* st; };
__device__ __forceinline__ XcdBarrier xcd_barrier_post(unsigned* bar, volatile LAS unsigned* st) {
    XcdBarrier b; b.bar = bar; b.x = xb_xcc_id(); b.st = st;
    if (threadIdx.x == 0) (void)xb_add(&bar[XB_XCNT(b.x)], 1u);
    return b;
}
__device__ __forceinline__ void xcd_barrier_complete(unsigned* bar, unsigned x, unsigned& nloc, unsigned& nx) {
    const unsigned G = gridDim.x * gridDim.y * gridDim.z;
    unsigned sum, cnt, mine, sp = 0u;
    for (;;) {
        sum = 0u; cnt = 0u; mine = 0u;
#pragma unroll
        for (unsigned j = 0; j < 16; ++j) { const unsigned c = xb_ld(&bar[XB_XCNT(j)]); sum += c; cnt += (c > 0u) ? 1u : 0u; mine = (j == x) ? c : mine; }
        if (sum == G) break;
        __builtin_amdgcn_s_sleep(1);
        if ((++sp & 255u) == 0u) { if (xb_ld(&bar[XB_TMO])) break; if (sp > XB_SPIN_CAP) { atomicAdd(&bar[XB_TMO], 1u); break; } }
    }
    nloc = mine > 0u ? mine : 1u; nx = cnt > 0u ? cnt : 1u;
}
__device__ __forceinline__ void xcd_barrier(const XcdBarrier& b) {
    asm volatile("s_waitcnt vmcnt(0)" ::: "memory");
    __syncthreads();
    if (threadIdx.x == 0) {
        unsigned* bar = b.bar;
        __builtin_amdgcn_s_waitcnt(0);
        unsigned nloc = b.st[0], nx = b.st[1];
        if (nloc == 0u) { xcd_barrier_complete(bar, b.x, nloc, nx); b.st[0] = nloc; b.st[1] = nx; }
        const unsigned old = xb_add(&bar[XB_XSUB(b.x)], 1u);
        const unsigned gen = old / nloc;
        if (old + 1u == (gen + 1u) * nloc) {
            __builtin_amdgcn_fence(__ATOMIC_RELEASE, "agent");
            asm volatile("s_waitcnt vmcnt(0)" ::: "memory");
            const unsigned og = xb_add(&bar[XB_TOP], 1u);
            const unsigned tg = og / nx;
            if (og + 1u == (tg + 1u) * nx) xb_add(&bar[XB_TOPGEN], 1u);
            else XB_SPIN(xb_ld(&bar[XB_TOPGEN]) == tg, bar);
            __builtin_amdgcn_fence(__ATOMIC_ACQUIRE, "agent");
            xb_add(&bar[XB_XGEN(b.x)], 1u);
            asm volatile("s_waitcnt vmcnt(0)" ::: "memory");
        } else {
            XB_SPIN(xb_ld(&bar[XB_XGEN(b.x)]) == gen, bar);
            __builtin_amdgcn_fence(__ATOMIC_ACQUIRE, "agent");
            asm volatile("s_waitcnt vmcnt(0)" ::: "memory");
        }
    }
    __syncthreads();
}

__device__ __forceinline__ const float* ada_ptr(const unsigned char* ws, int layer, int r, int chunk) { return (const float*)(ws + WS_ADA) + (size_t)(layer * 5 + r) * 6144 + chunk * 1024; }
__device__ __forceinline__ int kv_row(int m) { return m < TL ? ((m >> 13) * KVL + (m & 8191)) : (((m - TL) >> 8) * KVL + SEQ + ((m - TL) & 255)); }
__device__ __forceinline__ int mod_row(int m) { return m < TL ? (m >> 13) : 4; }
__device__ __forceinline__ int block_excl_scan(int v, LAS int* tmp, int& total) {
    const int lane = threadIdx.x & 63, w = threadIdx.x >> 6;
    int inc = v;
#pragma unroll
    for (int o = 1; o < 64; o <<= 1) { const int t = __shfl_up(inc, o); if (lane >= o) inc += t; }
    if (lane == 63) tmp[w] = inc;
    __syncthreads();
    int base = 0, tot = 0;
#pragma unroll
    for (int i = 0; i < 8; ++i) { const int t = tmp[i]; if (i < w) base += t; tot += t; }
    __syncthreads();
    total = tot;
    return base + inc - v;
}
__device__ __forceinline__ void tr_item(const float* W, int Krows, int ldw, bf16_t* dst, long drow0, int ldd, int dk0, LAS float* scr, int k0, int n0, int lane) {
    float ld[32];
#pragma unroll
    for (int i = 0; i < 32; ++i) { const int k = k0 + 2 * i + (lane >> 5); ld[i] = (k < Krows) ? W[(size_t)k * ldw + n0 + (lane & 31)] : 0.f; }
#pragma unroll
    for (int i = 0; i < 32; ++i) scr[(2 * i + (lane >> 5)) * 33 + (lane & 31)] = ld[i];
    LDS_WAIT(); asm volatile("" ::: "memory");
    const int c = lane & 7;
#pragma unroll
    for (int j = 0; j < 4; ++j) { const int n = (lane >> 3) + 8 * j; const LAS float* s = scr + (8 * c) * 33 + n;
        u32x4 o; o.x = cvt_pk_bf16(s[0 * 33], s[1 * 33]); o.y = cvt_pk_bf16(s[2 * 33], s[3 * 33]); o.z = cvt_pk_bf16(s[4 * 33], s[5 * 33]); o.w = cvt_pk_bf16(s[6 * 33], s[7 * 33]);
        *(u32x4*)(dst + (size_t)(drow0 + n) * ldd + dk0 + k0 + 8 * c) = o; }
    LDS_WAIT(); asm volatile("" ::: "memory");
}
__device__ __forceinline__ void tr_item_fp8(const float* W, int ldw, unsigned char* dst, long drow0, int ldd, LAS float* scr, int k0, int n0, int lane, float scale) {
    float ld[32];
#pragma unroll
    for (int i = 0; i < 32; ++i) ld[i] = W[(size_t)(k0 + 2 * i + (lane >> 5)) * ldw + n0 + (lane & 31)];
#pragma unroll
    for (int i = 0; i < 32; ++i) scr[(2 * i + (lane >> 5)) * 33 + (lane & 31)] = ld[i] * scale;
    LDS_WAIT(); asm volatile("" ::: "memory");
    const int c = lane & 7;
#pragma unroll
    for (int j = 0; j < 4; ++j) { const int n = (lane >> 3) + 8 * j; const LAS float* s = scr + (8 * c) * 33 + n;
        u32x2 o; o.x = pk_fp8x4(s[0 * 33], s[1 * 33], s[2 * 33], s[3 * 33]); o.y = pk_fp8x4(s[4 * 33], s[5 * 33], s[6 * 33], s[7 * 33]);
        *(u32x2*)(dst + (size_t)(drow0 + n) * ldd + k0 + 8 * c) = o; }
    LDS_WAIT(); asm volatile("" ::: "memory");
}
constexpr float W8_SCALE = 32.0f;
__device__ __forceinline__ void moe_convert(KAREF A, int layer, LAS unsigned char* lds, int gw, int ngw, int wave, int lane) {
    LAS float* scr = (LAS float*)(lds + RING_OFF + wave * 16384);
    const float* WG = A.in[layer ? I1_WEG : I0_WEG]; const float* WU = A.in[layer ? I1_WEU : I0_WEU]; const float* WD = A.in[layer ? I1_WED : I0_WED];
    unsigned char* B1 = A.ws + WS_MOEW1; unsigned char* B2 = A.ws + WS_MOEW2;
    constexpr int I_GU = 32 * 1024, I_D = 16 * 1024;
    for (int it = gw; it < I_GU + I_D; it += ngw) {
        if (it < I_GU) { const int mi = it >> 10, e = mi >> 1, which = mi & 1, w = it & 1023, kb = w >> 6, nb = w & 63, n0 = 32 * nb;
            tr_item_fp8((which ? WU : WG) + (size_t)e * DM * FF, FF, B1 + (size_t)e * 4096 * DM, (long)((n0 >> 7) * 256 + (n0 & 127) + which * 128), DM, scr, 64 * kb, n0, lane, W8_SCALE); }
        else { const int r = it - I_GU, e = r >> 10, w = r & 1023, kb = w >> 5, nb = w & 31;
            tr_item_fp8(WD + (size_t)e * FF * DM, DM, B2 + (size_t)e * DM * FF, (long)(32 * nb), FF, scr, 64 * kb, 32 * nb, lane, W8_SCALE); }
    }
}
__device__ __forceinline__ void p0_prologue(KAREF A, LAS unsigned char* lds, int G) {
    const int tid = threadIdx.x, lane = tid & 63, wave = __builtin_amdgcn_readfirstlane(tid >> 6);
    const int gw = blockIdx.x * 8 + wave, ngw = G * 8;
    LAS float* scr = (LAS float*)(lds + RING_OFF + wave * 16384);
    unsigned char* ws = A.ws;
    bf16_t* BMIX = (bf16_t*)(ws + WS_BMIX); bf16_t* BMIX16 = (bf16_t*)(ws + WS_BMIX16); bf16_t* B2 = (bf16_t*)(ws + WS_B2);
    constexpr int NJ = 19;
    for (int it = gw; ; it += ngw) {
        int r = it; const float* W = nullptr; int Kr = 0, N = 0, ldd = 0, dk0 = 0; long drow = 0; bf16_t* dst = nullptr; bool found = false, f8 = false;
#define JOB(Wp, KR, NN, DST, DROW, LDD, DK0) if (!found) { const int cnt = (((KR) + 63) / 64) * ((NN) / 32); if (r < cnt) { W = (Wp); Kr = (KR); N = (NN); dst = (DST); drow = (DROW); ldd = (LDD); dk0 = (DK0); found = true; } else r -= cnt; }
#define JOB8(Wp, NN, DROW) if (!found) { const int cnt = (DM / 64) * ((NN) / 32); if (r < cnt) { W = (Wp); Kr = DM; N = (NN); drow = (DROW); f8 = true; found = true; } else r -= cnt; }
        JOB(A.in[I0_WIN], DM, 1792, (bf16_t*)(ws + WS_WIN), 0, DM, 0)
        JOB(A.in[I0_WOUT], DM, DM, (bf16_t*)(ws + WS_WOUT), 0, DM, 0)
        JOB(A.in[I1_WR], DM, DM, BMIX16, 0, DM, 0)
        JOB8(A.in[I1_WK], DM, 1024)
        JOB(A.in[I1_WV], DM, DM, BMIX16, 1024, DM, 0)
        JOB8(A.in[I1_G1], 160, 3072)
        JOB8(A.in[I1_W1], 64, 3328)
        JOB8(A.in[I1_W1] + DM * 64, 64, 3328 + 64)
        JOB8(A.in[I1_A1], 64, 3584)
        JOB8(A.in[I1_A1] + DM * 64, 64, 3584 + 64)
        JOB(A.in[I1_W2], 64, DM, B2, 0, 256, 0)
        JOB(A.in[I1_W2] + 64 * DM, 64, DM, B2, 1024, 256, 64)
        JOB(A.in[I1_A2], 64, DM, B2, 2048, 256, 128)
        JOB(A.in[I1_A2] + 64 * DM, 64, DM, B2, 3072, 256, 192)
        JOB(A.in[I1_G2], 160, DM, B2, 4096, 256, 0)
        JOB(A.in[I1_WO], DM, DM, (bf16_t*)(ws + WS_WO), 0, DM, 0)
#undef JOB
#undef JOB8
        if (!found) {
            if (r >= 128) break;
            const int pair = r >> 2, which = (r >> 1) & 1, nb = r & 1;
            W = A.in[which ? I0_WR : I0_WI] + (size_t)pair * 64 * 64; Kr = 64; N = 64; dst = (bf16_t*)(ws + WS_WGATE); drow = (long)pair * 128 + which * 64 + 32 * nb; ldd = 64; dk0 = 0;
            tr_item(W, Kr, N, dst, drow, ldd, dk0, scr, 0, 32 * nb, lane);
            continue;
        }
        const int nblk = N / 32, kb = r / nblk, nb = r % nblk;
        if (f8) tr_item_fp8(W, N, (unsigned char*)BMIX, drow + 32 * nb, DM, scr, 64 * kb, 32 * nb, lane, W8_SCALE);
        else tr_item(W, Kr, N, dst, drow + 32 * nb, ldd, dk0, scr, 64 * kb, 32 * nb, lane);
    }
    (void)NJ;
    moe_convert(A, 0, lds, gw, ngw, wave, lane);
    __syncthreads();
    if (blockIdx.x < 192) {
        const int layer = blockIdx.x / 96, cb = blockIdx.x % 96, col = cb * 64 + lane;
        LAS float* sil = (LAS float*)(lds);
        LAS float* part = (LAS float*)(lds + 32768);
        for (int i = tid; i < 5 * 1024; i += 512) { const int rr = i >> 10, k = i & 1023; const float v = rr < 4 ? A.in[I_C][rr * 1024 + k] : A.in[I_CCTX][k]; sil[i] = v / (1.0f + expf(-v)); }
        __syncthreads();
        const float* wm = A.in[layer ? I1_WMOD : I0_WMOD];
        float acc[5] = {0.f, 0.f, 0.f, 0.f, 0.f};
        for (int k = wave * 128; k < wave * 128 + 128; ++k) { const float wv = wm[(size_t)k * 6144 + col];
#pragma unroll
            for (int rr = 0; rr < 5; ++rr) acc[rr] += sil[rr * 1024 + k] * wv; }
#pragma unroll
        for (int rr = 0; rr < 5; ++rr) part[(wave * 5 + rr) * 64 + lane] = acc[rr];
        __syncthreads();
        if (tid < 320) { const int rr = tid >> 6, l = tid & 63; float s = 0.f;
#pragma unroll
            for (int w = 0; w < 8; ++w) s += part[(w * 5 + rr) * 64 + l];
            ((float*)(ws + WS_ADA))[(size_t)(layer * 5 + rr) * 6144 + cb * 64 + l] = s + A.in[layer ? I1_BMOD : I0_BMOD][cb * 64 + l]; }
        __syncthreads();
    }
    if (blockIdx.x == G - 1) {
        float* tab = (float*)(ws + WS_ROPE);
        for (int i = tid; i < 192 * 16; i += 512) {
            const int pos = i >> 4, f = i & 15; const int p = pos < 128 ? pos : pos - 128;
            double inv = 1.0; for (int q = 0; q < f; ++q) inv *= 0.5623413251903491;
            const float invf = (float)inv;
            const float angf = (float)p * invf;
            double x = (double)angf; const double n = rint(x * 0.15915494309189535); x -= n * 6.283185307179586477;
            const double x2 = x * x; double sn = 0.0, cs = 0.0;
            for (int t = 27; t >= 1; t -= 2) sn = sn * x2 * (-1.0 / ((double)(t + 1) * (double)(t + 2))) + 1.0;
            for (int t = 26; t >= 0; t -= 2) cs = cs * x2 * (-1.0 / ((double)(t + 1) * (double)(t + 2))) + 1.0;
            tab[pos * 32 + f] = (float)cs; tab[pos * 32 + 16 + f] = (float)(sn * x);
        }
    }
}
__device__ __forceinline__ void norm_mod_row(const float* xr, const float* gain, const float* sh, const float* sc, bf16_t* orow, int lane) {
    f32x4 v[4]; float ss = 0.f;
#pragma unroll
    for (int j = 0; j < 4; ++j) { v[j] = *(const f32x4*)(xr + 4 * (lane + 64 * j)); ss += (v[j].x * v[j].x + v[j].y * v[j].y) + (v[j].z * v[j].z + v[j].w * v[j].w); }
    const float rs = __builtin_amdgcn_rsqf(wave_sum(ss) * (1.f / DM) + 1e-6f);
#pragma unroll
    for (int j = 0; j < 4; ++j) { const int col = 4 * (lane + 64 * j);
        const f32x4 g = *(const f32x4*)(gain + col), a = *(const f32x4*)(sc + col), b = *(const f32x4*)(sh + col);
        const f32x4 y = v[j] * rs * g * (a + 1.0f) + b;
        u32x2 w; w.x = cvt_pk_bf16(y.x, y.y); w.y = cvt_pk_bf16(y.z, y.w);
        *(u32x2*)(orow + col) = w; }
}
__device__ __forceinline__ const float* xs_row(KAREF A, int m) { return m < TL ? A.out + (size_t)m * DM : (const float*)(A.ws + WS_CTXS) + (size_t)(m - TL) * DM; }
__device__ __forceinline__ float* xs_row_w(KAREF A, int m) { return m < TL ? A.out + (size_t)m * DM : (float*)(A.ws + WS_CTXS) + (size_t)(m - TL) * DM; }

__device__ __forceinline__ void p1_norm0(KAREF A, int G) {
    const int lane = threadIdx.x & 63, wave = threadIdx.x >> 6, gw = blockIdx.x * 8 + wave, ngw = G * 8;
    bf16_t* H = (bf16_t*)(A.ws + WS_ACT + A_H);
    f32x4 gq[4], aq[4], bq[4], vn[4]; int rcur = -1;
#pragma unroll
    for (int j = 0; j < 4; ++j) gq[j] = *(const f32x4*)(A.in[I0_NMIX] + 4 * (lane + 64 * j));
#define P1_ROW(M) ((M) < TL ? A.in[I_X] + (size_t)(M) * DM : A.in[I_CTX] + (size_t)((M) - TL) * DM)
    { const int m0 = gw < TT ? gw : 0; const float* x0 = P1_ROW(m0);
#pragma unroll
      for (int j = 0; j < 4; ++j) vn[j] = *(const f32x4*)(x0 + 4 * (lane + 64 * j)); }
    for (int m = gw; m < TT; m += ngw) {
        const int r = mod_row(m);
        if (r != rcur) { const float* sh = ada_ptr(A.ws, 0, r, 0); const float* sc = ada_ptr(A.ws, 0, r, 1); rcur = r;
#pragma unroll
            for (int j = 0; j < 4; ++j) { bq[j] = *(const f32x4*)(sh + 4 * (lane + 64 * j)); aq[j] = *(const f32x4*)(sc + 4 * (lane + 64 * j)); } }
        f32x4 v[4]; float ss = 0.f;
#pragma unroll
        for (int j = 0; j < 4; ++j) v[j] = vn[j];
        { const int mn = m + ngw < TT ? m + ngw : m; const float* xn = P1_ROW(mn);
#pragma unroll
          for (int j = 0; j < 4; ++j) vn[j] = *(const f32x4*)(xn + 4 * (lane + 64 * j)); }
#pragma unroll
        for (int j = 0; j < 4; ++j) ss += (v[j].x * v[j].x + v[j].y * v[j].y) + (v[j].z * v[j].z + v[j].w * v[j].w);
        const float rs = __builtin_amdgcn_rsqf(wave_sum(ss) * (1.f / DM) + 1e-6f);
#pragma unroll
        for (int j = 0; j < 4; ++j) { const int col = 4 * (lane + 64 * j); const f32x4 y = v[j] * rs * gq[j] * (aq[j] + 1.0f) + bq[j];
            u32x2 w; w.x = cvt_pk_bf16(y.x, y.y); w.y = cvt_pk_bf16(y.z, y.w);
            *(u32x2*)(H + (size_t)m * DM + col) = w; }
    }
#undef P1_ROW
}

struct EpiWin {
    static constexpr bool PERM = true;
    bf16_t* XA; bf16_t* GA; float* QR; float* KR; bf16_t* VB;
    __device__ __forceinline__ void operator()(const f32x4 (&acc)[2][2][4][2], const pg8::Unit& u, int wr, int wc, int fr, int fq) const {
        const int row0 = u.pm * 256 + wr * 64 + fr, tile = u.pn;
#pragma unroll
        for (int ai = 0; ai < 2; ++ai)
#pragma unroll
            for (int m = 0; m < 4; ++m) { const int row = row0 + ai * 128 + m * 16;
#pragma unroll
                for (int bj = 0; bj < 2; ++bj) { const int colt = bj * 128 + wc * 32 + 8 * fq; const f32x4 v0 = acc[ai][bj][m][0], v1 = acc[ai][bj][m][1];
                    u32x4 w; w.x = cvt_pk_bf16(v0[0], v0[1]); w.y = cvt_pk_bf16(v0[2], v0[3]); w.z = cvt_pk_bf16(v1[0], v1[1]); w.w = cvt_pk_bf16(v1[2], v1[3]);
                    if (tile < 2) *(u32x4*)(XA + (size_t)row * 512 + tile * 256 + colt) = w;
                    else if (tile < 4) *(u32x4*)(GA + (size_t)row * 512 + (tile - 2) * 256 + colt) = w;
                    else if (tile < 6) *(u32x4*)((bf16_t*)QR + (size_t)row * 512 + (tile - 4) * 256 + colt) = w;
                    else if (bj == 0) { float* p = KR + (size_t)row * 128 + colt; *(f32x4*)p = v0; *(f32x4*)(p + 4) = v1; }
                    else *(u32x4*)(VB + (size_t)kv_row(row) * 128 + (colt - 128)) = w; } }
    }
};

struct EpiResidD {
    static constexpr bool PERM = false;
    const float* src; float* dst; const bf16_t* delta; const float* gate;
    __device__ __forceinline__ void operator()(const f32x4 (&acc)[2][2][4][2], const pg8::Unit& u, int wr, int wc, int fr, int fq) const {
        const int row0 = u.pm * 256 + wr * 64 + fr, col0 = u.pn * 256 + wc * 32 + 4 * fq; const int r = u.pm >> 5;
        const float* s0 = src + (size_t)row0 * DM; float* d0 = dst + (size_t)row0 * DM; const bf16_t* e0 = delta + (size_t)row0 * DM;
        f32x4 gv[2][2];
#pragma unroll
        for (int bj = 0; bj < 2; ++bj)
#pragma unroll
            for (int n = 0; n < 2; ++n) gv[bj][n] = *(const f32x4*)(gate + (size_t)r * 6144 + col0 + bj * 128 + n * 16);
        f32x4 sv[2][4]; u32x2 dv[2][4];
#define ER_LOAD(slot, st) do { const size_t off_ = (size_t)(((st) >> 2) * 128 + ((st) & 3) * 16) * DM + col0; _Pragma("unroll") for (int bj = 0; bj < 2; ++bj) _Pragma("unroll") for (int n = 0; n < 2; ++n) { \
            sv[slot][bj * 2 + n] = *(const f32x4*)(s0 + off_ + bj * 128 + n * 16); dv[slot][bj * 2 + n] = *(const u32x2*)(e0 + off_ + bj * 128 + n * 16); } } while (0)
        ER_LOAD(0, 0); ER_LOAD(1, 1);
#pragma unroll
        for (int st = 0; st < 8; ++st) { const int ai = st >> 2, m = st & 3; const size_t off = (size_t)(ai * 128 + m * 16) * DM + col0;
            f32x4 o[4];
#pragma unroll
            for (int bj = 0; bj < 2; ++bj)
#pragma unroll
                for (int n = 0; n < 2; ++n) { const u32x2 dw = dv[st & 1][bj * 2 + n]; o[bj * 2 + n] = sv[st & 1][bj * 2 + n] + (f32x4){bflo(dw.x), bfhi(dw.x), bflo(dw.y), bfhi(dw.y)} + gv[bj][n] * acc[ai][bj][m][n]; }
            if (st + 2 < 8) ER_LOAD(st & 1, st + 2);
#pragma unroll
            for (int bj = 0; bj < 2; ++bj)
#pragma unroll
                for (int n = 0; n < 2; ++n) *(f32x4*)(d0 + off + bj * 128 + n * 16) = o[bj * 2 + n];
            asm volatile("" ::: "memory"); }
#undef ER_LOAD
    }
};
__device__ __forceinline__ void p5_ctx_outproj(KAREF A, int G) {
    const int tid = threadIdx.x, lane = tid & 63, wave = tid >> 6, fr = lane & 15, fq = lane >> 4;
    const bf16_t* Y = (const bf16_t*)(A.ws + WS_ACT + A_YCAT) + (size_t)TL * DM; const bf16_t* W = (const bf16_t*)(A.ws + WS_WOUT);
    const float* gate = ada_ptr(A.ws, 0, 4, 2); const float* src = A.in[I_CTX]; float* dst = (float*)(A.ws + WS_CTXS);
    for (int tile = blockIdx.x; tile < (TC / 64) * (DM / 64); tile += G) {
        const int r0 = (tile >> 4) * 64 + (wave >> 1) * 16, c0 = (tile & 15) * 64 + (wave & 1) * 32;
        const bf16_t* ap = Y + (size_t)(r0 + fr) * DM + 8 * fq; const bf16_t* bp0 = W + (size_t)(c0 + fr) * DM + 8 * fq; const bf16_t* bp1 = bp0 + (size_t)16 * DM;
        f32x4 acc0 = (f32x4){0.f, 0.f, 0.f, 0.f}, acc1 = acc0;
#pragma unroll 8
        for (int k0 = 0; k0 < DM; k0 += 32) { const bf16x8 a = *(const bf16x8*)(ap + k0), b0 = *(const bf16x8*)(bp0 + k0), b1 = *(const bf16x8*)(bp1 + k0);
            acc0 = __builtin_amdgcn_mfma_f32_16x16x32_bf16(a, b0, acc0, 0, 0, 0); acc1 = __builtin_amdgcn_mfma_f32_16x16x32_bf16(a, b1, acc1, 0, 0, 0); }
        const float g0 = gate[c0 + fr], g1 = gate[c0 + 16 + fr];
#pragma unroll
        for (int r = 0; r < 4; ++r) { const size_t o = (size_t)(r0 + 4 * fq + r) * DM + c0 + fr; dst[o] = src[o] + g0 * acc0[r]; dst[o + 16] = src[o + 16] + g1 * acc1[r]; }
    }
}

__device__ __forceinline__ void p3_kprep(KAREF A, int G) {
    const int lane = threadIdx.x & 63, wave = threadIdx.x >> 6, gw = blockIdx.x * 8 + wave, ngw = G * 8;
    const float* KR = (const float*)(A.ws + WS_ACT + A_KR); bf16_t* KN = (bf16_t*)(A.ws + WS_ACT + A_KN); const float* tab = (const float*)(A.ws + WS_ROPE);
    const int head = lane >> 5, p = lane & 31;
    const float g0 = A.in[I0_KG][2 * p], g1 = A.in[I0_KG][2 * p + 1];
    for (int m0 = gw; m0 < TT; m0 += 4 * ngw) {
        f32x2 v[4]; float cs[4], sn[4]; int mm[4]; bool ok[4];
#pragma unroll
        for (int q = 0; q < 4; ++q) { const int m = m0 + q * ngw; ok[q] = m < TT; mm[q] = ok[q] ? m : m0; v[q] = *(const f32x2*)(KR + (size_t)mm[q] * 128 + head * 64 + 2 * p);
            cs[q] = 1.f; sn[q] = 0.f;
            if (mm[q] < TL) { const int t = mm[q] & 8191; const float* tb = tab + (p < 16 ? (t >> 6) : 128 + (t & 63)) * 32 + (p & 15); cs[q] = tb[0]; sn[q] = tb[16]; } }
#pragma unroll
        for (int q = 0; q < 4; ++q) {
            float ss = v[q].x * v[q].x + v[q].y * v[q].y;
#pragma unroll
            for (int o = 1; o < 32; o <<= 1) ss += __shfl_xor(ss, o);
            const float rs = __builtin_amdgcn_rsqf(ss * (1.f / 64.f) + 1e-6f);
            const float x1 = v[q].x * rs * g0, x2 = v[q].y * rs * g1;
            const float y0 = x1 * cs[q] - x2 * sn[q], y1 = x1 * sn[q] + x2 * cs[q];
            if (ok[q]) *(unsigned*)(KN + (size_t)kv_row(mm[q]) * 128 + head * 64 + 2 * p) = cvt_pk_bf16(y0, y1); }
    }
}

constexpr int L_XCF = 0, L_XCB = 17408, L_WG = 26624, L_AB = 45056, L_SC = 78336, L_CAR = 82432, L_PAR = 82944;
template <int MODE>
__device__ __forceinline__ void lru_dir(KAREF A, LAS unsigned char* lds, int d, int n, int seqrow0, int L, int t_begin, int t_end, float h0, float& h_end, float& a_prod) {
    const int tid = threadIdx.x, lane = tid & 63, wid = tid >> 6;
    LAS float* XCF = (LAS float*)(lds + L_XCF);
    LAS bf16_t* XCB = (LAS bf16_t*)(lds + L_XCB);
    LAS bf16_t* WGl = (LAS bf16_t*)(lds + L_WG);
    LAS f32x2* AB = (LAS f32x2*)(lds + L_AB);
    LAS f32x2* SC = (LAS f32x2*)(lds + L_SC);
    LAS float* CAR = (LAS float*)(lds + L_CAR);
    LAS float* PAR = (LAS float*)(lds + L_PAR);
    const bf16_t* XA = (const bf16_t*)(A.ws + WS_ACT + A_XA); const bf16_t* GA = (const bf16_t*)(A.ws + WS_ACT + A_GA);
    float* HF = (float*)(A.ws + WS_ACT + A_HF); bf16_t* YCAT = (bf16_t*)(A.ws + WS_ACT + A_YCAT);
    __syncthreads();
    { const bf16_t* src = (const bf16_t*)(A.ws + WS_WGATE) + (size_t)(d * 8 + n) * 128 * 64; const int row = tid >> 2, part = tid & 3;
      const u32x4 w0 = *(const u32x4*)(src + row * 64 + part * 16), w1 = *(const u32x4*)(src + row * 64 + part * 16 + 8);
      *(LAS u32x4*)(WGl + row * 72 + part * 16) = w0; *(LAS u32x4*)(WGl + row * 72 + part * 16 + 8) = w1; }
    if (tid < 64) { const int c = tid, ch = 64 * n + c;
#pragma unroll
        for (int j = 0; j < 4; ++j) PAR[j * 64 + c] = A.in[I0_CONVW][j * 512 + ch];
        PAR[256 + c] = A.in[I0_CONVB][ch]; PAR[320 + c] = A.in[I0_BI][d * 512 + ch]; PAR[384 + c] = A.in[I0_BR][d * 512 + ch];
        const float lam = A.in[I0_LAM][d * 512 + ch]; PAR[448 + c] = -8.0f * log1pf(expf(-lam));
        CAR[c] = h0; }
    __syncthreads();
    const int nsub = (t_end - t_begin) >> 6; float ap = 1.f, hfin = 0.f; int par = 0;
#define LRU_BAR() do { LDS_WAIT(); __builtin_amdgcn_s_barrier(); asm volatile("" ::: "memory"); } while (0)
    u32x4 xw[4];
#define LRU_PREFETCH(SI) do { const int t0_ = t_begin + (d ? nsub - 1 - (SI) : (SI)) * 64; _Pragma("unroll") for (int j = 0; j < 4; ++j) { const int ts = t0_ + (tid >> 3) + j - 2; \
        xw[j] = (ts >= 0 && ts < L) ? *(const u32x4*)(XA + (size_t)(seqrow0 + ts) * 512 + 64 * n + (tid & 7) * 8) : (u32x4){0u, 0u, 0u, 0u}; } } while (0)
    LRU_PREFETCH(0);
    float cw8[4][8], cb8[8];
    { const int ch8 = (tid & 7) * 8;
#pragma unroll
      for (int i = 0; i < 8; ++i) { cb8[i] = PAR[256 + ch8 + i];
#pragma unroll
          for (int j = 0; j < 4; ++j) cw8[j][i] = PAR[j * 64 + ch8 + i]; } }
    bf16x8 wgf[2][4];
    { const int half = wid >> 2, fr = lane & 15, fq = lane >> 4;
#pragma unroll
      for (int q = 0; q < 2; ++q) { const int cbase = 32 * half + 16 * q;
          wgf[q][0] = *(const LAS bf16x8*)(WGl + (cbase + fr) * 72 + 8 * fq); wgf[q][1] = *(const LAS bf16x8*)(WGl + (cbase + fr) * 72 + 32 + 8 * fq);
          wgf[q][2] = *(const LAS bf16x8*)(WGl + (64 + cbase + fr) * 72 + 8 * fq); wgf[q][3] = *(const LAS bf16x8*)(WGl + (64 + cbase + fr) * 72 + 32 + 8 * fq); } }
    for (int si = 0; si < nsub; ++si) {
        const int t0 = t_begin + (d ? nsub - 1 - si : si) * 64;
        { const int tt = tid >> 3, ch8 = (tid & 7) * 8; float a8[8];
#pragma unroll
          for (int i = 0; i < 8; ++i) a8[i] = cb8[i];
#pragma unroll
          for (int j = 0; j < 4; ++j) {
              { const u32x4 w = xw[j];
                  a8[0] += cw8[j][0] * bflo(w.x); a8[1] += cw8[j][1] * bfhi(w.x); a8[2] += cw8[j][2] * bflo(w.y); a8[3] += cw8[j][3] * bfhi(w.y);
                  a8[4] += cw8[j][4] * bflo(w.z); a8[5] += cw8[j][5] * bfhi(w.z); a8[6] += cw8[j][6] * bflo(w.w); a8[7] += cw8[j][7] * bfhi(w.w); } }
          *(LAS f32x4*)(XCF + tt * 68 + ch8) = (f32x4){a8[0], a8[1], a8[2], a8[3]}; *(LAS f32x4*)(XCF + tt * 68 + ch8 + 4) = (f32x4){a8[4], a8[5], a8[6], a8[7]};
          u32x4 o; o.x = cvt_pk_bf16(a8[0], a8[1]); o.y = cvt_pk_bf16(a8[2], a8[3]); o.z = cvt_pk_bf16(a8[4], a8[5]); o.w = cvt_pk_bf16(a8[6], a8[7]);
          *(LAS u32x4*)(XCB + tt * 72 + ch8) = o; }
        if (si + 1 < nsub) LRU_PREFETCH(si + 1);
        LRU_BAR();
        { const int mt = wid & 3, half = wid >> 2, fr = lane & 15, fq = lane >> 4;
          const bf16x8 a0 = *(const LAS bf16x8*)(XCB + (mt * 16 + fr) * 72 + 8 * fq), a1 = *(const LAS bf16x8*)(XCB + (mt * 16 + fr) * 72 + 32 + 8 * fq);
#pragma unroll
          for (int q = 0; q < 2; ++q) { const int cbase = 32 * half + 16 * q, c = cbase + fr;
              const bf16x8 bi0 = wgf[q][0], bi1 = wgf[q][1], br0 = wgf[q][2], br1 = wgf[q][3];
              f32x4 gi = __builtin_amdgcn_mfma_f32_16x16x32_bf16(a0, bi0, (f32x4){0.f, 0.f, 0.f, 0.f}, 0, 0, 0); gi = __builtin_amdgcn_mfma_f32_16x16x32_bf16(a1, bi1, gi, 0, 0, 0);
              f32x4 gr = __builtin_amdgcn_mfma_f32_16x16x32_bf16(a0, br0, (f32x4){0.f, 0.f, 0.f, 0.f}, 0, 0, 0); gr = __builtin_amdgcn_mfma_f32_16x16x32_bf16(a1, br1, gr, 0, 0, 0);
              const float bic = PAR[320 + c], brc = PAR[384 + c], lsl = PAR[448 + c];
#pragma unroll
              for (int j = 0; j < 4; ++j) { const int tt = mt * 16 + 4 * fq + j; const float xcv = XCF[tt * 68 + c];
                  const float ig = sigm(gi[j] + bic), rg = sigm(gr[j] + brc), la = rg * lsl, av = fexp(la);
                  const float bb = __builtin_amdgcn_sqrtf(fmaxf(1.0f - av * av, 0.f)) * ig * xcv;
                  AB[tt * 65 + c] = (f32x2){av, bb}; } } }
        LRU_BAR();
        { const int c = tid & 63, sc = wid; float av[8], bv[8]; float Al = 1.f, Hl = 0.f;
#pragma unroll
          for (int i = 0; i < 8; ++i) { const int p = 8 * sc + i, tt = d ? 63 - p : p; const f32x2 ab = AB[tt * 65 + c]; av[i] = ab.x; bv[i] = ab.y; Hl = ab.x * Hl + ab.y; Al *= ab.x; }
          SC[sc * 64 + c] = (f32x2){Al, Hl};
          float hfv[8], gav[8];
          if (MODE == 2) {
#pragma unroll
              for (int i = 0; i < 8; ++i) { const int p = 8 * sc + i, tt = d ? 63 - p : p; const size_t row = (size_t)(seqrow0 + t0 + tt);
                  hfv[i] = __hip_atomic_load(HF + row * 512 + 64 * n + c, RLX_AGENT); gav[i] = bf2f(GA[row * 512 + 64 * n + c]); } }
          LRU_BAR();
          float h = CAR[par * 64 + c]; float apl = 1.f;
#pragma unroll
          for (int s2 = 0; s2 < 8; ++s2) { const f32x2 t = SC[s2 * 64 + c]; if (s2 < sc) h = t.x * h + t.y; apl *= t.x; }
          if (MODE == 0) { h = Al * h + Hl; }
          else {
#pragma unroll
              for (int i = 0; i < 8; ++i) { h = av[i] * h + bv[i]; const int p = 8 * sc + i, tt = d ? 63 - p : p; const size_t row = (size_t)(seqrow0 + t0 + tt);
                  if (MODE == 1) HF[row * 512 + 64 * n + c] = h;
                  else { const float hf = hfv[i]; const float g = gav[i];
                      const float y = (h + hf) * gelu_tanh(g); YCAT[row * 1024 + 64 * n + c] = (bf16_t)(cvt_pk_bf16(y, 0.f) & 0xffffu); } } }
          if (sc == 7) { CAR[(par ^ 1) * 64 + c] = h; ap *= apl; hfin = h; }
          par ^= 1; }
    }
#undef LRU_PREFETCH
#undef LRU_BAR
    h_end = hfin; a_prod = ap;
}
__device__ __forceinline__ void p3_lru_pass1(KAREF A, LAS unsigned char* lds, int G) {
    const int tid = threadIdx.x, c = tid & 63;
    f32x2* CARRY = (f32x2*)(A.ws + WS_CARRY); float* HLAST = (float*)(A.ws + WS_HLAST);
    for (int u = blockIdx.x; u < 256 + 32; u += G) {
        float he, ap;
        if (u < 256) { const int b = u >> 6, n = (u >> 3) & 7, s = u & 7;
#pragma unroll 1
            for (int d = 0; d < 2; ++d) { lru_dir<0>(A, lds, d, n, b * SEQ, SEQ, s * 1024, s * 1024 + 1024, 0.f, he, ap);
                if (tid >= 448) CARRY[(size_t)((b * 8 + s) * 2 + d) * 512 + 64 * n + c] = (f32x2){ap, he}; } }
        else { const int v = u - 256, b = v >> 3, n = v & 7;
            lru_dir<1>(A, lds, 0, n, TL + b * CTXL, CTXL, 0, CTXL, 0.f, he, ap);
            if (tid >= 448) HLAST[(b * 2 + 0) * 512 + 64 * n + c] = he;
            VM_WAIT(); __syncthreads();
            lru_dir<2>(A, lds, 1, n, TL + b * CTXL, CTXL, 0, CTXL, 0.f, he, ap);
            if (tid >= 448) HLAST[(b * 2 + 1) * 512 + 64 * n + c] = he; }
    }
}
__device__ __forceinline__ void p4_lru_pass2(KAREF A, LAS unsigned char* lds, int G) {
    const int tid = threadIdx.x, c = tid & 63;
    const f32x2* CARRY = (const f32x2*)(A.ws + WS_CARRY); const float* HLAST = (const float*)(A.ws + WS_HLAST);
    for (int u = blockIdx.x; u < 256; u += G) {
        const int b = u >> 6, n = (u >> 3) & 7, s = u & 7; float he, ap;
        float hf0 = HLAST[(b * 2 + 0) * 512 + 64 * n + c], hb0 = HLAST[(b * 2 + 1) * 512 + 64 * n + c];
        for (int s2 = 0; s2 < s; ++s2) { const f32x2 t = CARRY[(size_t)((b * 8 + s2) * 2 + 0) * 512 + 64 * n + c]; hf0 = t.x * hf0 + t.y; }
        for (int s2 = 7; s2 > s; --s2) { const f32x2 t = CARRY[(size_t)((b * 8 + s2) * 2 + 1) * 512 + 64 * n + c]; hb0 = t.x * hb0 + t.y; }
        lru_dir<1>(A, lds, 0, n, b * SEQ, SEQ, s * 1024, s * 1024 + 1024, hf0, he, ap);
        VM_WAIT(); __syncthreads();
        lru_dir<2>(A, lds, 1, n, b * SEQ, SEQ, s * 1024, s * 1024 + 1024, hb0, he, ap);
    }
}

struct EpiResid {
    static constexpr bool PERM = false;
    const float* src_lat; const float* src_ctx; float* dst_lat; float* dst_ctx; const float* gate;
    __device__ __forceinline__ void operator()(const f32x4 (&acc)[2][2][4][2], const pg8::Unit& u, int wr, int wc, int fr, int fq) const {
        const int row0 = u.pm * 256 + wr * 64 + fr, col0 = u.pn * 256 + wc * 32 + 4 * fq;
        const bool lat = u.pm < TL / 256; const int r = lat ? (u.pm >> 5) : 4;
        const float* src = lat ? src_lat + (size_t)row0 * DM : src_ctx + (size_t)(row0 - TL) * DM; float* dst = lat ? dst_lat + (size_t)row0 * DM : dst_ctx + (size_t)(row0 - TL) * DM;
        f32x4 gv[2][2];
#pragma unroll
        for (int bj = 0; bj < 2; ++bj)
#pragma unroll
            for (int n = 0; n < 2; ++n) gv[bj][n] = *(const f32x4*)(gate + (size_t)r * 6144 + col0 + bj * 128 + n * 16);
        f32x4 sv[4][4];
#define ER_LOAD(slot, st) do { const size_t off_ = (size_t)(((st) >> 2) * 128 + ((st) & 3) * 16) * DM + col0; _Pragma("unroll") for (int bj = 0; bj < 2; ++bj) _Pragma("unroll") for (int n = 0; n < 2; ++n) sv[slot][bj * 2 + n] = *(const f32x4*)(src + off_ + bj * 128 + n * 16); } while (0)
        ER_LOAD(0, 0); ER_LOAD(1, 1); ER_LOAD(2, 2); ER_LOAD(3, 3);
#pragma unroll
        for (int st = 0; st < 8; ++st) { const int ai = st >> 2, m = st & 3; const size_t off = (size_t)(ai * 128 + m * 16) * DM + col0;
            f32x4 o[4];
#pragma unroll
            for (int bj = 0; bj < 2; ++bj)
#pragma unroll
                for (int n = 0; n < 2; ++n) o[bj * 2 + n] = sv[st & 3][bj * 2 + n] + gv[bj][n] * acc[ai][bj][m][n];
            if (st + 4 < 8) ER_LOAD(st & 3, st + 4);
#pragma unroll
            for (int bj = 0; bj < 2; ++bj)
#pragma unroll
                for (int n = 0; n < 2; ++n) *(f32x4*)(dst + off + bj * 128 + n * 16) = o[bj * 2 + n];
            asm volatile("" ::: "memory"); }
#undef ER_LOAD
    }
};
__device__ __forceinline__ void p4_attention(KAREF A, char* lds, int G) {
    const attn_body::bf16* QR = (const attn_body::bf16*)(A.ws + WS_ACT + A_QR); const attn_body::bf16* KN = (const attn_body::bf16*)(A.ws + WS_ACT + A_KN); const attn_body::bf16* VB = (const attn_body::bf16*)(A.ws + WS_ACT + A_VB);
    attn_body::bf16* YC = (attn_body::bf16*)(A.ws + WS_ACT + A_YCAT); const float* tab = (const float*)(A.ws + WS_ROPE); const float* qg = A.in[I0_QG];
    const int vcu = (G % 8 == 0) ? (int)((blockIdx.x % 8) * (G / 8) + blockIdx.x / 8) : (int)blockIdx.x;
    for (int u = vcu; u < 1024 + 32; u += G) {
        if (u < 1024) { const int bh = u >> 5, qb = u & 31, b = bh >> 3, h = bh & 7;
            attn_body::attn_unit<8>(b * SEQ + qb * 256, h, b * KVL, KVL / 64, 1, qb * 256, QR, qg, tab, KN, VB, YC, lds); }
        else { const int v = u - 1024, b = v >> 3, h = v & 7;
            attn_body::attn_unit<8>(TL + b * CTXL, h, b * KVL + SEQ, CTXL / 64, 0, 0, QR, qg, tab, KN, VB, YC, lds); }
    }
}

__device__ __forceinline__ void p6_norm_router(KAREF A, LAS unsigned char* lds, int G, int layer, int nrows) {
    const int tid = threadIdx.x, lane = tid & 63, wave = tid >> 6, gw = blockIdx.x * 8 + wave, ngw = G * 8;
    LAS float* RT = (LAS float*)lds;
    const float* router = A.in[layer ? I1_ROUTER : I0_ROUTER];
    for (int i = tid; i < 16 * 1024; i += 512) { const int k = i >> 4, e = i & 15; RT[e * 1024 + k] = router[i]; }
    __syncthreads();
    unsigned char* H2 = A.ws + WS_ACT + A_H2; float* AFFL = (float*)(A.ws + WS_AFFL); float* AFFC = (float*)(A.ws + WS_AFFC);
    const float* gain = A.in[layer ? I1_NFFN : I0_NFFN];
    f32x4 gq[4], aq[4], bq[4], na[4], nb[4]; int rcur = -1; const int npairs = nrows >> 1;
#pragma unroll
    for (int j = 0; j < 4; ++j) gq[j] = *(const f32x4*)(gain + 4 * (lane + 64 * j));
#define RT_PAIRLOAD(PI) do { const int pi_ = (PI) < npairs ? (PI) : npairs - 1; const float* p_ = xs_row(A, 2 * pi_); const float* q_ = xs_row(A, 2 * pi_ + 1); \
        _Pragma("unroll") for (int j = 0; j < 4; ++j) { na[j] = *(const f32x4*)(p_ + 4 * (lane + 64 * j)); nb[j] = *(const f32x4*)(q_ + 4 * (lane + 64 * j)); } } while (0)
#define RT_TAIL(pe, AFF) do { \
        _Pragma("unroll") for (int i = 0; i < 8; ++i) { const bool up = (lane & 32) != 0; const float send = up ? pe[i] : pe[i + 8], keep = up ? pe[i + 8] : pe[i]; pe[i] = keep + __shfl_xor(send, 32); } \
        _Pragma("unroll") for (int i = 0; i < 4; ++i) { const bool up = (lane & 16) != 0; const float send = up ? pe[i] : pe[i + 4], keep = up ? pe[i + 4] : pe[i]; pe[i] = keep + __shfl_xor(send, 16); } \
        _Pragma("unroll") for (int i = 0; i < 2; ++i) { const bool up = (lane & 8) != 0; const float send = up ? pe[i] : pe[i + 2], keep = up ? pe[i + 2] : pe[i]; pe[i] = keep + __shfl_xor(send, 8); } \
        { const bool up = (lane & 4) != 0; const float send = up ? pe[0] : pe[1], keep = up ? pe[1] : pe[0]; pe[0] = keep + __shfl_xor(send, 4); } \
        float lg = pe[0]; lg += __shfl_xor(lg, 2); lg += __shfl_xor(lg, 1); \
        float mx = lg; \
        _Pragma("unroll") for (int o = 4; o < 64; o <<= 1) mx = fmaxf(mx, __shfl_xor(mx, o)); \
        const float ex = expf(lg - mx); float sm = ex; \
        _Pragma("unroll") for (int o = 4; o < 64; o <<= 1) sm += __shfl_xor(sm, o); \
        AFF = ex / sm; } while (0)
    RT_PAIRLOAD(gw);
#pragma unroll 1
    for (int pi = gw; pi < npairs; pi += ngw) {
        const int m = 2 * pi; const int r = mod_row(m);
        if (r != rcur) { const float* sh = ada_ptr(A.ws, layer, r, 3); const float* sc = ada_ptr(A.ws, layer, r, 4); rcur = r;
#pragma unroll
            for (int j = 0; j < 4; ++j) { aq[j] = *(const f32x4*)(sc + 4 * (lane + 64 * j)); bq[j] = *(const f32x4*)(sh + 4 * (lane + 64 * j)); } }
        f32x4 va[4], vb[4]; float ssA = 0.f, ssB = 0.f;
#pragma unroll
        for (int j = 0; j < 4; ++j) { va[j] = na[j]; vb[j] = nb[j]; }
        RT_PAIRLOAD(pi + ngw);
#pragma unroll
        for (int j = 0; j < 4; ++j) { ssA += (va[j].x * va[j].x + va[j].y * va[j].y) + (va[j].z * va[j].z + va[j].w * va[j].w); ssB += (vb[j].x * vb[j].x + vb[j].y * vb[j].y) + (vb[j].z * vb[j].z + vb[j].w * vb[j].w); }
        const float rsA = __builtin_amdgcn_rsqf(wave_sum(ssA) * (1.f / DM) + 1e-6f), rsB = __builtin_amdgcn_rsqf(wave_sum(ssB) * (1.f / DM) + 1e-6f);
        float peA[16], peB[16];
#pragma unroll
        for (int e = 0; e < 16; ++e) { peA[e] = 0.f; peB[e] = 0.f; }
#pragma unroll
        for (int j = 0; j < 4; ++j) { const int col = 4 * (lane + 64 * j);
            const f32x4 yA = va[j] * rsA * gq[j] * (aq[j] + 1.0f) + bq[j], yB = vb[j] * rsB * gq[j] * (aq[j] + 1.0f) + bq[j];
            *(unsigned*)(H2 + (size_t)m * DM + col) = pk_fp8x4(yA.x, yA.y, yA.z, yA.w); *(unsigned*)(H2 + (size_t)(m + 1) * DM + col) = pk_fp8x4(yB.x, yB.y, yB.z, yB.w);
#pragma unroll
            for (int e = 0; e < 16; ++e) { const f32x4 rw = *(const LAS f32x4*)(RT + e * 1024 + col);
                peA[e] += (yA.x * rw.x + yA.y * rw.y) + (yA.z * rw.z + yA.w * rw.w); peB[e] += (yB.x * rw.x + yB.y * rw.y) + (yB.z * rw.z + yB.w * rw.w); }
            asm volatile("" ::: "memory"); }
        float affA, affB; RT_TAIL(peA, affA); RT_TAIL(peB, affB);
        const int e = (lane >> 2) & 15;
        if ((lane & 3) == 0) { if (m < TL) *(f32x2*)(AFFL + (size_t)((m >> 13) * 16 + e) * SEQ + (m & 8191)) = (f32x2){affA, affB}; else { const int j = m - TL; *(f32x2*)(AFFC + (size_t)((j >> 8) * 16 + e) * CTXL + (j & 255)) = (f32x2){affA, affB}; } }
    }
#undef RT_PAIRLOAD
#undef RT_TAIL
}

__device__ __forceinline__ void topk_unit(const float* aff, int N, int cap, int src_row0, int xe_row0, int* SRCROW, float* GROW, int* slotmap, LAS unsigned char* lds) {
    const int tid = threadIdx.x;
    LAS unsigned* keys = (LAS unsigned*)lds;
    LAS unsigned* hist = (LAS unsigned*)(lds + 32768);
    LAS unsigned* ctl = (LAS unsigned*)(lds + 32768 + 1024);
    LAS int* tmp = (LAS int*)(lds + 32768 + 1024 + 64);
    __syncthreads();
    for (int i = tid; i < N; i += 512) keys[i] = __float_as_uint(aff[i]);
    if (tid == 0) { ctl[0] = 0u; ctl[1] = (unsigned)cap; }
    unsigned mask = 0u;
#pragma unroll 1
    for (int shift = 24; shift >= 0; shift -= 8) {
        if (tid < 256) hist[tid] = 0u;
        __syncthreads();
        const unsigned prefix = ctl[0];
        for (int i = tid; i < N; i += 512) { const unsigned k = keys[i]; if ((k & mask) == prefix) __hip_atomic_fetch_add(&hist[(k >> shift) & 255u], 1u, __ATOMIC_RELAXED, __HIP_MEMORY_SCOPE_WORKGROUP); }
        __syncthreads();
        { const unsigned need = ctl[1]; const int hv = tid < 256 ? (int)hist[255 - tid] : 0; int tot_; const int above = block_excl_scan(hv, tmp, tot_);
          if (tid < 256 && (unsigned)above < need && need <= (unsigned)(above + hv)) { ctl[0] = prefix | ((unsigned)(255 - tid) << shift); ctl[1] = need - (unsigned)above; } }
        mask |= 0xffu << shift;
        __syncthreads();
    }
    const unsigned tau = ctl[0]; const int need_eq = (int)ctl[1];
    const int per = N >= 512 ? N / 512 : 1; const int base = tid * per; const bool act = base < N;
    int neq = 0;
    if (act) for (int i = 0; i < per; ++i) neq += (keys[base + i] == tau) ? 1 : 0;
    int tot; int eqrank = block_excl_scan(neq, tmp, tot);
    int nsel = 0;
    if (act) { int er = eqrank; for (int i = 0; i < per; ++i) { const unsigned k = keys[base + i]; if (k > tau) ++nsel; else if (k == tau) { if (er < need_eq) ++nsel; ++er; } } }
    int slot = block_excl_scan(nsel, tmp, tot);
    if (act) { int er = eqrank; for (int i = 0; i < per; ++i) { const unsigned k = keys[base + i]; bool sel = false; if (k > tau) sel = true; else if (k == tau) { sel = er < need_eq; ++er; }
            if (sel) { SRCROW[xe_row0 + slot] = src_row0 + base + i; GROW[xe_row0 + slot] = __uint_as_float(k); slotmap[base + i] = xe_row0 + slot; ++slot; } else slotmap[base + i] = -1; } }
}
__device__ __forceinline__ void p7_topk(KAREF A, LAS unsigned char* lds, int G, bool with_ctx) {
    int* SRCROW = (int*)(A.ws + WS_SRCROW); float* GROW = (float*)(A.ws + WS_GROW);
    const int nun = with_ctx ? 128 : 64;
    for (int u = blockIdx.x; u < nun; u += G) {
        if (u < 64) { const int b = u >> 4, e = u & 15; topk_unit((const float*)(A.ws + WS_AFFL) + (size_t)u * SEQ, SEQ, CAPL, b * SEQ, (b * 16 + e) * CAPL, SRCROW, GROW, (int*)(A.ws + WS_SLOTL) + (size_t)u * SEQ, lds); }
        else { const int v = u - 64, b = v >> 4, e = v & 15; topk_unit((const float*)(A.ws + WS_AFFC) + (size_t)v * CTXL, CTXL, CAPC, TL + b * CTXL, XE_CTX0 + e * 256 + b * CAPC, SRCROW, GROW, (int*)(A.ws + WS_SLOTC) + (size_t)v * CTXL, lds); }
    }
}

__device__ __forceinline__ void p8_gather(KAREF A, int G, bool with_ctx) {
    const int lane = threadIdx.x & 63, wave = threadIdx.x >> 6, gw = blockIdx.x * 8 + wave, ngw = G * 8;
    const int* SRCROW = (const int*)(A.ws + WS_SRCROW); const unsigned char* H2 = A.ws + WS_ACT + A_H2; unsigned char* XE = A.ws + WS_ACT + A_XE;
    const int nr = with_ctx ? XE_CTX0 + NE * 128 : XE_CTX0;
    for (int i0 = gw; i0 < nr; i0 += 4 * ngw) {
        int xr[4], src[4]; bool ok[4];
#pragma unroll
        for (int q = 0; q < 4; ++q) { const int i = i0 + q * ngw; ok[q] = i < nr; const int ic = ok[q] ? i : i0; xr[q] = ic; if (ic >= XE_CTX0) { const int j = ic - XE_CTX0; xr[q] = XE_CTX0 + (j >> 7) * 256 + (j & 127); } }
#pragma unroll
        for (int q = 0; q < 4; ++q) src[q] = SRCROW[xr[q]];
        u32x4 a[4];
#pragma unroll
        for (int q = 0; q < 4; ++q) a[q] = *(const u32x4*)(H2 + (size_t)src[q] * DM + 16 * lane);
#pragma unroll
        for (int q = 0; q < 4; ++q) if (ok[q]) *(u32x4*)(XE + (size_t)xr[q] * DM + 16 * lane) = a[q];
    }
}

struct MoeOrder1 {
    int G, c, nun;
    __device__ __forceinline__ bool next(int i, pg8::Unit& u) const {
        const long L = (long)i * G + c; if (L >= nun) return false;
        if (L < 4096) { const int e = (int)(L >> 8), j = (int)(L & 255), x = j & 7, sI = j >> 3, rt = (x & 1) * 8 + (sI & 7), pnl = (x >> 1) * 4 + (sI >> 3);
            u.am = ((rt >> 2) * 16 + e) * 4 + (rt & 3); u.bn = e * 16 + pnl; }
        else { const int j = (int)L - 4096, e = j >> 4, pnl = j & 15; u.am = XE_CTX0 / 256 + e; u.bn = e * 16 + pnl; }
        u.pm = u.am; u.pn = u.bn & 15; return true;
    }
    __device__ __forceinline__ void a_ready(const pg8::Unit&) const {}
    __device__ __forceinline__ void done(const pg8::Unit&) const {}
};
struct MoeOrder2 {
    int G, c, nun;
    __device__ bool next(int i, pg8::Unit& u) const {
        const long L = (long)i * G + c; if (L >= nun) return false;
        if (L < 1024) { const int e4 = (int)(L >> 8), j = (int)(L & 255), v = (j & 7) * 32 + (j >> 3), e = 4 * e4 + (v >> 6), w = v & 63, rt = w >> 2, pnl = w & 3;
            u.am = ((rt >> 2) * 16 + e) * 4 + (rt & 3); u.bn = e * 4 + pnl; }
        else { const int j = (int)L - 1024, e = j >> 2, pnl = j & 3; u.am = XE_CTX0 / 256 + e; u.bn = e * 4 + pnl; }
        u.pm = u.am; u.pn = u.bn & 3; return true;
    }
    __device__ __forceinline__ void a_ready(const pg8::Unit&) const {}
    __device__ __forceinline__ void done(const pg8::Unit&) const {}
};
struct EpiSwiGLU {
    static constexpr bool PERM = true;
    unsigned char* HID;
    __device__ __forceinline__ void operator()(const f32x4 (&acc)[2][2][4][2], const pg8::Unit& u, int wr, int wc, int fr, int fq) const {
        const int row0 = u.pm * 256 + wr * 64 + fr, col0 = u.pn * 128 + wc * 32 + 8 * fq; constexpr float is = 1.0f / W8_SCALE;
#pragma unroll
        for (int ai = 0; ai < 2; ++ai)
#pragma unroll
            for (int m = 0; m < 4; ++m) { const f32x4 g0 = acc[ai][0][m][0] * is, g1 = acc[ai][0][m][1] * is, u0 = acc[ai][1][m][0] * is, u1 = acc[ai][1][m][1] * is;
                u32x2 w; w.x = pk_fp8x4(silu_f(g0[0]) * u0[0], silu_f(g0[1]) * u0[1], silu_f(g0[2]) * u0[2], silu_f(g0[3]) * u0[3]);
                w.y = pk_fp8x4(silu_f(g1[0]) * u1[0], silu_f(g1[1]) * u1[1], silu_f(g1[2]) * u1[2], silu_f(g1[3]) * u1[3]);
                *(u32x2*)(HID + (size_t)(row0 + ai * 128 + m * 16) * FF + col0) = w; }
    }
};
constexpr float YE_SCALE = 16.0f;
struct EpiDown {
    static constexpr bool PERM = true;
    unsigned char* YE; const float* GROW;
    __device__ __forceinline__ void operator()(const f32x4 (&acc)[2][2][4][2], const pg8::Unit& u, int wr, int wc, int fr, int fq) const {
        const int row0 = u.pm * 256 + wr * 64 + fr, col0 = u.pn * 256 + wc * 32 + 8 * fq;
#pragma unroll
        for (int ai = 0; ai < 2; ++ai)
#pragma unroll
            for (int m = 0; m < 4; ++m) { const int row = row0 + ai * 128 + m * 16; const float gt = GROW[row] * (YE_SCALE / W8_SCALE);
#pragma unroll
                for (int bj = 0; bj < 2; ++bj) { const f32x4 v0 = acc[ai][bj][m][0] * gt, v1 = acc[ai][bj][m][1] * gt;
                    u32x2 w; w.x = pk_fp8x4(v0[0], v0[1], v0[2], v0[3]); w.y = pk_fp8x4(v1[0], v1[1], v1[2], v1[3]);
                    *(u32x2*)(YE + (size_t)row * DM + col0 + bj * 128) = w; } }
    }
};

__device__ __forceinline__ void p11_combine(KAREF A, int G, int layer, int nrows) {
    const int lane = threadIdx.x & 63, wave = threadIdx.x >> 6, gw = blockIdx.x * 8 + wave, ngw = G * 8;
    const unsigned char* YE = A.ws + WS_ACT + A_YE; const int* SLOTL = (const int*)(A.ws + WS_SLOTL); const int* SLOTC = (const int*)(A.ws + WS_SLOTC);
#define CB_SLOT(M, DST) do { const int m_ = (M); DST = -1; if (lane < 16) { if (m_ < TL) DST = SLOTL[(size_t)((m_ >> 13) * 16 + lane) * SEQ + (m_ & 8191)]; else { const int j_ = m_ - TL; DST = SLOTC[(size_t)((j_ >> 8) * 16 + lane) * CTXL + (j_ & 255)]; } } } while (0)
    int smn; f32x4 xn[4], g[4]; int rcur = -1;
    { const int m0 = gw < nrows ? gw : 0; CB_SLOT(m0, smn); const float* x0 = xs_row(A, m0);
#pragma unroll
      for (int j = 0; j < 4; ++j) xn[j] = *(const f32x4*)(x0 + 4 * (lane + 64 * j)); }
    for (int m = gw; m < nrows; m += ngw) {
        const int sm = smn; f32x4 x[4];
#pragma unroll
        for (int j = 0; j < 4; ++j) x[j] = xn[j];
        unsigned long long bal = __ballot(sm >= 0);
        bool ok[4]; int xr[4];
#pragma unroll
        for (int q = 0; q < 4; ++q) { ok[q] = bal != 0ull; const int e = ok[q] ? __builtin_ctzll(bal) : 0; if (ok[q]) bal &= bal - 1; const int rr = __builtin_amdgcn_readlane(sm, e); xr[q] = ok[q] ? rr : 0; }
        unsigned w[4][4];
#pragma unroll
        for (int q = 0; q < 4; ++q)
#pragma unroll
            for (int j = 0; j < 4; ++j) w[q][j] = *(const unsigned*)(YE + (size_t)xr[q] * DM + 4 * (lane + 64 * j));
        { const int r = mod_row(m); if (r != rcur) { const float* gt = ada_ptr(A.ws, layer, r, 5); rcur = r;
#pragma unroll
            for (int j = 0; j < 4; ++j) g[j] = *(const f32x4*)(gt + 4 * (lane + 64 * j)) * (1.0f / YE_SCALE); } }
        { const int mn = m + ngw < nrows ? m + ngw : m; CB_SLOT(mn, smn); const float* xp = xs_row(A, mn);
#pragma unroll
          for (int j = 0; j < 4; ++j) xn[j] = *(const f32x4*)(xp + 4 * (lane + 64 * j)); }
        f32x4 acc[4];
#pragma unroll
        for (int j = 0; j < 4; ++j) acc[j] = (f32x4){0.f, 0.f, 0.f, 0.f};
#pragma unroll
        for (int q = 0; q < 4; ++q) if (ok[q]) {
#pragma unroll
            for (int j = 0; j < 4; ++j) { const f32x2 lo = __builtin_amdgcn_cvt_pk_f32_fp8(w[q][j], false), hi = __builtin_amdgcn_cvt_pk_f32_fp8(w[q][j], true); acc[j] += (f32x4){lo.x, lo.y, hi.x, hi.y}; } }
        while (bal) { const int e = __builtin_ctzll(bal); bal &= bal - 1; const int rr = __builtin_amdgcn_readlane(sm, e);
#pragma unroll
            for (int j = 0; j < 4; ++j) { const unsigned ww = *(const unsigned*)(YE + (size_t)rr * DM + 4 * (lane + 64 * j)); const f32x2 lo = __builtin_amdgcn_cvt_pk_f32_fp8(ww, false), hi = __builtin_amdgcn_cvt_pk_f32_fp8(ww, true); acc[j] += (f32x4){lo.x, lo.y, hi.x, hi.y}; } }
        float* xr_ = xs_row_w(A, m);
#pragma unroll
        for (int j = 0; j < 4; ++j) { const int col = 4 * (lane + 64 * j); *(f32x4*)(xr_ + col) = x[j] + g[j] * acc[j]; }
    }
#undef CB_SLOT
}
__device__ __forceinline__ void l1_h_row(const float* xr, const float* gain, const float* sh, const float* sc, int lane, f32x4 (&h)[4]) {
    f32x4 v[4]; float ss = 0.f;
#pragma unroll
    for (int j = 0; j < 4; ++j) { v[j] = *(const f32x4*)(xr + 4 * (lane + 64 * j)); ss += (v[j].x * v[j].x + v[j].y * v[j].y) + (v[j].z * v[j].z + v[j].w * v[j].w); }
    const float rs = __builtin_amdgcn_rsqf(wave_sum(ss) * (1.f / DM) + 1e-6f);
#pragma unroll
    for (int j = 0; j < 4; ++j) { const int col = 4 * (lane + 64 * j); const f32x4 g = *(const f32x4*)(gain + col), a = *(const f32x4*)(sc + col), b = *(const f32x4*)(sh + col); h[j] = v[j] * rs * g * (a + 1.0f) + b; }
}
__device__ __forceinline__ void l1_h_from_raw(const f32x4 (&v)[4], const LAS float* gainl, const f32x4 (&shq)[4], const f32x4 (&scq)[4], int lane, f32x4 (&h)[4]) {
    float ss = 0.f;
#pragma unroll
    for (int j = 0; j < 4; ++j) ss += (v[j].x * v[j].x + v[j].y * v[j].y) + (v[j].z * v[j].z + v[j].w * v[j].w);
    const float rs = __builtin_amdgcn_rsqf(wave_sum(ss) * (1.f / DM) + 1e-6f);
#pragma unroll
    for (int j = 0; j < 4; ++j) { const f32x4 g = *(const LAS f32x4*)(gainl + 4 * (lane + 64 * j)); h[j] = v[j] * rs * g * (scq[j] + 1.0f) + shq[j]; }
}
__device__ __forceinline__ void p12_l1_prep(KAREF A, LAS unsigned char* lds, int G) {
    const int tid = threadIdx.x, lane = tid & 63, wave = tid >> 6, gw = blockIdx.x * 8 + wave, ngw = G * 8;
    unsigned char* XMIX8 = A.ws + WS_ACT + A_XMIX; bf16_t* XMIX16 = (bf16_t*)(A.ws + WS_ACT + A_XMIX16); bf16_t* DELTA = (bf16_t*)(A.ws + WS_DELTA);
    const unsigned char* YE = A.ws + WS_ACT + A_YE; const int* SLOTL = (const int*)(A.ws + WS_SLOTL); const int* SLOTC = (const int*)(A.ws + WS_SLOTC);
    LAS float* mul = (LAS float*)lds; LAS float* gainl = mul + 6 * DM;
    for (int i = tid; i < 6 * DM; i += 512) mul[i] = A.in[I1_MU][i];
    for (int i = tid; i < DM; i += 512) gainl[i] = A.in[I1_NMIX][i];
    __syncthreads();
    const int m_lo = (int)(((long)gw * TT) / ngw), m_hi = (int)(((long)(gw + 1) * TT) / ngw);
    if (m_lo >= m_hi) return;
#define L1_CL(M) ((M) < TT ? (M) : TT - 1)
#define L1_SLOT(DST, M) do { const int m_ = L1_CL(M); DST = -1; if (lane < 16) { if (m_ < TL) DST = SLOTL[(size_t)((m_ >> 13) * 16 + lane) * SEQ + (m_ & 8191)]; else { const int j_ = m_ - TL; DST = SLOTC[(size_t)((j_ >> 8) * 16 + lane) * CTXL + (j_ & 255)]; } } } while (0)
#define L1_RAW(DST, M) do { const float* p_ = xs_row(A, L1_CL(M)); _Pragma("unroll") for (int j = 0; j < 4; ++j) DST[j] = *(const f32x4*)(p_ + 4 * (lane + 64 * j)); } while (0)
#define L1_GATHER(W, OK, BAL, SM) do { BAL = __ballot((SM) >= 0); int xr_[4]; \
        _Pragma("unroll") for (int q = 0; q < 4; ++q) { OK[q] = BAL != 0ull; const int e_ = OK[q] ? __builtin_ctzll(BAL) : 0; if (OK[q]) BAL &= BAL - 1; const int rr_ = __builtin_amdgcn_readlane((SM), e_); xr_[q] = OK[q] ? rr_ : 0; } \
        _Pragma("unroll") for (int q = 0; q < 4; ++q) _Pragma("unroll") for (int j = 0; j < 4; ++j) W[q][j] = *(const unsigned*)(YE + (size_t)xr_[q] * DM + 4 * (lane + 64 * j)); } while (0)
#define L1_COMBINE(X, R, W, OK, BAL, SM, M, OWNER) do { f32x4 acc_[4]; \
        _Pragma("unroll") for (int j = 0; j < 4; ++j) acc_[j] = (f32x4){0.f, 0.f, 0.f, 0.f}; \
        _Pragma("unroll") for (int q = 0; q < 4; ++q) if (OK[q]) { _Pragma("unroll") for (int j = 0; j < 4; ++j) { const f32x2 lo_ = __builtin_amdgcn_cvt_pk_f32_fp8(W[q][j], false), hi_ = __builtin_amdgcn_cvt_pk_f32_fp8(W[q][j], true); acc_[j] += (f32x4){lo_.x, lo_.y, hi_.x, hi_.y}; } } \
        while (BAL) { const int e_ = __builtin_ctzll(BAL); BAL &= BAL - 1; const int rr_ = __builtin_amdgcn_readlane((SM), e_); \
            _Pragma("unroll") for (int j = 0; j < 4; ++j) { const unsigned ww_ = *(const unsigned*)(YE + (size_t)rr_ * DM + 4 * (lane + 64 * j)); const f32x2 lo_ = __builtin_amdgcn_cvt_pk_f32_fp8(ww_, false), hi_ = __builtin_amdgcn_cvt_pk_f32_fp8(ww_, true); acc_[j] += (f32x4){lo_.x, lo_.y, hi_.x, hi_.y}; } } \
        { const int rg_ = mod_row(L1_CL(M)); if (rg_ != rgate) { const float* gt_ = ada_ptr(A.ws, 0, rg_, 5); rgate = rg_; _Pragma("unroll") for (int j = 0; j < 4; ++j) gq[j] = *(const f32x4*)(gt_ + 4 * (lane + 64 * j)) * (1.0f / YE_SCALE); } } \
        _Pragma("unroll") for (int j = 0; j < 4; ++j) { const f32x4 dl_ = gq[j] * acc_[j]; X[j] = R[j] + dl_; \
            if ((OWNER) && (M) < TL) { u32x2 w_; w_.x = cvt_pk_bf16(dl_.x, dl_.y); w_.y = cvt_pk_bf16(dl_.z, dl_.w); *(u32x2*)(DELTA + (size_t)(M) * DM + 4 * (lane + 64 * j)) = w_; } } } while (0)
    f32x4 hp[4], hc[4], hn[4], shq[4], scq[4], gq[4], R[4], xk[4]; unsigned W[4][4]; bool ok[4]; unsigned long long bal; int smr, s2, s3, rcur = -1, rgate = -1;
    { const int r = mod_row(m_lo); const float* sh = ada_ptr(A.ws, 1, r, 0); const float* sc = ada_ptr(A.ws, 1, r, 1); rcur = r;
#pragma unroll
      for (int j = 0; j < 4; ++j) { shq[j] = *(const f32x4*)(sh + 4 * (lane + 64 * j)); scq[j] = *(const f32x4*)(sc + 4 * (lane + 64 * j)); }
      const int t0 = m_lo < TL ? (m_lo & 8191) : ((m_lo - TL) & 255);
      L1_SLOT(smr, m_lo); L1_RAW(R, m_lo); L1_GATHER(W, ok, bal, smr); L1_COMBINE(xk, R, W, ok, bal, smr, m_lo, true); l1_h_from_raw(xk, gainl, shq, scq, lane, hc);
      if (t0 > 0) { f32x4 xq[4]; L1_SLOT(smr, m_lo - 1); L1_RAW(R, m_lo - 1); L1_GATHER(W, ok, bal, smr); L1_COMBINE(xq, R, W, ok, bal, smr, m_lo - 1, false); l1_h_from_raw(xq, gainl, shq, scq, lane, hp); } else {
#pragma unroll
          for (int j = 0; j < 4; ++j) hp[j] = (f32x4){0.f, 0.f, 0.f, 0.f}; }
      L1_SLOT(smr, m_lo + 1); L1_RAW(R, m_lo + 1); L1_GATHER(W, ok, bal, smr); L1_SLOT(s2, m_lo + 2); L1_SLOT(s3, m_lo + 3); }
    for (int m = m_lo; m < m_hi; ++m) {
        const int r = mod_row(m);
        if (r != rcur) { const float* sh = ada_ptr(A.ws, 1, r, 0); const float* sc = ada_ptr(A.ws, 1, r, 1); rcur = r;
#pragma unroll
            for (int j = 0; j < 4; ++j) { shq[j] = *(const f32x4*)(sh + 4 * (lane + 64 * j)); scq[j] = *(const f32x4*)(sc + 4 * (lane + 64 * j)); } }
        const int t = m < TL ? (m & 8191) : ((m - TL) & 255), Ls = m < TL ? SEQ : CTXL;
        if (t == 0 && m != m_lo) {
            l1_h_from_raw(xk, gainl, shq, scq, lane, hc);
#pragma unroll
            for (int j = 0; j < 4; ++j) hp[j] = (f32x4){0.f, 0.f, 0.f, 0.f}; }
        L1_COMBINE(xk, R, W, ok, bal, smr, m + 1, m + 1 < m_hi);
        if (t < Ls - 1) l1_h_from_raw(xk, gainl, shq, scq, lane, hn); else {
#pragma unroll
            for (int j = 0; j < 4; ++j) hn[j] = (f32x4){0.f, 0.f, 0.f, 0.f}; }
        smr = s2; L1_GATHER(W, ok, bal, smr); L1_RAW(R, m + 2); s2 = s3; L1_SLOT(s3, m + 4);
#pragma unroll
        for (int j = 0; j < 4; ++j) { const int col = 4 * (lane + 64 * j); const f32x4 xx = (hp[j] + hn[j]) * 0.5f - hc[j];
#pragma unroll
            for (int q = 0; q < 6; ++q) { const f32x4 mq = *(const LAS f32x4*)(mul + q * DM + col); const f32x4 y = hc[j] + xx * mq;
                if (q == 0 || q == 3) { u32x2 w; w.x = cvt_pk_bf16(y.x, y.y); w.y = cvt_pk_bf16(y.z, y.w); *(u32x2*)(XMIX16 + (size_t)(q == 0 ? 0 : 1) * TT * DM + (size_t)m * DM + col) = w; }
                else { const int s8 = q == 2 ? 0 : q == 1 ? 1 : q - 2; *(unsigned*)(XMIX8 + (size_t)s8 * TT * DM + (size_t)m * DM + col) = pk_fp8x4(y.x, y.y, y.z, y.w); } }
            hp[j] = hc[j]; hc[j] = hn[j]; }
    }
#undef L1_CL
#undef L1_SLOT
#undef L1_RAW
#undef L1_GATHER
#undef L1_COMBINE
}

struct MixOrder {
    int G, c;
    __device__ bool next(int i, pg8::Unit& u) const {
        long L;
        if (i < 2) L = (long)i * G + c; else { if (c < 32) return false; L = 2L * G + (long)(i - 2) * (G - 32) + (c - 32); }
        if (L >= 132 * 7) return false;
        const int wgid = (int)L; const int grp = wgid / (8 * 7), w = wgid % (8 * 7), fm = grp * 8, gsz = (132 - fm) < 8 ? (132 - fm) : 8;
        u.pm = fm + w % gsz; const int lt = w / gsz;
        if (lt < 4) { u.pn = 4 + lt; u.am = u.pm; } else { u.pn = 8 + lt; u.am = (lt == 4 ? 3 : lt - 4) * 132 + u.pm; }
        u.bn = u.pn; return true;
    }
    __device__ __forceinline__ void a_ready(const pg8::Unit&) const {}
    __device__ __forceinline__ void done(const pg8::Unit&) const {}
};
struct MixOrder16 {
    int G, c;
    __device__ bool next(int i, pg8::Unit& u) const {
        const long L = (long)i * G + c; if (L >= 132 * 8) return false;
        const int wgid = (int)L; const int grp = wgid / (8 * 8), w = wgid % (8 * 8), fm = grp * 8, gsz = (132 - fm) < 8 ? (132 - fm) : 8;
        u.pm = fm + w % gsz; const int lt = w / gsz;
        u.pn = lt < 4 ? lt : lt + 4; u.am = (lt >> 2) * 132 + u.pm; u.bn = lt; return true;
    }
    __device__ __forceinline__ void a_ready(const pg8::Unit&) const {}
    __device__ __forceinline__ void done(const pg8::Unit&) const {}
};
struct EpiMix {
    static constexpr bool PERM = true;
    bf16_t* RKV; bf16_t* LG; bf16_t* LWA; float scl;
    __device__ __forceinline__ void operator()(const f32x4 (&acc)[2][2][4][2], const pg8::Unit& u, int wr, int wc, int fr, int fq) const {
        const int row0 = u.pm * 256 + wr * 64 + fr, tile = u.pn;
#pragma unroll
        for (int ai = 0; ai < 2; ++ai)
#pragma unroll
            for (int m = 0; m < 4; ++m) { const int row = row0 + ai * 128 + m * 16;
#pragma unroll
                for (int bj = 0; bj < 2; ++bj) { const int colt = bj * 128 + wc * 32 + 8 * fq; f32x4 v0 = acc[ai][bj][m][0] * scl, v1 = acc[ai][bj][m][1] * scl;
                    if (tile == 12) {
#pragma unroll
                        for (int i = 0; i < 4; ++i) { v0[i] = sigm(v0[i]); v1[i] = sigm(v1[i]); } }
                    if (tile == 13) {
#pragma unroll
                        for (int i = 0; i < 4; ++i) { v0[i] = tanh_f(v0[i]); v1[i] = tanh_f(v1[i]); } }
                    u32x4 w; w.x = cvt_pk_bf16(v0[0], v0[1]); w.y = cvt_pk_bf16(v0[2], v0[3]); w.z = cvt_pk_bf16(v1[0], v1[1]); w.w = cvt_pk_bf16(v1[2], v1[3]);
                    if (tile < 12) *(u32x4*)(RKV + (size_t)(tile >> 2) * TT * DM + (size_t)row * DM + (tile & 3) * 256 + colt) = w;
                    else if (tile == 12) *(u32x4*)(LG + (size_t)row * 256 + colt) = w;
                    else if (bj == 0) *(u32x4*)(LWA + (size_t)row * 256 + (tile - 13) * 128 + colt) = w; } }
    }
};
struct LoraOrder {
    int G, c;
    __device__ bool next(int i, pg8::Unit& u) const {
        const long L = (long)i * G + c; if (L >= 128 * 4) return false;
        const int wgid = (int)L; u.pm = (wgid >> 5) * 8 + (wgid & 7); u.pn = 16 + ((wgid & 31) >> 3); u.am = u.pm; u.bn = u.pn; u.nt = 4; u.koff = 0; return true;
    }
    __device__ __forceinline__ void a_ready(const pg8::Unit&) const {}
    __device__ __forceinline__ void done(const pg8::Unit&) const {}
};
struct EpiLora {
    static constexpr bool PERM = true;
    bf16_t* SD; bf16_t* AD; bf16_t* Gg; const float* w0; const float* a0;
    __device__ __forceinline__ void operator()(const f32x4 (&acc)[2][2][4][2], const pg8::Unit& u, int wr, int wc, int fr, int fq) const {
        const int row0 = u.pm * 256 + wr * 64 + fr, tile = u.pn, kind = tile >> 2;
        bf16_t* dst = kind < 2 ? SD + (size_t)kind * TT * DM : kind < 4 ? AD + (size_t)(kind - 2) * TT * DM : Gg;
        const float* bias = kind < 2 ? w0 + kind * DM : a0 + (kind - 2) * DM;
#pragma unroll
        for (int ai = 0; ai < 2; ++ai)
#pragma unroll
            for (int m = 0; m < 4; ++m) { const int row = row0 + ai * 128 + m * 16;
#pragma unroll
                for (int bj = 0; bj < 2; ++bj) { const int col = (tile & 3) * 256 + bj * 128 + wc * 32 + 8 * fq;
                    f32x4 v0 = acc[ai][bj][m][0], v1 = acc[ai][bj][m][1];
                    if (kind < 4) { v0 += *(const f32x4*)(bias + col); v1 += *(const f32x4*)(bias + col + 4);
#pragma unroll
                        for (int i = 0; i < 4; ++i) { v0[i] = sigm(v0[i]); v1[i] = sigm(v1[i]); } }
                    u32x4 w; w.x = cvt_pk_bf16(v0[0], v0[1]); w.y = cvt_pk_bf16(v0[2], v0[3]); w.z = cvt_pk_bf16(v1[0], v1[1]); w.w = cvt_pk_bf16(v1[2], v1[3]);
                    *(u32x4*)(dst + (size_t)row * DM + col) = w; }
                asm volatile("" ::: "memory"); }
    }
};

#define MFMA16(a, b, c) __builtin_amdgcn_mfma_f32_16x16x32_bf16((a), (b), (c), 0, 0, 0)
__device__ __forceinline__ void p14_lora2(KAREF A, LAS unsigned char* lds, int G) {
    const int tid = threadIdx.x, lane = tid & 63, wave = __builtin_amdgcn_readfirstlane(tid >> 6), fr = lane & 15, fq = lane >> 4, mw = wave & 3, nw = wave >> 2;
    LAS bf16_t* stg = (LAS bf16_t*)(lds + wave * 9216);
    const bf16_t* LG = (const bf16_t*)(A.ws + WS_ACT + A_LG); const bf16_t* LWA = (const bf16_t*)(A.ws + WS_ACT + A_LWA); const bf16_t* B2 = (const bf16_t*)(A.ws + WS_B2);
    for (int u = blockIdx.x; u < (TT / 128) * 20; u += G) {
        const int rt = u / 20, rem = u - rt * 20, kind = rem >> 2, cb = rem & 3;
        const bf16_t* Ap = (kind < 4 ? LWA + 64 * kind : LG) + (size_t)(rt * 128 + mw * 32 + fr) * 256 + 8 * fq;
        const bf16_t* Bp = B2 + (size_t)(kind * 1024 + cb * 256 + nw * 128 + fr) * 256 + (kind < 4 ? 64 * kind : 0) + 8 * fq;
        const int nk = kind < 4 ? 2 : 5;
        f32x4 acc[2][8];
#pragma unroll
        for (int mt = 0; mt < 2; ++mt)
#pragma unroll
            for (int nt = 0; nt < 8; ++nt) acc[mt][nt] = (f32x4){0.f, 0.f, 0.f, 0.f};
#pragma unroll
        for (int ks = 0; ks < 5; ++ks) if (ks < nk) {
            const bf16x8 a0 = *(const bf16x8*)(Ap + ks * 32), a1 = *(const bf16x8*)(Ap + 16 * 256 + ks * 32);
#pragma unroll
            for (int nt = 0; nt < 8; ++nt) { const bf16x8 bb = *(const bf16x8*)(Bp + (size_t)nt * 16 * 256 + ks * 32); acc[0][nt] = MFMA16(a0, bb, acc[0][nt]); acc[1][nt] = MFMA16(a1, bb, acc[1][nt]); } }
        const float* bias = kind < 2 ? A.in[I1_W0] + kind * DM : A.in[I1_A0] + (kind - 2) * DM;
#pragma unroll
        for (int nt = 0; nt < 8; ++nt) { const int cl = nt * 16 + fr; const float bv = kind < 4 ? bias[cb * 256 + nw * 128 + cl] : 0.f;
#pragma unroll
            for (int mt = 0; mt < 2; ++mt)
#pragma unroll
                for (int r = 0; r < 4; ++r) { float v = acc[mt][nt][r] + bv; if (kind < 4) v = sigm(v); stg[(mt * 16 + 4 * fq + r) * 136 + cl] = (bf16_t)(cvt_pk_bf16_c(v, 0.f) & 0xffffu); } }
        LDS_WAIT();
        bf16_t* dst = (kind < 2 ? (bf16_t*)(A.ws + WS_ACT + A_SD) + (size_t)kind * TT * DM : kind < 4 ? (bf16_t*)(A.ws + WS_ACT + A_AD) + (size_t)(kind - 2) * TT * DM : (bf16_t*)(A.ws + WS_ACT + A_G))
                      + (size_t)(rt * 128 + mw * 32) * DM + cb * 256 + nw * 128;
#pragma unroll
        for (int i = 0; i < 8; ++i) { const int row = 4 * i + (lane >> 4), ch = lane & 15; *(u32x4*)(dst + (size_t)row * DM + 8 * ch) = *(const LAS u32x4*)(stg + row * 136 + 8 * ch); }
        LDS_WAIT();
    }
}

#define DPP_ADD(x, ctrl) ((x) + __builtin_bit_cast(float, __builtin_amdgcn_update_dpp(0, __builtin_bit_cast(int, (x)), (ctrl), 0xf, 0xf, true)))
constexpr int CH = 32, NCHUNK = (CTXL + SEQ) / CH;
__device__ __forceinline__ int wkv_row(int b, int d, int i) { return i < CTXL ? TL + b * CTXL + (d ? CTXL - 1 - i : i) : b * SEQ + (d ? SEQ - 1 - (i - CTXL) : (i - CTXL)); }
__device__ __forceinline__ void unpack8(const u32x4 w, float (&f)[8]) { f[0] = bflo(w.x); f[1] = bfhi(w.x); f[2] = bflo(w.y); f[3] = bfhi(w.y); f[4] = bflo(w.z); f[5] = bfhi(w.z); f[6] = bflo(w.w); f[7] = bfhi(w.w); }
__device__ __forceinline__ u32x4 pack8(const float (&f)[8]) { u32x4 w; w.x = cvt_pk_bf16_c(f[0], f[1]); w.y = cvt_pk_bf16_c(f[2], f[3]); w.z = cvt_pk_bf16_c(f[4], f[5]); w.w = cvt_pk_bf16_c(f[6], f[7]); return w; }
#define DPP_MOV(x, ctrl) __builtin_bit_cast(float, __builtin_amdgcn_update_dpp(0, __builtin_bit_cast(int, (x)), (ctrl), 0xf, 0xf, true))
__device__ __forceinline__ void wkv_decay(const float (&sd)[8], float (&base)[8], int lane, float (&e)[8], float (&em1)[8], float (&einv)[8]) {
    const int jl = lane & 7;
#pragma unroll
    for (int i = 0; i < 8; ++i) { const float lw = -0.6065306597126334f * sd[i]; float x = lw;
        { const float t = DPP_MOV(x, 0x111); if (jl >= 1) x += t; } { const float t = DPP_MOV(x, 0x112); if (jl >= 2) x += t; } { const float t = DPP_MOV(x, 0x114); if (jl >= 4) x += t; }
        const float cs = base[i] + x; e[i] = fexp(cs); em1[i] = fexp(cs - lw); einv[i] = __builtin_amdgcn_rcpf(e[i]);
        base[i] += __shfl(x, lane | 7); }
}
__device__ __forceinline__ float sum_groups(float x) {
    x += DPP_MOV(x, 0x128);
    { auto r = __builtin_amdgcn_permlane16_swap(__float_as_uint(x), __float_as_uint(x), false, false); x = __uint_as_float(r[0]) + __uint_as_float(r[1]); }
    { auto r = __builtin_amdgcn_permlane32_swap(__float_as_uint(x), __float_as_uint(x), false, false); x = __uint_as_float(r[0]) + __uint_as_float(r[1]); }
    return x;
}
__device__ __forceinline__ bf16x8 frag(const LAS bf16_t* M, int pitch, int row0, int k0, int lane) { return *(const LAS bf16x8*)(M + (row0 + (lane & 15)) * pitch + k0 + 8 * (lane >> 4)); }

constexpr size_t WS_TOTG = WS_ACT + 724 * MiB;
constexpr size_t WS_BON = 25 * MiB;
constexpr size_t A_TBUF = 330 * MiB;
__device__ __forceinline__ void p15_tbuild(KAREF A, LAS unsigned char* lds, int gw, int ngw, int cp_lo, int cp_hi) {
    const int tid = threadIdx.x, lane = tid & 63, wave = tid >> 6;
    LAS unsigned char* wl = lds + wave * 16384;
    LAS bf16_t* AH = (LAS bf16_t*)wl; LAS bf16_t* BH = (LAS bf16_t*)(wl + 4096); LAS float* LL = (LAS float*)(wl + 8192);
    const bf16_t* Rr = (const bf16_t*)(A.ws + WS_ACT + A_RKV); const bf16_t* Kk = Rr + (size_t)TT * DM; bf16_t* TB = (bf16_t*)(A.ws + WS_ACT + A_TBUF);
    bf16_t* SDb = (bf16_t*)(A.ws + WS_ACT + A_SD); bf16_t* ADb = (bf16_t*)(A.ws + WS_ACT + A_AD); const bf16_t* LWA = (const bf16_t*)(A.ws + WS_LWA); const bf16_t* B2p = (const bf16_t*)(A.ws + WS_B2);
    const int jl = lane & 7, c8 = 8 * (lane >> 3), fr = lane & 15, fq = lane >> 4;
    static_assert(NCHUNK % 2 == 0, "pairs stay inside one chain");
    const int ncp = cp_hi - cp_lo, NQ = 128 * ncp;
#define TB_PAIR(q) (((q) / ncp) * (NCHUNK / 2) + cp_lo + (q) % ncp)
    u32x4 bw0[4];
    u32x4 gk[4], gr[4], lw[2][2], la[2][2];
#define TB_ROWLOAD(q, TASK) do { const int tk_ = (TASK); const int ch_ = tk_ / NCHUNK, cu_ = tk_ - ch_ * NCHUNK, d_ = ch_ & 1; \
        const size_t ro_ = (size_t)wkv_row(ch_ >> 5, d_, cu_ * CH + 8 * (q) + jl) * DM + ((ch_ >> 1) & 15) * 64 + c8, do_ = (size_t)d_ * TT * DM; \
        (void)do_; gk[q] = *(const u32x4*)(Kk + ro_); gr[q] = *(const u32x4*)(Rr + ro_); } while (0)
#define TB_BW0LOAD(TASK) do { const int tk_ = (TASK); const int ch_ = tk_ / NCHUNK, d_ = ch_ & 1, h_ = (ch_ >> 1) & 15; const bf16_t* br_ = B2p + (size_t)(d_ * 1024 + h_ * 64 + fr) * 256 + 64 * d_ + 8 * fq; \
        _Pragma("unroll") for (int ct = 0; ct < 4; ++ct) bw0[ct] = *(const u32x4*)(br_ + (size_t)(16 * ct) * 256); } while (0)
#define TB_LWALOAD(TASK) do { const int tk_ = (TASK); const int ch_ = tk_ / NCHUNK, cu_ = tk_ - ch_ * NCHUNK, d_ = ch_ & 1; \
        _Pragma("unroll") for (int rt_ = 0; rt_ < 2; ++rt_) { const bf16_t* lr_ = LWA + (size_t)wkv_row(ch_ >> 5, d_, cu_ * CH + 16 * rt_ + fr) * 256 + 64 * d_ + 8 * fq; \
            _Pragma("unroll") for (int ks_ = 0; ks_ < 2; ++ks_) { lw[rt_][ks_] = *(const u32x4*)(lr_ + 32 * ks_); la[rt_][ks_] = *(const u32x4*)(lr_ + 128 + 32 * ks_); } } } while (0)
    if (gw < NQ) { const int p0 = TB_PAIR(gw); TB_BW0LOAD(2 * p0); TB_LWALOAD(2 * p0); TB_ROWLOAD(0, 2 * p0); TB_ROWLOAD(1, 2 * p0); TB_ROWLOAD(2, 2 * p0); TB_ROWLOAD(3, 2 * p0); }
    for (int q = gw; q < NQ; q += ngw) {
        const int p = TB_PAIR(q); const int pn = (q + ngw < NQ) ? TB_PAIR(q + ngw) : p;
        const int chain = (2 * p) / NCHUNK, b = chain >> 5, h = (chain >> 1) & 15, d = chain & 1, hc = h * 64 + c8;
        float kkw[8]; { const f32x4 t0 = *(const f32x4*)(A.in[I1_KK] + hc), t1 = *(const f32x4*)(A.in[I1_KK] + hc + 4); kkw[0] = t0.x; kkw[1] = t0.y; kkw[2] = t0.z; kkw[3] = t0.w; kkw[4] = t1.x; kkw[5] = t1.y; kkw[6] = t1.z; kkw[7] = t1.w; }
        float kaw[8], rkw[8]; { const f32x4 t0 = *(const f32x4*)(A.in[I1_KA] + hc), t1 = *(const f32x4*)(A.in[I1_KA] + hc + 4), u0 = *(const f32x4*)(A.in[I1_RK] + hc), u1 = *(const f32x4*)(A.in[I1_RK] + hc + 4);
            kaw[0] = t0.x; kaw[1] = t0.y; kaw[2] = t0.z; kaw[3] = t0.w; kaw[4] = t1.x; kaw[5] = t1.y; kaw[6] = t1.z; kaw[7] = t1.w; rkw[0] = u0.x; rkw[1] = u0.y; rkw[2] = u0.z; rkw[3] = u0.w; rkw[4] = u1.x; rkw[5] = u1.y; rkw[6] = u1.z; rkw[7] = u1.w; }
#define TB_STEP(q, TASKN) do { float kf[8], sf[8], af[8], rf[8], e[8], em1[8], einv[8], ah[8], bh[8]; \
            const int cell_ = (8 * (q) + jl) * 64 + 8 * ((lane >> 3) ^ jl);                       \
            const u32x4 gsq = *(const LAS u32x4*)(AH + cell_), gaq = *(const LAS u32x4*)(BH + cell_);        \
            { const size_t ro_ = (size_t)d * TT * DM + (size_t)wkv_row(b, d, chunk * CH + 8 * (q) + jl) * DM + hc; *(u32x4*)(SDb + ro_) = gsq; *(u32x4*)(ADb + ro_) = gaq; } \
            unpack8(gk[q], kf); unpack8(gsq, sf); unpack8(gaq, af); unpack8(gr[q], rf); \
            asm volatile("" : "+v"(sf[0]), "+v"(sf[1]), "+v"(sf[2]), "+v"(sf[3]), "+v"(sf[4]), "+v"(sf[5]), "+v"(sf[6]), "+v"(sf[7])); \
            asm volatile("" : "+v"(kf[0]), "+v"(kf[1]), "+v"(kf[2]), "+v"(kf[3]), "+v"(kf[4]), "+v"(kf[5]), "+v"(kf[6]), "+v"(kf[7])); \
            asm volatile("" : "+v"(af[0]), "+v"(af[1]), "+v"(af[2]), "+v"(af[3]), "+v"(af[4]), "+v"(af[5]), "+v"(af[6]), "+v"(af[7])); \
            asm volatile("" : "+v"(rf[0]), "+v"(rf[1]), "+v"(rf[2]), "+v"(rf[3]), "+v"(rf[4]), "+v"(rf[5]), "+v"(rf[6]), "+v"(rf[7])); \
            TB_ROWLOAD(q, TASKN);                                         \
            wkv_decay(sf, base, lane, e, em1, einv); \
            if (lat) { float bq = 0.f; \
_Pragma("unroll") \
                for (int i = 0; i < 8; ++i) bq += rf[i] * kf[i] * ((af[i] - 1.0f) * kaw[i] + 1.0f) * rkw[i]; \
                bq = sum_groups(bq); \
                if ((lane >> 3) == 0) ((float*)(A.ws + WS_BON))[((size_t)d * TL + wkv_row(b, d, chunk * CH + 8 * (q) + jl)) * 16 + h] = bq; } \
            float ssq = 0.f; \
_Pragma("unroll") \
            for (int i = 0; i < 8; ++i) { kf[i] *= kkw[i]; ssq += kf[i] * kf[i]; } \
            const float rs = __builtin_amdgcn_rsqf(fmaxf(sum_groups(ssq), 1e-24f)); \
_Pragma("unroll") \
            for (int i = 0; i < 8; ++i) { const float kk = kf[i] * rs; ah[i] = -kk * em1[i]; bh[i] = kk * af[i] * einv[i]; } \
            *(LAS u32x4*)(AH + cell_) = pack8(ah); *(LAS u32x4*)(BH + cell_) = pack8(bh); \
            if ((q) < 3 && jl == 0) { float* tg = (float*)(A.ws + WS_TOTG) + ((size_t)task * 3 + (q)) * 64 + c8; *(f32x4*)tg = (f32x4){base[0], base[1], base[2], base[3]}; *(f32x4*)(tg + 4) = (f32x4){base[4], base[5], base[6], base[7]}; } } while (0)
#define TB_TASK(HALF, TASKN) do { const int task = 2 * p + (HALF), chunk = task - chain * NCHUNK; const bool lat = chunk >= CTXL / CH; const int taskn = (TASKN); \
            _Pragma("unroll") for (int mat = 0; mat < 2; ++mat) {     \
                const bf16_t* br_ = B2p + (size_t)((mat ? 2048 : 0) + d * 1024 + h * 64 + fr) * 256 + (mat ? 128 : 0) + 64 * d + 8 * fq; \
                u32x4 bfr[4][2]; \
                _Pragma("unroll") for (int ct = 0; ct < 4; ++ct) _Pragma("unroll") for (int ks = 0; ks < 2; ++ks) bfr[ct][ks] = (mat == 0 && ks == 0) ? bw0[ct] : *(const u32x4*)(br_ + (size_t)(16 * ct) * 256 + 32 * ks); \
                const float* bias_ = (mat ? A.in[I1_A0] : A.in[I1_W0]) + d * DM + h * 64 + 4 * fq; LAS bf16_t* buf_ = mat ? BH : AH; \
                _Pragma("unroll") for (int ct = 0; ct < 4; ++ct) { const f32x4 bv_ = *(const f32x4*)(bias_ + 16 * ct); \
                    _Pragma("unroll") for (int rt = 0; rt < 2; ++rt) { f32x4 acc_ = (f32x4){0.f, 0.f, 0.f, 0.f}; \
                        _Pragma("unroll") for (int ks = 0; ks < 2; ++ks) acc_ = MFMA16(__builtin_bit_cast(bf16x8, bfr[ct][ks]), __builtin_bit_cast(bf16x8, mat ? la[rt][ks] : lw[rt][ks]), acc_); \
                        acc_ = acc_ + bv_; u32x2 w_; w_.x = cvt_pk_bf16_c(sigm(acc_[0]), sigm(acc_[1])); w_.y = cvt_pk_bf16_c(sigm(acc_[2]), sigm(acc_[3])); \
                        *(LAS u32x2*)(buf_ + (16 * rt + fr) * 64 + 8 * ((2 * ct + (fq >> 1)) ^ (fr & 7)) + 4 * (fq & 1)) = w_; } } } \
            LDS_WAIT(); \
            TB_LWALOAD(taskn);                                            \
            float base[8]; \
_Pragma("unroll") \
            for (int i = 0; i < 8; ++i) base[i] = 0.f; \
            TB_STEP(0, taskn); TB_STEP(1, taskn); TB_STEP(2, taskn); TB_STEP(3, taskn); \
            TB_BW0LOAD(taskn); \
            LDS_WAIT(); \
            LAS float* LLh = LL + (HALF) * 1024; \
_Pragma("unroll") \
            for (int mt = 0; mt < 2; ++mt) \
_Pragma("unroll") \
                for (int nt = 0; nt < 2; ++nt) { f32x4 acc = (f32x4){0.f, 0.f, 0.f, 0.f}; \
_Pragma("unroll") \
                    for (int ks = 0; ks < 2; ++ks) acc = MFMA16(*(const LAS bf16x8*)(AH + (mt * 16 + fr) * 64 + 8 * ((4 * ks + fq) ^ (fr & 7))), *(const LAS bf16x8*)(BH + (nt * 16 + fr) * 64 + 8 * ((4 * ks + fq) ^ (fr & 7))), acc); \
_Pragma("unroll") \
                    for (int r = 0; r < 4; ++r) { const int j = mt * 16 + 4 * fq + r, m = nt * 16 + fr; LLh[j * 32 + m] = (m < j) ? acc[r] : 0.f; } } \
            LDS_WAIT(); } while (0)
        TB_TASK(0, 2 * p + 1);
        TB_TASK(1, 2 * pn);
#undef TB_TASK
#undef TB_STEP
        { const int c = lane & 31; const LAS float* Lm = LL + (lane >> 5) * 1024; float t[32];
#pragma unroll
          for (int i = 0; i < 32; ++i) { float s0 = (c == i) ? 1.f : 0.f, s1 = 0.f;
#pragma unroll
              for (int m4 = 0; m4 < (i + 3) / 4; ++m4) { const f32x4 l = *(const LAS f32x4*)(Lm + i * 32 + 4 * m4);
                  if (4 * m4 + 0 < i) s0 += l.x * t[4 * m4 + 0]; if (4 * m4 + 1 < i) s1 += l.y * t[4 * m4 + 1]; if (4 * m4 + 2 < i) s0 += l.z * t[4 * m4 + 2]; if (4 * m4 + 3 < i) s1 += l.w * t[4 * m4 + 3]; }
              t[i] = s0 + s1; }
          bf16_t* dst = TB + (size_t)(2 * p + (lane >> 5)) * 1024 + c;
#pragma unroll
          for (int i = 0; i < 32; ++i) dst[i * 32] = (bf16_t)(cvt_pk_bf16_c(t[i], 0.f) & 0xffffu); }
        LDS_WAIT();
    }
#undef TB_ROWLOAD
#undef TB_LWALOAD
#undef TB_BW0LOAD
#undef TB_PAIR
}
constexpr int R3_AH = 0, R3_RH = 4608, R3_T = 9216, R3_PV = 11776, R3_BYTES = 12032;
constexpr int R2_BH = 0, R2_KH = 4608, R2_VH = 9216, R2_BT = 13824, R2_KT = 18944, R2_VT = 24064, R2_LAK = 29184, R2_MRB = 31744, R2_MRK = 34304, R2_BYTES = 36864;
constexpr int R3_OFF = 0, R2_OFF = 3 * R3_BYTES, CHN_OFF = R2_OFF + 2 * R2_BYTES, CHN_BYTES = 4864, YS_OFF = RING_BYTES + 2048, YS_BYTES = 4608;
static_assert(CHN_OFF + 4 * CHN_BYTES <= RING_BYTES && YS_OFF + 2 * YS_BYTES <= LDS_BYTES, "chain LDS map");
__device__ __forceinline__ int wkv_perm(int x) { return (x & ~31) + 8 * ((x & 15) >> 2) + 4 * ((x & 31) >> 4) + (x & 3); }
constexpr int TB_CP_FIRST = 96;
constexpr int CHAIN_MID_IT = 2 * TB_CP_FIRST - 4;
__device__ __forceinline__ void p16_chain(KAREF A, LAS unsigned char* lds, int G, int variant, unsigned* handoff, const unsigned nhelp) {
    if (variant & 8) return;
    const int nch = (variant & 16) ? 16 : NCHUNK;
    const bool do_prep = !(variant & 2), do_state = !(variant & 1), do_store = (variant == 0);
    const int tid = threadIdx.x, lane = tid & 63, wave = __builtin_amdgcn_readfirstlane(tid >> 6), fr = lane & 15, fq = lane >> 4;
    const bf16_t* R = (const bf16_t*)(A.ws + WS_ACT + A_RKV); const bf16_t* Kk = R + (size_t)TT * DM; const bf16_t* V = Kk + (size_t)TT * DM; const bf16_t* TB = (const bf16_t*)(A.ws + WS_ACT + A_TBUF);
#define R3P(c) (lds + R3_OFF + ((c) % 3) * R3_BYTES)
#define R2P(c) (lds + R2_OFF + ((c) & 1) * R2_BYTES)
    for (int chain = blockIdx.x; chain < 128; chain += G) {
        const int b = chain >> 5, h = (chain >> 1) & 15, d = chain & 1;
        const bf16_t* SD = (const bf16_t*)(A.ws + WS_ACT + A_SD) + (size_t)d * TT * DM; const bf16_t* AD = (const bf16_t*)(A.ws + WS_ACT + A_AD) + (size_t)d * TT * DM;
        bf16_t* YD = (bf16_t*)(A.ws + WS_ACT + (d ? A_YD1 : A_YD0));
        __syncthreads();
        if (wave >= 4) {
            const int pw = wave - 4, jl = lane & 7, c8 = 8 * (lane >> 3), hc = h * 64 + c8, ptid = pw * 64 + lane;
            const int pc0 = wkv_perm(c8);
#define WR_PERM(BASE, ROW, V) do { const u32x4 v_ = (V); LAS bf16_t* p_ = (LAS bf16_t*)(BASE) + (ROW) * 72 + pc0; *(LAS u32x2*)p_ = (u32x2){v_.x, v_.y}; *(LAS u32x2*)(p_ + 8) = (u32x2){v_.z, v_.w}; } while (0)
            float kkw[8], kaw[8];
            { const f32x4 t0 = *(const f32x4*)(A.in[I1_KK] + hc), t1 = *(const f32x4*)(A.in[I1_KK] + hc + 4), u0 = *(const f32x4*)(A.in[I1_KA] + hc), u1 = *(const f32x4*)(A.in[I1_KA] + hc + 4);
              kkw[0] = t0.x; kkw[1] = t0.y; kkw[2] = t0.z; kkw[3] = t0.w; kkw[4] = t1.x; kkw[5] = t1.y; kkw[6] = t1.z; kkw[7] = t1.w; kaw[0] = u0.x; kaw[1] = u0.y; kaw[2] = u0.z; kaw[3] = u0.w; kaw[4] = u1.x; kaw[5] = u1.y; kaw[6] = u1.z; kaw[7] = u1.w; }
            struct PrepRegs { u32x4 gr, gk, gv, gs, ga; f32x4 gb0, gb1; u32x2 gt; } SA, SB;
#define PREP_LOAD(S, cn) do { const size_t ro = (size_t)wkv_row(b, d, (cn) * CH + 8 * pw + jl) * DM + hc; S.gr = *(const u32x4*)(R + ro); S.gk = *(const u32x4*)(Kk + ro); S.gv = *(const u32x4*)(V + ro); S.gs = *(const u32x4*)(SD + ro); S.ga = *(const u32x4*)(AD + ro); \
            { const float* tg = (const float*)(A.ws + WS_TOTG) + (((size_t)chain * NCHUNK + (cn)) * 3 + (pw > 0 ? pw - 1 : 0)) * 64 + c8; S.gb0 = *(const f32x4*)tg; S.gb1 = *(const f32x4*)(tg + 4); } \
            S.gt = *(const u32x2*)(TB + ((size_t)chain * NCHUNK + (cn)) * 1024 + 4 * ptid); } while (0)
            PREP_LOAD(SA, 0); PREP_LOAD(SB, 1);
#define PREP_ITER(IT, S) do { const int it = (IT); const int c1 = it + 1, c2 = it + 2; \
                if (it == CHAIN_MID_IT && nhelp) { if (lane == 0) { unsigned sp_ = 0; while (xb_ld(handoff) < nhelp) { __builtin_amdgcn_s_sleep(2); if (++sp_ > (1u << 22)) break; } } __builtin_amdgcn_fence(__ATOMIC_ACQUIRE, "agent"); } \
                if (c1 >= 0 && c1 < NCHUNK && do_prep) {                        \
                    LAS unsigned char* o3 = R3P(c1); LAS unsigned char* o2 = R2P(c1); \
                    const LAS bf16_t* AH = (const LAS bf16_t*)(o3 + R3_AH); const LAS bf16_t* RH = (const LAS bf16_t*)(o3 + R3_RH); const LAS bf16_t* BH = (const LAS bf16_t*)(o2 + R2_BH); const LAS bf16_t* KH = (const LAS bf16_t*)(o2 + R2_KH); \
                    const int mt = pw >> 1, nt = pw & 1; \
                    f32x4 a0 = (f32x4){0.f, 0.f, 0.f, 0.f}, a1 = a0;     \
_Pragma("unroll") \
                    for (int ks = 0; ks < 2; ++ks) { const bf16x8 fa = frag(AH, 72, mt * 16, ks * 32, lane), fr_ = frag(RH, 72, mt * 16, ks * 32, lane), fb = frag(BH, 72, nt * 16, ks * 32, lane), fk = frag(KH, 72, nt * 16, ks * 32, lane); \
                        a0 = MFMA16(fa, fk, a0); a1 = MFMA16(fr_, fb, a1); } \
_Pragma("unroll") \
                    for (int r = 0; r < 4; ++r) { const int j = mt * 16 + 4 * fq + r, m = nt * 16 + fr; \
                        ((LAS bf16_t*)(o2 + R2_LAK))[j * 40 + m] = (bf16_t)(cvt_pk_bf16_c((m < j) ? a0[r] : 0.f, 0.f) & 0xffffu); \
                        ((LAS bf16_t*)(o2 + R2_MRB))[j * 40 + wkv_perm(m)] = (bf16_t)(cvt_pk_bf16_c((m <= j) ? a1[r] : 0.f, 0.f) & 0xffffu); \
                        } \
                } \
                if (c2 < NCHUNK && do_prep) {                                   \
                    LAS unsigned char* o3 = R3P(c2); LAS unsigned char* o2 = R2P(c2); \
                    float rf[8], kf[8], sf[8], af[8], base[8], e[8], em1[8], einv[8], o1[8], o2v[8]; \
_Pragma("unroll") \
                    for (int i = 0; i < 8; ++i) base[i] = 0.f; \
                    if (pw > 0) { base[0] = S.gb0.x; base[1] = S.gb0.y; base[2] = S.gb0.z; base[3] = S.gb0.w; base[4] = S.gb1.x; base[5] = S.gb1.y; base[6] = S.gb1.z; base[7] = S.gb1.w; } \
                    unpack8(S.gs, sf); unpack8(S.gk, kf); unpack8(S.ga, af); unpack8(S.gr, rf); \
                    *(LAS u32x4*)((LAS bf16_t*)(o2 + R2_VH) + (8 * pw + jl) * 72 + c8) = S.gv; \
                    *(LAS u32x2*)((LAS bf16_t*)(o3 + R3_T) + (ptid >> 3) * 40 + 8 * (ptid & 3) + 4 * ((ptid & 7) >> 2)) = S.gt; \
                    asm volatile("" : "+v"(sf[0]), "+v"(sf[1]), "+v"(sf[2]), "+v"(sf[3]), "+v"(sf[4]), "+v"(sf[5]), "+v"(sf[6]), "+v"(sf[7])); \
                    asm volatile("" : "+v"(kf[0]), "+v"(kf[1]), "+v"(kf[2]), "+v"(kf[3]), "+v"(kf[4]), "+v"(kf[5]), "+v"(kf[6]), "+v"(kf[7])); \
                    asm volatile("" : "+v"(af[0]), "+v"(af[1]), "+v"(af[2]), "+v"(af[3]), "+v"(af[4]), "+v"(af[5]), "+v"(af[6]), "+v"(af[7])); \
                    asm volatile("" : "+v"(rf[0]), "+v"(rf[1]), "+v"(rf[2]), "+v"(rf[3]), "+v"(rf[4]), "+v"(rf[5]), "+v"(rf[6]), "+v"(rf[7])); \
                    PREP_LOAD(S, (c2 + 2 < NCHUNK ? c2 + 2 : NCHUNK - 1)); \
                    wkv_decay(sf, base, lane, e, em1, einv); \
                    float ssq = 0.f; \
_Pragma("unroll") \
                    for (int i = 0; i < 8; ++i) { const float kv = kf[i] * kkw[i]; ssq += kv * kv; } \
                    const float rs = __builtin_amdgcn_rsqf(fmaxf(sum_groups(ssq), 1e-24f)); const int j = 8 * pw + jl; \
_Pragma("unroll") \
                    for (int i = 0; i < 8; ++i) { const float kk = kf[i] * kkw[i] * rs; o1[i] = -kk * em1[i]; o2v[i] = kk * af[i] * einv[i]; } \
                    WR_PERM(o3 + R3_AH, j, pack8(o1)); WR_PERM(o2 + R2_BH, j, pack8(o2v)); \
_Pragma("unroll") \
                    for (int i = 0; i < 8; ++i) { o1[i] = kf[i] * ((af[i] - 1.0f) * kaw[i] + 1.0f) * einv[i]; o2v[i] = rf[i] * e[i]; } \
                    WR_PERM(o2 + R2_KH, j, pack8(o1)); WR_PERM(o3 + R3_RH, j, pack8(o2v)); \
                    if (j == 31) { *(LAS f32x4*)((LAS float*)(o3 + R3_PV) + c8) = (f32x4){e[0], e[1], e[2], e[3]}; *(LAS f32x4*)((LAS float*)(o3 + R3_PV) + c8 + 4) = (f32x4){e[4], e[5], e[6], e[7]}; } \
                } \
                LDS_WAIT(); __builtin_amdgcn_s_barrier(); asm volatile("" ::: "memory"); \
            } while (0)
            {
#pragma unroll 1
              for (int it2 = -2; it2 + 1 < nch; it2 += 2) { PREP_ITER(it2, SA); PREP_ITER(it2 + 1, SB); } }
#undef PREP_ITER
#undef PREP_LOAD
#undef WR_PERM
        } else {
#define Y_FLUSH(chunk) do { if ((chunk) >= CTXL / CH && do_store) { const LAS bf16_t* YSf = (const LAS bf16_t*)(lds + YS_OFF + ((chunk) & 1) * YS_BYTES); const int st = wave * 64 + lane, row = st >> 3, cch = st & 7; const u32x4 yv = *(const LAS u32x4*)(YSf + row * 72 + 8 * cch); \
                *(u32x4*)(YD + (size_t)wkv_row(b, d, (chunk) * CH + row) * DM + h * 64 + 8 * cch) = yv; } } while (0)
            f32x4 X[4];
#pragma unroll
            for (int mt = 0; mt < 4; ++mt) X[mt] = (f32x4){0.f, 0.f, 0.f, 0.f};
#pragma unroll 1
            for (int it = -2; it < nch; ++it) {
                if (it >= 1) Y_FLUSH(it - 1);
                if (it >= 0 && do_state) {
                    const LAS unsigned char* o3 = R3P(it); const LAS unsigned char* o2 = R2P(it); LAS bf16_t* YS = (LAS bf16_t*)(lds + YS_OFF + (it & 1) * YS_BYTES);
                    const LAS bf16_t* AH = (const LAS bf16_t*)(o3 + R3_AH); const LAS bf16_t* LAK = (const LAS bf16_t*)(o2 + R2_LAK); const LAS bf16_t* TT_ = (const LAS bf16_t*)(o3 + R3_T); const LAS bf16_t* VT = (const LAS bf16_t*)(o2 + R2_VT);
                    const LAS bf16_t* RH = (const LAS bf16_t*)(o3 + R3_RH); const LAS bf16_t* MRB = (const LAS bf16_t*)(o2 + R2_MRB); const LAS bf16_t* MRK = (const LAS bf16_t*)(o2 + R2_MRK);
                    const LAS bf16_t* BT = (const LAS bf16_t*)(o2 + R2_BT); const LAS bf16_t* KT = (const LAS bf16_t*)(o2 + R2_KT); const LAS float* PV = (const LAS float*)(o3 + R3_PV);
#define ACC2OP(DST, A0, A1) do { u32x4 w_; w_.x = cvt_pk_bf16_c(A0[0], A0[1]); w_.y = cvt_pk_bf16_c(A0[2], A0[3]); w_.z = cvt_pk_bf16_c(A1[0], A1[1]); w_.w = cvt_pk_bf16_c(A1[2], A1[3]); DST = __builtin_bit_cast(bf16x8, w_); } while (0)
                    bf16x8 x0, x1, zt, ut; ACC2OP(x0, X[0], X[1]); ACC2OP(x1, X[2], X[3]);
                    const bf16x8 vt = frag(VT, 40, 16 * wave, 0, lane);
                    f32x4 Z0 = (f32x4){0.f, 0.f, 0.f, 0.f}, Z1 = Z0;
                    Z0 = MFMA16(frag(AH, 72, 0, 0, lane), x0, Z0); Z0 = MFMA16(frag(AH, 72, 0, 32, lane), x1, Z0); Z0 = MFMA16(frag(LAK, 40, 0, 0, lane), vt, Z0);
                    Z1 = MFMA16(frag(AH, 72, 16, 0, lane), x0, Z1); Z1 = MFMA16(frag(AH, 72, 16, 32, lane), x1, Z1); Z1 = MFMA16(frag(LAK, 40, 16, 0, lane), vt, Z1);
                    ACC2OP(zt, Z0, Z1);
                    const f32x4 zero4 = (f32x4){0.f, 0.f, 0.f, 0.f}; const f32x4 U0 = MFMA16(frag(TT_, 40, 0, 0, lane), zt, zero4), U1 = MFMA16(frag(TT_, 40, 16, 0, lane), zt, zero4);
                    ACC2OP(ut, U0, U1);
#undef ACC2OP
                    if (it >= CTXL / CH && do_store) {
#pragma unroll
                        for (int mt = 0; mt < 2; ++mt) { f32x4 Y = (f32x4){0.f, 0.f, 0.f, 0.f};
                            Y = MFMA16(frag(RH, 72, mt * 16, 0, lane), x0, Y); Y = MFMA16(frag(RH, 72, mt * 16, 32, lane), x1, Y); Y = MFMA16(frag(MRB, 40, mt * 16, 0, lane), ut, Y); Y = MFMA16(frag(MRK, 40, mt * 16, 0, lane), vt, Y);
#pragma unroll
                            for (int r = 0; r < 4; ++r) YS[(mt * 16 + 4 * fq + r) * 72 + 16 * wave + fr] = (bf16_t)(cvt_pk_bf16_c(Y[r], 0.f) & 0xffffu); } }
#pragma unroll
                    for (int mt = 0; mt < 4; ++mt) { X[mt] = MFMA16(frag(BT, 40, mt * 16, 0, lane), ut, X[mt]); X[mt] = MFMA16(frag(KT, 40, mt * 16, 0, lane), vt, X[mt]);
                        const f32x4 p = *(const LAS f32x4*)(PV + mt * 16 + 4 * fq); X[mt] = X[mt] * p; }
                }
                if (it + 1 >= 0 && it + 1 < NCHUNK) {
                    const LAS unsigned char* o3n = R3P(it + 1); LAS unsigned char* o2n = R2P(it + 1);
                    const LAS bf16_t* RHn = (const LAS bf16_t*)(o3n + R3_RH); const LAS bf16_t* KHg = (const LAS bf16_t*)(o2n + R2_KH);
                    const int gmt = wave >> 1, gnt = wave & 1; f32x4 a2 = (f32x4){0.f, 0.f, 0.f, 0.f};
#pragma unroll
                    for (int ks = 0; ks < 2; ++ks) a2 = MFMA16(frag(RHn, 72, gmt * 16, ks * 32, lane), frag(KHg, 72, gnt * 16, ks * 32, lane), a2);
#pragma unroll
                    for (int r = 0; r < 4; ++r) { const int j = gmt * 16 + 4 * fq + r, m = gnt * 16 + fr;
                        ((LAS bf16_t*)(o2n + R2_MRK))[j * 40 + m] = (bf16_t)(cvt_pk_bf16_c((m <= j) ? a2[r] : 0.f, 0.f) & 0xffffu); } }
                if (it + 1 >= 0 && it + 1 < NCHUNK) {
                    LAS unsigned char* opn = R2P(it + 1);
                    const LAS bf16_t* BHn = (const LAS bf16_t*)(opn + R2_BH); const LAS bf16_t* KHn = (const LAS bf16_t*)(opn + R2_KH); const LAS bf16_t* VHn = (const LAS bf16_t*)(opn + R2_VH);
                    u32x4 tb, tk, tv; unsigned short eb[8], ek[8], ev[8];
#pragma unroll
                    for (int i = 0; i < 8; ++i) { eb[i] = BHn[(8 * wave + i) * 72 + wkv_perm(lane)]; ek[i] = KHn[(8 * wave + i) * 72 + wkv_perm(lane)]; ev[i] = VHn[(8 * wave + i) * 72 + lane]; }
                    tb.x = eb[0] | ((unsigned)eb[1] << 16); tb.y = eb[2] | ((unsigned)eb[3] << 16); tb.z = eb[4] | ((unsigned)eb[5] << 16); tb.w = eb[6] | ((unsigned)eb[7] << 16);
                    tk.x = ek[0] | ((unsigned)ek[1] << 16); tk.y = ek[2] | ((unsigned)ek[3] << 16); tk.z = ek[4] | ((unsigned)ek[5] << 16); tk.w = ek[6] | ((unsigned)ek[7] << 16);
                    tv.x = ev[0] | ((unsigned)ev[1] << 16); tv.y = ev[2] | ((unsigned)ev[3] << 16); tv.z = ev[4] | ((unsigned)ev[5] << 16); tv.w = ev[6] | ((unsigned)ev[7] << 16);
                    { LAS bf16_t* bt_ = (LAS bf16_t*)(opn + R2_BT) + lane * 40 + 16 * (wave & 1) + 4 * (wave >> 1); *(LAS u32x2*)bt_ = (u32x2){tb.x, tb.y}; *(LAS u32x2*)(bt_ + 8) = (u32x2){tb.z, tb.w}; } *(LAS u32x4*)((LAS bf16_t*)(opn + R2_KT) + lane * 40 + 8 * wave) = tk; *(LAS u32x4*)((LAS bf16_t*)(opn + R2_VT) + lane * 40 + 8 * wave) = tv; }
                LDS_WAIT(); __builtin_amdgcn_s_barrier(); asm volatile("" ::: "memory");
            }
            Y_FLUSH(NCHUNK - 1);
#undef Y_FLUSH
        }
    }
#undef R3P
#undef R2P
}

__device__ __forceinline__ void p16_readout(KAREF A, int G) {
    const int lane = threadIdx.x & 63, wave = threadIdx.x >> 6, gw = blockIdx.x * 8 + wave, ngw = G * 8;
    const bf16_t* V = (const bf16_t*)(A.ws + WS_ACT + A_RKV) + 2 * (size_t)TT * DM; const bf16_t* Gg = (const bf16_t*)(A.ws + WS_ACT + A_G);
    const bf16_t* Y0 = (const bf16_t*)(A.ws + WS_ACT + A_YD0); const bf16_t* Y1 = (const bf16_t*)(A.ws + WS_ACT + A_YD1); bf16_t* O = (bf16_t*)(A.ws + WS_ACT + A_O);
    const float* BON = (const float*)(A.ws + WS_BON);
    const int c0 = 16 * lane;
    float gng[16], gnb[16];
#pragma unroll
    for (int i = 0; i < 16; ++i) { gng[i] = A.in[I1_GNG][c0 + i]; gnb[i] = A.in[I1_GNB][c0 + i]; }
    u32x4 nq[8]; float nb0, nb1;
#define RO_LOAD(M) do { const size_t o_ = (size_t)(M) * DM + c0; nq[0] = *(const u32x4*)(Y0 + o_); nq[1] = *(const u32x4*)(Y0 + o_ + 8); nq[2] = *(const u32x4*)(Y1 + o_); nq[3] = *(const u32x4*)(Y1 + o_ + 8); \
        nq[4] = *(const u32x4*)(V + o_); nq[5] = *(const u32x4*)(V + o_ + 8); nq[6] = *(const u32x4*)(Gg + o_); nq[7] = *(const u32x4*)(Gg + o_ + 8); \
        nb0 = BON[(size_t)(M) * 16 + (lane >> 2)]; nb1 = BON[((size_t)TL + (M)) * 16 + (lane >> 2)]; } while (0)
    RO_LOAD(gw < TL ? gw : 0);
    for (int m = gw; m < TL; m += ngw) {
        const size_t o = (size_t)m * DM + c0;
        float y[16], rr[16], vv[16], gg[16];
#define UP16(dst, w0, w1) do { dst[0] = bflo(w0.x); dst[1] = bfhi(w0.x); dst[2] = bflo(w0.y); dst[3] = bfhi(w0.y); dst[4] = bflo(w0.z); dst[5] = bfhi(w0.z); dst[6] = bflo(w0.w); dst[7] = bfhi(w0.w); \
        dst[8] = bflo(w1.x); dst[9] = bfhi(w1.x); dst[10] = bflo(w1.y); dst[11] = bfhi(w1.y); dst[12] = bflo(w1.z); dst[13] = bfhi(w1.z); dst[14] = bflo(w1.w); dst[15] = bfhi(w1.w); } while (0)
        UP16(y, nq[0], nq[1]); UP16(rr, nq[2], nq[3]); UP16(vv, nq[4], nq[5]); UP16(gg, nq[6], nq[7]);
#undef UP16
        const float bs = nb0 + nb1;
        { const int mn = m + ngw < TL ? m + ngw : m; RO_LOAD(mn); }
        float s = 0.f;
#pragma unroll
        for (int i = 0; i < 16; ++i) { y[i] += rr[i]; s += y[i]; }
        s += __shfl_xor(s, 1); s += __shfl_xor(s, 2);
        const float mean = s * (1.f / 64.f); float q = 0.f;
#pragma unroll
        for (int i = 0; i < 16; ++i) { const float dlt = y[i] - mean; q += dlt * dlt; }
        q += __shfl_xor(q, 1); q += __shfl_xor(q, 2);
        const float rstd = __builtin_amdgcn_rsqf(q * (1.f / 64.f) + 64e-5f);
        unsigned w[8];
#pragma unroll
        for (int i = 0; i < 8; ++i) { const float o0 = ((y[2 * i] - mean) * rstd * gng[2 * i] + gnb[2 * i] + bs * vv[2 * i]) * gg[2 * i], o1 = ((y[2 * i + 1] - mean) * rstd * gng[2 * i + 1] + gnb[2 * i + 1] + bs * vv[2 * i + 1]) * gg[2 * i + 1];
            w[i] = cvt_pk_bf16(o0, o1); }
        *(u32x4*)(O + o) = (u32x4){w[0], w[1], w[2], w[3]}; *(u32x4*)(O + o + 8) = (u32x4){w[4], w[5], w[6], w[7]};
    }
#undef RO_LOAD
}
#if defined(DBG_WKV)
__device__ __forceinline__ float rowsum16(float x) { x = DPP_ADD(x, 0xB1); x = DPP_ADD(x, 0x4E); x = DPP_ADD(x, 0x141); x = DPP_ADD(x, 0x140); return x; }
constexpr int WKV_TB = 32, WKV_STEP_F = 6 * 64, WKV_BUF_F = WKV_TB * WKV_STEP_F;
__device__ __forceinline__ void p15_wkv_old(KAREF A, LAS unsigned char* lds, int G) {
    const int tid = threadIdx.x, lane = tid & 63, wid = tid >> 6;
    LAS float* BUF = (LAS float*)lds;
    LAS float* YB = (LAS float*)(lds + 2 * WKV_BUF_F * 4);
    const bf16_t* R = (const bf16_t*)(A.ws + WS_ACT + A_RKV); const bf16_t* Kk = R + (size_t)TT * DM; const bf16_t* V = Kk + (size_t)TT * DM;
    for (int u = blockIdx.x; u < 256; u += G) {
        const int chain = u >> 1, half = u & 1, b = chain >> 5, h = (chain >> 1) & 15, d = chain & 1;
        const bf16_t* SD = (const bf16_t*)(A.ws + WS_ACT + A_SD) + (size_t)d * TT * DM; const bf16_t* AD = (const bf16_t*)(A.ws + WS_ACT + A_AD) + (size_t)d * TT * DM;
        bf16_t* YD = (bf16_t*)(A.ws + WS_MOEW1) + (size_t)d * TL * DM;
        const int ls = tid >> 4, lc = 4 * (tid & 15), hc = h * 64 + lc;
        const f32x4 kkw = *(const f32x4*)(A.in[I1_KK] + hc), kaw = *(const f32x4*)(A.in[I1_KA] + hc);
        u32x2 gr, gk, gv, gs, ga;
#define WKV_LOAD(blk) do { const size_t ro = (size_t)wkv_row(b, d, (blk) * WKV_TB + ls) * DM + hc; gr = *(const u32x2*)(R + ro); gk = *(const u32x2*)(Kk + ro); gv = *(const u32x2*)(V + ro); gs = *(const u32x2*)(SD + ro); ga = *(const u32x2*)(AD + ro); } while (0)
#define WKV_STORE(bufi) do { LAS float* dst = BUF + (bufi) * WKV_BUF_F + ls * WKV_STEP_F + lc; \
        const f32x4 kf = (f32x4){bflo(gk.x), bfhi(gk.x), bflo(gk.y), bfhi(gk.y)}, af = (f32x4){bflo(ga.x), bfhi(ga.x), bflo(ga.y), bfhi(ga.y)}, sf = (f32x4){bflo(gs.x), bfhi(gs.x), bflo(gs.y), bfhi(gs.y)}; \
        const f32x4 kkv = kf * kkw; float ssq = (kkv.x * kkv.x + kkv.y * kkv.y) + (kkv.z * kkv.z + kkv.w * kkv.w); ssq = rowsum16(ssq); \
        const f32x4 kkn = kkv * __builtin_amdgcn_rsqf(fmaxf(ssq, 1e-24f)); \
        f32x4 wd; wd.x = fexp(-0.6065306597126334f * sf.x); wd.y = fexp(-0.6065306597126334f * sf.y); wd.z = fexp(-0.6065306597126334f * sf.z); wd.w = fexp(-0.6065306597126334f * sf.w); \
        *(LAS f32x4*)(dst) = wd; *(LAS f32x4*)(dst + 64) = -kkn; *(LAS f32x4*)(dst + 128) = kkn * af; *(LAS f32x4*)(dst + 192) = kf * ((af - 1.0f) * kaw + 1.0f); \
        *(LAS f32x4*)(dst + 256) = (f32x4){bflo(gr.x), bfhi(gr.x), bflo(gr.y), bfhi(gr.y)}; *(LAS f32x4*)(dst + 320) = (f32x4){bflo(gv.x), bfhi(gv.x), bflo(gv.y), bfhi(gv.y)}; } while (0)
        __syncthreads();
        WKV_LOAD(0); WKV_STORE(0);
        __syncthreads();
        const int g = lane >> 4, j = lane & 15, vrow = 32 * half + 4 * wid + g;
        float S0 = 0.f, S1 = 0.f, S2 = 0.f, S3 = 0.f;
        constexpr int NBLK = (CTXL + SEQ) / WKV_TB;
#pragma unroll 1
        for (int blk = 0; blk < NBLK; ++blk) {
            const int cur = blk & 1;
            if (blk + 1 < NBLK) WKV_LOAD(blk + 1);
            const LAS float* bp = BUF + cur * WKV_BUF_F + 4 * j;
#pragma unroll 1
            for (int t8 = 0; t8 < WKV_TB; t8 += 8) {
                float yv[8];
#pragma unroll
                for (int tt = 0; tt < 8; ++tt) {
                    const LAS float* sp = bp + (t8 + tt) * WKV_STEP_F;
                    const f32x4 w4 = *(const LAS f32x4*)(sp), a4 = *(const LAS f32x4*)(sp + 64), b4 = *(const LAS f32x4*)(sp + 128), k4 = *(const LAS f32x4*)(sp + 192), r4 = *(const LAS f32x4*)(sp + 256);
                    const float v1 = BUF[cur * WKV_BUF_F + (t8 + tt) * WKV_STEP_F + 320 + vrow];
                    float sa = (S0 * a4.x + S1 * a4.y) + (S2 * a4.z + S3 * a4.w);
                    const float t0 = S0 * w4.x + v1 * k4.x, t1 = S1 * w4.y + v1 * k4.y, t2 = S2 * w4.z + v1 * k4.z, t3 = S3 * w4.w + v1 * k4.w;
                    sa = rowsum16(sa);
                    S0 = sa * b4.x + t0; S1 = sa * b4.y + t1; S2 = sa * b4.z + t2; S3 = sa * b4.w + t3;
                    yv[tt] = (S0 * r4.x + S1 * r4.y) + (S2 * r4.z + S3 * r4.w);
                }
#pragma unroll
                for (int tt = 0; tt < 8; ++tt) { const float y = rowsum16(yv[tt]); if (j == 0) YB[(t8 + tt) * 32 + 4 * wid + g] = y; }
            }
            __syncthreads();
            if (blk * WKV_TB >= CTXL) {
                const int m = wkv_row(b, d, blk * WKV_TB + ls); const int r2 = 2 * (tid & 15);
                *(unsigned*)(YD + (size_t)m * DM + h * 64 + 32 * half + r2) = cvt_pk_bf16(YB[ls * 32 + r2], YB[ls * 32 + r2 + 1]); }
            if (blk + 1 < NBLK) WKV_STORE(cur ^ 1);
            __syncthreads();
        }
#undef WKV_LOAD
#undef WKV_STORE
    }
}

#endif
constexpr int N_PHASES = 25;
__global__ void __launch_bounds__(512, 2) fwd_kernel(KArgs A_unused) {
    const __attribute__((address_space(4))) KArgs* kp = (const __attribute__((address_space(4))) KArgs*)__builtin_amdgcn_kernarg_segment_ptr();
    extern __shared__ __attribute__((aligned(16))) unsigned char lds_raw[];
    LAS unsigned char* lds = (LAS unsigned char*)lds_raw;
    const int G = gridDim.x, tid = threadIdx.x;
    for (int u = tid; u < (LDS_BYTES - LDSCTL_OFF) / 4; u += 512) ((LAS unsigned*)(lds + LDSCTL_OFF))[u] = 0u;
    __syncthreads();
    const int lo = kp->ph_lo, hi = kp->ph_hi;
    const bool use_bar = (hi - lo) > 1;
    XcdBarrier bar; bar.bar = (unsigned*)(kp->ws + WS_CTL) + 4096; bar.x = 0; bar.st = (volatile LAS unsigned*)(lds + MISC_OFF) + 8;
    if (use_bar) bar = xcd_barrier_post((unsigned*)(kp->ws + WS_CTL) + 4096, (volatile LAS unsigned*)(lds + MISC_OFF) + 8);
#ifndef ONLY_PHASE
#define ONLY_PHASE -1
#endif
#ifndef DBG_STOP
#define DBG_STOP 99
#endif
#define IN(k) ((ONLY_PHASE < 0 || ONLY_PHASE == (k)) && (k) < DBG_STOP && lo <= (k) && (k) < hi)
#ifndef DBG_REP
#define DBG_REP -1
#endif
#ifndef DBG_VAR
#define DBG_VAR 0
#endif
#ifndef DBG_REPN
#define DBG_REPN 2
#endif
#define REPEAT(k) for (int rep_ = 0; rep_ < ((k) == DBG_REP ? DBG_REPN : 1); ++rep_)
#if defined(DBG_TIME)
#define TSTAMP(k) do { if (blockIdx.x == 0 && tid == 0 && ((k) == DBG_TIME || (k) == DBG_TIME + 1)) ((unsigned long long*)(kp->ws + WS_CTL))[1100 + ((k) - DBG_TIME)] = wall_clock64(); } while (0)
#else
#define TSTAMP(k) do {} while (0)
#endif
#define SEAM(k) do { if (IN(k) && IN((k) + 1)) xcd_barrier(bar); } while (0)

    if (IN(0)) REPEAT(0) { TSTAMP(0); __syncthreads(); KAREF A = *ka_launder(kp); unsigned char* ws = A.ws; unsigned char* act = ws + WS_ACT; (void)act; p0_prologue(A, lds, G); } SEAM(0);
    if (IN(1)) REPEAT(1) { TSTAMP(1); __syncthreads(); KAREF A = *ka_launder(kp); unsigned char* ws = A.ws; unsigned char* act = ws + WS_ACT; (void)act; p1_norm0(A, G); } SEAM(1);
    if (IN(2)) REPEAT(2) { TSTAMP(2); __syncthreads(); KAREF A = *ka_launder(kp); unsigned char* ws = A.ws; unsigned char* act = ws + WS_ACT; (void)act;
        pg8::Gemm g{(const bf16_t*)(act + A_H), (const bf16_t*)(ws + WS_WIN), DM}; pg8::StaticOrder S; S.init(TT, 1792, G, (int)blockIdx.x);
        EpiWin E{(bf16_t*)(act + A_XA), (bf16_t*)(act + A_GA), (float*)(act + A_QR), (float*)(act + A_KR), (bf16_t*)(act + A_VB)};
        pg8::gemm_phase<EpiWin, pg8::StaticOrder, true, true>(lds + RING_OFF, g, S, E);
    } SEAM(2);
    if (IN(3)) REPEAT(3) { TSTAMP(3); __syncthreads(); KAREF A = *ka_launder(kp); unsigned char* ws = A.ws; unsigned char* act = ws + WS_ACT; (void)act; p3_kprep(A, G); p3_lru_pass1(A, lds, G); } SEAM(3);
    if (IN(4)) REPEAT(4) { TSTAMP(4); __syncthreads(); KAREF A = *ka_launder(kp); unsigned char* ws = A.ws; unsigned char* act = ws + WS_ACT; (void)act; p4_lru_pass2(A, lds, G); __syncthreads(); p4_attention(A, (char*)lds_raw + RING_OFF, G); } SEAM(4);
    if (IN(5)) REPEAT(5) { TSTAMP(5); __syncthreads(); KAREF A = *ka_launder(kp); unsigned char* ws = A.ws; unsigned char* act = ws + WS_ACT; (void)act;
        pg8::Gemm g{(const bf16_t*)(act + A_YCAT), (const bf16_t*)(ws + WS_WOUT), DM}; pg8::StaticOrder S; S.init(TL, DM, G, (int)blockIdx.x);
        EpiResid E{A.in[I_X], A.in[I_CTX], A.out, (float*)(ws + WS_CTXS), ada_ptr(ws, 0, 0, 2)};
        pg8::gemm_phase<EpiResid, pg8::StaticOrder, true, true>(lds + RING_OFF, g, S, E);
        p5_ctx_outproj(A, G);
    } SEAM(5);
    if (IN(6)) REPEAT(6) { TSTAMP(6); __syncthreads(); KAREF A = *ka_launder(kp); unsigned char* ws = A.ws; unsigned char* act = ws + WS_ACT; (void)act; p6_norm_router(A, lds, G, 0, TT); } SEAM(6);
    if (IN(7)) REPEAT(7) { TSTAMP(7); __syncthreads(); KAREF A = *ka_launder(kp); unsigned char* ws = A.ws; unsigned char* act = ws + WS_ACT; (void)act; p7_topk(A, lds, G, true); } SEAM(7);
#define FILL_AIDX(S_) do { pg8::PG8_LAS_US* t_ = (pg8::PG8_LAS_US*)(lds + RING_BYTES + 2048); const int* sr_ = (const int*)(ws + WS_SRCROW); pg8::Unit u_; \
        for (int i_ = tid >> 8; (S_).next(i_, u_); i_ += 2) { const int v_ = sr_[(size_t)u_.am * 256 + (tid & 255)]; t_[i_ * 256 + (tid & 255)] = (unsigned short)(((unsigned)v_ < (unsigned)TT) ? v_ : 0); } \
        __syncthreads(); } while (0)
    if (IN(9)) REPEAT(9) { TSTAMP(9); __syncthreads(); KAREF A = *ka_launder(kp); unsigned char* ws = A.ws; unsigned char* act = ws + WS_ACT; (void)act;
        int k8 = DM / 2; asm volatile("" : "+s"(k8));
        MoeOrder1 S{G, (int)blockIdx.x, 4096 + 256}; FILL_AIDX(S);
        pg8::Gemm g{(const bf16_t*)(act + A_H2), (const bf16_t*)(ws + WS_MOEW1), k8, (const pg8::PG8_LAS_US*)(lds + RING_BYTES + 2048)};
        EpiSwiGLU E{act + A_HID};
        pg8::gemm_phase<EpiSwiGLU, MoeOrder1, true, true, true, false, true>(lds + RING_OFF, g, S, E);
    } SEAM(9);
    if (IN(10)) REPEAT(10) { TSTAMP(10); __syncthreads(); KAREF A = *ka_launder(kp); unsigned char* ws = A.ws; unsigned char* act = ws + WS_ACT; (void)act;
        int k8 = FF / 2; asm volatile("" : "+s"(k8));
        pg8::Gemm g{(const bf16_t*)(act + A_HID), (const bf16_t*)(ws + WS_MOEW2), k8}; MoeOrder2 S{G, (int)blockIdx.x, 1024 + 64};
        EpiDown E{act + A_YE, (const float*)(ws + WS_GROW)};
        pg8::gemm_phase<EpiDown, MoeOrder2, true, true, true>(lds + RING_OFF, g, S, E);
    } SEAM(10);
    if (IN(12)) REPEAT(12) { TSTAMP(12); __syncthreads(); KAREF A = *ka_launder(kp); unsigned char* ws = A.ws; unsigned char* act = ws + WS_ACT; (void)act; p12_l1_prep(A, lds, G);
    } SEAM(12);
    if (IN(13)) REPEAT(13) { TSTAMP(13); __syncthreads(); KAREF A = *ka_launder(kp); unsigned char* ws = A.ws; unsigned char* act = ws + WS_ACT; (void)act;
        { int k8 = DM / 2; asm volatile("" : "+s"(k8));
          pg8::Gemm g{(const bf16_t*)(act + A_XMIX), (const bf16_t*)(ws + WS_BMIX), k8}; MixOrder S{G, (int)blockIdx.x};
          EpiMix E{(bf16_t*)(act + A_RKV), (bf16_t*)(act + A_LG), (bf16_t*)(ws + WS_LWA), 1.0f / W8_SCALE};
          pg8::gemm_phase<EpiMix, MixOrder, true, true, true>(lds + RING_OFF, g, S, E); }
        { int k16 = DM; asm volatile("" : "+s"(k16));
          pg8::Gemm g{(const bf16_t*)(act + A_XMIX16), (const bf16_t*)(ws + WS_BMIX16), k16}; MixOrder16 S{G, (int)blockIdx.x};
          EpiMix E{(bf16_t*)(act + A_RKV), (bf16_t*)(act + A_LG), (bf16_t*)(ws + WS_LWA), 1.0f};
          pg8::gemm_phase<EpiMix, MixOrder16, true, true>(lds + RING_OFF, g, S, E); }
    } SEAM(13);
    if (IN(14)) REPEAT(14) { TSTAMP(14); __syncthreads(); KAREF A = *ka_launder(kp); unsigned char* ws = A.ws; unsigned char* act = ws + WS_ACT; (void)act;
        int k2 = 256; asm volatile("" : "+s"(k2));
        pg8::Gemm g{(const bf16_t*)(act + A_LG), (const bf16_t*)(ws + WS_B2), k2}; LoraOrder S{G, (int)blockIdx.x};
        EpiLora E{(bf16_t*)(act + A_SD), (bf16_t*)(act + A_AD), (bf16_t*)(act + A_G), A.in[I1_W0], A.in[I1_A0]};
        pg8::gemm_phase<EpiLora, LoraOrder, true, true, false, true>(lds + RING_OFF, g, S, E);
    }
    if (IN(15)) REPEAT(15) { TSTAMP(15); __syncthreads(); KAREF A = *ka_launder(kp); unsigned char* ws = A.ws; unsigned char* act = ws + WS_ACT; (void)act; p15_tbuild(A, lds, (int)blockIdx.x * 8 + (tid >> 6), G * 8, 0, (use_bar && G > 128) ? TB_CP_FIRST : NCHUNK / 2); } SEAM(15);
    if (IN(16)) REPEAT(16) { TSTAMP(16); __syncthreads(); KAREF A = *ka_launder(kp); unsigned char* ws = A.ws; unsigned char* act = ws + WS_ACT; (void)act; (void)ws;
        unsigned* handoff = (unsigned*)(ws + WS_CTL) + 16384; const bool split = use_bar && G > 128;
        if ((int)blockIdx.x < 128) p16_chain(A, lds, G, 0, handoff, split ? (unsigned)(G - 128) : 0u);
        else { const int wave = tid >> 6;
            if (split) { p15_tbuild(A, lds, ((int)blockIdx.x - 128) * 8 + wave, (G - 128) * 8, TB_CP_FIRST, NCHUNK / 2);
                asm volatile("s_waitcnt vmcnt(0)" ::: "memory"); __syncthreads();
                if (tid == 0) { __builtin_amdgcn_fence(__ATOMIC_RELEASE, "agent"); (void)xb_add(handoff, 1u); } }
            moe_convert(A, 1, lds, ((int)blockIdx.x - 128) * 8 + wave, (G - 128) * 8, wave, tid & 63); }
#if defined(DBG_WKV)
        __syncthreads(); p15_wkv_old(A, lds, G);
#endif
    } SEAM(16);
    if (IN(17)) REPEAT(17) { TSTAMP(17); __syncthreads(); KAREF A = *ka_launder(kp); unsigned char* ws = A.ws; unsigned char* act = ws + WS_ACT; (void)act; p16_readout(A, G);
    } SEAM(17);
    if (IN(18)) REPEAT(18) { TSTAMP(18); __syncthreads(); KAREF A = *ka_launder(kp); unsigned char* ws = A.ws; unsigned char* act = ws + WS_ACT; (void)act;
        pg8::Gemm g{(const bf16_t*)(act + A_O), (const bf16_t*)(ws + WS_WO), DM}; pg8::StaticOrder S; S.init(TL, DM, G, (int)blockIdx.x);
        EpiResidD E{A.out, A.out, (const bf16_t*)(ws + WS_DELTA), ada_ptr(ws, 1, 0, 2)};
        pg8::gemm_phase<EpiResidD, pg8::StaticOrder, true, true>(lds + RING_OFF, g, S, E);
    } SEAM(18);
    if (IN(19)) REPEAT(19) { TSTAMP(19); __syncthreads(); KAREF A = *ka_launder(kp); unsigned char* ws = A.ws; unsigned char* act = ws + WS_ACT; (void)act; p6_norm_router(A, lds, G, 1, TL); } SEAM(19);
    if (IN(20)) REPEAT(20) { TSTAMP(20); __syncthreads(); KAREF A = *ka_launder(kp); unsigned char* ws = A.ws; unsigned char* act = ws + WS_ACT; (void)act; p7_topk(A, lds, G, false); } SEAM(20);
    if (IN(22)) REPEAT(22) { TSTAMP(22); __syncthreads(); KAREF A = *ka_launder(kp); unsigned char* ws = A.ws; unsigned char* act = ws + WS_ACT; (void)act;
        int k8 = DM / 2; asm volatile("" : "+s"(k8));
        MoeOrder1 S{G, (int)blockIdx.x, 4096}; FILL_AIDX(S);
        pg8::Gemm g{(const bf16_t*)(act + A_H2), (const bf16_t*)(ws + WS_MOEW1), k8, (const pg8::PG8_LAS_US*)(lds + RING_BYTES + 2048)};
        EpiSwiGLU E{act + A_HID};
        pg8::gemm_phase<EpiSwiGLU, MoeOrder1, true, true, true, false, true>(lds + RING_OFF, g, S, E);
    } SEAM(22);
    if (IN(23)) REPEAT(23) { TSTAMP(23); __syncthreads(); KAREF A = *ka_launder(kp); unsigned char* ws = A.ws; unsigned char* act = ws + WS_ACT; (void)act;
        int k8 = FF / 2; asm volatile("" : "+s"(k8));
        pg8::Gemm g{(const bf16_t*)(act + A_HID), (const bf16_t*)(ws + WS_MOEW2), k8}; MoeOrder2 S{G, (int)blockIdx.x, 1024};
        EpiDown E{act + A_YE, (const float*)(ws + WS_GROW)};
        pg8::gemm_phase<EpiDown, MoeOrder2, true, true, true>(lds + RING_OFF, g, S, E);
    } SEAM(23);
    if (IN(24)) REPEAT(24) { TSTAMP(24); __syncthreads(); KAREF A = *ka_launder(kp); unsigned char* ws = A.ws; unsigned char* act = ws + WS_ACT; (void)act; p11_combine(A, G, 1, TL); }
#undef IN
#undef SEAM
}

#ifndef N_LAUNCH_MODE
#define N_LAUNCH_MODE 0
#endif
extern "C" void kernel_launch(void* const* d_in, const int* in_sizes, int n_in, void* d_out, int out_size, void* d_ws, size_t ws_size, hipStream_t stream) {
    static int grid = 0;
    if (grid == 0) {
        if (n_in != N_IN || in_sizes[0] != TL * DM || out_size != TL * DM || ws_size < WS_END) {
            fprintf(stderr, "kernel_launch: unexpected shapes (n_in %d, in0 %d, out %d, ws %zu < %zu?); nothing launched\n", n_in, n_in > 0 ? in_sizes[0] : -1, out_size, ws_size, (size_t)WS_END); grid = -1; return; }
        int dev = 0, cus = 0, per_cu = 0;
        if (hipGetDevice(&dev) != hipSuccess || hipDeviceGetAttribute(&cus, hipDeviceAttributeMultiprocessorCount, dev) != hipSuccess) { grid = -1; return; }
        if (hipFuncSetAttribute((const void*)fwd_kernel, hipFuncAttributeMaxDynamicSharedMemorySize, LDS_BYTES) != hipSuccess) { fprintf(stderr, "kernel_launch: hipFuncSetAttribute failed\n"); grid = -1; return; }
        if (hipOccupancyMaxActiveBlocksPerMultiprocessor(&per_cu, (const void*)fwd_kernel, 512, LDS_BYTES) != hipSuccess || per_cu < 1) { fprintf(stderr, "kernel_launch: occupancy query says %d\n", per_cu); }
        (void)hipGetLastError();
        grid = cus;
    }
    if (grid < 0) return;
    (void)hipMemsetAsync((char*)d_ws, 0, ZERO_BYTES, stream);
    KArgs a{};
    for (int i = 0; i < N_IN; ++i) a.in[i] = (const float*)d_in[i];
    a.out = (float*)d_out; a.ws = (unsigned char*)d_ws;
#if N_LAUNCH_MODE == 1
    for (int p = 0; p < N_PHASES; ++p) { a.ph_lo = p; a.ph_hi = p + 1; hipLaunchKernelGGL(fwd_kernel, dim3(grid), dim3(512), LDS_BYTES, stream, a); }
#else
    a.ph_lo = 0; a.ph_hi = N_PHASES; hipLaunchKernelGGL(fwd_kernel, dim3(grid), dim3(512), LDS_BYTES, stream, a);
#endif
}
```
